# Optimizing an MI355X kernel written in HIP

```python
import jax, jax.numpy as jnp
from jax import lax
import numpy as np

D_MODEL = 1024
BATCH = 4
SEQ = 8192
DEPTH = 1

CHUNK = 64
D_MLSTM = 1024
N_MLSTM_HEADS = 4
MLSTM_HEAD_DIM = D_MLSTM // N_MLSTM_HEADS
QKV_BLOCK = 4
N_QKV_BLOCKS = D_MLSTM // QKV_BLOCK
MLSTM_CONV_WIDTH = 4
D_CONV = 1024
CONV_WIDTH = 31
D_MIX = D_MLSTM + D_CONV
D_IN_PROJ = 2 * D_MLSTM + 2 * D_CONV
N_EXPERTS = 32
TOP_K = 4
D_FF = 1024
SWIGLU_ALPHA = 1.702
SWIGLU_LIMIT = 7.0
EXPERT_BLOCK = 256
EPS = 1e-5

kernel_name = 'hybrid_mlstm_conformer_conv_moe'


def rmsnorm(x, w):
    xf = x.astype(jnp.float32)
    y = xf * lax.rsqrt(jnp.mean(xf * xf, axis=-1, keepdims=True) + EPS)
    return (y * w.astype(jnp.float32)).astype(x.dtype)


def layernorm(x, w, b):
    xf = x.astype(jnp.float32)
    mu = jnp.mean(xf, axis=-1, keepdims=True)
    var = jnp.mean(jnp.square(xf - mu), axis=-1, keepdims=True)
    y = (xf - mu) * lax.rsqrt(var + EPS)
    return (y * w.astype(jnp.float32) + b.astype(jnp.float32)).astype(x.dtype)


def causal_depthwise_conv(x, w, b):
    width, ch = w.shape
    y = lax.conv_general_dilated(
        x, w[:, None, :].astype(x.dtype), window_strides=(1,), padding=[(width - 1, 0)],
        dimension_numbers=('NWC', 'WIO', 'NWC'), feature_group_count=ch)
    return y + b.astype(x.dtype)


def block_diag_proj(x, w):
    bsz, seq, _ = x.shape
    xb = x.reshape(bsz, seq, N_QKV_BLOCKS, QKV_BLOCK)
    return jnp.einsum('bsni,nio->bsno', xb, w.astype(x.dtype)).reshape(bsz, seq, D_MLSTM)


def mlstm_chunk_step(carry, chunk):
    c_prev, n_prev, m_prev = carry
    q, k, v, log_i, log_f = chunk
    length = q.shape[2]
    b = jnp.cumsum(log_f, axis=-1)
    g = b[..., -1]
    causal = jnp.tril(jnp.ones((length, length), dtype=bool))
    d_mat = jnp.where(causal, b[..., :, None] - b[..., None, :] + log_i[..., None, :], -jnp.inf)
    inter = b + m_prev[..., None]
    m = jnp.maximum(inter, jnp.max(d_mat, axis=-1))
    w_intra = jnp.exp(d_mat - m[..., None])
    w_inter = jnp.exp(inter - m)
    s = jnp.einsum('bhid,bhjd->bhij', q, k) * w_intra
    num = (w_inter[..., None] * jnp.einsum('bhid,bhde->bhie', q, c_prev)
           + jnp.einsum('bhij,bhje->bhie', s, v))
    den = w_inter * jnp.einsum('bhid,bhd->bhi', q, n_prev) + jnp.sum(s, axis=-1)
    h = num / jnp.maximum(jnp.abs(den), jnp.exp(-m))[..., None]
    a = g[..., None] - b + log_i
    m_new = jnp.maximum(g + m_prev, jnp.max(a, axis=-1))
    w_state = jnp.exp(a - m_new[..., None])
    decay = jnp.exp(g + m_prev - m_new)
    c_new = decay[..., None, None] * c_prev + jnp.einsum('bhj,bhjd,bhje->bhde', w_state, k, v)
    n_new = decay[..., None] * n_prev + jnp.einsum('bhj,bhjd->bhd', w_state, k)
    return (c_new, n_new, m_new), h


def mlstm_chunkwise(q, k, v, log_i, log_f):
    bsz, seq, nh, dh = q.shape
    nc = seq // CHUNK

    def to_chunks(t):
        return t.astype(jnp.float32).reshape(bsz, nc, CHUNK, nh, dh).transpose(1, 0, 3, 2, 4)

    def gate_chunks(t):
        return t.astype(jnp.float32).reshape(bsz, nc, CHUNK, nh).transpose(1, 0, 3, 2)

    xs = (to_chunks(q) * (dh ** -0.5), to_chunks(k), to_chunks(v), gate_chunks(log_i), gate_chunks(log_f))
    init = (jnp.zeros((bsz, nh, dh, dh), jnp.float32),
            jnp.zeros((bsz, nh, dh), jnp.float32),
            jnp.zeros((bsz, nh), jnp.float32))
    _, h = lax.scan(mlstm_chunk_step, init, xs)
    return h.transpose(1, 0, 3, 2, 4).reshape(bsz, seq, nh, dh)


def hybrid_mixer(a, w_in, mlstm_conv_w, mlstm_conv_b, w_q, w_k, w_v, w_igate, b_igate,
                 w_fgate, b_fgate, mlstm_norm_w, mlstm_skip, conv_dw_w, conv_dw_b,
                 conv_norm_w, conv_norm_b, w_out):
    bsz, seq, _ = a.shape
    proj = a @ w_in.astype(a.dtype)
    x_m, z, glu_a, glu_b = jnp.split(proj, [D_MLSTM, 2 * D_MLSTM, 2 * D_MLSTM + D_CONV], axis=-1)

    x_c = jax.nn.silu(causal_depthwise_conv(x_m, mlstm_conv_w, mlstm_conv_b))
    q = block_diag_proj(x_c, w_q)
    k = block_diag_proj(x_c, w_k)
    v = block_diag_proj(x_m, w_v)
    qkv = jnp.concatenate([q, k, v], axis=-1)
    log_i = (qkv @ w_igate.astype(a.dtype) + b_igate.astype(a.dtype)).astype(jnp.float32)
    log_f = jax.nn.log_sigmoid((qkv @ w_fgate.astype(a.dtype) + b_fgate.astype(a.dtype)).astype(jnp.float32))
    shp = (bsz, seq, N_MLSTM_HEADS, MLSTM_HEAD_DIM)
    h_m = mlstm_chunkwise(q.reshape(shp), k.reshape(shp), v.reshape(shp), log_i, log_f)
    mu = jnp.mean(h_m, axis=-1, keepdims=True)
    var = jnp.mean(jnp.square(h_m - mu), axis=-1, keepdims=True)
    h_m = ((h_m - mu) * lax.rsqrt(var + EPS)).reshape(bsz, seq, D_MLSTM)
    h_m = (h_m * mlstm_norm_w.astype(jnp.float32)).astype(a.dtype)
    y_m = (h_m + mlstm_skip.astype(a.dtype) * x_c) * jax.nn.silu(z)

    u = glu_a * jax.nn.sigmoid(glu_b)
    u = causal_depthwise_conv(u, conv_dw_w, conv_dw_b)
    y_c = jax.nn.silu(layernorm(u, conv_norm_w, conv_norm_b))

    return jnp.concatenate([y_m, y_c], axis=-1) @ w_out.astype(a.dtype)


def clamped_swiglu(hid):
    x_glu = jnp.minimum(hid[..., :D_FF], SWIGLU_LIMIT)
    x_lin = jnp.clip(hid[..., D_FF:], -SWIGLU_LIMIT, SWIGLU_LIMIT)
    return x_glu * jax.nn.sigmoid(SWIGLU_ALPHA * x_glu) * (x_lin + 1.0)


def moe_ffn(a, w_router, b_router, w1, b1, w2, b2):
    bsz, seq, dm = a.shape
    n_tok = bsz * seq
    xf = a.reshape(n_tok, dm)
    logits = (xf @ w_router.astype(a.dtype) + b_router.astype(a.dtype)).astype(jnp.float32)
    top_val, top_idx = lax.top_k(logits, TOP_K)
    gates = jax.nn.softmax(top_val, axis=-1)
    n_assign = n_tok * TOP_K
    expert_flat = top_idx.reshape(-1).astype(jnp.int32)
    gate_flat = gates.reshape(-1)
    counts = jnp.zeros((N_EXPERTS,), jnp.int32).at[expert_flat].add(1)
    starts = jnp.cumsum(counts) - counts
    padded = (counts + EXPERT_BLOCK - 1) // EXPERT_BLOCK * EXPERT_BLOCK
    pad_ends = jnp.cumsum(padded)
    pad_starts = pad_ends - padded
    order = jnp.argsort(expert_flat, stable=True)
    sorted_e = expert_flat[order]
    sorted_tok = (order // TOP_K).astype(jnp.int32)
    sorted_gate = gate_flat[order]
    dest = pad_starts[sorted_e] + jnp.arange(n_assign, dtype=jnp.int32) - starts[sorted_e]
    n_blocks = -(-n_assign // EXPERT_BLOCK) + N_EXPERTS
    n_rows = n_blocks * EXPERT_BLOCK
    row_tok = jnp.full((n_rows,), n_tok, jnp.int32).at[dest].set(sorted_tok)
    row_gate = jnp.zeros((n_rows,), jnp.float32).at[dest].set(sorted_gate)
    block_start = jnp.arange(n_blocks, dtype=jnp.int32) * EXPERT_BLOCK
    block_expert = jnp.minimum(jnp.searchsorted(pad_ends, block_start, side='right'), N_EXPERTS - 1)
    x_pad = jnp.concatenate([xf, jnp.zeros((1, dm), xf.dtype)], axis=0)

    def expert_block(args):
        tok, gate, e = args
        rows = x_pad[tok]
        hid = rows @ w1[e].astype(rows.dtype) + b1[e].astype(rows.dtype)
        y = clamped_swiglu(hid) @ w2[e].astype(rows.dtype) + b2[e].astype(rows.dtype)
        return y * gate[:, None].astype(y.dtype)

    y_rows = lax.map(expert_block, (row_tok.reshape(n_blocks, EXPERT_BLOCK),
                                    row_gate.reshape(n_blocks, EXPERT_BLOCK), block_expert))
    out = jnp.zeros((n_tok + 1, dm), a.dtype).at[row_tok].add(y_rows.reshape(n_rows, dm))
    return out[:n_tok].reshape(bsz, seq, dm)


def setup_inputs(seed: int = 0) -> dict:
    key = jax.random.key(seed)
    ks = jax.random.split(key, 32)
    f32 = jnp.float32
    L = DEPTH
    H = N_MLSTM_HEADS

    def nrm(k, shape, scale):
        return jax.random.normal(k, shape, f32) * scale

    return {
        'x': nrm(ks[0], (BATCH, SEQ, D_MODEL), 1.0),
        'norm_mix_w': 1.0 + nrm(ks[1], (L, D_MODEL), 0.01),
        'w_in': nrm(ks[2], (L, D_MODEL, D_IN_PROJ), D_MODEL ** -0.5),
        'mlstm_conv_w': nrm(ks[3], (L, MLSTM_CONV_WIDTH, D_MLSTM), MLSTM_CONV_WIDTH ** -0.5),
        'mlstm_conv_b': nrm(ks[4], (L, D_MLSTM), 0.01),
        'w_q': nrm(ks[5], (L, N_QKV_BLOCKS, QKV_BLOCK, QKV_BLOCK), QKV_BLOCK ** -0.5),
        'w_k': nrm(ks[6], (L, N_QKV_BLOCKS, QKV_BLOCK, QKV_BLOCK), QKV_BLOCK ** -0.5),
        'w_v': nrm(ks[7], (L, N_QKV_BLOCKS, QKV_BLOCK, QKV_BLOCK), QKV_BLOCK ** -0.5),
        'w_igate': nrm(ks[8], (L, 3 * D_MLSTM, H), 0.1 * (3 * D_MLSTM) ** -0.5),
        'b_igate': nrm(ks[9], (L, H), 0.1),
        'w_fgate': nrm(ks[10], (L, 3 * D_MLSTM, H), 0.1 * (3 * D_MLSTM) ** -0.5),
        'b_fgate': jnp.linspace(3.0, 6.0, H, dtype=f32)[None, :] + nrm(ks[11], (L, H), 0.1),
        'mlstm_norm_w': 1.0 + nrm(ks[12], (L, D_MLSTM), 0.01),
        'mlstm_skip': 1.0 + nrm(ks[13], (L, D_MLSTM), 0.01),
        'conv_dw_w': nrm(ks[14], (L, CONV_WIDTH, D_CONV), CONV_WIDTH ** -0.5),
        'conv_dw_b': nrm(ks[15], (L, D_CONV), 0.01),
        'conv_norm_w': 1.0 + nrm(ks[16], (L, D_CONV), 0.01),
        'conv_norm_b': nrm(ks[17], (L, D_CONV), 0.01),
        'w_out': nrm(ks[18], (L, D_MIX, D_MODEL), D_MIX ** -0.5),
        'norm_ffn_w': 1.0 + nrm(ks[19], (L, D_MODEL), 0.01),
        'w_router': nrm(ks[20], (L, D_MODEL, N_EXPERTS), D_MODEL ** -0.5),
        'b_router': nrm(ks[21], (L, N_EXPERTS), 0.01),
        'w1': nrm(ks[22], (L, N_EXPERTS, D_MODEL, 2 * D_FF), D_MODEL ** -0.5),
        'b1': nrm(ks[23], (L, N_EXPERTS, 2 * D_FF), 0.01),
        'w2': nrm(ks[24], (L, N_EXPERTS, D_FF, D_MODEL), D_FF ** -0.5),
        'b2': nrm(ks[25], (L, N_EXPERTS, D_MODEL), 0.01),
        'final_norm_w': 1.0 + nrm(ks[26], (D_MODEL,), 0.01),
    }


def reference(x, norm_mix_w, w_in, mlstm_conv_w, mlstm_conv_b, w_q, w_k, w_v, w_igate, b_igate,
              w_fgate, b_fgate, mlstm_norm_w, mlstm_skip, conv_dw_w, conv_dw_b, conv_norm_w,
              conv_norm_b, w_out, norm_ffn_w, w_router, b_router, w1, b1, w2, b2, final_norm_w):
    h = x
    for l in range(DEPTH):
        a = rmsnorm(h, norm_mix_w[l])
        h = h + hybrid_mixer(a, w_in[l], mlstm_conv_w[l], mlstm_conv_b[l], w_q[l], w_k[l], w_v[l],
                             w_igate[l], b_igate[l], w_fgate[l], b_fgate[l], mlstm_norm_w[l],
                             mlstm_skip[l], conv_dw_w[l], conv_dw_b[l], conv_norm_w[l],
                             conv_norm_b[l], w_out[l])
        a = rmsnorm(h, norm_ffn_w[l])
        h = h + moe_ffn(a, w_router[l], b_router[l], w1[l], b1[l], w2[l], b2[l])
    return rmsnorm(h, final_norm_w)
```

```cpp
#include <hip/hip_runtime.h>
#include <stdint.h>

#define NTOK 32768
#define SEQ 8192
#define DM 1024
#define DPROJ 4096
#define NEXP 32
#define NASSIGN (NTOK * 4)
#define EPSV 1e-5f

typedef unsigned short bf16_t;

__device__ __forceinline__ float bf2f(bf16_t h) { return __uint_as_float(((uint32_t)h) << 16); }
__device__ __forceinline__ bf16_t f2bf(float f) {
    uint32_t u = __float_as_uint(f);
    u += 0x7FFFu + ((u >> 16) & 1u);
    return (bf16_t)(u >> 16);
}
__device__ __forceinline__ float sigmoidf_(float x) { return 1.0f / (1.0f + __expf(-x)); }
__device__ __forceinline__ float siluf_(float x) { return x * sigmoidf_(x); }
__device__ __forceinline__ float logsigmoidf_(float x) { return fminf(x, 0.0f) - log1pf(__expf(-fabsf(x))); }

__device__ __forceinline__ float wave_sum(float v) {
#pragma unroll
    for (int o = 32; o > 0; o >>= 1) v += __shfl_xor(v, o);
    return v;
}
__device__ __forceinline__ float block_sum256(float v, float* red) {
    v = wave_sum(v);
    __syncthreads();
    if ((threadIdx.x & 63) == 0) red[threadIdx.x >> 6] = v;
    __syncthreads();
    return red[0] + red[1] + red[2] + red[3];
}

__global__ __launch_bounds__(256) void k_rstd(const float* __restrict__ x, float* __restrict__ rstd) {
    const int row = blockIdx.x * 4 + (threadIdx.x >> 6);
    const int lane = threadIdx.x & 63;
    const float4* p = (const float4*)(x + (size_t)row * DM);
    float s = 0.f;
#pragma unroll
    for (int i = 0; i < 4; i++) { float4 v = p[lane + i * 64]; s += v.x * v.x + v.y * v.y + v.z * v.z + v.w * v.w; }
    s = wave_sum(s);
    if (lane == 0) rstd[row] = rsqrtf(s * (1.0f / DM) + EPSV);
}

template <int NB, class AF, class BF>
__device__ __forceinline__ void tile_gemm(float (&acc)[NB][4][4], int K, AF af, BF bf, float* As, float* Bs) {
    const int tid = threadIdx.x;
    const int ty = tid >> 4, tx = tid & 15;
    for (int k0 = 0; k0 < K; k0 += 16) {
#pragma unroll
        for (int i = 0; i < 4; i++) {
            int idx = tid + i * 256;
            int r = idx >> 4, kk = idx & 15;
            As[kk * 68 + r] = af(r, k0 + kk);
        }
#pragma unroll
        for (int b = 0; b < NB; b++) {
#pragma unroll
            for (int i = 0; i < 4; i++) {
                int idx = tid + i * 256;
                int kk = idx >> 6, c = idx & 63;
                Bs[(b * 16 + kk) * 64 + c] = bf(b, k0 + kk, c);
            }
        }
        __syncthreads();
#pragma unroll
        for (int kk = 0; kk < 16; kk++) {
            float a[4];
#pragma unroll
            for (int i = 0; i < 4; i++) a[i] = As[kk * 68 + ty * 4 + i];
#pragma unroll
            for (int b = 0; b < NB; b++) {
                float bb[4];
#pragma unroll
                for (int j = 0; j < 4; j++) bb[j] = Bs[(b * 16 + kk) * 64 + tx * 4 + j];
#pragma unroll
                for (int i = 0; i < 4; i++)
#pragma unroll
                    for (int j = 0; j < 4; j++) acc[b][i][j] += a[i] * bb[j];
            }
        }
        __syncthreads();
    }
}

__global__ __launch_bounds__(256) void k_inproj(const float* __restrict__ x, const float* __restrict__ rstd,
                                                const float* __restrict__ nw, const float* __restrict__ w_in,
                                                bf16_t* __restrict__ proj) {
    __shared__ float As[16 * 68];
    __shared__ float Bs[16 * 64];
    const int col0 = blockIdx.x * 64, row0 = blockIdx.y * 64;
    float acc[1][4][4];
#pragma unroll
    for (int i = 0; i < 4; i++)
#pragma unroll
        for (int j = 0; j < 4; j++) acc[0][i][j] = 0.f;
    auto af = [&](int r, int k) -> float { return x[(size_t)(row0 + r) * DM + k] * rstd[row0 + r] * nw[k]; };
    auto bf = [&](int b, int k, int c) -> float { return w_in[(size_t)k * DPROJ + col0 + c]; };
    tile_gemm<1>(acc, DM, af, bf, As, Bs);
    const int ty = threadIdx.x >> 4, tx = threadIdx.x & 15;
#pragma unroll
    for (int i = 0; i < 4; i++)
#pragma unroll
        for (int j = 0; j < 4; j++)
            proj[(size_t)(row0 + ty * 4 + i) * DPROJ + col0 + tx * 4 + j] = f2bf(acc[0][i][j]);
}

struct PreOut { float xc[4], q[4], k[4], v[4]; };
__device__ __forceinline__ PreOut mlstm_pre(const bf16_t* __restrict__ proj, int t, int n, const float* __restrict__ cw,
                                            const float* __restrict__ cb, const float* __restrict__ wq,
                                            const float* __restrict__ wk, const float* __restrict__ wv) {
    PreOut o;
    const int s = t & (SEQ - 1);
    float xm[4][4];
#pragma unroll
    for (int kk = 0; kk < 4; kk++) {
        const int sp = s - 3 + kk;
        if (sp >= 0) {
            const uint2 raw = *(const uint2*)(proj + (size_t)(t - 3 + kk) * DPROJ + 4 * n);
            xm[kk][0] = bf2f((bf16_t)(raw.x & 0xFFFF)); xm[kk][1] = bf2f((bf16_t)(raw.x >> 16));
            xm[kk][2] = bf2f((bf16_t)(raw.y & 0xFFFF)); xm[kk][3] = bf2f((bf16_t)(raw.y >> 16));
        } else {
            xm[kk][0] = xm[kk][1] = xm[kk][2] = xm[kk][3] = 0.f;
        }
    }
#pragma unroll
    for (int c = 0; c < 4; c++) {
        float a = cb[4 * n + c];
#pragma unroll
        for (int kk = 0; kk < 4; kk++) a += cw[kk * DM + 4 * n + c] * xm[kk][c];
        o.xc[c] = siluf_(a);
    }
#pragma unroll
    for (int oo = 0; oo < 4; oo++) {
        float aq = 0.f, ak = 0.f, av = 0.f;
#pragma unroll
        for (int i = 0; i < 4; i++) {
            aq += o.xc[i] * wq[n * 16 + i * 4 + oo];
            ak += o.xc[i] * wk[n * 16 + i * 4 + oo];
            av += xm[3][i] * wv[n * 16 + i * 4 + oo];
        }
        o.q[oo] = aq; o.k[oo] = ak; o.v[oo] = av;
    }
    return o;
}

__global__ __launch_bounds__(256) void k_gates(const bf16_t* __restrict__ proj, const float* __restrict__ cw,
                                               const float* __restrict__ cb, const float* __restrict__ wq,
                                               const float* __restrict__ wk, const float* __restrict__ wv,
                                               const float* __restrict__ wig, const float* __restrict__ big,
                                               const float* __restrict__ wfg, const float* __restrict__ bfg,
                                               float* __restrict__ logi, float* __restrict__ logf) {
    __shared__ float red[4];
    const int t = blockIdx.x, n = threadIdx.x;
    PreOut p = mlstm_pre(proj, t, n, cw, cb, wq, wk, wv);
    float pi[4], pf[4];
#pragma unroll
    for (int h = 0; h < 4; h++) {
        float ai = 0.f, af = 0.f;
#pragma unroll
        for (int o = 0; o < 4; o++) {
            const int c = 4 * n + o;
            ai += p.q[o] * wig[(size_t)c * 4 + h] + p.k[o] * wig[(size_t)(1024 + c) * 4 + h] + p.v[o] * wig[(size_t)(2048 + c) * 4 + h];
            af += p.q[o] * wfg[(size_t)c * 4 + h] + p.k[o] * wfg[(size_t)(1024 + c) * 4 + h] + p.v[o] * wfg[(size_t)(2048 + c) * 4 + h];
        }
        pi[h] = ai; pf[h] = af;
    }
#pragma unroll
    for (int h = 0; h < 4; h++) {
        float si = block_sum256(pi[h], red);
        float sf = block_sum256(pf[h], red);
        if (threadIdx.x == 0) {
            logi[(size_t)t * 4 + h] = si + big[h];
            logf[(size_t)t * 4 + h] = logsigmoidf_(sf + bfg[h]);
        }
    }
}

#define MS_QK_STRIDE 258
#define MLSTM_LDS (2 * 64 * MS_QK_STRIDE * 2 + 64 * 32 * 4 + 64 * 65 * 4 + 256 * 32 * 4 + 256 * 4 + 8 * 64 * 4)
__global__ __launch_bounds__(256) void k_mlstm(const bf16_t* __restrict__ proj, const float* __restrict__ logi,
                                               const float* __restrict__ logf, const float* __restrict__ cw,
                                               const float* __restrict__ cb, const float* __restrict__ wq,
                                               const float* __restrict__ wk, const float* __restrict__ wv,
                                               bf16_t* __restrict__ hm) {
    extern __shared__ __attribute__((aligned(16))) unsigned char smem[];
    bf16_t* qs = (bf16_t*)smem;
    bf16_t* ks = qs + 64 * MS_QK_STRIDE;
    float* vs = (float*)(ks + 64 * MS_QK_STRIDE);
    float* Ss = vs + 64 * 32;
    float* Cs = Ss + 64 * 65;
    float* nvec = Cs + 256 * 32;
    float* bcum = nvec + 256;
    float* li = bcum + 64;
    float* lf = li + 64;
    float* mrow = lf + 64;
    float* winter = mrow + 64;
    float* wst = winter + 64;
    float* den = wst + 64;

    const int tid = threadIdx.x;
    const int bh = blockIdx.x >> 3, sl = blockIdx.x & 7;
    const int b = bh >> 2, h = bh & 3;
    for (int i = tid; i < 256 * 32; i += 256) Cs[i] = 0.f;
    nvec[tid] = 0.f;
    float m_prev = 0.f;
    __syncthreads();

    for (int c = 0; c < SEQ / 64; c++) {
        const int t0 = b * SEQ + c * 64;
        for (int it = 0; it < 16; it++) {
            const int idx = tid + it * 256;
            const int r = idx >> 6, n = idx & 63;
            PreOut p = mlstm_pre(proj, t0 + r, h * 64 + n, cw, cb, wq, wk, wv);
#pragma unroll
            for (int o = 0; o < 4; o++) {
                qs[r * MS_QK_STRIDE + 4 * n + o] = f2bf(p.q[o] * 0.0625f);
                ks[r * MS_QK_STRIDE + 4 * n + o] = f2bf(p.k[o]);
            }
            if ((n >> 3) == sl) {
#pragma unroll
                for (int o = 0; o < 4; o++) vs[r * 32 + (4 * n + o - 32 * sl)] = p.v[o];
            }
        }
        if (tid < 64) {
            li[tid] = logi[(size_t)(t0 + tid) * 4 + h];
            lf[tid] = logf[(size_t)(t0 + tid) * 4 + h];
        }
        __syncthreads();
        if (tid == 0) {
            float a = 0.f;
            for (int j = 0; j < 64; j++) { a += lf[j]; bcum[j] = a; }
        }
        __syncthreads();
        {
            const int j = tid & 63, ig = tid >> 6;
            for (int ii = 0; ii < 16; ii++) {
                const int i = ig * 16 + ii;
                const uint32_t* qp = (const uint32_t*)(qs + i * MS_QK_STRIDE);
                const uint32_t* kp = (const uint32_t*)(ks + j * MS_QK_STRIDE);
                float a = 0.f;
                for (int d2 = 0; d2 < 128; d2++) {
                    const uint32_t qq = qp[d2], kk = kp[d2];
                    a += __uint_as_float(qq << 16) * __uint_as_float(kk << 16);
                    a += __uint_as_float(qq & 0xFFFF0000u) * __uint_as_float(kk & 0xFFFF0000u);
                }
                Ss[i * 65 + j] = (j <= i) ? a : 0.f;
            }
        }
        if (tid < 64) {
            const int i = tid;
            float mx = bcum[i] + m_prev;
            for (int j = 0; j <= i; j++) mx = fmaxf(mx, bcum[i] - bcum[j] + li[j]);
            mrow[i] = mx;
            winter[i] = __expf(bcum[i] + m_prev - mx);
        }
        __syncthreads();
        {
            const int j = tid & 63, ig = tid >> 6;
            for (int ii = 0; ii < 16; ii++) {
                const int i = ig * 16 + ii;
                if (j <= i) Ss[i * 65 + j] *= __expf(bcum[i] - bcum[j] + li[j] - mrow[i]);
            }
        }
        __syncthreads();
        if (tid < 64) {
            const int i = tid;
            float a = 0.f;
            for (int d = 0; d < 256; d++) a += bf2f(qs[i * MS_QK_STRIDE + d]) * nvec[d];
            float s = 0.f;
            for (int j = 0; j < 64; j++) s += Ss[i * 65 + j];
            den[i] = winter[i] * a + s;
        }
        __syncthreads();
        {
            const int e = tid & 31, ig = tid >> 5;
            for (int ii = 0; ii < 8; ii++) {
                const int i = ig * 8 + ii;
                float a1 = 0.f;
                for (int d = 0; d < 256; d++) a1 += bf2f(qs[i * MS_QK_STRIDE + d]) * Cs[d * 32 + e];
                float a2 = 0.f;
                for (int j = 0; j < 64; j++) a2 += Ss[i * 65 + j] * vs[j * 32 + e];
                const float num = winter[i] * a1 + a2;
                const float hv = num / fmaxf(fabsf(den[i]), __expf(-mrow[i]));
                hm[(size_t)(t0 + i) * DM + h * 256 + sl * 32 + e] = f2bf(hv);
            }
        }
        const float g = bcum[63];
        float m_new = g + m_prev;
        for (int j = 0; j < 64; j++) m_new = fmaxf(m_new, g - bcum[j] + li[j]);
        const float decay = __expf(g + m_prev - m_new);
        __syncthreads();
        if (tid < 64) wst[tid] = __expf(g - bcum[tid] + li[tid] - m_new);
        __syncthreads();
        {
            const int e = tid & 31, dg = tid >> 5;
            for (int dd = 0; dd < 32; dd++) {
                const int d = dg * 32 + dd;
                float a = 0.f;
                for (int j = 0; j < 64; j++) a += wst[j] * bf2f(ks[j * MS_QK_STRIDE + d]) * vs[j * 32 + e];
                Cs[d * 32 + e] = decay * Cs[d * 32 + e] + a;
            }
            const int d = tid;
            float a = 0.f;
            for (int j = 0; j < 64; j++) a += wst[j] * bf2f(ks[j * MS_QK_STRIDE + d]);
            nvec[d] = decay * nvec[d] + a;
        }
        m_prev = m_new;
        __syncthreads();
    }
}

__global__ __launch_bounds__(256) void k_conv31(const bf16_t* __restrict__ proj, const float* __restrict__ cw,
                                                const float* __restrict__ cb, const float* __restrict__ nw,
                                                const float* __restrict__ nb, bf16_t* __restrict__ ymix) {
    __shared__ float red[4];
    const int t = blockIdx.x, n = threadIdx.x;
    const int s = t & (SEQ - 1);
    float acc[4];
#pragma unroll
    for (int c = 0; c < 4; c++) acc[c] = cb[4 * n + c];
    for (int k = 0; k < 31; k++) {
        const int sp = s - 30 + k;
        if (sp >= 0) {
            const bf16_t* rowp = proj + (size_t)(t - 30 + k) * DPROJ;
            const uint2 ra = *(const uint2*)(rowp + 2048 + 4 * n);
            const uint2 rb = *(const uint2*)(rowp + 3072 + 4 * n);
            float ga[4], gb[4];
            ga[0] = bf2f((bf16_t)(ra.x & 0xFFFF)); ga[1] = bf2f((bf16_t)(ra.x >> 16));
            ga[2] = bf2f((bf16_t)(ra.y & 0xFFFF)); ga[3] = bf2f((bf16_t)(ra.y >> 16));
            gb[0] = bf2f((bf16_t)(rb.x & 0xFFFF)); gb[1] = bf2f((bf16_t)(rb.x >> 16));
            gb[2] = bf2f((bf16_t)(rb.y & 0xFFFF)); gb[3] = bf2f((bf16_t)(rb.y >> 16));
#pragma unroll
            for (int c = 0; c < 4; c++) acc[c] += cw[k * DM + 4 * n + c] * (ga[c] * sigmoidf_(gb[c]));
        }
    }
    const float mean = block_sum256(acc[0] + acc[1] + acc[2] + acc[3], red) * (1.0f / DM);
    float vs = 0.f;
#pragma unroll
    for (int c = 0; c < 4; c++) { const float d = acc[c] - mean; vs += d * d; }
    const float var = block_sum256(vs, red) * (1.0f / DM);
    const float rs = rsqrtf(var + EPSV);
#pragma unroll
    for (int c = 0; c < 4; c++) {
        const float y = (acc[c] - mean) * rs * nw[4 * n + c] + nb[4 * n + c];
        ymix[(size_t)t * 2048 + 1024 + 4 * n + c] = f2bf(siluf_(y));
    }
}

__global__ __launch_bounds__(256) void k_ym(const bf16_t* __restrict__ proj, const bf16_t* __restrict__ hm,
                                            const float* __restrict__ cw, const float* __restrict__ cb,
                                            const float* __restrict__ wq, const float* __restrict__ wk,
                                            const float* __restrict__ wv, const float* __restrict__ mnw,
                                            const float* __restrict__ skip, bf16_t* __restrict__ ymix) {
    const int t = blockIdx.x, n = threadIdx.x;
    PreOut p = mlstm_pre(proj, t, n, cw, cb, wq, wk, wv);
    float hv[4];
#pragma unroll
    for (int c = 0; c < 4; c++) hv[c] = bf2f(hm[(size_t)t * DM + 4 * n + c]);
    const float mean = wave_sum(hv[0] + hv[1] + hv[2] + hv[3]) * (1.0f / 256.0f);
    float vs = 0.f;
#pragma unroll
    for (int c = 0; c < 4; c++) { const float d = hv[c] - mean; vs += d * d; }
    const float var = wave_sum(vs) * (1.0f / 256.0f);
    const float rs = rsqrtf(var + EPSV);
#pragma unroll
    for (int c = 0; c < 4; c++) {
        const int ch = 4 * n + c;
        const float hn = (hv[c] - mean) * rs * mnw[ch];
        const float z = bf2f(proj[(size_t)t * DPROJ + 1024 + ch]);
        const float y = (hn + skip[ch] * p.xc[c]) * siluf_(z);
        ymix[(size_t)t * 2048 + ch] = f2bf(y);
    }
}

__global__ __launch_bounds__(256) void k_outproj(const bf16_t* __restrict__ ymix, const float* __restrict__ w_out,
                                                 const float* __restrict__ x, float* __restrict__ hout) {
    __shared__ float As[16 * 68];
    __shared__ float Bs[16 * 64];
    const int col0 = blockIdx.x * 64, row0 = blockIdx.y * 64;
    float acc[1][4][4];
#pragma unroll
    for (int i = 0; i < 4; i++)
#pragma unroll
        for (int j = 0; j < 4; j++) acc[0][i][j] = 0.f;
    auto af = [&](int r, int k) -> float { return bf2f(ymix[(size_t)(row0 + r) * 2048 + k]); };
    auto bf = [&](int b, int k, int c) -> float { return w_out[(size_t)k * DM + col0 + c]; };
    tile_gemm<1>(acc, 2048, af, bf, As, Bs);
    const int ty = threadIdx.x >> 4, tx = threadIdx.x & 15;
#pragma unroll
    for (int i = 0; i < 4; i++)
#pragma unroll
        for (int j = 0; j < 4; j++) {
            const size_t o = (size_t)(row0 + ty * 4 + i) * DM + col0 + tx * 4 + j;
            hout[o] = x[o] + acc[0][i][j];
        }
}

__global__ __launch_bounds__(256) void k_router(const float* __restrict__ hbuf, const float* __restrict__ nfw,
                                                const float* __restrict__ wr, const float* __restrict__ br,
                                                bf16_t* __restrict__ a2, int* __restrict__ topi, float* __restrict__ topg) {
    __shared__ float av[DM];
    __shared__ float part[8][32];
    __shared__ float lg[32];
    __shared__ float red[4];
    const int t = blockIdx.x, tid = threadIdx.x;
    const float4 v = *(const float4*)(hbuf + (size_t)t * DM + tid * 4);
    const float ss = block_sum256(v.x * v.x + v.y * v.y + v.z * v.z + v.w * v.w, red);
    const float rs = rsqrtf(ss * (1.0f / DM) + EPSV);
    const float vv[4] = {v.x, v.y, v.z, v.w};
#pragma unroll
    for (int c = 0; c < 4; c++) {
        const float a = vv[c] * rs * nfw[tid * 4 + c];
        av[tid * 4 + c] = a;
        a2[(size_t)t * DM + tid * 4 + c] = f2bf(a);
    }
    __syncthreads();
    {
        const int e = tid & 31, pp = tid >> 5;
        float a = 0.f;
        for (int k = pp * 128; k < pp * 128 + 128; k++) a += av[k] * wr[(size_t)k * 32 + e];
        part[pp][e] = a;
    }
    __syncthreads();
    if (tid < 32) {
        float a = br[tid];
#pragma unroll
        for (int pp = 0; pp < 8; pp++) a += part[pp][tid];
        lg[tid] = a;
    }
    __syncthreads();
    if (tid == 0) {
        int sel[4]; float val[4];
        unsigned used = 0u;
#pragma unroll
        for (int r = 0; r < 4; r++) {
            int bi = -1; float bv = 0.f;
            for (int e = 0; e < 32; e++) {
                if (used & (1u << e)) continue;
                const float x = lg[e];
                if (bi < 0 || x > bv) { bi = e; bv = x; }
            }
            used |= 1u << bi;
            sel[r] = bi; val[r] = bv;
        }
        float ex[4], sum = 0.f;
#pragma unroll
        for (int r = 0; r < 4; r++) { ex[r] = __expf(val[r] - val[0]); sum += ex[r]; }
#pragma unroll
        for (int r = 0; r < 4; r++) {
            topi[(size_t)t * 4 + r] = sel[r];
            topg[(size_t)t * 4 + r] = ex[r] / sum;
        }
    }
}

__global__ __launch_bounds__(1024) void k_sort(const int* __restrict__ topi, const float* __restrict__ topg,
                                               int* __restrict__ estart, int* __restrict__ slot_tok,
                                               float* __restrict__ slot_gate) {
    extern __shared__ __attribute__((aligned(16))) unsigned char smem[];
    int* cnt = (int*)smem;
    __shared__ int es[33];
    __shared__ int tot[32];
    const int tid = threadIdx.x;
    for (int e = 0; e < 32; e++) cnt[tid * 32 + e] = 0;
    const int a0 = tid * 128;
    for (int a = a0; a < a0 + 128; a++) cnt[tid * 32 + topi[a]]++;
    __syncthreads();
    if (tid < 32) {
        int run = 0;
        for (int i = 0; i < 1024; i++) { const int c = cnt[i * 32 + tid]; cnt[i * 32 + tid] = run; run += c; }
        tot[tid] = run;
    }
    __syncthreads();
    if (tid == 0) {
        int run = 0;
        for (int e = 0; e < 32; e++) { es[e] = run; estart[e] = run; run += tot[e]; }
        es[32] = run; estart[32] = run;
    }
    __syncthreads();
    for (int a = a0; a < a0 + 128; a++) {
        const int e = topi[a];
        const int slot = es[e] + cnt[tid * 32 + e];
        cnt[tid * 32 + e]++;
        slot_tok[slot] = a >> 2;
        slot_gate[slot] = topg[a];
    }
}

__device__ __forceinline__ bool moe_tile(const int* __restrict__ estart, int rt, int& e_out, int& slot0, int& nrows) {
    for (int e = 0; e < NEXP; e++) {
        const int s0 = estart[e], s1 = estart[e + 1];
        const int nt = (s1 - s0 + 63) >> 6;
        if (rt < nt) {
            e_out = e; slot0 = s0 + rt * 64; nrows = min(64, s1 - slot0);
            return true;
        }
        rt -= nt;
    }
    return false;
}

__global__ __launch_bounds__(256) void k_moe1(const bf16_t* __restrict__ a2, const int* __restrict__ estart,
                                              const int* __restrict__ slot_tok, const float* __restrict__ w1,
                                              const float* __restrict__ b1, bf16_t* __restrict__ act) {
    __shared__ float As[16 * 68];
    __shared__ float Bs[2 * 16 * 64];
    __shared__ int toks[64];
    int e, slot0, nrows;
    if (!moe_tile(estart, blockIdx.y, e, slot0, nrows)) return;
    const int col0 = blockIdx.x * 64;
    if (threadIdx.x < 64) toks[threadIdx.x] = (threadIdx.x < nrows) ? slot_tok[slot0 + threadIdx.x] : -1;
    __syncthreads();
    float acc[2][4][4];
#pragma unroll
    for (int b = 0; b < 2; b++)
#pragma unroll
        for (int i = 0; i < 4; i++)
#pragma unroll
            for (int j = 0; j < 4; j++) acc[b][i][j] = 0.f;
    const float* w1e = w1 + (size_t)e * 1024 * 2048;
    auto af = [&](int r, int k) -> float { const int tk = toks[r]; return tk >= 0 ? bf2f(a2[(size_t)tk * DM + k]) : 0.f; };
    auto bf = [&](int b, int k, int c) -> float { return w1e[(size_t)k * 2048 + b * 1024 + col0 + c]; };
    tile_gemm<2>(acc, DM, af, bf, As, Bs);
    const int ty = threadIdx.x >> 4, tx = threadIdx.x & 15;
#pragma unroll
    for (int i = 0; i < 4; i++) {
        const int r = ty * 4 + i;
        if (r < nrows) {
#pragma unroll
            for (int j = 0; j < 4; j++) {
                const int col = col0 + tx * 4 + j;
                const float g = acc[0][i][j] + b1[(size_t)e * 2048 + col];
                const float l = acc[1][i][j] + b1[(size_t)e * 2048 + 1024 + col];
                const float xg = fminf(g, 7.0f);
                const float xl = fminf(fmaxf(l, -7.0f), 7.0f);
                act[(size_t)(slot0 + r) * DM + col] = f2bf(xg * sigmoidf_(1.702f * xg) * (xl + 1.0f));
            }
        }
    }
}

__global__ __launch_bounds__(256) void k_moe2(const bf16_t* __restrict__ act, const int* __restrict__ estart,
                                              const int* __restrict__ slot_tok, const float* __restrict__ slot_gate,
                                              const float* __restrict__ w2, const float* __restrict__ b2,
                                              float* __restrict__ hout) {
    __shared__ float As[16 * 68];
    __shared__ float Bs[16 * 64];
    int e, slot0, nrows;
    if (!moe_tile(estart, blockIdx.y, e, slot0, nrows)) return;
    const int col0 = blockIdx.x * 64;
    float acc[1][4][4];
#pragma unroll
    for (int i = 0; i < 4; i++)
#pragma unroll
        for (int j = 0; j < 4; j++) acc[0][i][j] = 0.f;
    const float* w2e = w2 + (size_t)e * 1024 * 1024;
    auto af = [&](int r, int k) -> float { return r < nrows ? bf2f(act[(size_t)(slot0 + r) * DM + k]) : 0.f; };
    auto bf = [&](int b, int k, int c) -> float { return w2e[(size_t)k * DM + col0 + c]; };
    tile_gemm<1>(acc, DM, af, bf, As, Bs);
    const int ty = threadIdx.x >> 4, tx = threadIdx.x & 15;
#pragma unroll
    for (int i = 0; i < 4; i++) {
        const int r = ty * 4 + i;
        if (r < nrows) {
            const int tk = slot_tok[slot0 + r];
            const float gt = slot_gate[slot0 + r];
#pragma unroll
            for (int j = 0; j < 4; j++) {
                const int col = col0 + tx * 4 + j;
                atomicAdd(&hout[(size_t)tk * DM + col], (acc[0][i][j] + b2[(size_t)e * DM + col]) * gt);
            }
        }
    }
}

__global__ __launch_bounds__(256) void k_final(float* __restrict__ hbuf, const float* __restrict__ fw) {
    const int row = blockIdx.x * 4 + (threadIdx.x >> 6);
    const int lane = threadIdx.x & 63;
    float4* p = (float4*)(hbuf + (size_t)row * DM);
    float4 v[4];
    float s = 0.f;
#pragma unroll
    for (int i = 0; i < 4; i++) { v[i] = p[lane + i * 64]; s += v[i].x * v[i].x + v[i].y * v[i].y + v[i].z * v[i].z + v[i].w * v[i].w; }
    s = wave_sum(s);
    const float rs = rsqrtf(s * (1.0f / DM) + EPSV);
#pragma unroll
    for (int i = 0; i < 4; i++) {
        const float4 w = *(const float4*)(fw + (lane + i * 64) * 4);
        float4 o; o.x = v[i].x * rs * w.x; o.y = v[i].y * rs * w.y; o.z = v[i].z * rs * w.z; o.w = v[i].w * rs * w.w;
        p[lane + i * 64] = o;
    }
}

extern "C" void kernel_launch(void* const* d_in, const int* in_sizes, int n_in, void* d_out, int out_size, void* d_ws,
                              size_t ws_size, hipStream_t stream) {
    const float* x = (const float*)d_in[0];
    const float* norm_mix_w = (const float*)d_in[1];
    const float* w_in = (const float*)d_in[2];
    const float* mconv_w = (const float*)d_in[3];
    const float* mconv_b = (const float*)d_in[4];
    const float* w_q = (const float*)d_in[5];
    const float* w_k = (const float*)d_in[6];
    const float* w_v = (const float*)d_in[7];
    const float* w_ig = (const float*)d_in[8];
    const float* b_ig = (const float*)d_in[9];
    const float* w_fg = (const float*)d_in[10];
    const float* b_fg = (const float*)d_in[11];
    const float* mnorm_w = (const float*)d_in[12];
    const float* mskip = (const float*)d_in[13];
    const float* cdw_w = (const float*)d_in[14];
    const float* cdw_b = (const float*)d_in[15];
    const float* cnorm_w = (const float*)d_in[16];
    const float* cnorm_b = (const float*)d_in[17];
    const float* w_out = (const float*)d_in[18];
    const float* nffn_w = (const float*)d_in[19];
    const float* w_router = (const float*)d_in[20];
    const float* b_router = (const float*)d_in[21];
    const float* w1 = (const float*)d_in[22];
    const float* b1 = (const float*)d_in[23];
    const float* w2 = (const float*)d_in[24];
    const float* b2 = (const float*)d_in[25];
    const float* final_w = (const float*)d_in[26];
    float* out = (float*)d_out;

    const size_t MiB = 1024 * 1024;
    if (ws_size < 460 * MiB) return;
    unsigned char* ws = (unsigned char*)d_ws;
    bf16_t* proj = (bf16_t*)(ws);
    bf16_t* hm = (bf16_t*)(ws + 256 * MiB);
    bf16_t* ymix = (bf16_t*)(ws + 320 * MiB);
    unsigned char* small = ws + 448 * MiB;
    float* rstd1 = (float*)(small);
    float* logi = (float*)(small + 1 * MiB);
    float* logf = (float*)(small + 2 * MiB);
    int* topi = (int*)(small + 3 * MiB);
    float* topg = (float*)(small + 4 * MiB);
    int* slot_tok = (int*)(small + 5 * MiB);
    float* slot_gate = (float*)(small + 6 * MiB);
    int* estart = (int*)(small + 7 * MiB);
    bf16_t* act = (bf16_t*)(ws);
    bf16_t* a2 = (bf16_t*)(ws + 256 * MiB);

    static bool attr_done = false;
    if (!attr_done) {
        hipFuncSetAttribute((const void*)k_mlstm, hipFuncAttributeMaxDynamicSharedMemorySize, MLSTM_LDS);
        hipFuncSetAttribute((const void*)k_sort, hipFuncAttributeMaxDynamicSharedMemorySize, 1024 * 32 * 4);
        attr_done = true;
    }

    k_rstd<<<NTOK / 4, 256, 0, stream>>>(x, rstd1);
    k_inproj<<<dim3(DPROJ / 64, NTOK / 64), 256, 0, stream>>>(x, rstd1, norm_mix_w, w_in, proj);
    k_gates<<<NTOK, 256, 0, stream>>>(proj, mconv_w, mconv_b, w_q, w_k, w_v, w_ig, b_ig, w_fg, b_fg, logi, logf);
    k_mlstm<<<16 * 8, 256, MLSTM_LDS, stream>>>(proj, logi, logf, mconv_w, mconv_b, w_q, w_k, w_v, hm);
    k_conv31<<<NTOK, 256, 0, stream>>>(proj, cdw_w, cdw_b, cnorm_w, cnorm_b, ymix);
    k_ym<<<NTOK, 256, 0, stream>>>(proj, hm, mconv_w, mconv_b, w_q, w_k, w_v, mnorm_w, mskip, ymix);
    k_outproj<<<dim3(DM / 64, NTOK / 64), 256, 0, stream>>>(ymix, w_out, x, out);
    k_router<<<NTOK, 256, 0, stream>>>(out, nffn_w, w_router, b_router, a2, topi, topg);
    k_sort<<<1, 1024, 1024 * 32 * 4, stream>>>(topi, topg, estart, slot_tok, slot_gate);
    k_moe1<<<dim3(DM / 64, NASSIGN / 64 + NEXP), 256, 0, stream>>>(a2, estart, slot_tok, w1, b1, act);
    k_moe2<<<dim3(DM / 64, NASSIGN / 64 + NEXP), 256, 0, stream>>>(act, estart, slot_tok, slot_gate, w2, b2, out);
    k_final<<<NTOK / 4, 256, 0, stream>>>(out, final_w);
}
```

```cpp
#include <hip/hip_runtime.h>
#include <stdint.h>

#define NTOK 32768
#define SEQ 8192
#define DM 1024
#define DPROJ 4096
#define NEXP 32
#define NASSIGN (NTOK * 4)
#define EPSV 1e-5f

typedef unsigned short bf16_t;

__device__ __forceinline__ float bf2f(bf16_t h) { return __uint_as_float(((uint32_t)h) << 16); }
__device__ __forceinline__ bf16_t f2bf(float f) {
    uint32_t u = __float_as_uint(f);
    u += 0x7FFFu + ((u >> 16) & 1u);
    return (bf16_t)(u >> 16);
}
__device__ __forceinline__ float sigmoidf_(float x) { return 1.0f / (1.0f + __expf(-x)); }
__device__ __forceinline__ float siluf_(float x) { return x * sigmoidf_(x); }
__device__ __forceinline__ float logsigmoidf_(float x) { return fminf(x, 0.0f) - log1pf(__expf(-fabsf(x))); }

__device__ __forceinline__ float wave_sum(float v) {
#pragma unroll
    for (int o = 32; o > 0; o >>= 1) v += __shfl_xor(v, o);
    return v;
}
__device__ __forceinline__ float block_sum256(float v, float* red) {
    v = wave_sum(v);
    __syncthreads();
    if ((threadIdx.x & 63) == 0) red[threadIdx.x >> 6] = v;
    __syncthreads();
    return red[0] + red[1] + red[2] + red[3];
}

template <int NB, class AF, class BF>
__device__ __forceinline__ void tile_gemm(float (&acc)[NB][4][4], int K, AF af, BF bf, float* As, float* Bs) {
    const int tid = threadIdx.x;
    const int ty = tid >> 4, tx = tid & 15;
    for (int k0 = 0; k0 < K; k0 += 16) {
#pragma unroll
        for (int i = 0; i < 4; i++) {
            int idx = tid + i * 256;
            int r = idx >> 4, kk = idx & 15;
            As[kk * 68 + r] = af(r, k0 + kk);
        }
#pragma unroll
        for (int b = 0; b < NB; b++) {
#pragma unroll
            for (int i = 0; i < 4; i++) {
                int idx = tid + i * 256;
                int kk = idx >> 6, c = idx & 63;
                Bs[(b * 16 + kk) * 64 + c] = bf(b, k0 + kk, c);
            }
        }
        __syncthreads();
#pragma unroll
        for (int kk = 0; kk < 16; kk++) {
            float a[4];
#pragma unroll
            for (int i = 0; i < 4; i++) a[i] = As[kk * 68 + ty * 4 + i];
#pragma unroll
            for (int b = 0; b < NB; b++) {
                float bb[4];
#pragma unroll
                for (int j = 0; j < 4; j++) bb[j] = Bs[(b * 16 + kk) * 64 + tx * 4 + j];
#pragma unroll
                for (int i = 0; i < 4; i++)
#pragma unroll
                    for (int j = 0; j < 4; j++) acc[b][i][j] += a[i] * bb[j];
            }
        }
        __syncthreads();
    }
}

struct PreOut { float xc[4], q[4], k[4], v[4]; };
__device__ __forceinline__ PreOut mlstm_pre(const bf16_t* __restrict__ proj, int t, int n, const float* __restrict__ cw,
                                            const float* __restrict__ cb, const float* __restrict__ wq,
                                            const float* __restrict__ wk, const float* __restrict__ wv) {
    PreOut o;
    const int s = t & (SEQ - 1);
    float xm[4][4];
#pragma unroll
    for (int kk = 0; kk < 4; kk++) {
        const int sp = s - 3 + kk;
        if (sp >= 0) {
            const uint2 raw = *(const uint2*)(proj + (size_t)(t - 3 + kk) * DM + 4 * n);
            xm[kk][0] = bf2f((bf16_t)(raw.x & 0xFFFF)); xm[kk][1] = bf2f((bf16_t)(raw.x >> 16));
            xm[kk][2] = bf2f((bf16_t)(raw.y & 0xFFFF)); xm[kk][3] = bf2f((bf16_t)(raw.y >> 16));
        } else {
            xm[kk][0] = xm[kk][1] = xm[kk][2] = xm[kk][3] = 0.f;
        }
    }
#pragma unroll
    for (int c = 0; c < 4; c++) {
        float a = cb[4 * n + c];
#pragma unroll
        for (int kk = 0; kk < 4; kk++) a += cw[kk * DM + 4 * n + c] * xm[kk][c];
        o.xc[c] = siluf_(a);
    }
#pragma unroll
    for (int oo = 0; oo < 4; oo++) {
        float aq = 0.f, ak = 0.f, av = 0.f;
#pragma unroll
        for (int i = 0; i < 4; i++) {
            aq += o.xc[i] * wq[n * 16 + i * 4 + oo];
            ak += o.xc[i] * wk[n * 16 + i * 4 + oo];
            av += xm[3][i] * wv[n * 16 + i * 4 + oo];
        }
        o.q[oo] = aq; o.k[oo] = ak; o.v[oo] = av;
    }
    return o;
}

__global__ __launch_bounds__(256) void k_gates(const bf16_t* __restrict__ proj, const float* __restrict__ cw,
                                               const float* __restrict__ cb, const float* __restrict__ wq,
                                               const float* __restrict__ wk, const float* __restrict__ wv,
                                               const float* __restrict__ wig, const float* __restrict__ big,
                                               const float* __restrict__ wfg, const float* __restrict__ bfg,
                                               float* __restrict__ logi, float* __restrict__ logf) {
    __shared__ float red[4];
    const int t = blockIdx.x, n = threadIdx.x;
    PreOut p = mlstm_pre(proj, t, n, cw, cb, wq, wk, wv);
    float pi[4], pf[4];
#pragma unroll
    for (int h = 0; h < 4; h++) {
        float ai = 0.f, af = 0.f;
#pragma unroll
        for (int o = 0; o < 4; o++) {
            const int c = 4 * n + o;
            ai += p.q[o] * wig[(size_t)c * 4 + h] + p.k[o] * wig[(size_t)(1024 + c) * 4 + h] + p.v[o] * wig[(size_t)(2048 + c) * 4 + h];
            af += p.q[o] * wfg[(size_t)c * 4 + h] + p.k[o] * wfg[(size_t)(1024 + c) * 4 + h] + p.v[o] * wfg[(size_t)(2048 + c) * 4 + h];
        }
        pi[h] = ai; pf[h] = af;
    }
#pragma unroll
    for (int h = 0; h < 4; h++) {
        float si = block_sum256(pi[h], red);
        float sf = block_sum256(pf[h], red);
        if (threadIdx.x == 0) {
            logi[(size_t)t * 4 + h] = si + big[h];
            logf[(size_t)t * 4 + h] = logsigmoidf_(sf + bfg[h]);
        }
    }
}

#define MS_QK_STRIDE 258
#define MLSTM_LDS (2 * 64 * MS_QK_STRIDE * 2 + 64 * 32 * 4 + 64 * 65 * 4 + 256 * 32 * 4 + 256 * 4 + 8 * 64 * 4)
__global__ __launch_bounds__(256) void k_mlstm(const bf16_t* __restrict__ proj, const float* __restrict__ logi,
                                               const float* __restrict__ logf, const float* __restrict__ cw,
                                               const float* __restrict__ cb, const float* __restrict__ wq,
                                               const float* __restrict__ wk, const float* __restrict__ wv,
                                               bf16_t* __restrict__ hm) {
    extern __shared__ __attribute__((aligned(16))) unsigned char smem[];
    bf16_t* qs = (bf16_t*)smem;
    bf16_t* ks = qs + 64 * MS_QK_STRIDE;
    float* vs = (float*)(ks + 64 * MS_QK_STRIDE);
    float* Ss = vs + 64 * 32;
    float* Cs = Ss + 64 * 65;
    float* nvec = Cs + 256 * 32;
    float* bcum = nvec + 256;
    float* li = bcum + 64;
    float* lf = li + 64;
    float* mrow = lf + 64;
    float* winter = mrow + 64;
    float* wst = winter + 64;
    float* den = wst + 64;

    const int tid = threadIdx.x;
    const int bh = blockIdx.x >> 3, sl = blockIdx.x & 7;
    const int b = bh >> 2, h = bh & 3;
    for (int i = tid; i < 256 * 32; i += 256) Cs[i] = 0.f;
    nvec[tid] = 0.f;
    float m_prev = 0.f;
    __syncthreads();

    for (int c = 0; c < SEQ / 64; c++) {
        const int t0 = b * SEQ + c * 64;
        for (int it = 0; it < 16; it++) {
            const int idx = tid + it * 256;
            const int r = idx >> 6, n = idx & 63;
            PreOut p = mlstm_pre(proj, t0 + r, h * 64 + n, cw, cb, wq, wk, wv);
#pragma unroll
            for (int o = 0; o < 4; o++) {
                qs[r * MS_QK_STRIDE + 4 * n + o] = f2bf(p.q[o] * 0.0625f);
                ks[r * MS_QK_STRIDE + 4 * n + o] = f2bf(p.k[o]);
            }
            if ((n >> 3) == sl) {
#pragma unroll
                for (int o = 0; o < 4; o++) vs[r * 32 + (4 * n + o - 32 * sl)] = p.v[o];
            }
        }
        if (tid < 64) {
            li[tid] = logi[(size_t)(t0 + tid) * 4 + h];
            lf[tid] = logf[(size_t)(t0 + tid) * 4 + h];
        }
        __syncthreads();
        if (tid == 0) {
            float a = 0.f;
            for (int j = 0; j < 64; j++) { a += lf[j]; bcum[j] = a; }
        }
        __syncthreads();
        {
            const int j = tid & 63, ig = tid >> 6;
            for (int ii = 0; ii < 16; ii++) {
                const int i = ig * 16 + ii;
                const uint32_t* qp = (const uint32_t*)(qs + i * MS_QK_STRIDE);
                const uint32_t* kp = (const uint32_t*)(ks + j * MS_QK_STRIDE);
                float a = 0.f;
                for (int d2 = 0; d2 < 128; d2++) {
                    const uint32_t qq = qp[d2], kk = kp[d2];
                    a += __uint_as_float(qq << 16) * __uint_as_float(kk << 16);
                    a += __uint_as_float(qq & 0xFFFF0000u) * __uint_as_float(kk & 0xFFFF0000u);
                }
                Ss[i * 65 + j] = (j <= i) ? a : 0.f;
            }
        }
        if (tid < 64) {
            const int i = tid;
            float mx = bcum[i] + m_prev;
            for (int j = 0; j <= i; j++) mx = fmaxf(mx, bcum[i] - bcum[j] + li[j]);
            mrow[i] = mx;
            winter[i] = __expf(bcum[i] + m_prev - mx);
        }
        __syncthreads();
        {
            const int j = tid & 63, ig = tid >> 6;
            for (int ii = 0; ii < 16; ii++) {
                const int i = ig * 16 + ii;
                if (j <= i) Ss[i * 65 + j] *= __expf(bcum[i] - bcum[j] + li[j] - mrow[i]);
            }
        }
        __syncthreads();
        if (tid < 64) {
            const int i = tid;
            float a = 0.f;
            for (int d = 0; d < 256; d++) a += bf2f(qs[i * MS_QK_STRIDE + d]) * nvec[d];
            float s = 0.f;
            for (int j = 0; j < 64; j++) s += Ss[i * 65 + j];
            den[i] = winter[i] * a + s;
        }
        __syncthreads();
        {
            const int e = tid & 31, ig = tid >> 5;
            for (int ii = 0; ii < 8; ii++) {
                const int i = ig * 8 + ii;
                float a1 = 0.f;
                for (int d = 0; d < 256; d++) a1 += bf2f(qs[i * MS_QK_STRIDE + d]) * Cs[d * 32 + e];
                float a2 = 0.f;
                for (int j = 0; j < 64; j++) a2 += Ss[i * 65 + j] * vs[j * 32 + e];
                const float num = winter[i] * a1 + a2;
                const float hv = num / fmaxf(fabsf(den[i]), __expf(-mrow[i]));
                hm[(size_t)(t0 + i) * DM + h * 256 + sl * 32 + e] = f2bf(hv);
            }
        }
        const float g = bcum[63];
        float m_new = g + m_prev;
        for (int j = 0; j < 64; j++) m_new = fmaxf(m_new, g - bcum[j] + li[j]);
        const float decay = __expf(g + m_prev - m_new);
        __syncthreads();
        if (tid < 64) wst[tid] = __expf(g - bcum[tid] + li[tid] - m_new);
        __syncthreads();
        {
            const int e = tid & 31, dg = tid >> 5;
            for (int dd = 0; dd < 32; dd++) {
                const int d = dg * 32 + dd;
                float a = 0.f;
                for (int j = 0; j < 64; j++) a += wst[j] * bf2f(ks[j * MS_QK_STRIDE + d]) * vs[j * 32 + e];
                Cs[d * 32 + e] = decay * Cs[d * 32 + e] + a;
            }
            const int d = tid;
            float a = 0.f;
            for (int j = 0; j < 64; j++) a += wst[j] * bf2f(ks[j * MS_QK_STRIDE + d]);
            nvec[d] = decay * nvec[d] + a;
        }
        m_prev = m_new;
        __syncthreads();
    }
}

__global__ __launch_bounds__(256) void k_conv31(const bf16_t* __restrict__ proj, const float* __restrict__ cw,
                                                const float* __restrict__ cb, const float* __restrict__ nw,
                                                const float* __restrict__ nb, bf16_t* __restrict__ ymix) {
    __shared__ float red[4];
    const int t = blockIdx.x, n = threadIdx.x;
    const int s = t & (SEQ - 1);
    float acc[4];
#pragma unroll
    for (int c = 0; c < 4; c++) acc[c] = cb[4 * n + c];
    for (int k = 0; k < 31; k++) {
        const int sp = s - 30 + k;
        if (sp >= 0) {
            const uint2 ra = *(const uint2*)(proj + (size_t)(t - 30 + k) * DM + 4 * n);
            float ga[4];
            ga[0] = bf2f((bf16_t)(ra.x & 0xFFFF)); ga[1] = bf2f((bf16_t)(ra.x >> 16));
            ga[2] = bf2f((bf16_t)(ra.y & 0xFFFF)); ga[3] = bf2f((bf16_t)(ra.y >> 16));
#pragma unroll
            for (int c = 0; c < 4; c++) acc[c] += cw[k * DM + 4 * n + c] * ga[c];
        }
    }
    const float mean = block_sum256(acc[0] + acc[1] + acc[2] + acc[3], red) * (1.0f / DM);
    float vs = 0.f;
#pragma unroll
    for (int c = 0; c < 4; c++) { const float d = acc[c] - mean; vs += d * d; }
    const float var = block_sum256(vs, red) * (1.0f / DM);
    const float rs = rsqrtf(var + EPSV);
#pragma unroll
    for (int c = 0; c < 4; c++) {
        const float y = (acc[c] - mean) * rs * nw[4 * n + c] + nb[4 * n + c];
        ymix[(size_t)t * 2048 + 1024 + 4 * n + c] = f2bf(siluf_(y));
    }
}

__global__ __launch_bounds__(256) void k_ym(const bf16_t* __restrict__ proj, const bf16_t* __restrict__ szb, const bf16_t* __restrict__ hm,
                                            const float* __restrict__ cw, const float* __restrict__ cb,
                                            const float* __restrict__ wq, const float* __restrict__ wk,
                                            const float* __restrict__ wv, const float* __restrict__ mnw,
                                            const float* __restrict__ skip, bf16_t* __restrict__ ymix) {
    const int t = blockIdx.x, n = threadIdx.x;
    PreOut p = mlstm_pre(proj, t, n, cw, cb, wq, wk, wv);
    float hv[4];
#pragma unroll
    for (int c = 0; c < 4; c++) hv[c] = bf2f(hm[(size_t)t * DM + 4 * n + c]);
    const float mean = wave_sum(hv[0] + hv[1] + hv[2] + hv[3]) * (1.0f / 256.0f);
    float vs = 0.f;
#pragma unroll
    for (int c = 0; c < 4; c++) { const float d = hv[c] - mean; vs += d * d; }
    const float var = wave_sum(vs) * (1.0f / 256.0f);
    const float rs = rsqrtf(var + EPSV);
#pragma unroll
    for (int c = 0; c < 4; c++) {
        const int ch = 4 * n + c;
        const float hn = (hv[c] - mean) * rs * mnw[ch];
        const float z = bf2f(szb[(size_t)t * DM + ch]);
        const float y = (hn + skip[ch] * p.xc[c]) * z;
        ymix[(size_t)t * 2048 + ch] = f2bf(y);
    }
}

__global__ __launch_bounds__(256) void k_outproj(const bf16_t* __restrict__ ymix, const float* __restrict__ w_out,
                                                 const float* __restrict__ x, float* __restrict__ hout) {
    __shared__ float As[16 * 68];
    __shared__ float Bs[16 * 64];
    const int col0 = blockIdx.x * 64, row0 = blockIdx.y * 64;
    float acc[1][4][4];
#pragma unroll
    for (int i = 0; i < 4; i++)
#pragma unroll
        for (int j = 0; j < 4; j++) acc[0][i][j] = 0.f;
    auto af = [&](int r, int k) -> float { return bf2f(ymix[(size_t)(row0 + r) * 2048 + k]); };
    auto bf = [&](int b, int k, int c) -> float { return w_out[(size_t)k * DM + col0 + c]; };
    tile_gemm<1>(acc, 2048, af, bf, As, Bs);
    const int ty = threadIdx.x >> 4, tx = threadIdx.x & 15;
#pragma unroll
    for (int i = 0; i < 4; i++)
#pragma unroll
        for (int j = 0; j < 4; j++) {
            const size_t o = (size_t)(row0 + ty * 4 + i) * DM + col0 + tx * 4 + j;
            hout[o] = x[o] + acc[0][i][j];
        }
}

__global__ __launch_bounds__(256) void k_router(const float* __restrict__ hbuf, const float* __restrict__ nfw,
                                                const float* __restrict__ wr, const float* __restrict__ br,
                                                bf16_t* __restrict__ a2, int* __restrict__ topi, float* __restrict__ topg) {
    __shared__ float av[DM];
    __shared__ float part[8][32];
    __shared__ float lg[32];
    __shared__ float red[4];
    const int t = blockIdx.x, tid = threadIdx.x;
    const float4 v = *(const float4*)(hbuf + (size_t)t * DM + tid * 4);
    const float ss = block_sum256(v.x * v.x + v.y * v.y + v.z * v.z + v.w * v.w, red);
    const float rs = rsqrtf(ss * (1.0f / DM) + EPSV);
    const float vv[4] = {v.x, v.y, v.z, v.w};
#pragma unroll
    for (int c = 0; c < 4; c++) {
        const float a = vv[c] * rs * nfw[tid * 4 + c];
        av[tid * 4 + c] = a;
        a2[(size_t)t * DM + tid * 4 + c] = f2bf(a);
    }
    __syncthreads();
    {
        const int e = tid & 31, pp = tid >> 5;
        float a = 0.f;
        for (int k = pp * 128; k < pp * 128 + 128; k++) a += av[k] * wr[(size_t)k * 32 + e];
        part[pp][e] = a;
    }
    __syncthreads();
    if (tid < 32) {
        float a = br[tid];
#pragma unroll
        for (int pp = 0; pp < 8; pp++) a += part[pp][tid];
        lg[tid] = a;
    }
    __syncthreads();
    if (tid == 0) {
        int sel[4]; float val[4];
        unsigned used = 0u;
#pragma unroll
        for (int r = 0; r < 4; r++) {
            int bi = -1; float bv = 0.f;
            for (int e = 0; e < 32; e++) {
                if (used & (1u << e)) continue;
                const float x = lg[e];
                if (bi < 0 || x > bv) { bi = e; bv = x; }
            }
            used |= 1u << bi;
            sel[r] = bi; val[r] = bv;
        }
        float ex[4], sum = 0.f;
#pragma unroll
        for (int r = 0; r < 4; r++) { ex[r] = __expf(val[r] - val[0]); sum += ex[r]; }
#pragma unroll
        for (int r = 0; r < 4; r++) {
            topi[(size_t)t * 4 + r] = sel[r];
            topg[(size_t)t * 4 + r] = ex[r] / sum;
        }
    }
}

__global__ __launch_bounds__(1024) void k_sort(const int* __restrict__ topi, const float* __restrict__ topg,
                                               int* __restrict__ estart, int* __restrict__ slot_tok,
                                               float* __restrict__ slot_gate) {
    extern __shared__ __attribute__((aligned(16))) unsigned char smem[];
    int* cnt = (int*)smem;
    __shared__ int es[33];
    __shared__ int tot[32];
    const int tid = threadIdx.x;
    for (int e = 0; e < 32; e++) cnt[tid * 32 + e] = 0;
    const int a0 = tid * 128;
    for (int a = a0; a < a0 + 128; a++) cnt[tid * 32 + topi[a]]++;
    __syncthreads();
    if (tid < 32) {
        int run = 0;
        for (int i = 0; i < 1024; i++) { const int c = cnt[i * 32 + tid]; cnt[i * 32 + tid] = run; run += c; }
        tot[tid] = run;
    }
    __syncthreads();
    if (tid == 0) {
        int run = 0;
        for (int e = 0; e < 32; e++) { es[e] = run; estart[e] = run; run += tot[e]; }
        es[32] = run; estart[32] = run;
    }
    __syncthreads();
    for (int a = a0; a < a0 + 128; a++) {
        const int e = topi[a];
        const int slot = es[e] + cnt[tid * 32 + e];
        cnt[tid * 32 + e]++;
        slot_tok[slot] = a >> 2;
        slot_gate[slot] = topg[a];
    }
}

__device__ __forceinline__ bool moe_tile(const int* __restrict__ estart, int rt, int& e_out, int& slot0, int& nrows) {
    for (int e = 0; e < NEXP; e++) {
        const int s0 = estart[e], s1 = estart[e + 1];
        const int nt = (s1 - s0 + 63) >> 6;
        if (rt < nt) {
            e_out = e; slot0 = s0 + rt * 64; nrows = min(64, s1 - slot0);
            return true;
        }
        rt -= nt;
    }
    return false;
}

__global__ __launch_bounds__(256) void k_moe1(const bf16_t* __restrict__ a2, const int* __restrict__ estart,
                                              const int* __restrict__ slot_tok, const float* __restrict__ w1,
                                              const float* __restrict__ b1, bf16_t* __restrict__ act) {
    __shared__ float As[16 * 68];
    __shared__ float Bs[2 * 16 * 64];
    __shared__ int toks[64];
    int e, slot0, nrows;
    if (!moe_tile(estart, blockIdx.y, e, slot0, nrows)) return;
    const int col0 = blockIdx.x * 64;
    if (threadIdx.x < 64) toks[threadIdx.x] = (threadIdx.x < nrows) ? slot_tok[slot0 + threadIdx.x] : -1;
    __syncthreads();
    float acc[2][4][4];
#pragma unroll
    for (int b = 0; b < 2; b++)
#pragma unroll
        for (int i = 0; i < 4; i++)
#pragma unroll
            for (int j = 0; j < 4; j++) acc[b][i][j] = 0.f;
    const float* w1e = w1 + (size_t)e * 1024 * 2048;
    auto af = [&](int r, int k) -> float { const int tk = toks[r]; return tk >= 0 ? bf2f(a2[(size_t)tk * DM + k]) : 0.f; };
    auto bf = [&](int b, int k, int c) -> float { return w1e[(size_t)k * 2048 + b * 1024 + col0 + c]; };
    tile_gemm<2>(acc, DM, af, bf, As, Bs);
    const int ty = threadIdx.x >> 4, tx = threadIdx.x & 15;
#pragma unroll
    for (int i = 0; i < 4; i++) {
        const int r = ty * 4 + i;
        if (r < nrows) {
#pragma unroll
            for (int j = 0; j < 4; j++) {
                const int col = col0 + tx * 4 + j;
                const float g = acc[0][i][j] + b1[(size_t)e * 2048 + col];
                const float l = acc[1][i][j] + b1[(size_t)e * 2048 + 1024 + col];
                const float xg = fminf(g, 7.0f);
                const float xl = fminf(fmaxf(l, -7.0f), 7.0f);
                act[(size_t)(slot0 + r) * DM + col] = f2bf(xg * sigmoidf_(1.702f * xg) * (xl + 1.0f));
            }
        }
    }
}

__global__ __launch_bounds__(256) void k_moe2(const bf16_t* __restrict__ act, const int* __restrict__ estart,
                                              const int* __restrict__ slot_tok, const float* __restrict__ slot_gate,
                                              const float* __restrict__ w2, const float* __restrict__ b2,
                                              float* __restrict__ hout) {
    __shared__ float As[16 * 68];
    __shared__ float Bs[16 * 64];
    int e, slot0, nrows;
    if (!moe_tile(estart, blockIdx.y, e, slot0, nrows)) return;
    const int col0 = blockIdx.x * 64;
    float acc[1][4][4];
#pragma unroll
    for (int i = 0; i < 4; i++)
#pragma unroll
        for (int j = 0; j < 4; j++) acc[0][i][j] = 0.f;
    const float* w2e = w2 + (size_t)e * 1024 * 1024;
    auto af = [&](int r, int k) -> float { return r < nrows ? bf2f(act[(size_t)(slot0 + r) * DM + k]) : 0.f; };
    auto bf = [&](int b, int k, int c) -> float { return w2e[(size_t)k * DM + col0 + c]; };
    tile_gemm<1>(acc, DM, af, bf, As, Bs);
    const int ty = threadIdx.x >> 4, tx = threadIdx.x & 15;
#pragma unroll
    for (int i = 0; i < 4; i++) {
        const int r = ty * 4 + i;
        if (r < nrows) {
            const int tk = slot_tok[slot0 + r];
            const float gt = slot_gate[slot0 + r];
#pragma unroll
            for (int j = 0; j < 4; j++) {
                const int col = col0 + tx * 4 + j;
                atomicAdd(&hout[(size_t)tk * DM + col], (acc[0][i][j] + b2[(size_t)e * DM + col]) * gt);
            }
        }
    }
}

__global__ __launch_bounds__(256) void k_final(float* __restrict__ hbuf, const float* __restrict__ fw) {
    const int row = blockIdx.x * 4 + (threadIdx.x >> 6);
    const int lane = threadIdx.x & 63;
    float4* p = (float4*)(hbuf + (size_t)row * DM);
    float4 v[4];
    float s = 0.f;
#pragma unroll
    for (int i = 0; i < 4; i++) { v[i] = p[lane + i * 64]; s += v[i].x * v[i].x + v[i].y * v[i].y + v[i].z * v[i].z + v[i].w * v[i].w; }
    s = wave_sum(s);
    const float rs = rsqrtf(s * (1.0f / DM) + EPSV);
#pragma unroll
    for (int i = 0; i < 4; i++) {
        const float4 w = *(const float4*)(fw + (lane + i * 64) * 4);
        float4 o; o.x = v[i].x * rs * w.x; o.y = v[i].y * rs * w.y; o.z = v[i].z * rs * w.z; o.w = v[i].w * rs * w.w;
        p[lane + i * 64] = o;
    }
}


#define LAS __attribute__((address_space(3)))
#define GAS __attribute__((address_space(1)))
typedef short bf16x8 __attribute__((ext_vector_type(8)));
typedef float f32x4 __attribute__((ext_vector_type(4)));
typedef float f32x2 __attribute__((ext_vector_type(2)));
typedef unsigned u32x4 __attribute__((ext_vector_type(4)));
typedef unsigned u32x2 __attribute__((ext_vector_type(2)));

__device__ __forceinline__ int lane_id() { int l = (int)__builtin_amdgcn_mbcnt_hi(~0u, __builtin_amdgcn_mbcnt_lo(~0u, 0u)); asm volatile("" : "+v"(l)); return l; }
namespace pg8 {
constexpr int BM = 256, BK = 64, HALF = 128, HTB = HALF * BK * 2, STAGE_BYTES = 8 * HTB, NXCD = 8, WGM = 8;
__host__ __device__ __forceinline__ int lds_byte(int r, int c) { const int st = (r >> 4) * 2 + (c >> 5), rr = r & 15, cc = c & 31, ob = rr * 64 + cc * 2; return st * 1024 + (ob ^ (((ob >> 9) & 1) << 5)); }
__host__ __device__ __forceinline__ void stage_rc(int b, int& R, int& C) { const int st = b / 1024, sb = b % 1024, swz = sb ^ (((sb >> 9) & 1) << 5); R = (st >> 1) * 16 + swz / 64; C = (st & 1) * 32 + (swz % 64) / 2; }
__host__ __device__ __forceinline__ int perm32(int rho) { const int n = rho >> 4, i = rho & 15; return 8 * (i >> 2) + 4 * n + (i & 3); }
__device__ __forceinline__ unsigned cvt_pk_bf16(float lo, float hi) { unsigned r; asm volatile("v_cvt_pk_bf16_f32 %0, %1, %2" : "=v"(r) : "v"(lo), "v"(hi)); return r; }

struct Unit { const char* A; const char* B; const int* gidx; int pm, pn, aux; };

template <class Epi, class Sched, bool GATHER>
__device__ __forceinline__ void gemm_phase(LAS unsigned char* lds, const int wid, const int K, const int lda, const int ldb, const Sched& S, const Epi& E) {
    const int lane = lane_id(), tid = (wid << 6) | lane, wr = wid >> 2, wc = wid & 3, fr = lane & 15, fq = lane >> 4;
    const int nt = K / BK;
    int Ra[2], Ca[2]; unsigned voffB[2];
#pragma unroll
    for (int i = 0; i < 2; ++i) { int R, C; stage_rc(tid * 16 + i * 8192, R, C); Ra[i] = R; Ca[i] = C; const int Rb = (R & ~31) + perm32(R & 31); voffB[i] = (unsigned)(Rb * ldb + C) * 2u; }
    const size_t kstep = (size_t)(BK * 2);
    const size_t hstepB = (size_t)HALF * ldb * 2;
    const unsigned ldsw = (unsigned)wid * 1024u;
    const int aoff = lds_byte(wr * 64 + fr, fq * 8), boff = lds_byte(wc * 32 + fr, fq * 8);
#define PG8_SA(b, h) (((b) * 2 + (h)) * HTB)
#define PG8_SB(b, h) ((4 + (b) * 2 + (h)) * HTB)
#define PG8_STAGE(bufoff, gbase, voff) do { _Pragma("unroll") for (int _i = 0; _i < 2; ++_i) \
        __builtin_amdgcn_global_load_lds((const unsigned*)((const char*)(gbase) + (voff)[_i]), (LAS unsigned*)(lds + (bufoff) + ldsw + _i * 8192), 16, 0, 0); } while (0)
#define PG8_LDA(dst, b, h) do { _Pragma("unroll") for (int m = 0; m < 4; ++m) _Pragma("unroll") for (int k = 0; k < 2; ++k) dst[m][k] = *(const LAS bf16x8*)(lds + PG8_SA(b, h) + aoff + m * 2048 + k * 1024); } while (0)
#define PG8_LDB(dst, b, h) do { _Pragma("unroll") for (int n = 0; n < 2; ++n) _Pragma("unroll") for (int k = 0; k < 2; ++k) dst[n][k] = *(const LAS bf16x8*)(lds + PG8_SB(b, h) + boff + n * 2048 + k * 1024); } while (0)
#define PG8_MMA(ai, bj, At, Bt) do { __builtin_amdgcn_s_setprio(1); _Pragma("unroll") for (int m = 0; m < 4; ++m) _Pragma("unroll") for (int n = 0; n < 2; ++n) _Pragma("unroll") for (int k = 0; k < 2; ++k) \
        acc[ai][bj][m][n] = __builtin_amdgcn_mfma_f32_16x16x32_bf16(Bt[n][k], At[m][k], acc[ai][bj][m][n], 0, 0, 0); __builtin_amdgcn_s_setprio(0); } while (0)
#define PG8_WAIT_V(n) asm volatile("s_waitcnt vmcnt(" #n ")" ::: "memory")
#define PG8_WAIT_L(n) asm volatile("s_waitcnt lgkmcnt(" #n ")" ::: "memory")
#define PG8_BAR __builtin_amdgcn_s_barrier()
#define PG8_SCHED __builtin_amdgcn_sched_barrier(0)
    Unit cur, nxt; int ui = 0;
    if (!S.next(0, cur)) return;
    unsigned offA[2][2], offN[2][2];
#pragma unroll
    for (int h = 0; h < 2; ++h)
#pragma unroll
        for (int i = 0; i < 2; ++i) {
            const int rr = h * HALF + Ra[i];
            const int row = GATHER ? cur.gidx[rr] : rr;
            offA[h][i] = (unsigned)(row * lda + Ca[i]) * 2u; offN[h][i] = offA[h][i];
        }
    f32x4 acc[2][2][4][2];
#pragma unroll
    for (int a = 0; a < 2; ++a)
#pragma unroll
        for (int b = 0; b < 2; ++b)
#pragma unroll
            for (int m = 0; m < 4; ++m)
#pragma unroll
                for (int n = 0; n < 2; ++n) acc[a][b][m][n] = (f32x4){0.f, 0.f, 0.f, 0.f};
    bf16x8 At[4][2], B0[2][2], B1[2][2];
    const char* cA = cur.A; const char* cB = cur.B;
    PG8_STAGE(PG8_SB(0, 0), cB, voffB); PG8_STAGE(PG8_SB(0, 1), cB + hstepB, voffB); PG8_STAGE(PG8_SA(0, 0), cA, offA[0]); PG8_STAGE(PG8_SA(0, 1), cA, offA[1]);
    if (wr == 1) PG8_BAR;
    PG8_WAIT_V(2); PG8_BAR;
    PG8_STAGE(PG8_SB(1, 0), cB + kstep, voffB); PG8_STAGE(PG8_SA(1, 0), cA + kstep, offA[0]); PG8_STAGE(PG8_SB(1, 1), cB + hstepB + kstep, voffB);
    PG8_WAIT_V(6); PG8_BAR;
    for (;;) {
        const bool has_next = S.next(ui + 1, nxt);
        const char* nA = has_next ? nxt.A : cA; const char* nB = has_next ? nxt.B : cB;
        if constexpr (GATHER) {
            if (has_next) {
#pragma unroll
                for (int h = 0; h < 2; ++h)
#pragma unroll
                    for (int i = 0; i < 2; ++i) offN[h][i] = (unsigned)(nxt.gidx[h * HALF + Ra[i]] * lda + Ca[i]) * 2u;
            }
        }
#pragma unroll 1
        for (int t = 0; t < nt; t += 2) {
            const bool last = (t == nt - 2);
            const char* a1 = cA + (size_t)(t + 1) * kstep;
            const char* a2 = last ? nA : cA + (size_t)(t + 2) * kstep; const char* b2 = last ? nB : cB + (size_t)(t + 2) * kstep;
            const char* a3 = a2 + kstep; const char* b3 = b2 + kstep;
            unsigned o2[2][2];
#pragma unroll
            for (int h = 0; h < 2; ++h)
#pragma unroll
                for (int i = 0; i < 2; ++i) o2[h][i] = (GATHER && last) ? offN[h][i] : offA[h][i];
            PG8_LDB(B0, 0, 0); PG8_LDB(B1, 0, 1); PG8_SCHED; PG8_LDA(At, 0, 0); PG8_STAGE(PG8_SA(1, 1), a1, offA[1]);
            PG8_WAIT_V(8); PG8_WAIT_L(0); PG8_BAR; PG8_MMA(0, 0, At, B0); PG8_MMA(0, 1, At, B1); PG8_BAR; PG8_SCHED;
            PG8_LDA(At, 0, 1); PG8_STAGE(PG8_SB(0, 0), b2, voffB); PG8_STAGE(PG8_SB(0, 1), b2 + hstepB, voffB); PG8_STAGE(PG8_SA(0, 0), a2, o2[0]);
            PG8_WAIT_V(8); PG8_WAIT_L(0); PG8_BAR; PG8_MMA(1, 0, At, B0); PG8_MMA(1, 1, At, B1); PG8_BAR; PG8_SCHED;
            PG8_LDB(B0, 1, 0); PG8_LDB(B1, 1, 1); PG8_SCHED; PG8_LDA(At, 1, 0); PG8_STAGE(PG8_SA(0, 1), a2, o2[1]);
            PG8_WAIT_V(8); PG8_WAIT_L(0); PG8_BAR; PG8_MMA(0, 0, At, B0); PG8_MMA(0, 1, At, B1); PG8_BAR; PG8_SCHED;
            PG8_LDA(At, 1, 1); PG8_STAGE(PG8_SB(1, 0), b3, voffB); PG8_STAGE(PG8_SB(1, 1), b3 + hstepB, voffB); PG8_STAGE(PG8_SA(1, 0), a3, o2[0]);
            PG8_WAIT_V(8); PG8_WAIT_L(0); PG8_BAR; PG8_MMA(1, 0, At, B0); PG8_MMA(1, 1, At, B1); PG8_BAR; PG8_SCHED;
        }
        if (wr == 0) PG8_BAR;
        E(acc, cur, wr, wc, fr, fq);
        if (!has_next) break;
#pragma unroll
        for (int a = 0; a < 2; ++a)
#pragma unroll
            for (int b = 0; b < 2; ++b)
#pragma unroll
                for (int m = 0; m < 4; ++m)
#pragma unroll
                    for (int n = 0; n < 2; ++n) acc[a][b][m][n] = (f32x4){0.f, 0.f, 0.f, 0.f};
        cur = nxt; cA = nA; cB = nB; ++ui;
        if constexpr (GATHER) {
#pragma unroll
            for (int h = 0; h < 2; ++h)
#pragma unroll
                for (int i = 0; i < 2; ++i) offA[h][i] = offN[h][i];
        }
        if (wr == 1) PG8_BAR;
    }
    PG8_WAIT_V(0);
    PG8_BAR;
#undef PG8_SA
#undef PG8_SB
#undef PG8_STAGE
#undef PG8_LDA
#undef PG8_LDB
#undef PG8_MMA
#undef PG8_WAIT_V
#undef PG8_WAIT_L
#undef PG8_BAR
#undef PG8_SCHED
}

struct DenseOrder {
    const char* A; const char* Bt; size_t a_tile_bytes, b_tile_bytes; int nM, nN, nwg, G, c;
    __device__ void init(const void* A_, const void* Bt_, int M, int N, int lda, int ldb, int G_, int c_) {
        A = (const char*)A_; Bt = (const char*)Bt_; nM = M / BM; nN = N / BM; nwg = nM * nN; G = G_; c = c_;
        a_tile_bytes = (size_t)BM * lda * 2; b_tile_bytes = (size_t)BM * ldb * 2;
    }
    __device__ __forceinline__ bool next(int i, Unit& u) const {
        const long L = (long)i * G + c; if (L >= nwg) return false;
        int wgid = (int)L; { const int q = nwg / NXCD, r = nwg % NXCD, xcd = wgid % NXCD, off = wgid / NXCD; wgid = (xcd < r ? xcd * (q + 1) : r * (q + 1) + (xcd - r) * q) + off; }
        const int nig = WGM * nN, gid = wgid / nig, fm = gid * WGM, gsz = (nM - fm) < WGM ? (nM - fm) : WGM;
        u.pm = fm + ((wgid % nig) % gsz); u.pn = (wgid % nig) / gsz; u.aux = 0; u.gidx = nullptr;
        u.A = A + (size_t)u.pm * a_tile_bytes; u.B = Bt + (size_t)u.pn * b_tile_bytes; return true;
    }
};
}

#define XB_TMO      128
#define XB_XCNT(j)  (256  + 64 * (j))
#define XB_XSUB(j)  (1280 + 64 * (j))
#define XB_XGEN(j)  (2304 + 64 * (j))
#define XB_TOP      3328
#define XB_TOPGEN   3392
#define XCD_BAR_WORDS 3456
#define XB_SPIN_CAP (1u << 18)

__device__ __forceinline__ unsigned xb_ld(unsigned* p)              { return __hip_atomic_load(p, __ATOMIC_RELAXED, __HIP_MEMORY_SCOPE_AGENT); }
__device__ __forceinline__ unsigned xb_add(unsigned* p, unsigned v) { return __hip_atomic_fetch_add(p, v, __ATOMIC_RELAXED, __HIP_MEMORY_SCOPE_AGENT); }
__device__ __forceinline__ unsigned xb_xcc_id() { return (unsigned)__builtin_amdgcn_s_getreg((3 << 11) | 20) & 0xFu; }
#define XB_SPIN(cond, bar) do { unsigned _sp = 0; while (cond) { __builtin_amdgcn_s_sleep(1); \
    if ((++_sp & 255u) == 0u) { if (xb_ld(&(bar)[XB_TMO])) break; if (_sp > XB_SPIN_CAP) { atomicAdd(&(bar)[XB_TMO], 1u); break; } } } } while (0)

struct XcdBarrier {
    unsigned* bar; unsigned x; int w;
    volatile LAS unsigned* st;
};
__device__ __forceinline__ XcdBarrier xcd_barrier_post(unsigned* bar, volatile LAS unsigned* st, int wave) {
    XcdBarrier b; b.bar = bar; b.x = xb_xcc_id(); b.st = st; b.w = wave;
    if (wave == 0 && lane_id() == 0) (void)xb_add(&bar[XB_XCNT(b.x)], 1u);
    return b;
}
__device__ __forceinline__ void xcd_barrier_complete(unsigned* bar, unsigned x, unsigned& nloc, unsigned& nx) {
    const unsigned G = gridDim.x * gridDim.y * gridDim.z;
    unsigned sum, cnt, mine, sp = 0u;
    for (;;) {
        sum = 0u; cnt = 0u; mine = 0u;
#pragma unroll
        for (unsigned j = 0; j < 16; ++j) { const unsigned c = xb_ld(&bar[XB_XCNT(j)]); sum += c; cnt += (c > 0u) ? 1u : 0u; mine = (j == x) ? c : mine; }
        if (sum == G) break;
        __builtin_amdgcn_s_sleep(1);
        if ((++sp & 255u) == 0u) { if (xb_ld(&bar[XB_TMO])) break; if (sp > XB_SPIN_CAP) { atomicAdd(&bar[XB_TMO], 1u); break; } }
    }
    nloc = mine > 0u ? mine : 1u; nx = cnt > 0u ? cnt : 1u;
}
__device__ __forceinline__ void xcd_barrier(const XcdBarrier& b) {
    asm volatile("s_waitcnt vmcnt(0)" ::: "memory");
    __syncthreads();
    if (b.w == 0 && lane_id() == 0) {
        unsigned* bar = b.bar;
        __builtin_amdgcn_s_waitcnt(0);
        unsigned nloc = b.st[0], nx = b.st[1];
        if (nloc == 0u) { xcd_barrier_complete(bar, b.x, nloc, nx); b.st[0] = nloc; b.st[1] = nx; }
        const unsigned old = xb_add(&bar[XB_XSUB(b.x)], 1u);
        const unsigned gen = old / nloc;
        if (old + 1u == (gen + 1u) * nloc) {
            __builtin_amdgcn_fence(__ATOMIC_RELEASE, "agent");
            asm volatile("s_waitcnt vmcnt(0)" ::: "memory");
            const unsigned og = xb_add(&bar[XB_TOP], 1u);
            const unsigned tg = og / nx;
            if (og + 1u == (tg + 1u) * nx) xb_add(&bar[XB_TOPGEN], 1u);
            else XB_SPIN(xb_ld(&bar[XB_TOPGEN]) == tg, bar);
            __builtin_amdgcn_fence(__ATOMIC_ACQUIRE, "agent");
            xb_add(&bar[XB_XGEN(b.x)], 1u);
            asm volatile("s_waitcnt vmcnt(0)" ::: "memory");
        } else {
            XB_SPIN(xb_ld(&bar[XB_XGEN(b.x)]) == gen, bar);
            __builtin_amdgcn_fence(__ATOMIC_ACQUIRE, "agent");
            asm volatile("s_waitcnt vmcnt(0)" ::: "memory");
        }
    }
    __syncthreads();
}

constexpr size_t MiB = 1u << 20;
constexpr size_t WS_CTL = 0, CTL_ZERO_BYTES = 1 * MiB;
constexpr size_t WS_SMALL = 1 * MiB;
constexpr size_t WS_RSTD1 = WS_SMALL;
constexpr size_t WS_LOGI = WS_SMALL + 1 * MiB;
constexpr size_t WS_LOGF = WS_SMALL + 2 * MiB;
constexpr size_t WS_TOPI = WS_SMALL + 3 * MiB;
constexpr size_t WS_TOPG = WS_SMALL + 4 * MiB;
constexpr size_t WS_STOK = WS_SMALL + 5 * MiB;
constexpr size_t WS_SGATE = WS_SMALL + 6 * MiB;
constexpr size_t WS_ESTART = WS_SMALL + 7 * MiB;
constexpr size_t WS_BTIN = 17 * MiB;
constexpr size_t WS_BTOUT = 25 * MiB;
constexpr size_t WS_BT1 = 29 * MiB;
constexpr size_t WS_BT2 = 157 * MiB;
constexpr size_t WS_R1 = 221 * MiB;
constexpr size_t WS_XM = 285 * MiB;
constexpr size_t WS_SZ = 349 * MiB;
constexpr size_t WS_U = 413 * MiB;
constexpr size_t WS_Q = 477 * MiB;
constexpr size_t WS_YMIX = 477 * MiB;
constexpr size_t WS_ACT = 285 * MiB;
constexpr size_t WS_NEED = 925 * MiB;

constexpr int NWAVES = 8;
constexpr int RING_BYTES = 131072;
constexpr int LDSCTL_OFF = RING_BYTES;
constexpr int LDS_BYTES = 147456;
constexpr int CW_BAR = 4096;

struct MegaArgs {
    const float* in[27];
    float* out;
    unsigned char* ws;
    int ph_lo, ph_hi, li, pad;
};

__device__ __forceinline__ unsigned pk2(float lo, float hi) { return (unsigned)f2bf(lo) | ((unsigned)f2bf(hi) << 16); }

__device__ __forceinline__ void p0_transpose_item(const float* W, int K, int N, bf16_t* WT, const float* ksc, int k0, int n0s, int n0d, LAS float* scr, int lane) {
#pragma unroll 8
    for (int i = 0; i < 32; ++i) { const int kk = 2 * i + (lane >> 5); float v = W[(size_t)(k0 + kk) * N + n0s + (lane & 31)]; if (ksc) v *= ksc[k0 + kk]; scr[kk * 33 + (lane & 31)] = v; }
    asm volatile("s_waitcnt lgkmcnt(0)" ::: "memory");
    const int c = lane & 7;
#pragma unroll
    for (int j = 0; j < 4; ++j) { const int n = (lane >> 3) + 8 * j; const LAS float* s = scr + (8 * c) * 33 + n;
        u32x4 o; o.x = pk2(s[0 * 33], s[1 * 33]); o.y = pk2(s[2 * 33], s[3 * 33]); o.z = pk2(s[4 * 33], s[5 * 33]); o.w = pk2(s[6 * 33], s[7 * 33]);
        *(u32x4*)(WT + (size_t)(n0d + n) * K + k0 + 8 * c) = o; }
    asm volatile("s_waitcnt lgkmcnt(0)" ::: "memory");
}
__device__ __forceinline__ int inproj_src_col(int nd) { if (nd < 2048) return nd; const int pn = (nd >> 8) - 8, lc = nd & 255; return 2048 + (lc >> 7) * 1024 + 128 * pn + (lc & 127); }
__device__ __forceinline__ int w1_src_col(int nd) { const int pn = nd >> 8, lc = nd & 255; return (lc >> 7) * 1024 + 128 * pn + (lc & 127); }

__device__ __forceinline__ void p0_prologue(const MegaArgs& a, LAS unsigned char* lds, int gw, int NGW, int wave, int lane) {
    LAS float* scr = (LAS float*)(lds + wave * 16384);
    unsigned char* ws = a.ws;
    const float* x = a.in[0];
    {
        bf16_t* xbf = (bf16_t*)(ws + WS_R1); float* rstd1 = (float*)(ws + WS_RSTD1);
        for (int m = gw; m < NTOK; m += NGW) {
            const f32x4* xr = (const f32x4*)(x + (size_t)m * DM) + lane;
            f32x4 v[4]; float s = 0.f;
#pragma unroll
            for (int j = 0; j < 4; ++j) { v[j] = xr[64 * j]; s += (v[j].x * v[j].x + v[j].y * v[j].y) + (v[j].z * v[j].z + v[j].w * v[j].w); }
            s = wave_sum(s);
            if (lane == 0) rstd1[m] = rsqrtf(s * (1.0f / DM) + EPSV);
            unsigned long long* o8 = (unsigned long long*)(xbf + (size_t)m * DM) + lane;
#pragma unroll
            for (int j = 0; j < 4; ++j) o8[64 * j] = (unsigned long long)pk2(v[j].x, v[j].y) | ((unsigned long long)pk2(v[j].z, v[j].w) << 32);
        }
    }
    constexpr int I_IN = (1024 / 64) * (4096 / 32);
    constexpr int I_OUT = (2048 / 64) * (1024 / 32);
    constexpr int I_W1 = 32 * (1024 / 64) * (2048 / 32);
    constexpr int I_W2 = 32 * (1024 / 64) * (1024 / 32);
    constexpr int NITEMS = I_IN + I_OUT + I_W1 + I_W2;
    for (int it = gw; it < NITEMS; it += NGW) {
        int r = it;
        if (r < I_IN) { const int kb = r / 128, nb = r % 128; p0_transpose_item(a.in[2], 1024, 4096, (bf16_t*)(ws + WS_BTIN), a.in[1], 64 * kb, inproj_src_col(32 * nb), 32 * nb, scr, lane); continue; }
        r -= I_IN;
        if (r < I_OUT) { const int kb = r / 32, nb = r % 32; p0_transpose_item(a.in[18], 2048, 1024, (bf16_t*)(ws + WS_BTOUT), nullptr, 64 * kb, 32 * nb, 32 * nb, scr, lane); continue; }
        r -= I_OUT;
        if (r < I_W1) { const int e = r / 1024, rr = r % 1024, kb = rr / 64, nb = rr % 64;
            p0_transpose_item(a.in[22] + (size_t)e * 1024 * 2048, 1024, 2048, (bf16_t*)(ws + WS_BT1) + (size_t)e * 2048 * 1024, a.in[19], 64 * kb, w1_src_col(32 * nb), 32 * nb, scr, lane); continue; }
        r -= I_W1;
        { const int e = r / 512, rr = r % 512, kb = rr / 32, nb = rr % 32;
            p0_transpose_item(a.in[24] + (size_t)e * 1024 * 1024, 1024, 1024, (bf16_t*)(ws + WS_BT2) + (size_t)e * 1024 * 1024, nullptr, 64 * kb, 32 * nb, 32 * nb, scr, lane); }
    }
}

struct EpiInProj {
    const float* rstd; bf16_t* xm; bf16_t* sz; bf16_t* u;
    __device__ __forceinline__ void operator()(const f32x4 (&acc)[2][2][4][2], const pg8::Unit& un, int wr, int wc, int fr, int fq) const {
        const int row0 = un.pm * 256 + wr * 64 + fr;
        const int cl = wc * 32 + 8 * fq;
#pragma unroll
        for (int ai = 0; ai < 2; ++ai)
#pragma unroll
            for (int m = 0; m < 4; ++m) {
                const int row = row0 + ai * 128 + m * 16;
                const float rs = rstd[row];
                if (un.pn < 8) {
                    bf16_t* dst = (un.pn < 4 ? xm : sz) + (size_t)row * DM + (un.pn & 3) * 256 + cl;
#pragma unroll
                    for (int bj = 0; bj < 2; ++bj) {
                        f32x4 v0 = acc[ai][bj][m][0] * rs, v1 = acc[ai][bj][m][1] * rs;
                        if (un.pn >= 4) {
#pragma unroll
                            for (int j = 0; j < 4; ++j) { v0[j] = siluf_(v0[j]); v1[j] = siluf_(v1[j]); }
                        }
                        u32x4 w; w.x = pg8::cvt_pk_bf16(v0[0], v0[1]); w.y = pg8::cvt_pk_bf16(v0[2], v0[3]); w.z = pg8::cvt_pk_bf16(v1[0], v1[1]); w.w = pg8::cvt_pk_bf16(v1[2], v1[3]);
                        *(u32x4*)(dst + bj * 128) = w;
                    }
                } else {
                    bf16_t* dst = u + (size_t)row * DM + (un.pn - 8) * 128 + cl;
                    f32x4 o0, o1;
#pragma unroll
                    for (int j = 0; j < 4; ++j) {
                        o0[j] = (acc[ai][0][m][0][j] * rs) * sigmoidf_(acc[ai][1][m][0][j] * rs);
                        o1[j] = (acc[ai][0][m][1][j] * rs) * sigmoidf_(acc[ai][1][m][1][j] * rs);
                    }
                    u32x4 w; w.x = pg8::cvt_pk_bf16(o0[0], o0[1]); w.y = pg8::cvt_pk_bf16(o0[2], o0[3]); w.z = pg8::cvt_pk_bf16(o1[0], o1[1]); w.w = pg8::cvt_pk_bf16(o1[2], o1[3]);
                    *(u32x4*)dst = w;
                }
            }
    }
};

constexpr size_t WS_WGCNT = WS_SMALL + 8 * MiB;
constexpr size_t WS_ASGE = WS_SMALL + 9 * MiB;
constexpr size_t WS_ASGR = WS_SMALL + 10 * MiB;
constexpr size_t WS_ASGG = WS_SMALL + 11 * MiB;
constexpr size_t WS_RSTD2 = WS_SMALL + 12 * MiB;
constexpr size_t WS_SRSTD = WS_SMALL + 13 * MiB;
constexpr size_t WS_TOKSLOT = WS_SMALL + 14 * MiB;
constexpr size_t WS_TILEEXP = WS_SMALL + 15 * MiB;
constexpr size_t WS_HBF = WS_R1;
constexpr size_t WS_YROWS = 605 * MiB;
constexpr int NSLOT = NASSIGN + NEXP * 256;
constexpr int TOK_PER_WG = NTOK / 256;

__device__ __forceinline__ void phase_router(const MegaArgs& a, LAS unsigned char* lds, int tid, int lane, int wave) {
    unsigned char* ws = a.ws;
    const float* hbuf = a.out;
    const float* nfw = a.in[19]; const float* wr = a.in[20]; const float* br = a.in[21];
    bf16_t* hbf = (bf16_t*)(ws + WS_HBF);
    float* rstd2 = (float*)(ws + WS_RSTD2);
    int* wgcnt = (int*)(ws + WS_WGCNT); int* asg_e = (int*)(ws + WS_ASGE); int* asg_r = (int*)(ws + WS_ASGR); float* asg_g = (float*)(ws + WS_ASGG);
    LAS float* hrow = (LAS float*)lds;
    LAS float* part = (LAS float*)(lds + 65536);
    LAS float* logit = (LAS float*)(lds + 65536 + 16384);
    LAS int* topi_l = (LAS int*)(lds + 65536 + 16384 + 2048);
    LAS float* topg_l = (LAS float*)(lds + 65536 + 16384 + 4096);
    LAS float* rstd_l = (LAS float*)(lds + 65536 + 16384 + 6144);
    LAS int* rank_l = (LAS int*)(lds + 65536 + 16384 + 8192);
    const int b = blockIdx.x;
    const int e = lane & 31, half = lane >> 5;
    float wreg[64];
    {
        const int kb = wave * 128 + half * 64;
#pragma unroll
        for (int i = 0; i < 64; ++i) wreg[i] = nfw[kb + i] * wr[(size_t)(kb + i) * 32 + e];
    }
    for (int bt = 0; bt < TOK_PER_WG / 16; ++bt) {
        const int t0 = b * TOK_PER_WG + bt * 16;
        {
            const int row = tid >> 5, seg = tid & 31;
            const f32x4* src = (const f32x4*)(hbuf + (size_t)(t0 + row) * DM);
            float ss = 0.f;
#pragma unroll
            for (int j = 0; j < 8; ++j) {
                const f32x4 v = src[seg + 32 * j];
                ss += (v.x * v.x + v.y * v.y) + (v.z * v.z + v.w * v.w);
                *(LAS f32x4*)(hrow + row * 1024 + (seg + 32 * j) * 4) = v;
                u32x2 w; w.x = pk2(v.x, v.y); w.y = pk2(v.z, v.w);
                *(u32x2*)(hbf + (size_t)(t0 + row) * DM + (seg + 32 * j) * 4) = w;
            }
#pragma unroll
            for (int o = 16; o > 0; o >>= 1) ss += __shfl_xor(ss, o);
            if (seg == 0) { const float rs = rsqrtf(ss * (1.0f / DM) + EPSV); rstd_l[row] = rs; rstd2[t0 + row] = rs; }
        }
        __syncthreads();
        {
            const int kb = wave * 128 + half * 64;
            for (int tk = 0; tk < 16; ++tk) {
                const LAS f32x4* hp = (const LAS f32x4*)(hrow + tk * 1024 + kb);
                float acc = 0.f;
#pragma unroll
                for (int i = 0; i < 16; ++i) { const f32x4 v = hp[i]; acc += v.x * wreg[4 * i] + v.y * wreg[4 * i + 1] + v.z * wreg[4 * i + 2] + v.w * wreg[4 * i + 3]; }
                acc += __shfl_xor(acc, 32);
                if (half == 0) part[(wave * 16 + tk) * 32 + e] = acc;
            }
        }
        __syncthreads();
        {
            const int tk = tid >> 5, ee = tid & 31;
            float s = 0.f;
#pragma unroll
            for (int w = 0; w < 8; ++w) s += part[(w * 16 + tk) * 32 + ee];
            logit[tk * 32 + ee] = s * rstd_l[tk] + br[ee];
        }
        __syncthreads();
        if (tid < 16) {
            int sel[4]; float val[4];
            unsigned used = 0u;
#pragma unroll
            for (int r = 0; r < 4; r++) {
                int bi = -1; float bv = 0.f;
                for (int ee = 0; ee < 32; ee++) {
                    if (used & (1u << ee)) continue;
                    const float xx = logit[tid * 32 + ee];
                    if (bi < 0 || xx > bv) { bi = ee; bv = xx; }
                }
                used |= 1u << bi;
                sel[r] = bi; val[r] = bv;
            }
            float ex[4], sum = 0.f;
#pragma unroll
            for (int r = 0; r < 4; r++) { ex[r] = __expf(val[r] - val[0]); sum += ex[r]; }
            const float inv = 1.0f / sum;
#pragma unroll
            for (int r = 0; r < 4; r++) { topi_l[(bt * 16 + tid) * 4 + r] = sel[r]; topg_l[(bt * 16 + tid) * 4 + r] = ex[r] * inv; }
        }
        __syncthreads();
    }
    if (wave == 0 && lane < 32) {
        int run = 0;
        for (int i = 0; i < TOK_PER_WG * 4; ++i) { const int ee = topi_l[i]; if (ee == lane) { rank_l[i] = run; ++run; } }
        wgcnt[b * 32 + lane] = run;
    }
    __syncthreads();
    {
        int i = tid; asm volatile("" : "+v"(i));
        const int aidx = b * TOK_PER_WG * 4 + i;
        asg_e[aidx] = topi_l[i]; asg_r[aidx] = rank_l[i]; asg_g[aidx] = topg_l[i];
    }
}

__device__ __forceinline__ void phase_slots(const MegaArgs& a, LAS unsigned char* lds, int tid) {
    unsigned char* ws = a.ws;
    const int* wgcnt = (const int*)(ws + WS_WGCNT); const int* asg_e = (const int*)(ws + WS_ASGE); const int* asg_r = (const int*)(ws + WS_ASGR); const float* asg_g = (const float*)(ws + WS_ASGG);
    const float* rstd2 = (const float*)(ws + WS_RSTD2);
    int* slot_tok = (int*)(ws + WS_STOK); float* slot_gate = (float*)(ws + WS_SGATE); float* slot_rstd = (float*)(ws + WS_SRSTD);
    int* tok_slot = (int*)(ws + WS_TOKSLOT); int* tile_exp = (int*)(ws + WS_TILEEXP);
    LAS int* tot = (LAS int*)lds; LAS int* bef = tot + 32; LAS int* tstart = bef + 32;
    const int b = blockIdx.x;
    if (tid < 32) {
        int t = 0, bf = 0;
        for (int bb = 0; bb < 256; ++bb) { const int c = wgcnt[bb * 32 + tid]; t += c; if (bb < b) bf += c; }
        tot[tid] = t; bef[tid] = bf;
    }
    __syncthreads();
    if (tid == 0) { int ts = 0; for (int e = 0; e < 32; ++e) { tstart[e] = ts; ts += (tot[e] + 255) >> 8; } tstart[32] = ts; }
    __syncthreads();
    {
        int tid_o = tid; asm volatile("" : "+v"(tid_o));
        const int aidx = b * TOK_PER_WG * 4 + tid_o;
        const int e = asg_e[aidx];
        const int slot = 256 * tstart[e] + bef[e] + asg_r[aidx];
        const int tk = aidx >> 2;
        slot_tok[slot] = tk; slot_gate[slot] = asg_g[aidx]; slot_rstd[slot] = rstd2[tk]; tok_slot[aidx] = slot;
    }
    if (b < 32) {
        const int e = b; const int s0 = 256 * tstart[e] + tot[e], s1 = 256 * tstart[e + 1];
        for (int s = s0 + tid; s < s1; s += NWAVES * 64) { slot_tok[s] = 0; slot_gate[s] = 0.f; slot_rstd[s] = 0.f; }
    }
    if (b == 0) {
        if (tid < 32) for (int t = tstart[tid]; t < tstart[tid + 1]; ++t) tile_exp[t] = tid;
        if (tid == 0) tile_exp[2048] = tstart[32];
    }
}

struct MoeOrder {
    const char* A; const char* Bt; const int* gidx; const int* tile_exp; size_t a_tile_bytes, b_exp_bytes, b_tile_bytes; int T, nN, group, c;
    __device__ __forceinline__ bool next(int i, pg8::Unit& u) const {
        const int x = c & 7, j = c >> 3;
        const int tile = (i * 8 + x) * group + (j % group);
        if (tile >= T) return false;
        const int e = tile_exp[tile];
        u.pm = tile; u.pn = j / group; u.aux = e;
        u.gidx = gidx ? gidx + 256 * tile : nullptr;
        u.A = gidx ? A : A + (size_t)tile * a_tile_bytes;
        u.B = Bt + (size_t)e * b_exp_bytes + (size_t)u.pn * b_tile_bytes;
        return true;
    }
};

struct EpiMoe1 {
    const float* srstd; const float* b1; bf16_t* act;
    __device__ __forceinline__ void operator()(const f32x4 (&acc)[2][2][4][2], const pg8::Unit& un, int wr, int wc, int fr, int fq) const {
        const int e = un.aux;
        const int cl = un.pn * 128 + wc * 32 + 8 * fq;
        f32x4 bg[2], bl[2];
#pragma unroll
        for (int n = 0; n < 2; ++n) { bg[n] = *(const f32x4*)(b1 + (size_t)e * 2048 + cl + 4 * n); bl[n] = *(const f32x4*)(b1 + (size_t)e * 2048 + 1024 + cl + 4 * n); }
        const int slot0 = un.pm * 256 + wr * 64 + fr;
#pragma unroll
        for (int ai = 0; ai < 2; ++ai)
#pragma unroll
            for (int m = 0; m < 4; ++m) {
                const int slot = slot0 + ai * 128 + m * 16;
                const float rs = srstd[slot];
                f32x4 o[2];
#pragma unroll
                for (int n = 0; n < 2; ++n)
#pragma unroll
                    for (int j = 0; j < 4; ++j) {
                        const float g = acc[ai][0][m][n][j] * rs + bg[n][j];
                        const float l = acc[ai][1][m][n][j] * rs + bl[n][j];
                        const float xg = fminf(g, 7.0f);
                        const float xl = fminf(fmaxf(l, -7.0f), 7.0f);
                        o[n][j] = xg * sigmoidf_(1.702f * xg) * (xl + 1.0f);
                    }
                u32x4 w; w.x = pg8::cvt_pk_bf16(o[0][0], o[0][1]); w.y = pg8::cvt_pk_bf16(o[0][2], o[0][3]); w.z = pg8::cvt_pk_bf16(o[1][0], o[1][1]); w.w = pg8::cvt_pk_bf16(o[1][2], o[1][3]);
                *(u32x4*)(act + (size_t)slot * DM + cl) = w;
            }
    }
};
struct EpiMoe2 {
    const float* sgate; const float* b2; bf16_t* yrows;
    __device__ __forceinline__ void operator()(const f32x4 (&acc)[2][2][4][2], const pg8::Unit& un, int wr, int wc, int fr, int fq) const {
        const int e = un.aux;
        const int c0 = un.pn * 256 + wc * 32 + 8 * fq;
        f32x4 bv[2][2];
#pragma unroll
        for (int bj = 0; bj < 2; ++bj)
#pragma unroll
            for (int n = 0; n < 2; ++n) bv[bj][n] = *(const f32x4*)(b2 + (size_t)e * DM + c0 + bj * 128 + 4 * n);
        const int slot0 = un.pm * 256 + wr * 64 + fr;
#pragma unroll
        for (int ai = 0; ai < 2; ++ai)
#pragma unroll
            for (int m = 0; m < 4; ++m) {
                const int slot = slot0 + ai * 128 + m * 16;
                const float gt = sgate[slot];
#pragma unroll
                for (int bj = 0; bj < 2; ++bj) {
                    const f32x4 v0 = (acc[ai][bj][m][0] + bv[bj][0]) * gt, v1 = (acc[ai][bj][m][1] + bv[bj][1]) * gt;
                    u32x4 w; w.x = pg8::cvt_pk_bf16(v0[0], v0[1]); w.y = pg8::cvt_pk_bf16(v0[2], v0[3]); w.z = pg8::cvt_pk_bf16(v1[0], v1[1]); w.w = pg8::cvt_pk_bf16(v1[2], v1[3]);
                    *(u32x4*)(yrows + (size_t)slot * DM + c0 + bj * 128) = w;
                }
            }
    }
};

__device__ __forceinline__ void phase_final(const MegaArgs& a, int gw, int NGW, int lane) {
    unsigned char* ws = a.ws;
    float* hbuf = a.out; const float* fw = a.in[26];
    const bf16_t* yrows = (const bf16_t*)(ws + WS_YROWS); const int* tok_slot = (const int*)(ws + WS_TOKSLOT);
    for (int t = gw; t < NTOK; t += NGW) {
        f32x4* hp = (f32x4*)(hbuf + (size_t)t * DM) + lane;
        f32x4 v[4];
#pragma unroll
        for (int j = 0; j < 4; ++j) v[j] = hp[64 * j];
#pragma unroll
        for (int r = 0; r < 4; ++r) {
            const int slot = tok_slot[t * 4 + r];
            const u32x2* yp = (const u32x2*)(yrows + (size_t)slot * DM) + lane;
#pragma unroll
            for (int j = 0; j < 4; ++j) {
                const u32x2 w = yp[64 * j];
                v[j].x += __uint_as_float(w.x << 16); v[j].y += __uint_as_float(w.x & 0xFFFF0000u);
                v[j].z += __uint_as_float(w.y << 16); v[j].w += __uint_as_float(w.y & 0xFFFF0000u);
            }
        }
        float s = 0.f;
#pragma unroll
        for (int j = 0; j < 4; ++j) s += (v[j].x * v[j].x + v[j].y * v[j].y) + (v[j].z * v[j].z + v[j].w * v[j].w);
        s = wave_sum(s);
        const float rs = rsqrtf(s * (1.0f / DM) + EPSV);
#pragma unroll
        for (int j = 0; j < 4; ++j) {
            const f32x4 w = *((const f32x4*)fw + lane + 64 * j);
            f32x4 o; o.x = v[j].x * rs * w.x; o.y = v[j].y * rs * w.y; o.z = v[j].z * rs * w.z; o.w = v[j].w * rs * w.w;
            hp[64 * j] = o;
        }
    }
}

constexpr int CT = 8;
__device__ __forceinline__ void phase_conv31(const MegaArgs& a, LAS unsigned char* lds, int tid, int lane, int wave, int G) {
    unsigned char* ws = a.ws;
    const __amdgpu_buffer_rsrc_t urs = __builtin_amdgcn_make_buffer_rsrc((void*)(ws + WS_U), 0, NTOK * 2048, 0x00020000);
    const float* cb = a.in[15]; const float* nw = a.in[16]; const float* nb = a.in[17];
    const __amdgpu_buffer_rsrc_t wrs = __builtin_amdgcn_make_buffer_rsrc((void*)a.in[14], 0, 31 * 4096, 0x00020000);
    unsigned* ymix = (unsigned*)(ws + WS_YMIX);
    LAS float* red = (LAS float*)lds;
    const f32x2 bias = *(const f32x2*)(cb + 2 * tid);
    const f32x2 gw2 = *(const f32x2*)(nw + 2 * tid);
    const f32x2 gb2 = *(const f32x2*)(nb + 2 * tid);
    for (int it = blockIdx.x; it < NTOK / CT; it += G) {
        const int t0 = it * CT;
        const int s0 = t0 & (SEQ - 1);
        unsigned uw[CT + 30];
#pragma unroll
        for (int r = 0; r < CT + 30; ++r) {
            const int sp = s0 - 30 + r;
            uw[r] = (sp >= 0) ? (unsigned)__builtin_amdgcn_raw_buffer_load_b32(urs, tid * 4, (t0 - 30 + r) * 2048, 0) : 0u;
        }
        float acc0[CT], acc1[CT];
#pragma unroll
        for (int t = 0; t < CT; ++t) { acc0[t] = bias.x; acc1[t] = bias.y; }
#pragma unroll
        for (int k = 0; k < 31; ++k) {
            const u32x2 wraw = __builtin_amdgcn_raw_buffer_load_b64(wrs, tid * 8, k * 4096, 0);
            f32x2 w; w.x = __uint_as_float(wraw.x); w.y = __uint_as_float(wraw.y);
#pragma unroll
            for (int t = 0; t < CT; ++t) {
                const unsigned p = uw[t + k];
                acc0[t] += w.x * __uint_as_float(p << 16);
                acc1[t] += w.y * __uint_as_float(p & 0xFFFF0000u);
            }
        }
        float sm[CT], sq[CT];
#pragma unroll
        for (int t = 0; t < CT; ++t) { sm[t] = acc0[t] + acc1[t]; sq[t] = acc0[t] * acc0[t] + acc1[t] * acc1[t]; }
#pragma unroll
        for (int t = 0; t < CT; ++t) { sm[t] = wave_sum(sm[t]); sq[t] = wave_sum(sq[t]); }
        __syncthreads();
        if (lane == 0) {
#pragma unroll
            for (int t = 0; t < CT; ++t) { red[wave * 32 + t] = sm[t]; red[wave * 32 + CT + t] = sq[t]; }
        }
        __syncthreads();
#pragma unroll
        for (int t = 0; t < CT; ++t) {
            float s = 0.f, q = 0.f;
#pragma unroll
            for (int w = 0; w < 8; ++w) { s += red[w * 32 + t]; q += red[w * 32 + CT + t]; }
            const float mean = s * (1.0f / DM);
            const float var = fmaxf(q * (1.0f / DM) - mean * mean, 0.f);
            const float rs = rsqrtf(var + EPSV);
            const float y0 = siluf_((acc0[t] - mean) * rs * gw2.x + gb2.x);
            const float y1 = siluf_((acc1[t] - mean) * rs * gw2.y + gb2.y);
            ymix[(size_t)(t0 + t) * 1024 + 512 + tid] = pk2(y0, y1);
        }
    }
}

__device__ __forceinline__ void phase_ym(const MegaArgs& a, int gw, int NGW, int lane) {
    unsigned char* ws = a.ws;
    const bf16_t* xm = (const bf16_t*)(ws + WS_XM); const bf16_t* szb = (const bf16_t*)(ws + WS_SZ); const bf16_t* hm = (const bf16_t*)(ws + WS_R1);
    bf16_t* ymix = (bf16_t*)(ws + WS_YMIX);
    const float* cw = a.in[3]; const float* cb = a.in[4]; const float* mnw = a.in[12]; const float* skip = a.in[13];
    for (int t = gw; t < NTOK; t += NGW) {
        const int s = t & (SEQ - 1);
#pragma unroll
        for (int j = 0; j < 4; ++j) {
            const int ch = 4 * lane + 256 * j;
            f32x4 xc = *(const f32x4*)(cb + ch);
#pragma unroll
            for (int kk = 0; kk < 4; ++kk) {
                if (s - 3 + kk >= 0) {
                    const u32x2 raw = *(const u32x2*)(xm + (size_t)(t - 3 + kk) * DM + ch);
                    const f32x4 w = *(const f32x4*)(cw + kk * DM + ch);
                    xc.x += w.x * __uint_as_float(raw.x << 16); xc.y += w.y * __uint_as_float(raw.x & 0xFFFF0000u);
                    xc.z += w.z * __uint_as_float(raw.y << 16); xc.w += w.w * __uint_as_float(raw.y & 0xFFFF0000u);
                }
            }
            xc.x = siluf_(xc.x); xc.y = siluf_(xc.y); xc.z = siluf_(xc.z); xc.w = siluf_(xc.w);
            const u32x2 hr = *(const u32x2*)(hm + (size_t)t * DM + ch);
            f32x4 hv; hv.x = __uint_as_float(hr.x << 16); hv.y = __uint_as_float(hr.x & 0xFFFF0000u); hv.z = __uint_as_float(hr.y << 16); hv.w = __uint_as_float(hr.y & 0xFFFF0000u);
            const float mean = wave_sum((hv.x + hv.y) + (hv.z + hv.w)) * (1.0f / 256.0f);
            const f32x4 d = hv - mean;
            const float var = wave_sum((d.x * d.x + d.y * d.y) + (d.z * d.z + d.w * d.w)) * (1.0f / 256.0f);
            const float rs = rsqrtf(var + EPSV);
            const f32x4 nwv = *(const f32x4*)(mnw + ch); const f32x4 sk = *(const f32x4*)(skip + ch);
            const u32x2 zr = *(const u32x2*)(szb + (size_t)t * DM + ch);
            f32x4 zv; zv.x = __uint_as_float(zr.x << 16); zv.y = __uint_as_float(zr.x & 0xFFFF0000u); zv.z = __uint_as_float(zr.y << 16); zv.w = __uint_as_float(zr.y & 0xFFFF0000u);
            const f32x4 y = (d * rs * nwv + sk * xc) * zv;
            u32x2 o; o.x = pk2(y.x, y.y); o.y = pk2(y.z, y.w);
            *(u32x2*)(ymix + (size_t)t * 2048 + ch) = o;
        }
    }
}

struct EpiOutProj {
    const float* x; float* hout; bf16_t* hbf;
    __device__ __forceinline__ void operator()(const f32x4 (&acc)[2][2][4][2], const pg8::Unit& un, int wr, int wc, int fr, int fq) const {
        const int row0 = un.pm * 256 + wr * 64 + fr;
        const int c0 = un.pn * 256 + wc * 32 + 8 * fq;
#pragma unroll
        for (int ai = 0; ai < 2; ++ai)
#pragma unroll
            for (int m = 0; m < 4; ++m) {
                const size_t off = (size_t)(row0 + ai * 128 + m * 16) * DM + c0;
#pragma unroll
                for (int bj = 0; bj < 2; ++bj) {
                    const f32x4 x0 = *(const f32x4*)(x + off + bj * 128), x1 = *(const f32x4*)(x + off + bj * 128 + 4);
                    const f32x4 v0 = acc[ai][bj][m][0] + x0, v1 = acc[ai][bj][m][1] + x1;
                    *(f32x4*)(hout + off + bj * 128) = v0; *(f32x4*)(hout + off + bj * 128 + 4) = v1;
                    u32x4 w; w.x = pg8::cvt_pk_bf16(v0[0], v0[1]); w.y = pg8::cvt_pk_bf16(v0[2], v0[3]); w.z = pg8::cvt_pk_bf16(v1[0], v1[1]); w.w = pg8::cvt_pk_bf16(v1[2], v1[3]);
                    *(u32x4*)(hbf + off + bj * 128) = w;
                }
            }
    }
};

constexpr size_t WS_GCT = WS_SMALL + 512 * 1024;
constexpr size_t WS_GVT = WS_GCT + 32 * 1024;
constexpr size_t WS_FCUM = WS_SMALL + 3 * MiB;
constexpr size_t WS_UVAL = WS_SMALL + 4 * MiB;
constexpr size_t WS_MVAL = WS_SMALL + 7 * MiB;
constexpr size_t WS_ITEMS = WS_SMALL + 8 * MiB;
constexpr size_t WS_DN = WS_SMALL + 9 * MiB;
constexpr size_t WS_NPREV = WS_SMALL + 10 * MiB;
constexpr size_t WS_QB = 477 * MiB;
constexpr size_t WS_KB = 541 * MiB;
constexpr size_t WS_AEXT = 605 * MiB;
constexpr size_t WS_BEXT = 733 * MiB;
constexpr size_t WS_DCT = 861 * MiB;
constexpr size_t WS_KWT = WS_R1;
constexpr size_t WS_HM = WS_R1;
constexpr int RINV_OFF = LDSCTL_OFF + 1024;

__device__ __forceinline__ void unpack8(const u32x4 r, float (&f)[8]) {
    f[0] = __uint_as_float(r.x << 16); f[1] = __uint_as_float(r.x & 0xFFFF0000u); f[2] = __uint_as_float(r.y << 16); f[3] = __uint_as_float(r.y & 0xFFFF0000u);
    f[4] = __uint_as_float(r.z << 16); f[5] = __uint_as_float(r.z & 0xFFFF0000u); f[6] = __uint_as_float(r.w << 16); f[7] = __uint_as_float(r.w & 0xFFFF0000u);
}

__device__ __forceinline__ void p0_gate_tables(const MegaArgs& a, int gw, int NGW, int lane) {
    const float* wq = a.in[5]; const float* wk = a.in[6]; const float* wv = a.in[7]; const float* wig = a.in[8]; const float* wfg = a.in[10];
    bf16_t* gct = (bf16_t*)(a.ws + WS_GCT);
    for (int idx = gw * 64 + lane; idx < 2 * 16 * 1024; idx += NGW * 64) {
        const int tbl = idx >> 14, col = (idx >> 10) & 15, ch = idx & 1023;
        float v = 0.f;
        if (col < 8) {
            const float* Wg = (col < 4) ? wig : wfg; const int hh = col & 3, n = ch >> 2, i = ch & 3;
#pragma unroll
            for (int o = 0; o < 4; ++o) {
                if (tbl == 0) v += wq[n * 16 + i * 4 + o] * Wg[(size_t)(4 * n + o) * 4 + hh] + wk[n * 16 + i * 4 + o] * Wg[(size_t)(1024 + 4 * n + o) * 4 + hh];
                else v += wv[n * 16 + i * 4 + o] * Wg[(size_t)(2048 + 4 * n + o) * 4 + hh];
            }
        }
        gct[idx] = f2bf(v);
    }
}

__device__ __forceinline__ void phase_gates(const MegaArgs& a, int gw, int NGW, int lane) {
    unsigned char* ws = a.ws;
    const bf16_t* xm = (const bf16_t*)(ws + WS_XM);
    const bf16_t* gct = (const bf16_t*)(ws + WS_GCT); const bf16_t* gvt = (const bf16_t*)(ws + WS_GVT);
    const float* cw = a.in[3]; const float* cb = a.in[4]; const float* big = a.in[9]; const float* bfg = a.in[11];
    float* logi = (float*)(ws + WS_LOGI); float* logf = (float*)(ws + WS_LOGF);
    const int tok = lane & 15, kq = lane >> 4;
    for (int tile = gw; tile < NTOK / 16; tile += NGW) {
        const int t = tile * 16 + tok, s = t & (SEQ - 1);
        f32x4 acc = (f32x4){0.f, 0.f, 0.f, 0.f};
        for (int ks = 0; ks < 32; ++ks) {
            const int ch0 = 32 * ks + 8 * kq;
            float xc[8];
            {
                const f32x4 b0 = *(const f32x4*)(cb + ch0), b1 = *(const f32x4*)(cb + ch0 + 4);
                xc[0] = b0.x; xc[1] = b0.y; xc[2] = b0.z; xc[3] = b0.w; xc[4] = b1.x; xc[5] = b1.y; xc[6] = b1.z; xc[7] = b1.w;
            }
            u32x4 cur = (u32x4){0u, 0u, 0u, 0u};
#pragma unroll
            for (int kk = 0; kk < 4; ++kk) {
                u32x4 raw = (u32x4){0u, 0u, 0u, 0u};
                if (s - 3 + kk >= 0) raw = *(const u32x4*)(xm + (size_t)(t - 3 + kk) * DM + ch0);
                if (kk == 3) cur = raw;
                float xf[8]; unpack8(raw, xf);
                const f32x4 w0 = *(const f32x4*)(cw + kk * DM + ch0), w1 = *(const f32x4*)(cw + kk * DM + ch0 + 4);
                xc[0] += w0.x * xf[0]; xc[1] += w0.y * xf[1]; xc[2] += w0.z * xf[2]; xc[3] += w0.w * xf[3];
                xc[4] += w1.x * xf[4]; xc[5] += w1.y * xf[5]; xc[6] += w1.z * xf[6]; xc[7] += w1.w * xf[7];
            }
#pragma unroll
            for (int i = 0; i < 8; ++i) xc[i] = siluf_(xc[i]);
            u32x4 a1; a1.x = pk2(xc[0], xc[1]); a1.y = pk2(xc[2], xc[3]); a1.z = pk2(xc[4], xc[5]); a1.w = pk2(xc[6], xc[7]);
            const u32x4 b1 = *(const u32x4*)(gct + (size_t)tok * 1024 + ch0);
            const u32x4 b2 = *(const u32x4*)(gvt + (size_t)tok * 1024 + ch0);
            acc = __builtin_amdgcn_mfma_f32_16x16x32_bf16(__builtin_bit_cast(bf16x8, a1), __builtin_bit_cast(bf16x8, b1), acc, 0, 0, 0);
            acc = __builtin_amdgcn_mfma_f32_16x16x32_bf16(__builtin_bit_cast(bf16x8, cur), __builtin_bit_cast(bf16x8, b2), acc, 0, 0, 0);
        }
        const int col = lane & 15;
        if (col < 8) {
            const int hh = col & 3;
#pragma unroll
            for (int r = 0; r < 4; ++r) {
                const int tt = tile * 16 + 4 * kq + r;
                if (col < 4) logi[(size_t)hh * NTOK + tt] = acc[r] + big[hh];
                else logf[(size_t)hh * NTOK + tt] = logsigmoidf_(acc[r] + bfg[hh]);
            }
        }
    }
}

__device__ __forceinline__ void phase_prep(const MegaArgs& a, LAS unsigned char* lds, int tid, int lane, int wave, int G) {
    unsigned char* ws = a.ws;
    const float* logi = (const float*)(ws + WS_LOGI); const float* logf = (const float*)(ws + WS_LOGF);
    float* Fcum = (float*)(ws + WS_FCUM); float* Uval = (float*)(ws + WS_UVAL); float* Mval = (float*)(ws + WS_MVAL);
    float* items = (float*)(ws + WS_ITEMS); float* dn = (float*)(ws + WS_DN);
    const bf16_t* xm = (const bf16_t*)(ws + WS_XM);
    bf16_t* qb = (bf16_t*)(ws + WS_QB); bf16_t* kb = (bf16_t*)(ws + WS_KB); bf16_t* aext = (bf16_t*)(ws + WS_AEXT); bf16_t* bext = (bf16_t*)(ws + WS_BEXT); bf16_t* kwt = (bf16_t*)(ws + WS_KWT);
    const float* cw = a.in[3]; const float* cb = a.in[4]; const float* wq = a.in[5]; const float* wk = a.in[6]; const float* wv = a.in[7];
    LAS float* gch = (LAS float*)lds;
    LAS float* umaxch = gch + 32;
    LAS float* wint_l = umaxch + 32;
    LAS float* wst_l = wint_l + 256;
    LAS float* dn_l = wst_l + 256;
    for (int it = blockIdx.x; it < 512; it += G) {
        const int bh = it >> 5, c = it & 31, b = bh >> 2, h = bh & 3;
        const int tb = b * SEQ, t0 = tb + c * 256;
        {
            const int cc = tid >> 4, sub = tid & 15;
            const size_t gbase = (size_t)h * NTOK + tb + cc * 256 + 16 * sub;
            float F[16], u[16];
            {
                const f32x4* lfp = (const f32x4*)(logf + gbase); const f32x4* lip = (const f32x4*)(logi + gbase);
#pragma unroll
                for (int q4 = 0; q4 < 4; ++q4) { const f32x4 v = lfp[q4], w = lip[q4]; F[4 * q4] = v.x; F[4 * q4 + 1] = v.y; F[4 * q4 + 2] = v.z; F[4 * q4 + 3] = v.w; u[4 * q4] = w.x; u[4 * q4 + 1] = w.y; u[4 * q4 + 2] = w.z; u[4 * q4 + 3] = w.w; }
            }
#pragma unroll
            for (int jj = 1; jj < 16; ++jj) F[jj] += F[jj - 1];
            const float total = F[15];
            float incl = total;
#pragma unroll
            for (int o = 1; o < 16; o <<= 1) { const float v = __shfl_up(incl, o, 16); if (sub >= o) incl += v; }
            const float excl = incl - total;
            float um = -3.0e38f;
#pragma unroll
            for (int jj = 0; jj < 16; ++jj) { F[jj] += excl; u[jj] -= F[jj]; um = fmaxf(um, u[jj]); }
            float umx = um;
#pragma unroll
            for (int o = 1; o < 16; o <<= 1) umx = fmaxf(umx, __shfl_xor(umx, o, 16));
            const float gsum = __shfl(incl, 15, 16);
            if (sub == 0) { gch[cc] = gsum; umaxch[cc] = umx; }
            float cm[16]; cm[0] = u[0];
#pragma unroll
            for (int jj = 1; jj < 16; ++jj) cm[jj] = fmaxf(cm[jj - 1], u[jj]);
            float inclm = cm[15];
#pragma unroll
            for (int o = 1; o < 16; o <<= 1) { const float v = __shfl_up(inclm, o, 16); if (sub >= o) inclm = fmaxf(inclm, v); }
            float exclm = __shfl_up(inclm, 1, 16); if (sub == 0) exclm = -3.0e38f;
            __syncthreads();
            float m = 0.f;
            for (int c2 = 0; c2 < c; ++c2) m = gch[c2] + fmaxf(m, umaxch[c2]);
            const float mprev = m, g_c = gch[c], umax_c = umaxch[c], m_c = g_c + fmaxf(mprev, umax_c);
            if (tid == 0) { items[it] = __expf(g_c + mprev - m_c); items[512 + it] = __expf(g_c + umax_c - m_c); items[1024 + it] = mprev; }
            if (cc == c) {
#pragma unroll
                for (int jj = 0; jj < 16; ++jj) {
                    const float M = fmaxf(mprev, fmaxf(cm[jj], exclm));
                    Fcum[gbase + jj] = F[jj]; Uval[gbase + jj] = u[jj]; Mval[gbase + jj] = M;
                    wint_l[16 * sub + jj] = __expf(mprev - M); wst_l[16 * sub + jj] = __expf(u[jj] - umax_c);
                }
            }
            __syncthreads();
        }
        {
            const int ch = h * 256 + 4 * lane;
            float cwv[4][4], wqv[16], wkv[16], wvv[16];
            const f32x4 cbv = *(const f32x4*)(cb + ch);
#pragma unroll
            for (int kk = 0; kk < 4; ++kk) { const f32x4 w = *(const f32x4*)(cw + kk * DM + ch); cwv[kk][0] = w.x; cwv[kk][1] = w.y; cwv[kk][2] = w.z; cwv[kk][3] = w.w; }
            {
                const int n = ch >> 2;
#pragma unroll
                for (int q4 = 0; q4 < 4; ++q4) {
                    const f32x4 x1 = *(const f32x4*)(wq + n * 16 + 4 * q4), x2 = *(const f32x4*)(wk + n * 16 + 4 * q4), x3 = *(const f32x4*)(wv + n * 16 + 4 * q4);
                    wqv[4 * q4] = x1.x; wqv[4 * q4 + 1] = x1.y; wqv[4 * q4 + 2] = x1.z; wqv[4 * q4 + 3] = x1.w;
                    wkv[4 * q4] = x2.x; wkv[4 * q4 + 1] = x2.y; wkv[4 * q4 + 2] = x2.z; wkv[4 * q4 + 3] = x2.w;
                    wvv[4 * q4] = x3.x; wvv[4 * q4 + 1] = x3.y; wvv[4 * q4 + 2] = x3.z; wvv[4 * q4 + 3] = x3.w;
                }
            }
            float xw[3][4];
            const int i0 = 32 * wave;
#pragma unroll
            for (int kk = 0; kk < 3; ++kk) {
                const int sp = c * 256 + i0 - 3 + kk;
                u32x2 raw = (u32x2){0u, 0u};
                if (sp >= 0) raw = *(const u32x2*)(xm + (size_t)(t0 + i0 - 3 + kk) * DM + ch);
                xw[kk][0] = __uint_as_float(raw.x << 16); xw[kk][1] = __uint_as_float(raw.x & 0xFFFF0000u); xw[kk][2] = __uint_as_float(raw.y << 16); xw[kk][3] = __uint_as_float(raw.y & 0xFFFF0000u);
            }
            float dnacc[4] = {0.f, 0.f, 0.f, 0.f};
            for (int pb = 0; pb < 4; ++pb) {
                unsigned vtp[4][4], kwp[4][4];
                float vprev[4], kprev[4];
#pragma unroll
                for (int pp = 0; pp < 8; ++pp) {
                    const int i = i0 + pb * 8 + pp;
                    const u32x2 raw = *(const u32x2*)(xm + (size_t)(t0 + i) * DM + ch);
                    float x3[4];
                    x3[0] = __uint_as_float(raw.x << 16); x3[1] = __uint_as_float(raw.x & 0xFFFF0000u); x3[2] = __uint_as_float(raw.y << 16); x3[3] = __uint_as_float(raw.y & 0xFFFF0000u);
                    float xc[4];
#pragma unroll
                    for (int cc = 0; cc < 4; ++cc) xc[cc] = siluf_(cbv[cc] + cwv[0][cc] * xw[0][cc] + cwv[1][cc] * xw[1][cc] + cwv[2][cc] * xw[2][cc] + cwv[3][cc] * x3[cc]);
                    float qv[4], kv[4], vv[4];
#pragma unroll
                    for (int o = 0; o < 4; ++o) {
                        qv[o] = (xc[0] * wqv[o] + xc[1] * wqv[4 + o] + xc[2] * wqv[8 + o] + xc[3] * wqv[12 + o]) * 0.0625f;
                        kv[o] = xc[0] * wkv[o] + xc[1] * wkv[4 + o] + xc[2] * wkv[8 + o] + xc[3] * wkv[12 + o];
                        vv[o] = x3[0] * wvv[o] + x3[1] * wvv[4 + o] + x3[2] * wvv[8 + o] + x3[3] * wvv[12 + o];
                    }
                    const float wi = wint_l[i], wsj = wst_l[i];
                    u32x2 o2;
                    o2.x = pk2(qv[0], qv[1]); o2.y = pk2(qv[2], qv[3]);
                    *(u32x2*)(qb + (size_t)(t0 + i) * DM + ch) = o2;
                    o2.x = pk2(kv[0], kv[1]); o2.y = pk2(kv[2], kv[3]);
                    *(u32x2*)(kb + (size_t)(t0 + i) * DM + ch) = o2;
                    o2.x = pk2(qv[0] * wi, qv[1] * wi); o2.y = pk2(qv[2] * wi, qv[3] * wi);
                    *(u32x2*)(aext + ((size_t)it * 256 + i) * 512 + 256 + 4 * lane) = o2;
#pragma unroll
                    for (int o = 0; o < 4; ++o) {
                        const float kwv = kv[o] * wsj;
                        dnacc[o] += kwv;
                        if (pp & 1) { vtp[o][pp >> 1] = pk2(vprev[o], vv[o]); kwp[o][pp >> 1] = pk2(kprev[o], kwv); }
                        else { vprev[o] = vv[o]; kprev[o] = kwv; }
                    }
#pragma unroll
                    for (int cc = 0; cc < 4; ++cc) { xw[0][cc] = xw[1][cc]; xw[1][cc] = xw[2][cc]; xw[2][cc] = x3[cc]; }
                }
                const int j0 = i0 + pb * 8;
#pragma unroll
                for (int o = 0; o < 4; ++o) {
                    u32x4 w; w.x = vtp[o][0]; w.y = vtp[o][1]; w.z = vtp[o][2]; w.w = vtp[o][3];
                    *(u32x4*)(bext + ((size_t)it * 256 + 4 * lane + o) * 512 + j0) = w;
                    u32x4 w2; w2.x = kwp[o][0]; w2.y = kwp[o][1]; w2.z = kwp[o][2]; w2.w = kwp[o][3];
                    *(u32x4*)(kwt + ((size_t)it * 256 + 4 * lane + o) * 256 + j0) = w2;
                }
            }
#pragma unroll
            for (int o = 0; o < 4; ++o) dn_l[wave * 256 + 4 * lane + o] = dnacc[o];
            __syncthreads();
            if (tid < 256) {
                float s = 0.f;
#pragma unroll
                for (int w = 0; w < 8; ++w) s += dn_l[w * 256 + tid];
                dn[(size_t)it * 256 + tid] = s;
            }
            __syncthreads();
        }
    }
}

struct ItemOrder {
    const char* A; const char* B; size_t a_item_bytes, b_item_bytes; int per_token; int G, c;
    __device__ __forceinline__ bool next(int i, pg8::Unit& u) const {
        const int it = i * G + c; if (it >= 512) return false;
        u.pm = it; u.pn = 0; u.aux = i; u.gidx = nullptr;
        if (per_token) { const int bh = it >> 5, cc = it & 31, b = bh >> 2, h = bh & 3; const size_t off = ((size_t)(b * SEQ + cc * 256) * DM + h * 256) * 2; u.A = A + off; u.B = B + off; }
        else { u.A = A + (size_t)it * a_item_bytes; u.B = B + (size_t)it * b_item_bytes; }
        return true;
    }
};
struct EpiP {
    const float* Uval; const float* Mval; bf16_t* aext;
    __device__ __forceinline__ void operator()(const f32x4 (&acc)[2][2][4][2], const pg8::Unit& un, int wr, int wc, int fr, int fq) const {
        const int it = un.pm, bh = it >> 5, cc = it & 31, b = bh >> 2, h = bh & 3;
        const size_t gb = (size_t)h * NTOK + b * SEQ + cc * 256;
        const int jb = wc * 32 + 8 * fq;
#pragma unroll
        for (int bj = 0; bj < 2; ++bj) {
            f32x4 uj[2];
#pragma unroll
            for (int n = 0; n < 2; ++n) uj[n] = *(const f32x4*)(Uval + gb + bj * 128 + jb + 4 * n);
#pragma unroll
            for (int ai = 0; ai < 2; ++ai)
#pragma unroll
                for (int m = 0; m < 4; ++m) {
                    const int i = ai * 128 + wr * 64 + m * 16 + fr;
                    const float Mi = Mval[gb + i];
                    f32x4 o[2];
#pragma unroll
                    for (int n = 0; n < 2; ++n)
#pragma unroll
                        for (int jj = 0; jj < 4; ++jj) {
                            const int j = bj * 128 + jb + 4 * n + jj;
                            o[n][jj] = (j <= i) ? acc[ai][bj][m][n][jj] * __expf(uj[n][jj] - Mi) : 0.f;
                        }
                    u32x4 w; w.x = pg8::cvt_pk_bf16(o[0][0], o[0][1]); w.y = pg8::cvt_pk_bf16(o[0][2], o[0][3]); w.z = pg8::cvt_pk_bf16(o[1][0], o[1][1]); w.w = pg8::cvt_pk_bf16(o[1][2], o[1][3]);
                    *(u32x4*)(aext + ((size_t)it * 256 + i) * 512 + bj * 128 + jb) = w;
                    asm volatile("" ::: "memory");
                }
        }
    }
};
struct EpiDC {
    bf16_t* dct;
    __device__ __forceinline__ void operator()(const f32x4 (&acc)[2][2][4][2], const pg8::Unit& un, int wr, int wc, int fr, int fq) const {
        const int it = un.pm; const int cb0 = wc * 32 + 8 * fq;
#pragma unroll
        for (int ai = 0; ai < 2; ++ai)
#pragma unroll
            for (int m = 0; m < 4; ++m) {
                const int r = ai * 128 + wr * 64 + m * 16 + fr;
#pragma unroll
                for (int bj = 0; bj < 2; ++bj) {
                    const f32x4 v0 = acc[ai][bj][m][0], v1 = acc[ai][bj][m][1];
                    u32x4 w; w.x = pg8::cvt_pk_bf16(v0[0], v0[1]); w.y = pg8::cvt_pk_bf16(v0[2], v0[3]); w.z = pg8::cvt_pk_bf16(v1[0], v1[1]); w.w = pg8::cvt_pk_bf16(v1[2], v1[3]);
                    *(u32x4*)(dct + ((size_t)it * 256 + r) * 256 + bj * 128 + cb0) = w;
                }
            }
    }
};
struct EpiO {
    LAS const float* rinv; bf16_t* hm;
    __device__ __forceinline__ void operator()(const f32x4 (&acc)[2][2][4][2], const pg8::Unit& un, int wr, int wc, int fr, int fq) const {
        const int it = un.pm, bh = it >> 5, cc = it & 31, b = bh >> 2, h = bh & 3;
        const size_t t0 = (size_t)b * SEQ + cc * 256; const int eb = wc * 32 + 8 * fq;
#pragma unroll
        for (int ai = 0; ai < 2; ++ai)
#pragma unroll
            for (int m = 0; m < 4; ++m) {
                const int i = ai * 128 + wr * 64 + m * 16 + fr;
                const float ri = rinv[un.aux * 256 + i];
#pragma unroll
                for (int bj = 0; bj < 2; ++bj) {
                    const f32x4 v0 = acc[ai][bj][m][0] * ri, v1 = acc[ai][bj][m][1] * ri;
                    u32x4 w; w.x = pg8::cvt_pk_bf16(v0[0], v0[1]); w.y = pg8::cvt_pk_bf16(v0[2], v0[3]); w.z = pg8::cvt_pk_bf16(v1[0], v1[1]); w.w = pg8::cvt_pk_bf16(v1[2], v1[3]);
                    *(u32x4*)(hm + (t0 + i) * DM + h * 256 + bj * 128 + eb) = w;
                }
            }
    }
};

__device__ __forceinline__ void phase_scan(const MegaArgs& a, int tid) {
    unsigned char* ws = a.ws;
    const float* items = (const float*)(ws + WS_ITEMS); const bf16_t* dct = (const bf16_t*)(ws + WS_DCT); bf16_t* bext = (bf16_t*)(ws + WS_BEXT);
    const float* dn = (const float*)(ws + WS_DN); float* nprev = (float*)(ws + WS_NPREV);
    int tid_o = tid; asm volatile("" : "+v"(tid_o));
    const int gid = blockIdx.x * (NWAVES * 64) + tid_o;
    if (gid < 16 * 256 * 32) {
        const int bh = gid >> 13, e = (gid >> 5) & 255, d8 = gid & 31;
        float st[8];
#pragma unroll
        for (int i = 0; i < 8; ++i) st[i] = 0.f;
        for (int c = 0; c < 32; ++c) {
            const int it = bh * 32 + c;
            u32x4 w; w.x = pk2(st[0], st[1]); w.y = pk2(st[2], st[3]); w.z = pk2(st[4], st[5]); w.w = pk2(st[6], st[7]);
            *(u32x4*)(bext + ((size_t)it * 256 + e) * 512 + 256 + 8 * d8) = w;
            const u32x4 r = *(const u32x4*)(dct + ((size_t)it * 256 + e) * 256 + 8 * d8);
            float dv[8]; unpack8(r, dv);
            const float dec = items[it], sc = items[512 + it];
#pragma unroll
            for (int i = 0; i < 8; ++i) st[i] = dec * st[i] + sc * dv[i];
        }
    }
    if (gid < 16 * 256) {
        const int bh = gid >> 8, d = gid & 255;
        float st = 0.f;
        for (int c = 0; c < 32; ++c) {
            const int it = bh * 32 + c;
            nprev[(size_t)it * 256 + d] = st;
            st = items[it] * st + items[512 + it] * dn[(size_t)it * 256 + d];
        }
    }
}

__device__ __forceinline__ void g3_rinv(const MegaArgs& a, LAS unsigned char* lds, int tid, int G) {
    unsigned char* ws = a.ws;
    const bf16_t* aext = (const bf16_t*)(ws + WS_AEXT); const float* nprev = (const float*)(ws + WS_NPREV);
    const float* Fcum = (const float*)(ws + WS_FCUM); const float* Mval = (const float*)(ws + WS_MVAL);
    LAS float* rinv = (LAS float*)(lds + RINV_OFF);
    for (int ui = 0; ui < 2; ++ui) {
        const int it = ui * G + blockIdx.x; if (it >= 512) break;
        const int bh = it >> 5, cc = it & 31, b = bh >> 2, h = bh & 3;
        const int i = tid >> 1, part = tid & 1;
        const u32x4* rowp = (const u32x4*)(aext + ((size_t)it * 256 + i) * 512 + part * 256);
        float s = 0.f;
        if (part == 0) {
            for (int q = 0; q < 32; ++q) { float f[8]; unpack8(rowp[q], f); s += ((f[0] + f[1]) + (f[2] + f[3])) + ((f[4] + f[5]) + (f[6] + f[7])); }
        } else {
            const f32x4* np = (const f32x4*)(nprev + (size_t)it * 256);
            for (int q = 0; q < 32; ++q) { float f[8]; unpack8(rowp[q], f); const f32x4 n0 = np[2 * q], n1 = np[2 * q + 1];
                s += (f[0] * n0.x + f[1] * n0.y + f[2] * n0.z + f[3] * n0.w) + (f[4] * n1.x + f[5] * n1.y + f[6] * n1.z + f[7] * n1.w); }
        }
        s += __shfl_xor(s, 1);
        const size_t gi = (size_t)h * NTOK + b * SEQ + cc * 256 + i;
        const float mi = Fcum[gi] + Mval[gi];
        if (part == 0) rinv[ui * 256 + i] = 1.0f / fmaxf(fabsf(s), __expf(-mi));
    }
    __syncthreads();
}

__global__ void __launch_bounds__(NWAVES * 64, 2) mega_fwd(MegaArgs args) {
    extern __shared__ __attribute__((aligned(16))) unsigned char lds_raw[];
    LAS unsigned char* lds = (LAS unsigned char*)lds_raw;
    const int wave = __builtin_amdgcn_readfirstlane(threadIdx.x >> 6);
#define lane lane_id()
#define tid ((wave << 6) | lane_id())
    const int G = gridDim.x;
    const int gw = blockIdx.x * NWAVES + wave, NGW = G * NWAVES;
    unsigned char* ws = args.ws;
    unsigned* ctl = (unsigned*)(ws + WS_CTL);
    for (int u = tid; u < (LDS_BYTES - LDSCTL_OFF) / 4; u += NWAVES * 64) ((LAS unsigned*)(lds + LDSCTL_OFF))[u] = 0u;
    __syncthreads();
    XcdBarrier bar = xcd_barrier_post(ctl + CW_BAR + args.li * XCD_BAR_WORDS, (volatile LAS unsigned*)(lds + LDSCTL_OFF + 64), wave);
    const int lo = args.ph_lo, hi = args.ph_hi;
#define IN(k) (lo <= (k) && (k) < hi)
#define BOTH(k) (IN(k) && IN((k) + 1))

    if (IN(0)) { p0_prologue(args, lds, gw, NGW, wave, lane); p0_gate_tables(args, gw, NGW, lane); if (BOTH(0)) xcd_barrier(bar); }

    if (IN(1)) {
        pg8::DenseOrder S; S.init(ws + WS_R1, ws + WS_BTIN, NTOK, DPROJ, DM, DM, G, (int)blockIdx.x);
        EpiInProj E{(const float*)(ws + WS_RSTD1), (bf16_t*)(ws + WS_XM), (bf16_t*)(ws + WS_SZ), (bf16_t*)(ws + WS_U)};
        pg8::gemm_phase<EpiInProj, pg8::DenseOrder, false>(lds, wave, DM, DM, DM, S, E);
        if (BOTH(1)) xcd_barrier(bar);
    }

    if (IN(2)) { phase_gates(args, gw, NGW, lane); if (BOTH(2)) xcd_barrier(bar); }
    if (IN(3)) { phase_prep(args, lds, tid, lane, wave, G); if (BOTH(3)) xcd_barrier(bar); }
    if (IN(4)) {
        {
            ItemOrder S; S.A = (const char*)(ws + WS_QB); S.B = (const char*)(ws + WS_KB); S.a_item_bytes = 0; S.b_item_bytes = 0; S.per_token = 1; S.G = G; S.c = (int)blockIdx.x;
            EpiP E{(const float*)(ws + WS_UVAL), (const float*)(ws + WS_MVAL), (bf16_t*)(ws + WS_AEXT)};
            pg8::gemm_phase<EpiP, ItemOrder, false>(lds, wave, 256, DM, DM, S, E);
        }
        {
            ItemOrder S; S.A = (const char*)(ws + WS_BEXT); S.B = (const char*)(ws + WS_KWT); S.a_item_bytes = (size_t)256 * 512 * 2; S.b_item_bytes = (size_t)256 * 256 * 2; S.per_token = 0; S.G = G; S.c = (int)blockIdx.x;
            EpiDC E{(bf16_t*)(ws + WS_DCT)};
            pg8::gemm_phase<EpiDC, ItemOrder, false>(lds, wave, 256, 512, 256, S, E);
        }
        if (BOTH(4)) xcd_barrier(bar);
    }
    if (IN(5)) { phase_scan(args, tid); if (BOTH(5)) xcd_barrier(bar); }
    if (IN(6)) {
        g3_rinv(args, lds, tid, G);
        ItemOrder S; S.A = (const char*)(ws + WS_AEXT); S.B = (const char*)(ws + WS_BEXT); S.a_item_bytes = (size_t)256 * 512 * 2; S.b_item_bytes = (size_t)256 * 512 * 2; S.per_token = 0; S.G = G; S.c = (int)blockIdx.x;
        EpiO E{(LAS const float*)(lds + RINV_OFF), (bf16_t*)(ws + WS_HM)};
        pg8::gemm_phase<EpiO, ItemOrder, false>(lds, wave, 512, 512, 512, S, E);
        if (BOTH(6)) xcd_barrier(bar);
    }
    if (IN(7)) { phase_conv31(args, lds, tid, lane, wave, G); phase_ym(args, gw, NGW, lane); if (BOTH(7)) xcd_barrier(bar); }
    if (IN(8)) {
        pg8::DenseOrder S; S.init(ws + WS_YMIX, ws + WS_BTOUT, NTOK, DM, 2048, 2048, G, (int)blockIdx.x);
        EpiOutProj E{args.in[0], args.out, (bf16_t*)(ws + WS_HBF)};
        pg8::gemm_phase<EpiOutProj, pg8::DenseOrder, false>(lds, wave, 2048, 2048, 2048, S, E);
        if (BOTH(8)) xcd_barrier(bar);
    }
    if (IN(9)) { phase_router(args, lds, tid, lane, wave); if (BOTH(9)) xcd_barrier(bar); }
    if (IN(10)) { phase_slots(args, lds, tid); if (BOTH(10)) xcd_barrier(bar); }
    if (IN(11)) {
        const int T = __hip_atomic_load((const int*)(ws + WS_TILEEXP) + 2048, __ATOMIC_RELAXED, __HIP_MEMORY_SCOPE_AGENT);
        MoeOrder S; S.A = (const char*)(ws + WS_HBF); S.Bt = (const char*)(ws + WS_BT1); S.gidx = (const int*)(ws + WS_STOK); S.tile_exp = (const int*)(ws + WS_TILEEXP);
        S.a_tile_bytes = 0; S.b_exp_bytes = (size_t)2048 * 1024 * 2; S.b_tile_bytes = (size_t)256 * 1024 * 2; S.T = T; S.nN = 8; S.group = 4; S.c = (int)blockIdx.x;
        EpiMoe1 E{(const float*)(ws + WS_SRSTD), args.in[23], (bf16_t*)(ws + WS_ACT)};
        pg8::gemm_phase<EpiMoe1, MoeOrder, true>(lds, wave, DM, DM, DM, S, E);
        if (BOTH(11)) xcd_barrier(bar);
    }
    if (IN(12)) {
        const int T = __hip_atomic_load((const int*)(ws + WS_TILEEXP) + 2048, __ATOMIC_RELAXED, __HIP_MEMORY_SCOPE_AGENT);
        MoeOrder S; S.A = (const char*)(ws + WS_ACT); S.Bt = (const char*)(ws + WS_BT2); S.gidx = nullptr; S.tile_exp = (const int*)(ws + WS_TILEEXP);
        S.a_tile_bytes = (size_t)256 * 1024 * 2; S.b_exp_bytes = (size_t)1024 * 1024 * 2; S.b_tile_bytes = (size_t)256 * 1024 * 2; S.T = T; S.nN = 4; S.group = 8; S.c = (int)blockIdx.x;
        EpiMoe2 E{(const float*)(ws + WS_SGATE), args.in[25], (bf16_t*)(ws + WS_YROWS)};
        pg8::gemm_phase<EpiMoe2, MoeOrder, false>(lds, wave, DM, DM, DM, S, E);
        if (BOTH(12)) xcd_barrier(bar);
    }
    if (IN(13)) { phase_final(args, gw, NGW, lane); }
#undef IN
#undef BOTH
#undef lane
#undef tid
}

static int g_grid = 0;
static bool mega_setup(size_t ws_size) {
    if (g_grid == 0) {
        int dev = 0, cus = 0, per_cu = 0;
        if (ws_size < WS_NEED) { g_grid = -1; return false; }
        if (hipGetDevice(&dev) != hipSuccess || hipDeviceGetAttribute(&cus, hipDeviceAttributeMultiprocessorCount, dev) != hipSuccess) { g_grid = -1; return false; }
        if (hipFuncSetAttribute((const void*)mega_fwd, hipFuncAttributeMaxDynamicSharedMemorySize, LDS_BYTES) != hipSuccess) { g_grid = -1; return false; }
        (void)hipOccupancyMaxActiveBlocksPerMultiprocessor(&per_cu, (const void*)mega_fwd, NWAVES * 64, LDS_BYTES);
        (void)hipGetLastError();
        g_grid = cus;
    }
    return g_grid > 0;
}
static void mega_launch(const MegaArgs& base, int lo, int hi, int li, hipStream_t stream) {
    MegaArgs a = base; a.ph_lo = lo; a.ph_hi = hi; a.li = li; a.pad = 0;
    hipLaunchKernelGGL(mega_fwd, dim3(g_grid), dim3(NWAVES * 64), LDS_BYTES, stream, a);
}

extern "C" void kernel_launch(void* const* d_in, const int* in_sizes, int n_in, void* d_out, int out_size, void* d_ws,
                              size_t ws_size, hipStream_t stream) {
    const float* mconv_w = (const float*)d_in[3];
    const float* mconv_b = (const float*)d_in[4];
    const float* w_q = (const float*)d_in[5];
    const float* w_k = (const float*)d_in[6];
    const float* w_v = (const float*)d_in[7];
    const float* w_ig = (const float*)d_in[8];
    const float* b_ig = (const float*)d_in[9];
    const float* w_fg = (const float*)d_in[10];
    const float* b_fg = (const float*)d_in[11];
    const float* mnorm_w = (const float*)d_in[12];
    const float* mskip = (const float*)d_in[13];
    const float* cdw_w = (const float*)d_in[14];
    const float* cdw_b = (const float*)d_in[15];
    const float* cnorm_w = (const float*)d_in[16];
    const float* cnorm_b = (const float*)d_in[17];
    const float* w_out = (const float*)d_in[18];
    const float* nffn_w = (const float*)d_in[19];
    const float* w_router = (const float*)d_in[20];
    const float* b_router = (const float*)d_in[21];
    const float* w1 = (const float*)d_in[22];
    const float* b1 = (const float*)d_in[23];
    const float* w2 = (const float*)d_in[24];
    const float* b2 = (const float*)d_in[25];
    const float* final_w = (const float*)d_in[26];
    const float* x = (const float*)d_in[0];
    float* out = (float*)d_out;
    if (!mega_setup(ws_size)) return;
    unsigned char* ws = (unsigned char*)d_ws;
    (void)hipMemsetAsync(ws + WS_CTL, 0, CTL_ZERO_BYTES, stream);
    MegaArgs a{};
    for (int i = 0; i < 27; ++i) a.in[i] = (const float*)d_in[i];
    a.out = out; a.ws = ws;

    bf16_t* xm = (bf16_t*)(ws + WS_XM);
    bf16_t* szb = (bf16_t*)(ws + WS_SZ);
    bf16_t* ub = (bf16_t*)(ws + WS_U);
    bf16_t* hm = (bf16_t*)(ws + WS_R1);
    bf16_t* ymix = (bf16_t*)(ws + WS_YMIX);
    float* logi = (float*)(ws + WS_LOGI);
    float* logf = (float*)(ws + WS_LOGF);
    int* topi = (int*)(ws + WS_TOPI);
    float* topg = (float*)(ws + WS_TOPG);
    int* slot_tok = (int*)(ws + WS_STOK);
    float* slot_gate = (float*)(ws + WS_SGATE);
    int* estart = (int*)(ws + WS_ESTART);
    bf16_t* act = (bf16_t*)(ws + WS_ACT);
    bf16_t* a2 = (bf16_t*)(ws + WS_R1);

    mega_launch(a, 0, 14, 0, stream);
}
```

```cpp
#include <hip/hip_runtime.h>
#include <stdint.h>

#define NTOK 32768
#define SEQ 8192
#define DM 1024
#define DPROJ 4096
#define NEXP 32
#define NASSIGN (NTOK * 4)
#define EPSV 1e-5f

typedef unsigned short bf16_t;

__device__ __forceinline__ float bf2f(bf16_t h) { return __uint_as_float(((uint32_t)h) << 16); }
__device__ __forceinline__ bf16_t f2bf(float f) {
    uint32_t u = __float_as_uint(f);
    u += 0x7FFFu + ((u >> 16) & 1u);
    return (bf16_t)(u >> 16);
}
__device__ __forceinline__ float sigmoidf_(float x) { return __builtin_amdgcn_rcpf(1.0f + __expf(-x)); }
__device__ __forceinline__ float siluf_(float x) { return x * sigmoidf_(x); }
__device__ __forceinline__ float logsigmoidf_(float x) { return fminf(x, 0.0f) - log1pf(__expf(-fabsf(x))); }

template <int CTRL> __device__ __forceinline__ float dpp_mov_f(float v) { return __builtin_bit_cast(float, __builtin_amdgcn_update_dpp(0, __builtin_bit_cast(int, v), CTRL, 0xf, 0xf, false)); }
__device__ __forceinline__ float wave_sum(float v) {
    v += dpp_mov_f<0xB1>(v); v += dpp_mov_f<0x4E>(v); v += dpp_mov_f<0x124>(v); v += dpp_mov_f<0x128>(v);
    v += __builtin_bit_cast(float, __builtin_amdgcn_ds_swizzle(__builtin_bit_cast(int, v), 0x401F));
    const auto rr = __builtin_amdgcn_permlane32_swap(__float_as_uint(v), __float_as_uint(v), false, false);
    return __uint_as_float(rr[0]) + __uint_as_float(rr[1]);
}
__device__ __forceinline__ float block_sum256(float v, float* red) {
    v = wave_sum(v);
    __syncthreads();
    if ((threadIdx.x & 63) == 0) red[threadIdx.x >> 6] = v;
    __syncthreads();
    return red[0] + red[1] + red[2] + red[3];
}

template <int NB, class AF, class BF>
__device__ __forceinline__ void tile_gemm(float (&acc)[NB][4][4], int K, AF af, BF bf, float* As, float* Bs) {
    const int tid = threadIdx.x;
    const int ty = tid >> 4, tx = tid & 15;
    for (int k0 = 0; k0 < K; k0 += 16) {
#pragma unroll
        for (int i = 0; i < 4; i++) {
            int idx = tid + i * 256;
            int r = idx >> 4, kk = idx & 15;
            As[kk * 68 + r] = af(r, k0 + kk);
        }
#pragma unroll
        for (int b = 0; b < NB; b++) {
#pragma unroll
            for (int i = 0; i < 4; i++) {
                int idx = tid + i * 256;
                int kk = idx >> 6, c = idx & 63;
                Bs[(b * 16 + kk) * 64 + c] = bf(b, k0 + kk, c);
            }
        }
        __syncthreads();
#pragma unroll
        for (int kk = 0; kk < 16; kk++) {
            float a[4];
#pragma unroll
            for (int i = 0; i < 4; i++) a[i] = As[kk * 68 + ty * 4 + i];
#pragma unroll
            for (int b = 0; b < NB; b++) {
                float bb[4];
#pragma unroll
                for (int j = 0; j < 4; j++) bb[j] = Bs[(b * 16 + kk) * 64 + tx * 4 + j];
#pragma unroll
                for (int i = 0; i < 4; i++)
#pragma unroll
                    for (int j = 0; j < 4; j++) acc[b][i][j] += a[i] * bb[j];
            }
        }
        __syncthreads();
    }
}

struct PreOut { float xc[4], q[4], k[4], v[4]; };
__device__ __forceinline__ PreOut mlstm_pre(const bf16_t* __restrict__ proj, int t, int n, const float* __restrict__ cw,
                                            const float* __restrict__ cb, const float* __restrict__ wq,
                                            const float* __restrict__ wk, const float* __restrict__ wv) {
    PreOut o;
    const int s = t & (SEQ - 1);
    float xm[4][4];
#pragma unroll
    for (int kk = 0; kk < 4; kk++) {
        const int sp = s - 3 + kk;
        if (sp >= 0) {
            const uint2 raw = *(const uint2*)(proj + (size_t)(t - 3 + kk) * DM + 4 * n);
            xm[kk][0] = bf2f((bf16_t)(raw.x & 0xFFFF)); xm[kk][1] = bf2f((bf16_t)(raw.x >> 16));
            xm[kk][2] = bf2f((bf16_t)(raw.y & 0xFFFF)); xm[kk][3] = bf2f((bf16_t)(raw.y >> 16));
        } else {
            xm[kk][0] = xm[kk][1] = xm[kk][2] = xm[kk][3] = 0.f;
        }
    }
#pragma unroll
    for (int c = 0; c < 4; c++) {
        float a = cb[4 * n + c];
#pragma unroll
        for (int kk = 0; kk < 4; kk++) a += cw[kk * DM + 4 * n + c] * xm[kk][c];
        o.xc[c] = siluf_(a);
    }
#pragma unroll
    for (int oo = 0; oo < 4; oo++) {
        float aq = 0.f, ak = 0.f, av = 0.f;
#pragma unroll
        for (int i = 0; i < 4; i++) {
            aq += o.xc[i] * wq[n * 16 + i * 4 + oo];
            ak += o.xc[i] * wk[n * 16 + i * 4 + oo];
            av += xm[3][i] * wv[n * 16 + i * 4 + oo];
        }
        o.q[oo] = aq; o.k[oo] = ak; o.v[oo] = av;
    }
    return o;
}

__global__ __launch_bounds__(256) void k_gates(const bf16_t* __restrict__ proj, const float* __restrict__ cw,
                                               const float* __restrict__ cb, const float* __restrict__ wq,
                                               const float* __restrict__ wk, const float* __restrict__ wv,
                                               const float* __restrict__ wig, const float* __restrict__ big,
                                               const float* __restrict__ wfg, const float* __restrict__ bfg,
                                               float* __restrict__ logi, float* __restrict__ logf) {
    __shared__ float red[4];
    const int t = blockIdx.x, n = threadIdx.x;
    PreOut p = mlstm_pre(proj, t, n, cw, cb, wq, wk, wv);
    float pi[4], pf[4];
#pragma unroll
    for (int h = 0; h < 4; h++) {
        float ai = 0.f, af = 0.f;
#pragma unroll
        for (int o = 0; o < 4; o++) {
            const int c = 4 * n + o;
            ai += p.q[o] * wig[(size_t)c * 4 + h] + p.k[o] * wig[(size_t)(1024 + c) * 4 + h] + p.v[o] * wig[(size_t)(2048 + c) * 4 + h];
            af += p.q[o] * wfg[(size_t)c * 4 + h] + p.k[o] * wfg[(size_t)(1024 + c) * 4 + h] + p.v[o] * wfg[(size_t)(2048 + c) * 4 + h];
        }
        pi[h] = ai; pf[h] = af;
    }
#pragma unroll
    for (int h = 0; h < 4; h++) {
        float si = block_sum256(pi[h], red);
        float sf = block_sum256(pf[h], red);
        if (threadIdx.x == 0) {
            logi[(size_t)t * 4 + h] = si + big[h];
            logf[(size_t)t * 4 + h] = logsigmoidf_(sf + bfg[h]);
        }
    }
}

#define MS_QK_STRIDE 258
#define MLSTM_LDS (2 * 64 * MS_QK_STRIDE * 2 + 64 * 32 * 4 + 64 * 65 * 4 + 256 * 32 * 4 + 256 * 4 + 8 * 64 * 4)
__global__ __launch_bounds__(256) void k_mlstm(const bf16_t* __restrict__ proj, const float* __restrict__ logi,
                                               const float* __restrict__ logf, const float* __restrict__ cw,
                                               const float* __restrict__ cb, const float* __restrict__ wq,
                                               const float* __restrict__ wk, const float* __restrict__ wv,
                                               bf16_t* __restrict__ hm) {
    extern __shared__ __attribute__((aligned(16))) unsigned char smem[];
    bf16_t* qs = (bf16_t*)smem;
    bf16_t* ks = qs + 64 * MS_QK_STRIDE;
    float* vs = (float*)(ks + 64 * MS_QK_STRIDE);
    float* Ss = vs + 64 * 32;
    float* Cs = Ss + 64 * 65;
    float* nvec = Cs + 256 * 32;
    float* bcum = nvec + 256;
    float* li = bcum + 64;
    float* lf = li + 64;
    float* mrow = lf + 64;
    float* winter = mrow + 64;
    float* wst = winter + 64;
    float* den = wst + 64;

    const int tid = threadIdx.x;
    const int bh = blockIdx.x >> 3, sl = blockIdx.x & 7;
    const int b = bh >> 2, h = bh & 3;
    for (int i = tid; i < 256 * 32; i += 256) Cs[i] = 0.f;
    nvec[tid] = 0.f;
    float m_prev = 0.f;
    __syncthreads();

    for (int c = 0; c < SEQ / 64; c++) {
        const int t0 = b * SEQ + c * 64;
        for (int it = 0; it < 16; it++) {
            const int idx = tid + it * 256;
            const int r = idx >> 6, n = idx & 63;
            PreOut p = mlstm_pre(proj, t0 + r, h * 64 + n, cw, cb, wq, wk, wv);
#pragma unroll
            for (int o = 0; o < 4; o++) {
                qs[r * MS_QK_STRIDE + 4 * n + o] = f2bf(p.q[o] * 0.0625f);
                ks[r * MS_QK_STRIDE + 4 * n + o] = f2bf(p.k[o]);
            }
            if ((n >> 3) == sl) {
#pragma unroll
                for (int o = 0; o < 4; o++) vs[r * 32 + (4 * n + o - 32 * sl)] = p.v[o];
            }
        }
        if (tid < 64) {
            li[tid] = logi[(size_t)(t0 + tid) * 4 + h];
            lf[tid] = logf[(size_t)(t0 + tid) * 4 + h];
        }
        __syncthreads();
        if (tid == 0) {
            float a = 0.f;
            for (int j = 0; j < 64; j++) { a += lf[j]; bcum[j] = a; }
        }
        __syncthreads();
        {
            const int j = tid & 63, ig = tid >> 6;
            for (int ii = 0; ii < 16; ii++) {
                const int i = ig * 16 + ii;
                const uint32_t* qp = (const uint32_t*)(qs + i * MS_QK_STRIDE);
                const uint32_t* kp = (const uint32_t*)(ks + j * MS_QK_STRIDE);
                float a = 0.f;
                for (int d2 = 0; d2 < 128; d2++) {
                    const uint32_t qq = qp[d2], kk = kp[d2];
                    a += __uint_as_float(qq << 16) * __uint_as_float(kk << 16);
                    a += __uint_as_float(qq & 0xFFFF0000u) * __uint_as_float(kk & 0xFFFF0000u);
                }
                Ss[i * 65 + j] = (j <= i) ? a : 0.f;
            }
        }
        if (tid < 64) {
            const int i = tid;
            float mx = bcum[i] + m_prev;
            for (int j = 0; j <= i; j++) mx = fmaxf(mx, bcum[i] - bcum[j] + li[j]);
            mrow[i] = mx;
            winter[i] = __expf(bcum[i] + m_prev - mx);
        }
        __syncthreads();
        {
            const int j = tid & 63, ig = tid >> 6;
            for (int ii = 0; ii < 16; ii++) {
                const int i = ig * 16 + ii;
                if (j <= i) Ss[i * 65 + j] *= __expf(bcum[i] - bcum[j] + li[j] - mrow[i]);
            }
        }
        __syncthreads();
        if (tid < 64) {
            const int i = tid;
            float a = 0.f;
            for (int d = 0; d < 256; d++) a += bf2f(qs[i * MS_QK_STRIDE + d]) * nvec[d];
            float s = 0.f;
            for (int j = 0; j < 64; j++) s += Ss[i * 65 + j];
            den[i] = winter[i] * a + s;
        }
        __syncthreads();
        {
            const int e = tid & 31, ig = tid >> 5;
            for (int ii = 0; ii < 8; ii++) {
                const int i = ig * 8 + ii;
                float a1 = 0.f;
                for (int d = 0; d < 256; d++) a1 += bf2f(qs[i * MS_QK_STRIDE + d]) * Cs[d * 32 + e];
                float a2 = 0.f;
                for (int j = 0; j < 64; j++) a2 += Ss[i * 65 + j] * vs[j * 32 + e];
                const float num = winter[i] * a1 + a2;
                const float hv = num / fmaxf(fabsf(den[i]), __expf(-mrow[i]));
                hm[(size_t)(t0 + i) * DM + h * 256 + sl * 32 + e] = f2bf(hv);
            }
        }
        const float g = bcum[63];
        float m_new = g + m_prev;
        for (int j = 0; j < 64; j++) m_new = fmaxf(m_new, g - bcum[j] + li[j]);
        const float decay = __expf(g + m_prev - m_new);
        __syncthreads();
        if (tid < 64) wst[tid] = __expf(g - bcum[tid] + li[tid] - m_new);
        __syncthreads();
        {
            const int e = tid & 31, dg = tid >> 5;
            for (int dd = 0; dd < 32; dd++) {
                const int d = dg * 32 + dd;
                float a = 0.f;
                for (int j = 0; j < 64; j++) a += wst[j] * bf2f(ks[j * MS_QK_STRIDE + d]) * vs[j * 32 + e];
                Cs[d * 32 + e] = decay * Cs[d * 32 + e] + a;
            }
            const int d = tid;
            float a = 0.f;
            for (int j = 0; j < 64; j++) a += wst[j] * bf2f(ks[j * MS_QK_STRIDE + d]);
            nvec[d] = decay * nvec[d] + a;
        }
        m_prev = m_new;
        __syncthreads();
    }
}

__global__ __launch_bounds__(256) void k_conv31(const bf16_t* __restrict__ proj, const float* __restrict__ cw,
                                                const float* __restrict__ cb, const float* __restrict__ nw,
                                                const float* __restrict__ nb, bf16_t* __restrict__ ymix) {
    __shared__ float red[4];
    const int t = blockIdx.x, n = threadIdx.x;
    const int s = t & (SEQ - 1);
    float acc[4];
#pragma unroll
    for (int c = 0; c < 4; c++) acc[c] = cb[4 * n + c];
    for (int k = 0; k < 31; k++) {
        const int sp = s - 30 + k;
        if (sp >= 0) {
            const uint2 ra = *(const uint2*)(proj + (size_t)(t - 30 + k) * DM + 4 * n);
            float ga[4];
            ga[0] = bf2f((bf16_t)(ra.x & 0xFFFF)); ga[1] = bf2f((bf16_t)(ra.x >> 16));
            ga[2] = bf2f((bf16_t)(ra.y & 0xFFFF)); ga[3] = bf2f((bf16_t)(ra.y >> 16));
#pragma unroll
            for (int c = 0; c < 4; c++) acc[c] += cw[k * DM + 4 * n + c] * ga[c];
        }
    }
    const float mean = block_sum256(acc[0] + acc[1] + acc[2] + acc[3], red) * (1.0f / DM);
    float vs = 0.f;
#pragma unroll
    for (int c = 0; c < 4; c++) { const float d = acc[c] - mean; vs += d * d; }
    const float var = block_sum256(vs, red) * (1.0f / DM);
    const float rs = rsqrtf(var + EPSV);
#pragma unroll
    for (int c = 0; c < 4; c++) {
        const float y = (acc[c] - mean) * rs * nw[4 * n + c] + nb[4 * n + c];
        ymix[(size_t)t * 2048 + 1024 + 4 * n + c] = f2bf(siluf_(y));
    }
}

__global__ __launch_bounds__(256) void k_ym(const bf16_t* __restrict__ proj, const bf16_t* __restrict__ szb, const bf16_t* __restrict__ hm,
                                            const float* __restrict__ cw, const float* __restrict__ cb,
                                            const float* __restrict__ wq, const float* __restrict__ wk,
                                            const float* __restrict__ wv, const float* __restrict__ mnw,
                                            const float* __restrict__ skip, bf16_t* __restrict__ ymix) {
    const int t = blockIdx.x, n = threadIdx.x;
    PreOut p = mlstm_pre(proj, t, n, cw, cb, wq, wk, wv);
    float hv[4];
#pragma unroll
    for (int c = 0; c < 4; c++) hv[c] = bf2f(hm[(size_t)t * DM + 4 * n + c]);
    const float mean = wave_sum(hv[0] + hv[1] + hv[2] + hv[3]) * (1.0f / 256.0f);
    float vs = 0.f;
#pragma unroll
    for (int c = 0; c < 4; c++) { const float d = hv[c] - mean; vs += d * d; }
    const float var = wave_sum(vs) * (1.0f / 256.0f);
    const float rs = rsqrtf(var + EPSV);
#pragma unroll
    for (int c = 0; c < 4; c++) {
        const int ch = 4 * n + c;
        const float hn = (hv[c] - mean) * rs * mnw[ch];
        const float z = bf2f(szb[(size_t)t * DM + ch]);
        const float y = (hn + skip[ch] * p.xc[c]) * z;
        ymix[(size_t)t * 2048 + ch] = f2bf(y);
    }
}

__global__ __launch_bounds__(256) void k_outproj(const bf16_t* __restrict__ ymix, const float* __restrict__ w_out,
                                                 const float* __restrict__ x, float* __restrict__ hout) {
    __shared__ float As[16 * 68];
    __shared__ float Bs[16 * 64];
    const int col0 = blockIdx.x * 64, row0 = blockIdx.y * 64;
    float acc[1][4][4];
#pragma unroll
    for (int i = 0; i < 4; i++)
#pragma unroll
        for (int j = 0; j < 4; j++) acc[0][i][j] = 0.f;
    auto af = [&](int r, int k) -> float { return bf2f(ymix[(size_t)(row0 + r) * 2048 + k]); };
    auto bf = [&](int b, int k, int c) -> float { return w_out[(size_t)k * DM + col0 + c]; };
    tile_gemm<1>(acc, 2048, af, bf, As, Bs);
    const int ty = threadIdx.x >> 4, tx = threadIdx.x & 15;
#pragma unroll
    for (int i = 0; i < 4; i++)
#pragma unroll
        for (int j = 0; j < 4; j++) {
            const size_t o = (size_t)(row0 + ty * 4 + i) * DM + col0 + tx * 4 + j;
            hout[o] = x[o] + acc[0][i][j];
        }
}

__global__ __launch_bounds__(256) void k_router(const float* __restrict__ hbuf, const float* __restrict__ nfw,
                                                const float* __restrict__ wr, const float* __restrict__ br,
                                                bf16_t* __restrict__ a2, int* __restrict__ topi, float* __restrict__ topg) {
    __shared__ float av[DM];
    __shared__ float part[8][32];
    __shared__ float lg[32];
    __shared__ float red[4];
    const int t = blockIdx.x, tid = threadIdx.x;
    const float4 v = *(const float4*)(hbuf + (size_t)t * DM + tid * 4);
    const float ss = block_sum256(v.x * v.x + v.y * v.y + v.z * v.z + v.w * v.w, red);
    const float rs = rsqrtf(ss * (1.0f / DM) + EPSV);
    const float vv[4] = {v.x, v.y, v.z, v.w};
#pragma unroll
    for (int c = 0; c < 4; c++) {
        const float a = vv[c] * rs * nfw[tid * 4 + c];
        av[tid * 4 + c] = a;
        a2[(size_t)t * DM + tid * 4 + c] = f2bf(a);
    }
    __syncthreads();
    {
        const int e = tid & 31, pp = tid >> 5;
        float a = 0.f;
        for (int k = pp * 128; k < pp * 128 + 128; k++) a += av[k] * wr[(size_t)k * 32 + e];
        part[pp][e] = a;
    }
    __syncthreads();
    if (tid < 32) {
        float a = br[tid];
#pragma unroll
        for (int pp = 0; pp < 8; pp++) a += part[pp][tid];
        lg[tid] = a;
    }
    __syncthreads();
    if (tid == 0) {
        int sel[4]; float val[4];
        unsigned used = 0u;
#pragma unroll
        for (int r = 0; r < 4; r++) {
            int bi = -1; float bv = 0.f;
            for (int e = 0; e < 32; e++) {
                if (used & (1u << e)) continue;
                const float x = lg[e];
                if (bi < 0 || x > bv) { bi = e; bv = x; }
            }
            used |= 1u << bi;
            sel[r] = bi; val[r] = bv;
        }
        float ex[4], sum = 0.f;
#pragma unroll
        for (int r = 0; r < 4; r++) { ex[r] = __expf(val[r] - val[0]); sum += ex[r]; }
#pragma unroll
        for (int r = 0; r < 4; r++) {
            topi[(size_t)t * 4 + r] = sel[r];
            topg[(size_t)t * 4 + r] = ex[r] / sum;
        }
    }
}

__global__ __launch_bounds__(1024) void k_sort(const int* __restrict__ topi, const float* __restrict__ topg,
                                               int* __restrict__ estart, int* __restrict__ slot_tok,
                                               float* __restrict__ slot_gate) {
    extern __shared__ __attribute__((aligned(16))) unsigned char smem[];
    int* cnt = (int*)smem;
    __shared__ int es[33];
    __shared__ int tot[32];
    const int tid = threadIdx.x;
    for (int e = 0; e < 32; e++) cnt[tid * 32 + e] = 0;
    const int a0 = tid * 128;
    for (int a = a0; a < a0 + 128; a++) cnt[tid * 32 + topi[a]]++;
    __syncthreads();
    if (tid < 32) {
        int run = 0;
        for (int i = 0; i < 1024; i++) { const int c = cnt[i * 32 + tid]; cnt[i * 32 + tid] = run; run += c; }
        tot[tid] = run;
    }
    __syncthreads();
    if (tid == 0) {
        int run = 0;
        for (int e = 0; e < 32; e++) { es[e] = run; estart[e] = run; run += tot[e]; }
        es[32] = run; estart[32] = run;
    }
    __syncthreads();
    for (int a = a0; a < a0 + 128; a++) {
        const int e = topi[a];
        const int slot = es[e] + cnt[tid * 32 + e];
        cnt[tid * 32 + e]++;
        slot_tok[slot] = a >> 2;
        slot_gate[slot] = topg[a];
    }
}

__device__ __forceinline__ bool moe_tile(const int* __restrict__ estart, int rt, int& e_out, int& slot0, int& nrows) {
    for (int e = 0; e < NEXP; e++) {
        const int s0 = estart[e], s1 = estart[e + 1];
        const int nt = (s1 - s0 + 63) >> 6;
        if (rt < nt) {
            e_out = e; slot0 = s0 + rt * 64; nrows = min(64, s1 - slot0);
            return true;
        }
        rt -= nt;
    }
    return false;
}

__global__ __launch_bounds__(256) void k_moe1(const bf16_t* __restrict__ a2, const int* __restrict__ estart,
                                              const int* __restrict__ slot_tok, const float* __restrict__ w1,
                                              const float* __restrict__ b1, bf16_t* __restrict__ act) {
    __shared__ float As[16 * 68];
    __shared__ float Bs[2 * 16 * 64];
    __shared__ int toks[64];
    int e, slot0, nrows;
    if (!moe_tile(estart, blockIdx.y, e, slot0, nrows)) return;
    const int col0 = blockIdx.x * 64;
    if (threadIdx.x < 64) toks[threadIdx.x] = (threadIdx.x < nrows) ? slot_tok[slot0 + threadIdx.x] : -1;
    __syncthreads();
    float acc[2][4][4];
#pragma unroll
    for (int b = 0; b < 2; b++)
#pragma unroll
        for (int i = 0; i < 4; i++)
#pragma unroll
            for (int j = 0; j < 4; j++) acc[b][i][j] = 0.f;
    const float* w1e = w1 + (size_t)e * 1024 * 2048;
    auto af = [&](int r, int k) -> float { const int tk = toks[r]; return tk >= 0 ? bf2f(a2[(size_t)tk * DM + k]) : 0.f; };
    auto bf = [&](int b, int k, int c) -> float { return w1e[(size_t)k * 2048 + b * 1024 + col0 + c]; };
    tile_gemm<2>(acc, DM, af, bf, As, Bs);
    const int ty = threadIdx.x >> 4, tx = threadIdx.x & 15;
#pragma unroll
    for (int i = 0; i < 4; i++) {
        const int r = ty * 4 + i;
        if (r < nrows) {
#pragma unroll
            for (int j = 0; j < 4; j++) {
                const int col = col0 + tx * 4 + j;
                const float g = acc[0][i][j] + b1[(size_t)e * 2048 + col];
                const float l = acc[1][i][j] + b1[(size_t)e * 2048 + 1024 + col];
                const float xg = fminf(g, 7.0f);
                const float xl = fminf(fmaxf(l, -7.0f), 7.0f);
                act[(size_t)(slot0 + r) * DM + col] = f2bf(xg * sigmoidf_(1.702f * xg) * (xl + 1.0f));
            }
        }
    }
}

__global__ __launch_bounds__(256) void k_moe2(const bf16_t* __restrict__ act, const int* __restrict__ estart,
                                              const int* __restrict__ slot_tok, const float* __restrict__ slot_gate,
                                              const float* __restrict__ w2, const float* __restrict__ b2,
                                              float* __restrict__ hout) {
    __shared__ float As[16 * 68];
    __shared__ float Bs[16 * 64];
    int e, slot0, nrows;
    if (!moe_tile(estart, blockIdx.y, e, slot0, nrows)) return;
    const int col0 = blockIdx.x * 64;
    float acc[1][4][4];
#pragma unroll
    for (int i = 0; i < 4; i++)
#pragma unroll
        for (int j = 0; j < 4; j++) acc[0][i][j] = 0.f;
    const float* w2e = w2 + (size_t)e * 1024 * 1024;
    auto af = [&](int r, int k) -> float { return r < nrows ? bf2f(act[(size_t)(slot0 + r) * DM + k]) : 0.f; };
    auto bf = [&](int b, int k, int c) -> float { return w2e[(size_t)k * DM + col0 + c]; };
    tile_gemm<1>(acc, DM, af, bf, As, Bs);
    const int ty = threadIdx.x >> 4, tx = threadIdx.x & 15;
#pragma unroll
    for (int i = 0; i < 4; i++) {
        const int r = ty * 4 + i;
        if (r < nrows) {
            const int tk = slot_tok[slot0 + r];
            const float gt = slot_gate[slot0 + r];
#pragma unroll
            for (int j = 0; j < 4; j++) {
                const int col = col0 + tx * 4 + j;
                atomicAdd(&hout[(size_t)tk * DM + col], (acc[0][i][j] + b2[(size_t)e * DM + col]) * gt);
            }
        }
    }
}

__global__ __launch_bounds__(256) void k_final(float* __restrict__ hbuf, const float* __restrict__ fw) {
    const int row = blockIdx.x * 4 + (threadIdx.x >> 6);
    const int lane = threadIdx.x & 63;
    float4* p = (float4*)(hbuf + (size_t)row * DM);
    float4 v[4];
    float s = 0.f;
#pragma unroll
    for (int i = 0; i < 4; i++) { v[i] = p[lane + i * 64]; s += v[i].x * v[i].x + v[i].y * v[i].y + v[i].z * v[i].z + v[i].w * v[i].w; }
    s = wave_sum(s);
    const float rs = rsqrtf(s * (1.0f / DM) + EPSV);
#pragma unroll
    for (int i = 0; i < 4; i++) {
        const float4 w = *(const float4*)(fw + (lane + i * 64) * 4);
        float4 o; o.x = v[i].x * rs * w.x; o.y = v[i].y * rs * w.y; o.z = v[i].z * rs * w.z; o.w = v[i].w * rs * w.w;
        p[lane + i * 64] = o;
    }
}


#define LAS __attribute__((address_space(3)))
#define GAS __attribute__((address_space(1)))
typedef short bf16x8 __attribute__((ext_vector_type(8)));
typedef float f32x4 __attribute__((ext_vector_type(4)));
typedef float f32x2 __attribute__((ext_vector_type(2)));
typedef unsigned u32x4 __attribute__((ext_vector_type(4)));
typedef unsigned u32x2 __attribute__((ext_vector_type(2)));

__device__ __forceinline__ int lane_id() { int l = (int)__builtin_amdgcn_mbcnt_hi(~0u, __builtin_amdgcn_mbcnt_lo(~0u, 0u)); asm volatile("" : "+v"(l)); return l; }
namespace pg8 {
__device__ __forceinline__ const char* uni_ptr(const char* p) { const unsigned long long v = (unsigned long long)p; const unsigned lo = __builtin_amdgcn_readfirstlane((unsigned)v), hi = __builtin_amdgcn_readfirstlane((unsigned)(v >> 32)); return (const char*)(((unsigned long long)hi << 32) | lo); }
typedef int i32x4 __attribute__((ext_vector_type(4)));
typedef int i32x8 __attribute__((ext_vector_type(8)));
__device__ __forceinline__ void mfma8_tied(f32x4& acc, const i32x8 a, const i32x8 b, const int sa, const int sb) {
    asm volatile("v_mfma_scale_f32_16x16x128_f8f6f4 %0, %1, %2, %0, %3, %4 op_sel_hi:[0,0,0]" : "+v"(acc) : "v"(a), "v"(b), "v"(sa), "v"(sb));
}
__device__ __forceinline__ i32x8 cat8(const bf16x8 lo, const bf16x8 hi) { return __builtin_shufflevector(__builtin_bit_cast(i32x4, lo), __builtin_bit_cast(i32x4, hi), 0, 1, 2, 3, 4, 5, 6, 7); }
constexpr int BM = 256, BK = 64, HALF = 128, HTB = HALF * BK * 2, STAGE_BYTES = 8 * HTB, NXCD = 8, WGM = 8;
__host__ __device__ __forceinline__ int lds_byte(int r, int c) { const int st = (r >> 4) * 2 + (c >> 5), rr = r & 15, cc = c & 31, ob = rr * 64 + cc * 2; return st * 1024 + (ob ^ (((ob >> 9) & 1) << 5)); }
__host__ __device__ __forceinline__ void stage_rc(int b, int& R, int& C) { const int st = b / 1024, sb = b % 1024, swz = sb ^ (((sb >> 9) & 1) << 5); R = (st >> 1) * 16 + swz / 64; C = (st & 1) * 32 + (swz % 64) / 2; }
__host__ __device__ __forceinline__ int perm32(int rho) { const int n = rho >> 4, i = rho & 15; return 8 * (i >> 2) + 4 * n + (i & 3); }
__device__ __forceinline__ unsigned cvt_pk_bf16(float lo, float hi) { unsigned r; asm volatile("v_cvt_pk_bf16_f32 %0, %1, %2" : "=v"(r) : "v"(lo), "v"(hi)); return r; }

struct Unit { const char* A; const char* B; const int* gidx; int pm, pn, aux; };

template <class Epi, class Sched, bool GATHER, bool FP8 = false>
__device__ __forceinline__ void gemm_phase(LAS unsigned char* lds, const int wid, const int K, const int lda, const int ldb, const Sched& S, const Epi& E, const int scale_w = 0x7F7F7F7F, const int scale_a = 0x7F7F7F7F) {
    const int lane = lane_id(), tid = (wid << 6) | lane, wr = wid >> 2, wc = wid & 3, fr = lane & 15, fq = lane >> 4;
    const int nt = K / BK;
    int Ra[2], Ca[2]; unsigned voffB[2];
#pragma unroll
    for (int i = 0; i < 2; ++i) { int R, C; stage_rc(tid * 16 + i * 8192, R, C); Ra[i] = R; Ca[i] = C; const int Rb = (R & ~31) + perm32(R & 31); voffB[i] = (unsigned)(Rb * ldb + C) * 2u; }
    const size_t kstep = (size_t)(BK * 2);
    const size_t hstepB = (size_t)HALF * ldb * 2;
    const unsigned ldsw = (unsigned)wid * 1024u;
    const unsigned ldsb = (unsigned)(size_t)lds;
    const int aoff = lds_byte(wr * 64 + fr, fq * 8), boff = lds_byte(wc * 32 + fr, fq * 8);
#define PG8_SA(b, h) (((b) * 2 + (h)) * HTB)
#define PG8_SB(b, h) ((4 + (b) * 2 + (h)) * HTB)
#define PG8_STAGE(bufoff, gbase, voff) do { const unsigned long long _ub = (unsigned long long)uni_ptr((const char*)(gbase)); _Pragma("unroll") for (int _i = 0; _i < 2; ++_i) { \
        unsigned _keep; const unsigned _ld = (unsigned)__builtin_amdgcn_readfirstlane((int)(ldsb + (unsigned)(bufoff) + ldsw + (unsigned)_i * 8192u)); \
        asm volatile("s_nop 4\n\ts_mov_b32 %0, m0\n\ts_mov_b32 m0, %3\n\ts_nop 0\n\tglobal_load_lds_dwordx4 %1, %2\n\ts_mov_b32 m0, %0" : "=&s"(_keep) : "v"((voff)[_i]), "s"(_ub), "s"(_ld) : "memory"); } } while (0)
#define PG8_LDA(dst, b, h) do { _Pragma("unroll") for (int m = 0; m < 4; ++m) _Pragma("unroll") for (int k = 0; k < 2; ++k) dst[m][k] = *(const LAS bf16x8*)(lds + PG8_SA(b, h) + aoff + m * 2048 + k * 1024); } while (0)
#define PG8_LDB(dst, b, h) do { _Pragma("unroll") for (int n = 0; n < 2; ++n) _Pragma("unroll") for (int k = 0; k < 2; ++k) dst[n][k] = *(const LAS bf16x8*)(lds + PG8_SB(b, h) + boff + n * 2048 + k * 1024); } while (0)
#define PG8_MMA(ai, bj, At, Bt) do { __builtin_amdgcn_s_setprio(1); _Pragma("unroll") for (int m = 0; m < 4; ++m) _Pragma("unroll") for (int n = 0; n < 2; ++n) { \
        if constexpr (FP8) { mfma8_tied(acc[ai][bj][m][n], cat8(Bt[n][0], Bt[n][1]), cat8(At[m][0], At[m][1]), scale_w, scale_a); } \
        else { _Pragma("unroll") for (int k = 0; k < 2; ++k) acc[ai][bj][m][n] = __builtin_amdgcn_mfma_f32_16x16x32_bf16(Bt[n][k], At[m][k], acc[ai][bj][m][n], 0, 0, 0); } } \
        __builtin_amdgcn_s_setprio(0); } while (0)
#define PG8_WAIT_V(n) asm volatile("s_waitcnt vmcnt(" #n ")" ::: "memory")
#define PG8_WAIT_L(n) asm volatile("s_waitcnt lgkmcnt(" #n ")" ::: "memory")
#define PG8_BAR __builtin_amdgcn_s_barrier()
#define PG8_SCHED __builtin_amdgcn_sched_barrier(0)
    Unit cur, nxt; int ui = 0;
    if (!S.next(0, cur)) return;
    unsigned offA[2][2], offN[2][2];
#pragma unroll
    for (int h = 0; h < 2; ++h)
#pragma unroll
        for (int i = 0; i < 2; ++i) {
            const int rr = h * HALF + Ra[i];
            const int row = GATHER ? cur.gidx[rr] : rr;
            offA[h][i] = (unsigned)(row * lda + Ca[i]) * 2u; offN[h][i] = offA[h][i];
        }
    f32x4 acc[2][2][4][2];
#pragma unroll
    for (int a = 0; a < 2; ++a)
#pragma unroll
        for (int b = 0; b < 2; ++b)
#pragma unroll
            for (int m = 0; m < 4; ++m)
#pragma unroll
                for (int n = 0; n < 2; ++n) acc[a][b][m][n] = (f32x4){0.f, 0.f, 0.f, 0.f};
    bf16x8 At[4][2], B0[2][2], B1[2][2];
    const char* cA = cur.A; const char* cB = cur.B;
    PG8_STAGE(PG8_SB(0, 0), cB, voffB); PG8_STAGE(PG8_SB(0, 1), cB + hstepB, voffB); PG8_STAGE(PG8_SA(0, 0), cA, offA[0]); PG8_STAGE(PG8_SA(0, 1), cA, offA[1]);
    if (wr == 1) PG8_BAR;
    PG8_WAIT_V(2); PG8_BAR;
    PG8_STAGE(PG8_SB(1, 0), cB + kstep, voffB); PG8_STAGE(PG8_SA(1, 0), cA + kstep, offA[0]); PG8_STAGE(PG8_SB(1, 1), cB + hstepB + kstep, voffB);
    PG8_WAIT_V(6); PG8_BAR;
    for (;;) {
        const bool has_next = S.next(ui + 1, nxt);
        const char* nA = has_next ? nxt.A : cA; const char* nB = has_next ? nxt.B : cB;
        if constexpr (GATHER) {
            if (has_next) {
#pragma unroll
                for (int h = 0; h < 2; ++h)
#pragma unroll
                    for (int i = 0; i < 2; ++i) offN[h][i] = (unsigned)(nxt.gidx[h * HALF + Ra[i]] * lda + Ca[i]) * 2u;
            }
        }
#pragma unroll 1
        for (int t = 0; t < nt; t += 2) {
            const bool last = (t == nt - 2);
            const char* a1 = cA + (size_t)(t + 1) * kstep;
            const char* a2 = last ? nA : cA + (size_t)(t + 2) * kstep; const char* b2 = last ? nB : cB + (size_t)(t + 2) * kstep;
            const char* a3 = a2 + kstep; const char* b3 = b2 + kstep;
            unsigned o2[2][2];
#pragma unroll
            for (int h = 0; h < 2; ++h)
#pragma unroll
                for (int i = 0; i < 2; ++i) o2[h][i] = (GATHER && last) ? offN[h][i] : offA[h][i];
            PG8_LDB(B0, 0, 0); PG8_LDB(B1, 0, 1); PG8_SCHED; PG8_LDA(At, 0, 0); PG8_STAGE(PG8_SA(1, 1), a1, offA[1]);
            PG8_WAIT_V(8); PG8_WAIT_L(0); PG8_BAR; PG8_MMA(0, 0, At, B0); PG8_MMA(0, 1, At, B1); PG8_BAR; PG8_SCHED;
            PG8_LDA(At, 0, 1); PG8_STAGE(PG8_SB(0, 0), b2, voffB); PG8_STAGE(PG8_SB(0, 1), b2 + hstepB, voffB); PG8_STAGE(PG8_SA(0, 0), a2, o2[0]);
            PG8_WAIT_V(8); PG8_WAIT_L(0); PG8_BAR; PG8_MMA(1, 0, At, B0); PG8_MMA(1, 1, At, B1); PG8_BAR; PG8_SCHED;
            PG8_LDB(B0, 1, 0); PG8_LDB(B1, 1, 1); PG8_SCHED; PG8_LDA(At, 1, 0); PG8_STAGE(PG8_SA(0, 1), a2, o2[1]);
            PG8_WAIT_V(8); PG8_WAIT_L(0); PG8_BAR; PG8_MMA(0, 0, At, B0); PG8_MMA(0, 1, At, B1); PG8_BAR; PG8_SCHED;
            PG8_LDA(At, 1, 1); PG8_STAGE(PG8_SB(1, 0), b3, voffB); PG8_STAGE(PG8_SB(1, 1), b3 + hstepB, voffB); PG8_STAGE(PG8_SA(1, 0), a3, o2[0]);
            PG8_WAIT_V(8); PG8_WAIT_L(0); PG8_BAR; PG8_MMA(1, 0, At, B0); PG8_MMA(1, 1, At, B1); PG8_BAR; PG8_SCHED;
        }
        if (wr == 0) PG8_BAR;
        if constexpr (FP8) asm volatile("s_nop 15\n\ts_nop 15" ::: "memory");
        E(acc, cur, wr, wc, fr, fq);
        if (!has_next) break;
#pragma unroll
        for (int a = 0; a < 2; ++a)
#pragma unroll
            for (int b = 0; b < 2; ++b)
#pragma unroll
                for (int m = 0; m < 4; ++m)
#pragma unroll
                    for (int n = 0; n < 2; ++n) acc[a][b][m][n] = (f32x4){0.f, 0.f, 0.f, 0.f};
        cur = nxt; cA = nA; cB = nB; ++ui;
        if constexpr (GATHER) {
#pragma unroll
            for (int h = 0; h < 2; ++h)
#pragma unroll
                for (int i = 0; i < 2; ++i) offA[h][i] = offN[h][i];
        }
        if (wr == 1) PG8_BAR;
    }
    PG8_WAIT_V(0);
    PG8_BAR;
#undef PG8_SA
#undef PG8_SB
#undef PG8_STAGE
#undef PG8_LDA
#undef PG8_LDB
#undef PG8_MMA
#undef PG8_WAIT_V
#undef PG8_WAIT_L
#undef PG8_BAR
#undef PG8_SCHED
}

struct DenseOrder {
    const char* A; const char* Bt; size_t a_tile_bytes, b_tile_bytes; int nM, nN, nwg, G, c;
    __device__ void init(const void* A_, const void* Bt_, int M, int N, int lda, int ldb, int G_, int c_) {
        A = (const char*)A_; Bt = (const char*)Bt_; nM = M / BM; nN = N / BM; nwg = nM * nN; G = G_; c = c_;
        a_tile_bytes = (size_t)BM * lda * 2; b_tile_bytes = (size_t)BM * ldb * 2;
    }
    __device__ __forceinline__ bool next(int i, Unit& u) const {
        const long L = (long)i * G + c; if (L >= nwg) return false;
        int wgid = (int)L; { const int q = nwg / NXCD, r = nwg % NXCD, xcd = wgid % NXCD, off = wgid / NXCD; wgid = (xcd < r ? xcd * (q + 1) : r * (q + 1) + (xcd - r) * q) + off; }
        const int nig = WGM * nN, gid = wgid / nig, fm = gid * WGM, gsz = (nM - fm) < WGM ? (nM - fm) : WGM;
        u.pm = fm + ((wgid % nig) % gsz); u.pn = (wgid % nig) / gsz; u.aux = 0; u.gidx = nullptr;
        u.A = A + (size_t)u.pm * a_tile_bytes; u.B = Bt + (size_t)u.pn * b_tile_bytes; return true;
    }
};
}

#define XB_TMO      128
#define XB_XCNT(j)  (256  + 64 * (j))
#define XB_XSUB(j)  (1280 + 64 * (j))
#define XB_XGEN(j)  (2304 + 64 * (j))
#define XB_TOP      3328
#define XB_TOPGEN   3392
#define XCD_BAR_WORDS 3456
#define XB_SPIN_CAP (1u << 18)

__device__ __forceinline__ unsigned xb_ld(unsigned* p)              { return __hip_atomic_load(p, __ATOMIC_RELAXED, __HIP_MEMORY_SCOPE_AGENT); }
__device__ __forceinline__ unsigned xb_add(unsigned* p, unsigned v) { return __hip_atomic_fetch_add(p, v, __ATOMIC_RELAXED, __HIP_MEMORY_SCOPE_AGENT); }
__device__ __forceinline__ unsigned xb_xcc_id() { return (unsigned)__builtin_amdgcn_s_getreg((3 << 11) | 20) & 0xFu; }
#define XB_SPIN(cond, bar) do { unsigned _sp = 0; while (cond) { __builtin_amdgcn_s_sleep(1); \
    if ((++_sp & 255u) == 0u) { if (xb_ld(&(bar)[XB_TMO])) break; if (_sp > XB_SPIN_CAP) { atomicAdd(&(bar)[XB_TMO], 1u); break; } } } } while (0)

struct XcdBarrier {
    unsigned* bar; unsigned x; int w;
    volatile LAS unsigned* st;
};
__device__ __forceinline__ XcdBarrier xcd_barrier_post(unsigned* bar, volatile LAS unsigned* st, int wave) {
    XcdBarrier b; b.bar = bar; b.x = xb_xcc_id(); b.st = st; b.w = wave;
    if (wave == 0 && lane_id() == 0) (void)xb_add(&bar[XB_XCNT(b.x)], 1u);
    return b;
}
__device__ __forceinline__ void xcd_barrier_complete(unsigned* bar, unsigned x, unsigned& nloc, unsigned& nx) {
    const unsigned G = gridDim.x * gridDim.y * gridDim.z;
    unsigned sum, cnt, mine, sp = 0u;
    for (;;) {
        sum = 0u; cnt = 0u; mine = 0u;
#pragma unroll
        for (unsigned j = 0; j < 16; ++j) { const unsigned c = xb_ld(&bar[XB_XCNT(j)]); sum += c; cnt += (c > 0u) ? 1u : 0u; mine = (j == x) ? c : mine; }
        if (sum == G) break;
        __builtin_amdgcn_s_sleep(1);
        if ((++sp & 255u) == 0u) { if (xb_ld(&bar[XB_TMO])) break; if (sp > XB_SPIN_CAP) { atomicAdd(&bar[XB_TMO], 1u); break; } }
    }
    nloc = mine > 0u ? mine : 1u; nx = cnt > 0u ? cnt : 1u;
}
__device__ __forceinline__ void xcd_barrier(const XcdBarrier& b) {
    asm volatile("s_waitcnt vmcnt(0)" ::: "memory");
    __syncthreads();
    if (b.w == 0 && lane_id() == 0) {
        unsigned* bar = b.bar;
        __builtin_amdgcn_s_waitcnt(0);
        unsigned nloc = b.st[0], nx = b.st[1];
        if (nloc == 0u) { xcd_barrier_complete(bar, b.x, nloc, nx); b.st[0] = nloc; b.st[1] = nx; }
        const unsigned old = xb_add(&bar[XB_XSUB(b.x)], 1u);
        const unsigned gen = old / nloc;
        if (old + 1u == (gen + 1u) * nloc) {
            __builtin_amdgcn_fence(__ATOMIC_RELEASE, "agent");
            asm volatile("s_waitcnt vmcnt(0)" ::: "memory");
            const unsigned og = xb_add(&bar[XB_TOP], 1u);
            const unsigned tg = og / nx;
            if (og + 1u == (tg + 1u) * nx) xb_add(&bar[XB_TOPGEN], 1u);
            else XB_SPIN(xb_ld(&bar[XB_TOPGEN]) == tg, bar);
            __builtin_amdgcn_fence(__ATOMIC_ACQUIRE, "agent");
            xb_add(&bar[XB_XGEN(b.x)], 1u);
            asm volatile("s_waitcnt vmcnt(0)" ::: "memory");
        } else {
            XB_SPIN(xb_ld(&bar[XB_XGEN(b.x)]) == gen, bar);
            __builtin_amdgcn_fence(__ATOMIC_ACQUIRE, "agent");
            asm volatile("s_waitcnt vmcnt(0)" ::: "memory");
        }
    }
    __syncthreads();
}

constexpr size_t MiB = 1u << 20;
constexpr size_t WS_CTL = 0, CTL_ZERO_BYTES = 1 * MiB;
constexpr size_t WS_SMALL = 1 * MiB;
constexpr size_t WS_RSTD1 = WS_SMALL;
constexpr size_t WS_LOGI = WS_SMALL + 1 * MiB;
constexpr size_t WS_LOGF = WS_SMALL + 2 * MiB;
constexpr size_t WS_TOPI = WS_SMALL + 3 * MiB;
constexpr size_t WS_TOPG = WS_SMALL + 4 * MiB;
constexpr size_t WS_STOK = WS_SMALL + 5 * MiB;
constexpr size_t WS_SGATE = WS_SMALL + 6 * MiB;
constexpr size_t WS_ESTART = WS_SMALL + 7 * MiB;
constexpr size_t WS_BTIN = 17 * MiB;
constexpr size_t WS_BTOUT = 25 * MiB;
constexpr size_t WS_BT1 = 29 * MiB;
constexpr size_t WS_BT2 = 157 * MiB;
constexpr size_t WS_R1 = 221 * MiB;
constexpr size_t WS_XM = 285 * MiB;
constexpr size_t WS_SZ = 349 * MiB;
constexpr size_t WS_U = 413 * MiB;
constexpr size_t WS_Q = 477 * MiB;
constexpr size_t WS_YMIX = 477 * MiB;
constexpr size_t WS_ACT = 285 * MiB;
constexpr size_t WS_NEED = 925 * MiB;

constexpr int NWAVES = 8;
constexpr int RING_BYTES = 131072;
constexpr int LDSCTL_OFF = RING_BYTES;
constexpr int LDS_BYTES = 147456;
constexpr int CW_BAR = 4096;

struct MegaArgs {
    const float* in[27];
    float* out;
    unsigned char* ws;
    int ph_lo, ph_hi, li, pad;
};

__device__ __forceinline__ unsigned pk2(float lo, float hi) { return pg8::cvt_pk_bf16(lo, hi); }

__device__ __forceinline__ void p0_transpose_item(const float* W, int K, int N, bf16_t* WT, const float* ksc, int k0, int n0s, int n0d, LAS float* scr, int lane) {
    const int kr = lane >> 4, nq = lane & 15;
    f32x4 v[16];
#pragma unroll
    for (int i = 0; i < 16; ++i) v[i] = *(const f32x4*)(W + (size_t)(k0 + 4 * i + kr) * N + n0s + 4 * nq);
    if (ksc) {
#pragma unroll
        for (int i = 0; i < 16; ++i) v[i] = v[i] * ksc[k0 + 4 * i + kr];
    }
    const int c = lane >> 4, nl = lane & 15;
#pragma unroll
    for (int half = 0; half < 2; ++half) {
#pragma unroll
        for (int ii = 0; ii < 8; ++ii) *(LAS f32x4*)(scr + (4 * ii + kr) * 68 + 4 * nq) = v[8 * half + ii];
        asm volatile("s_waitcnt lgkmcnt(0)" ::: "memory");
#pragma unroll
        for (int j = 0; j < 4; ++j) { const int n = nl + 16 * j; const LAS float* sp = scr + (8 * c) * 68 + n;
            u32x4 o; o.x = pk2(sp[0 * 68], sp[1 * 68]); o.y = pk2(sp[2 * 68], sp[3 * 68]); o.z = pk2(sp[4 * 68], sp[5 * 68]); o.w = pk2(sp[6 * 68], sp[7 * 68]);
            *(u32x4*)(WT + (size_t)(n0d + n) * K + k0 + 32 * half + 8 * c) = o; }
        asm volatile("s_waitcnt lgkmcnt(0)" ::: "memory");
    }
}
__device__ __forceinline__ unsigned pk4_fp8(float a, float b, float c, float d) { int w = __builtin_amdgcn_cvt_pk_fp8_f32(a, b, 0, false); w = __builtin_amdgcn_cvt_pk_fp8_f32(c, d, w, true); return (unsigned)w; }
__device__ __forceinline__ void p0_transpose_item8(const float* W, int K, int N, unsigned char* WT, const float* ksc, float mul, int k0, int n0s, int n0d, LAS float* scr, int lane) {
    const int kr = lane >> 4, nq = lane & 15;
    f32x4 v[16];
#pragma unroll
    for (int i = 0; i < 16; ++i) v[i] = *(const f32x4*)(W + (size_t)(k0 + 4 * i + kr) * N + n0s + 4 * nq);
#pragma unroll
    for (int i = 0; i < 16; ++i) v[i] = v[i] * (ksc ? ksc[k0 + 4 * i + kr] * mul : mul);
    const int c = lane >> 4, nl = lane & 15;
#pragma unroll
    for (int half = 0; half < 2; ++half) {
#pragma unroll
        for (int ii = 0; ii < 8; ++ii) *(LAS f32x4*)(scr + (4 * ii + kr) * 68 + 4 * nq) = v[8 * half + ii];
        asm volatile("s_waitcnt lgkmcnt(0)" ::: "memory");
#pragma unroll
        for (int j = 0; j < 4; ++j) { const int n = nl + 16 * j; const LAS float* sp = scr + (8 * c) * 68 + n;
            u32x2 o; o.x = pk4_fp8(sp[0 * 68], sp[1 * 68], sp[2 * 68], sp[3 * 68]); o.y = pk4_fp8(sp[4 * 68], sp[5 * 68], sp[6 * 68], sp[7 * 68]);
            *(u32x2*)(WT + (size_t)(n0d + n) * K + k0 + 32 * half + 8 * c) = o; }
        asm volatile("s_waitcnt lgkmcnt(0)" ::: "memory");
    }
}
__device__ __forceinline__ int inproj_src_col(int nd) { if (nd < 2048) return nd; const int pn = (nd >> 8) - 8, lc = nd & 255; return 2048 + (lc >> 7) * 1024 + 128 * pn + (lc & 127); }
__device__ __forceinline__ int w1_src_col(int nd) { const int pn = nd >> 8, lc = nd & 255; return (lc >> 7) * 1024 + 128 * pn + (lc & 127); }

__device__ __forceinline__ void p0_prologue(const MegaArgs& a, LAS unsigned char* lds, int gw, int NGW, int wave, int lane) {
    LAS float* scr = (LAS float*)(lds + wave * 16384);
    unsigned char* ws = a.ws;
    const float* x = a.in[0];
    {
        bf16_t* xbf = (bf16_t*)(ws + WS_R1); float* rstd1 = (float*)(ws + WS_RSTD1);
        for (int m = gw; m < NTOK; m += NGW) {
            const f32x4* xr = (const f32x4*)(x + (size_t)m * DM) + lane;
            f32x4 v[4]; float s = 0.f;
#pragma unroll
            for (int j = 0; j < 4; ++j) { v[j] = xr[64 * j]; s += (v[j].x * v[j].x + v[j].y * v[j].y) + (v[j].z * v[j].z + v[j].w * v[j].w); }
            s = wave_sum(s);
            if (lane == 0) rstd1[m] = rsqrtf(s * (1.0f / DM) + EPSV);
            unsigned long long* o8 = (unsigned long long*)(xbf + (size_t)m * DM) + lane;
#pragma unroll
            for (int j = 0; j < 4; ++j) o8[64 * j] = (unsigned long long)pk2(v[j].x, v[j].y) | ((unsigned long long)pk2(v[j].z, v[j].w) << 32);
        }
    }
    constexpr int I_IN = (1024 / 64) * (4096 / 64);
    constexpr int I_OUT = (2048 / 64) * (1024 / 64);
    constexpr int I_W1 = 32 * (1024 / 64) * (2048 / 64);
    constexpr int I_W2 = 32 * (1024 / 64) * (1024 / 64);
    constexpr int NITEMS = I_IN + I_OUT + I_W1 + I_W2;
    for (int it = gw; it < NITEMS; it += NGW) {
        int r = it;
        if (r < I_IN) { const int kb = r / 64, nb = r % 64; p0_transpose_item(a.in[2], 1024, 4096, (bf16_t*)(ws + WS_BTIN), a.in[1], 64 * kb, inproj_src_col(64 * nb), 64 * nb, scr, lane); continue; }
        r -= I_IN;
        if (r < I_OUT) { const int kb = r / 16, nb = r % 16; p0_transpose_item(a.in[18], 2048, 1024, (bf16_t*)(ws + WS_BTOUT), nullptr, 64 * kb, 64 * nb, 64 * nb, scr, lane); continue; }
        r -= I_OUT;
        if (r < I_W1) { const int e = r / 512, rr = r % 512, kb = rr / 32, nb = rr % 32;
            p0_transpose_item8(a.in[22] + (size_t)e * 1024 * 2048, 1024, 2048, ws + WS_BT1 + (size_t)e * 2048 * 1024, a.in[19], 32.0f, 64 * kb, w1_src_col(64 * nb), 64 * nb, scr, lane); continue; }
        r -= I_W1;
        { const int e = r / 256, rr = r % 256, kb = rr / 16, nb = rr % 16;
            p0_transpose_item8(a.in[24] + (size_t)e * 1024 * 1024, 1024, 1024, ws + WS_BT2 + (size_t)e * 1024 * 1024, nullptr, 32.0f, 64 * kb, 64 * nb, 64 * nb, scr, lane); }
    }
}

struct EpiInProj {
    const float* rstd; bf16_t* xm; bf16_t* sz; bf16_t* u;
    __device__ __forceinline__ void operator()(const f32x4 (&acc)[2][2][4][2], const pg8::Unit& un, int wr, int wc, int fr, int fq) const {
        const int row0 = un.pm * 256 + wr * 64 + fr;
        const int cl = wc * 32 + 8 * fq;
#pragma unroll
        for (int ai = 0; ai < 2; ++ai)
#pragma unroll
            for (int m = 0; m < 4; ++m) {
                const int row = row0 + ai * 128 + m * 16;
                const float rs = rstd[row];
                if (un.pn < 8) {
                    bf16_t* dst = (un.pn < 4 ? xm : sz) + (size_t)row * DM + (un.pn & 3) * 256 + cl;
#pragma unroll
                    for (int bj = 0; bj < 2; ++bj) {
                        f32x4 v0 = acc[ai][bj][m][0] * rs, v1 = acc[ai][bj][m][1] * rs;
                        if (un.pn >= 4) {
#pragma unroll
                            for (int j = 0; j < 4; ++j) { v0[j] = siluf_(v0[j]); v1[j] = siluf_(v1[j]); }
                        }
                        u32x4 w; w.x = pg8::cvt_pk_bf16(v0[0], v0[1]); w.y = pg8::cvt_pk_bf16(v0[2], v0[3]); w.z = pg8::cvt_pk_bf16(v1[0], v1[1]); w.w = pg8::cvt_pk_bf16(v1[2], v1[3]);
                        *(u32x4*)(dst + bj * 128) = w;
                    }
                } else {
                    bf16_t* dst = u + (size_t)row * DM + (un.pn - 8) * 128 + cl;
                    f32x4 o0, o1;
#pragma unroll
                    for (int j = 0; j < 4; ++j) {
                        o0[j] = (acc[ai][0][m][0][j] * rs) * sigmoidf_(acc[ai][1][m][0][j] * rs);
                        o1[j] = (acc[ai][0][m][1][j] * rs) * sigmoidf_(acc[ai][1][m][1][j] * rs);
                    }
                    u32x4 w; w.x = pg8::cvt_pk_bf16(o0[0], o0[1]); w.y = pg8::cvt_pk_bf16(o0[2], o0[3]); w.z = pg8::cvt_pk_bf16(o1[0], o1[1]); w.w = pg8::cvt_pk_bf16(o1[2], o1[3]);
                    *(u32x4*)dst = w;
                }
            }
    }
};

constexpr size_t WS_WGCNT = WS_SMALL + 8 * MiB;
constexpr size_t WS_ASGE = WS_SMALL + 9 * MiB;
constexpr size_t WS_ASGR = WS_SMALL + 10 * MiB;
constexpr size_t WS_ASGG = WS_SMALL + 11 * MiB;
constexpr size_t WS_RSTD2 = WS_SMALL + 12 * MiB;
constexpr size_t WS_SRSTD = WS_SMALL + 13 * MiB;
constexpr size_t WS_TOKSLOT = WS_SMALL + 14 * MiB;
constexpr size_t WS_TILEEXP = WS_SMALL + 15 * MiB;
constexpr size_t WS_HBF = WS_R1;
constexpr size_t WS_YROWS = 605 * MiB;
constexpr int NSLOT = NASSIGN + NEXP * 256;
constexpr int TOK_PER_WG = NTOK / 256;

__device__ __forceinline__ void phase_router(const MegaArgs& a, LAS unsigned char* lds, int tid, int lane, int wave) {
    unsigned char* ws = a.ws;
    const float* hbuf = a.out;
    const float* nfw = a.in[19]; const float* wr = a.in[20]; const float* br = a.in[21];
    float* rstd2 = (float*)(ws + WS_RSTD2);
    int* wgcnt = (int*)(ws + WS_WGCNT); int* asg_e = (int*)(ws + WS_ASGE); int* asg_r = (int*)(ws + WS_ASGR); float* asg_g = (float*)(ws + WS_ASGG);
    LAS float* hrow = (LAS float*)lds;
    LAS float* part = (LAS float*)(lds + 65536);
    LAS float* logit = (LAS float*)(lds + 65536 + 16384);
    LAS int* topi_l = (LAS int*)(lds + 65536 + 16384 + 2048);
    LAS float* topg_l = (LAS float*)(lds + 65536 + 16384 + 4096);
    LAS float* rstd_l = (LAS float*)(lds + 65536 + 16384 + 6144);
    LAS int* rank_l = (LAS int*)(lds + 65536 + 16384 + 8192);
    const int b = blockIdx.x;
    const int e = lane & 31, half = lane >> 5;
    float wreg[64];
    {
        const int kb = wave * 128 + half * 64;
#pragma unroll
        for (int i = 0; i < 64; ++i) wreg[i] = nfw[kb + i] * wr[(size_t)(kb + i) * 32 + e];
    }
    for (int bt = 0; bt < TOK_PER_WG / 16; ++bt) {
        const int t0 = b * TOK_PER_WG + bt * 16;
        {
            const int row = tid >> 5, seg = tid & 31;
            const f32x4* src = (const f32x4*)(hbuf + (size_t)(t0 + row) * DM);
            float ss = 0.f;
#pragma unroll
            for (int j = 0; j < 8; ++j) {
                const f32x4 v = src[seg + 32 * j];
                ss += (v.x * v.x + v.y * v.y) + (v.z * v.z + v.w * v.w);
                *(LAS f32x4*)(hrow + row * 1024 + (seg + 32 * j) * 4) = v;
            }
#pragma unroll
            for (int o = 16; o > 0; o >>= 1) ss += __shfl_xor(ss, o);
            if (seg == 0) { const float rs = rsqrtf(ss * (1.0f / DM) + EPSV); rstd_l[row] = rs; rstd2[t0 + row] = rs; }
        }
        __syncthreads();
        {
            const int kb = wave * 128 + half * 64;
            for (int tk = 0; tk < 16; ++tk) {
                const LAS f32x4* hp = (const LAS f32x4*)(hrow + tk * 1024 + kb);
                float acc = 0.f;
#pragma unroll
                for (int i = 0; i < 16; ++i) { const f32x4 v = hp[i]; acc += v.x * wreg[4 * i] + v.y * wreg[4 * i + 1] + v.z * wreg[4 * i + 2] + v.w * wreg[4 * i + 3]; }
                acc += __shfl_xor(acc, 32);
                if (half == 0) part[(wave * 16 + tk) * 32 + e] = acc;
            }
        }
        __syncthreads();
        {
            const int tk = tid >> 5, ee = tid & 31;
            float s = 0.f;
#pragma unroll
            for (int w = 0; w < 8; ++w) s += part[(w * 16 + tk) * 32 + ee];
            logit[tk * 32 + ee] = s * rstd_l[tk] + br[ee];
        }
        __syncthreads();
        if (tid < 16) {
            int sel[4]; float val[4];
            unsigned used = 0u;
#pragma unroll
            for (int r = 0; r < 4; r++) {
                int bi = -1; float bv = 0.f;
                for (int ee = 0; ee < 32; ee++) {
                    if (used & (1u << ee)) continue;
                    const float xx = logit[tid * 32 + ee];
                    if (bi < 0 || xx > bv) { bi = ee; bv = xx; }
                }
                used |= 1u << bi;
                sel[r] = bi; val[r] = bv;
            }
            float ex[4], sum = 0.f;
#pragma unroll
            for (int r = 0; r < 4; r++) { ex[r] = __expf(val[r] - val[0]); sum += ex[r]; }
            const float inv = 1.0f / sum;
#pragma unroll
            for (int r = 0; r < 4; r++) { topi_l[(bt * 16 + tid) * 4 + r] = sel[r]; topg_l[(bt * 16 + tid) * 4 + r] = ex[r] * inv; }
        }
        __syncthreads();
    }
    if (wave == 0 && lane < 32) {
        int run = 0;
        for (int i = 0; i < TOK_PER_WG * 4; ++i) { const int ee = topi_l[i]; if (ee == lane) { rank_l[i] = run; ++run; } }
        wgcnt[b * 32 + lane] = run;
    }
    __syncthreads();
    {
        int i = tid; asm volatile("" : "+v"(i));
        const int aidx = b * TOK_PER_WG * 4 + i;
        asg_e[aidx] = topi_l[i]; asg_r[aidx] = rank_l[i]; asg_g[aidx] = topg_l[i];
    }
}

__device__ __forceinline__ void phase_slots(const MegaArgs& a, LAS unsigned char* lds, int tid) {
    unsigned char* ws = a.ws;
    const int* wgcnt = (const int*)(ws + WS_WGCNT); const int* asg_e = (const int*)(ws + WS_ASGE); const int* asg_r = (const int*)(ws + WS_ASGR); const float* asg_g = (const float*)(ws + WS_ASGG);
    const float* rstd2 = (const float*)(ws + WS_RSTD2);
    int* slot_tok = (int*)(ws + WS_STOK); float* slot_gate = (float*)(ws + WS_SGATE); float* slot_rstd = (float*)(ws + WS_SRSTD);
    int* tok_slot = (int*)(ws + WS_TOKSLOT); int* tile_exp = (int*)(ws + WS_TILEEXP);
    LAS int* tot = (LAS int*)lds; LAS int* bef = tot + 32; LAS int* tstart = bef + 32;
    const int b = blockIdx.x;
    if (tid < 32) {
        int t = 0, bf = 0;
        for (int bb = 0; bb < 256; ++bb) { const int c = wgcnt[bb * 32 + tid]; t += c; if (bb < b) bf += c; }
        tot[tid] = t; bef[tid] = bf;
    }
    __syncthreads();
    if (tid == 0) { int ts = 0; for (int e = 0; e < 32; ++e) { tstart[e] = ts; ts += (tot[e] + 255) >> 8; } tstart[32] = ts; }
    __syncthreads();
    {
        int tid_o = tid; asm volatile("" : "+v"(tid_o));
        const int aidx = b * TOK_PER_WG * 4 + tid_o;
        const int e = asg_e[aidx];
        const int slot = 256 * tstart[e] + bef[e] + asg_r[aidx];
        const int tk = aidx >> 2;
        slot_tok[slot] = tk; slot_gate[slot] = asg_g[aidx]; slot_rstd[slot] = rstd2[tk]; tok_slot[aidx] = slot;
    }
    if (b < 32) {
        const int e = b; const int s0 = 256 * tstart[e] + tot[e], s1 = 256 * tstart[e + 1];
        for (int s = s0 + tid; s < s1; s += NWAVES * 64) { slot_tok[s] = 0; slot_gate[s] = 0.f; slot_rstd[s] = 0.f; }
    }
    if (b == 0) {
        if (tid < 32) for (int t = tstart[tid]; t < tstart[tid + 1]; ++t) tile_exp[t] = tid;
        if (tid == 0) tile_exp[2048] = tstart[32];
    }
}

struct MoeOrder {
    const char* A; const char* Bt; const int* gidx; const int* tile_exp; size_t a_tile_bytes, b_exp_bytes, b_tile_bytes; int T, nN, group, c;
    __device__ __forceinline__ bool next(int i, pg8::Unit& u) const {
        const int x = c & 7, j = c >> 3;
        const int tile = (i * 8 + x) * group + (j % group);
        if (tile >= T) return false;
        const int e = __builtin_amdgcn_readfirstlane(tile_exp[tile]);
        u.pm = tile; u.pn = j / group; u.aux = e;
        u.gidx = gidx ? gidx + 256 * tile : nullptr;
        u.A = gidx ? A : A + (size_t)tile * a_tile_bytes;
        u.B = Bt + (size_t)e * b_exp_bytes + (size_t)u.pn * b_tile_bytes;
        return true;
    }
};

struct EpiMoe1 {
    const float* srstd; const float* b1; unsigned char* act;
    __device__ __forceinline__ void operator()(const f32x4 (&acc)[2][2][4][2], const pg8::Unit& un, int wr, int wc, int fr, int fq) const {
        const int e = un.aux;
        const int cl = un.pn * 128 + wc * 32 + 8 * fq;
        f32x4 bg[2], bl[2];
#pragma unroll
        for (int n = 0; n < 2; ++n) { bg[n] = *(const f32x4*)(b1 + (size_t)e * 2048 + cl + 4 * n); bl[n] = *(const f32x4*)(b1 + (size_t)e * 2048 + 1024 + cl + 4 * n); }
        const int slot0 = un.pm * 256 + wr * 64 + fr;
#pragma unroll
        for (int ai = 0; ai < 2; ++ai)
#pragma unroll
            for (int m = 0; m < 4; ++m) {
                const int slot = slot0 + ai * 128 + m * 16;
                const float rs = srstd[slot];
                f32x4 o[2];
#pragma unroll
                for (int n = 0; n < 2; ++n)
#pragma unroll
                    for (int j = 0; j < 4; ++j) {
                        const float g = acc[ai][0][m][n][j] * rs + bg[n][j];
                        const float l = acc[ai][1][m][n][j] * rs + bl[n][j];
                        const float xg = fminf(g, 7.0f);
                        const float xl = fminf(fmaxf(l, -7.0f), 7.0f);
                        o[n][j] = xg * sigmoidf_(1.702f * xg) * (xl + 1.0f);
                    }
                u32x2 w; w.x = pk4_fp8(o[0][0], o[0][1], o[0][2], o[0][3]); w.y = pk4_fp8(o[1][0], o[1][1], o[1][2], o[1][3]);
                *(u32x2*)(act + (size_t)slot * DM + cl) = w;
            }
    }
};
struct EpiMoe2 {
    const float* sgate; const float* b2; bf16_t* yrows;
    __device__ __forceinline__ void operator()(const f32x4 (&acc)[2][2][4][2], const pg8::Unit& un, int wr, int wc, int fr, int fq) const {
        const int e = un.aux;
        const int c0 = un.pn * 256 + wc * 32 + 8 * fq;
        f32x4 bv[2][2];
#pragma unroll
        for (int bj = 0; bj < 2; ++bj)
#pragma unroll
            for (int n = 0; n < 2; ++n) bv[bj][n] = *(const f32x4*)(b2 + (size_t)e * DM + c0 + bj * 128 + 4 * n);
        const int slot0 = un.pm * 256 + wr * 64 + fr;
#pragma unroll
        for (int ai = 0; ai < 2; ++ai)
#pragma unroll
            for (int m = 0; m < 4; ++m) {
                const int slot = slot0 + ai * 128 + m * 16;
                const float gt = sgate[slot];
#pragma unroll
                for (int bj = 0; bj < 2; ++bj) {
                    const f32x4 v0 = (acc[ai][bj][m][0] + bv[bj][0]) * gt, v1 = (acc[ai][bj][m][1] + bv[bj][1]) * gt;
                    u32x4 w; w.x = pg8::cvt_pk_bf16(v0[0], v0[1]); w.y = pg8::cvt_pk_bf16(v0[2], v0[3]); w.z = pg8::cvt_pk_bf16(v1[0], v1[1]); w.w = pg8::cvt_pk_bf16(v1[2], v1[3]);
                    *(u32x4*)(yrows + (size_t)slot * DM + c0 + bj * 128) = w;
                }
            }
    }
};

struct FinBuf { f32x4 h[4]; u32x2 y[4][4]; };
__device__ __forceinline__ void fin_load(const float* hbuf, const bf16_t* yrows, const int* tok_slot, int t, int lane, FinBuf& B) {
    const f32x4* hp = (const f32x4*)(hbuf + (size_t)t * DM) + lane;
#pragma unroll
    for (int j = 0; j < 4; ++j) B.h[j] = hp[64 * j];
#pragma unroll
    for (int r = 0; r < 4; ++r) {
        const int slot = __builtin_amdgcn_readfirstlane(__hip_atomic_load(tok_slot + t * 4 + r, __ATOMIC_RELAXED, __HIP_MEMORY_SCOPE_AGENT));
        const u32x2* yp = (const u32x2*)(yrows + (size_t)slot * DM) + lane;
#pragma unroll
        for (int j = 0; j < 4; ++j) B.y[r][j] = yp[64 * j];
    }
}
__device__ __forceinline__ void fin_compute(float* hbuf, const float* fw, int t, int lane, const FinBuf& B) {
    f32x4 v[4];
#pragma unroll
    for (int j = 0; j < 4; ++j) {
        v[j] = B.h[j];
#pragma unroll
        for (int r = 0; r < 4; ++r) {
            const u32x2 w = B.y[r][j];
            v[j].x += __uint_as_float(w.x << 16); v[j].y += __uint_as_float(w.x & 0xFFFF0000u);
            v[j].z += __uint_as_float(w.y << 16); v[j].w += __uint_as_float(w.y & 0xFFFF0000u);
        }
    }
    float s = 0.f;
#pragma unroll
    for (int j = 0; j < 4; ++j) s += (v[j].x * v[j].x + v[j].y * v[j].y) + (v[j].z * v[j].z + v[j].w * v[j].w);
    s = wave_sum(s);
    const float rs = rsqrtf(s * (1.0f / DM) + EPSV);
    f32x4* hp = (f32x4*)(hbuf + (size_t)t * DM) + lane;
#pragma unroll
    for (int j = 0; j < 4; ++j) {
        const f32x4 w = *((const f32x4*)fw + lane + 64 * j);
        hp[64 * j] = v[j] * rs * w;
    }
}
__device__ __forceinline__ void phase_final(const MegaArgs& a, int gw, int NGW, int lane) {
    unsigned char* ws = a.ws;
    float* hbuf = a.out; const float* fw = a.in[26];
    const bf16_t* yrows = (const bf16_t*)(ws + WS_YROWS); const int* tok_slot = (const int*)(ws + WS_TOKSLOT);
    FinBuf A, B;
    int t = gw;
    if (t < NTOK) fin_load(hbuf, yrows, tok_slot, t, lane, A);
    for (; t < NTOK; t += 2 * NGW) {
        const int t2 = t + NGW;
        if (t2 < NTOK) fin_load(hbuf, yrows, tok_slot, t2, lane, B);
        fin_compute(hbuf, fw, t, lane, A);
        if (t2 < NTOK) {
            const int t3 = t2 + NGW;
            if (t3 < NTOK) fin_load(hbuf, yrows, tok_slot, t3, lane, A);
            fin_compute(hbuf, fw, t2, lane, B);
        }
    }
}

constexpr int CT = 16;
constexpr int CONV_RED_OFF = LDSCTL_OFF + 4096;
__device__ __forceinline__ void conv_load_rows(const __amdgpu_buffer_rsrc_t urs, int t0, int tid, unsigned (&R)[CT + 30]) {
    const int s0 = t0 & (SEQ - 1);
#pragma unroll
    for (int r = 0; r < CT + 30; ++r) {
        const int sp = s0 - 30 + r;
        R[r] = (sp >= 0) ? (unsigned)__builtin_amdgcn_raw_buffer_load_b32(urs, tid * 4, (t0 - 30 + r) * 2048, 0) : 0u;
    }
}
__device__ __forceinline__ void phase_conv31(const MegaArgs& a, LAS unsigned char* lds, int tid, int lane, int wave, int G) {
    unsigned char* ws = a.ws;
    const __amdgpu_buffer_rsrc_t urs = __builtin_amdgcn_make_buffer_rsrc((void*)(ws + WS_U), 0, NTOK * 2048, 0x00020000);
    const float* cw = a.in[14]; const float* cb = a.in[15]; const float* nw = a.in[16]; const float* nb = a.in[17];
    unsigned* ymix = (unsigned*)(ws + WS_YMIX);
    LAS float* wl = (LAS float*)lds;
    LAS float* red = (LAS float*)(lds + CONV_RED_OFF);
    for (int i = tid; i < 31 * 256; i += NWAVES * 64) *(LAS f32x4*)(wl + 4 * i) = *(const f32x4*)(cw + 4 * i);
    const f32x2 bias = *(const f32x2*)(cb + 2 * tid);
    const f32x2 gw2 = *(const f32x2*)(nw + 2 * tid);
    const f32x2 gb2 = *(const f32x2*)(nb + 2 * tid);
    __syncthreads();
    unsigned R[CT + 30];
    int it = blockIdx.x;
    if (it < NTOK / CT) conv_load_rows(urs, it * CT, tid, R);
    for (; it < NTOK / CT; it += G) {
        const int t0 = it * CT;
        f32x2 uf[CT + 30];
#pragma unroll
        for (int r = 0; r < CT + 30; ++r) { uf[r].x = __uint_as_float(R[r] << 16); uf[r].y = __uint_as_float(R[r] & 0xFFFF0000u); }
        if (it + G < NTOK / CT) conv_load_rows(urs, (it + G) * CT, tid, R);
        f32x2 acc[CT];
#pragma unroll
        for (int t = 0; t < CT; ++t) acc[t] = bias;
#pragma unroll
        for (int k = 0; k < 31; ++k) {
            const f32x2 w = *(const LAS f32x2*)(wl + k * 1024 + 2 * tid);
#pragma unroll
            for (int t = 0; t < CT; ++t) acc[t] = __builtin_elementwise_fma(w, uf[t + k], acc[t]);
        }
        float acc0[CT], acc1[CT];
#pragma unroll
        for (int t = 0; t < CT; ++t) { acc0[t] = acc[t].x; acc1[t] = acc[t].y; }
        float sm[CT], sq[CT];
#pragma unroll
        for (int t = 0; t < CT; ++t) { sm[t] = acc0[t] + acc1[t]; sq[t] = acc0[t] * acc0[t] + acc1[t] * acc1[t]; }
#pragma unroll
        for (int t = 0; t < CT; ++t) { sm[t] = wave_sum(sm[t]); sq[t] = wave_sum(sq[t]); }
        __syncthreads();
        if (lane == 0) {
#pragma unroll
            for (int t = 0; t < CT; ++t) { red[wave * 32 + t] = sm[t]; red[wave * 32 + CT + t] = sq[t]; }
        }
        __syncthreads();
#pragma unroll
        for (int t = 0; t < CT; ++t) {
            float s2 = 0.f, q = 0.f;
#pragma unroll
            for (int w = 0; w < 8; ++w) { s2 += red[w * 32 + t]; q += red[w * 32 + CT + t]; }
            const float mean = s2 * (1.0f / DM);
            const float var = fmaxf(q * (1.0f / DM) - mean * mean, 0.f);
            const float rs = rsqrtf(var + EPSV);
            const float y0 = siluf_((acc0[t] - mean) * rs * gw2.x + gb2.x);
            const float y1 = siluf_((acc1[t] - mean) * rs * gw2.y + gb2.y);
            ymix[(size_t)(t0 + t) * 1024 + 512 + tid] = pk2(y0, y1);
        }
    }
    __syncthreads();
}

struct YmBuf { u32x2 X[4][4]; u32x2 H[4]; u32x2 Z[4]; };
__device__ __forceinline__ void ym_load(const bf16_t* xm, const bf16_t* hm, const bf16_t* szb, int t, int lane, YmBuf& B) {
    const int s = t & (SEQ - 1);
#pragma unroll
    for (int j = 0; j < 4; ++j) {
        const int ch = 4 * lane + 256 * j;
#pragma unroll
        for (int kk = 0; kk < 4; ++kk) B.X[j][kk] = (s - 3 + kk >= 0) ? *(const u32x2*)(xm + (size_t)(t - 3 + kk) * DM + ch) : (u32x2){0u, 0u};
        B.H[j] = *(const u32x2*)(hm + (size_t)t * DM + ch);
        B.Z[j] = *(const u32x2*)(szb + (size_t)t * DM + ch);
    }
}
__device__ __forceinline__ f32x4 up4(const u32x2 r) { f32x4 v; v.x = __uint_as_float(r.x << 16); v.y = __uint_as_float(r.x & 0xFFFF0000u); v.z = __uint_as_float(r.y << 16); v.w = __uint_as_float(r.y & 0xFFFF0000u); return v; }
__device__ __forceinline__ void ym_compute(const LAS float* wts, bf16_t* ymix, int t, int lane, const YmBuf& B) {
#pragma unroll
    for (int j = 0; j < 4; ++j) {
        const int ch = 4 * lane + 256 * j;
        f32x4 xc = *(const LAS f32x4*)(wts + 4 * 1024 + ch);
#pragma unroll
        for (int kk = 0; kk < 4; ++kk) xc = xc + *(const LAS f32x4*)(wts + kk * 1024 + ch) * up4(B.X[j][kk]);
        xc.x = siluf_(xc.x); xc.y = siluf_(xc.y); xc.z = siluf_(xc.z); xc.w = siluf_(xc.w);
        const f32x4 hv = up4(B.H[j]);
        const float mean = wave_sum((hv.x + hv.y) + (hv.z + hv.w)) * (1.0f / 256.0f);
        const f32x4 d = hv - mean;
        const float var = wave_sum((d.x * d.x + d.y * d.y) + (d.z * d.z + d.w * d.w)) * (1.0f / 256.0f);
        const float rs = rsqrtf(var + EPSV);
        const f32x4 nwv = *(const LAS f32x4*)(wts + 5 * 1024 + ch), sk = *(const LAS f32x4*)(wts + 6 * 1024 + ch);
        const f32x4 y = (d * rs * nwv + sk * xc) * up4(B.Z[j]);
        u32x2 o; o.x = pk2(y.x, y.y); o.y = pk2(y.z, y.w);
        *(u32x2*)(ymix + (size_t)t * 2048 + ch) = o;
    }
}
__device__ __forceinline__ void phase_ym(const MegaArgs& a, LAS unsigned char* lds, int tid, int gw, int NGW, int lane) {
    unsigned char* ws = a.ws;
    const bf16_t* xm = (const bf16_t*)(ws + WS_XM); const bf16_t* szb = (const bf16_t*)(ws + WS_SZ); const bf16_t* hm = (const bf16_t*)(ws + WS_R1);
    bf16_t* ymix = (bf16_t*)(ws + WS_YMIX);
    LAS float* wts = (LAS float*)lds;
    for (int i = tid; i < 7 * 1024; i += NWAVES * 64) {
        const int r = i >> 10, c = i & 1023;
        wts[i] = (r < 4) ? a.in[3][r * DM + c] : (r == 4 ? a.in[4][c] : (r == 5 ? a.in[12][c] : a.in[13][c]));
    }
    __syncthreads();
    YmBuf A, B;
    int t = gw;
    if (t < NTOK) ym_load(xm, hm, szb, t, lane, A);
    for (; t < NTOK; t += 2 * NGW) {
        const int t2 = t + NGW;
        if (t2 < NTOK) ym_load(xm, hm, szb, t2, lane, B);
        ym_compute(wts, ymix, t, lane, A);
        if (t2 < NTOK) {
            const int t3 = t2 + NGW;
            if (t3 < NTOK) ym_load(xm, hm, szb, t3, lane, A);
            ym_compute(wts, ymix, t2, lane, B);
        }
    }
    __syncthreads();
}

struct EpiOutProj {
    const float* x; float* hout; unsigned char* hq;
    __device__ __forceinline__ void operator()(const f32x4 (&acc)[2][2][4][2], const pg8::Unit& un, int wr, int wc, int fr, int fq) const {
        const int row0 = un.pm * 256 + wr * 64 + fr;
        const int c0 = un.pn * 256 + wc * 32 + 8 * fq;
#pragma unroll
        for (int ai = 0; ai < 2; ++ai)
#pragma unroll
            for (int m = 0; m < 4; ++m) {
                const size_t off = (size_t)(row0 + ai * 128 + m * 16) * DM + c0;
#pragma unroll
                for (int bj = 0; bj < 2; ++bj) {
                    const f32x4 x0 = *(const f32x4*)(x + off + bj * 128), x1 = *(const f32x4*)(x + off + bj * 128 + 4);
                    const f32x4 v0 = acc[ai][bj][m][0] + x0, v1 = acc[ai][bj][m][1] + x1;
                    *(f32x4*)(hout + off + bj * 128) = v0; *(f32x4*)(hout + off + bj * 128 + 4) = v1;
                    u32x2 w; w.x = pk4_fp8(v0[0], v0[1], v0[2], v0[3]); w.y = pk4_fp8(v1[0], v1[1], v1[2], v1[3]);
                    *(u32x2*)(hq + off + bj * 128) = w;
                }
            }
    }
};

constexpr size_t WS_GCT = WS_SMALL + 512 * 1024;
constexpr size_t WS_GVT = WS_GCT + 32 * 1024;
constexpr size_t WS_FCUM = WS_SMALL + 3 * MiB;
constexpr size_t WS_UVAL = WS_SMALL + 4 * MiB;
constexpr size_t WS_MVAL = WS_SMALL + 7 * MiB;
constexpr size_t WS_ITEMS = WS_SMALL + 8 * MiB;
constexpr size_t WS_DN = WS_SMALL + 9 * MiB;
constexpr size_t WS_NPREV = WS_SMALL + 10 * MiB;
constexpr size_t WS_QB = 477 * MiB;
constexpr size_t WS_KB = 541 * MiB;
constexpr size_t WS_AEXT = 605 * MiB;
constexpr size_t WS_BEXT = 733 * MiB;
constexpr size_t WS_DCT = 861 * MiB;
constexpr size_t WS_KWT = WS_R1;
constexpr size_t WS_HM = WS_R1;
constexpr int RINV_OFF = LDSCTL_OFF + 1024;

__device__ __forceinline__ void unpack8(const u32x4 r, float (&f)[8]) {
    f[0] = __uint_as_float(r.x << 16); f[1] = __uint_as_float(r.x & 0xFFFF0000u); f[2] = __uint_as_float(r.y << 16); f[3] = __uint_as_float(r.y & 0xFFFF0000u);
    f[4] = __uint_as_float(r.z << 16); f[5] = __uint_as_float(r.z & 0xFFFF0000u); f[6] = __uint_as_float(r.w << 16); f[7] = __uint_as_float(r.w & 0xFFFF0000u);
}

__device__ __forceinline__ void p0_gate_tables(const MegaArgs& a, int gw, int NGW, int lane) {
    const float* wq = a.in[5]; const float* wk = a.in[6]; const float* wv = a.in[7]; const float* wig = a.in[8]; const float* wfg = a.in[10];
    bf16_t* gct = (bf16_t*)(a.ws + WS_GCT);
    for (int idx = gw * 64 + lane; idx < 2 * 16 * 1024; idx += NGW * 64) {
        const int tbl = idx >> 14, col = (idx >> 10) & 15, ch = idx & 1023;
        float v = 0.f;
        if (col < 8) {
            const float* Wg = (col < 4) ? wig : wfg; const int hh = col & 3, n = ch >> 2, i = ch & 3;
#pragma unroll
            for (int o = 0; o < 4; ++o) {
                if (tbl == 0) v += wq[n * 16 + i * 4 + o] * Wg[(size_t)(4 * n + o) * 4 + hh] + wk[n * 16 + i * 4 + o] * Wg[(size_t)(1024 + 4 * n + o) * 4 + hh];
                else v += wv[n * 16 + i * 4 + o] * Wg[(size_t)(2048 + 4 * n + o) * 4 + hh];
            }
        }
        gct[idx] = f2bf(v);
    }
}

struct GateBuf { u32x4 row[4]; u32x4 b1, b2; };
__device__ __forceinline__ void gate_load(const bf16_t* xm, const bf16_t* gct, const bf16_t* gvt, int t, int s, int tok, int ch0, GateBuf& B) {
#pragma unroll
    for (int kk = 0; kk < 4; ++kk) B.row[kk] = (s - 3 + kk >= 0) ? *(const u32x4*)(xm + (size_t)(t - 3 + kk) * DM + ch0) : (u32x4){0u, 0u, 0u, 0u};
    B.b1 = *(const u32x4*)(gct + (size_t)tok * 1024 + ch0);
    B.b2 = *(const u32x4*)(gvt + (size_t)tok * 1024 + ch0);
}
__device__ __forceinline__ f32x4 gate_step(const LAS float* cwl, int ch0, const GateBuf& B, f32x4 acc) {
    float xc[8];
    {
        const f32x4 b0 = *(const LAS f32x4*)(cwl + 4 * 1024 + ch0), b1 = *(const LAS f32x4*)(cwl + 4 * 1024 + ch0 + 4);
        xc[0] = b0.x; xc[1] = b0.y; xc[2] = b0.z; xc[3] = b0.w; xc[4] = b1.x; xc[5] = b1.y; xc[6] = b1.z; xc[7] = b1.w;
    }
#pragma unroll
    for (int kk = 0; kk < 4; ++kk) {
        float xf[8]; unpack8(B.row[kk], xf);
        const f32x4 w0 = *(const LAS f32x4*)(cwl + kk * 1024 + ch0), w1 = *(const LAS f32x4*)(cwl + kk * 1024 + ch0 + 4);
        xc[0] += w0.x * xf[0]; xc[1] += w0.y * xf[1]; xc[2] += w0.z * xf[2]; xc[3] += w0.w * xf[3];
        xc[4] += w1.x * xf[4]; xc[5] += w1.y * xf[5]; xc[6] += w1.z * xf[6]; xc[7] += w1.w * xf[7];
    }
#pragma unroll
    for (int i = 0; i < 8; ++i) xc[i] = siluf_(xc[i]);
    u32x4 a1; a1.x = pk2(xc[0], xc[1]); a1.y = pk2(xc[2], xc[3]); a1.z = pk2(xc[4], xc[5]); a1.w = pk2(xc[6], xc[7]);
    acc = __builtin_amdgcn_mfma_f32_16x16x32_bf16(__builtin_bit_cast(bf16x8, a1), __builtin_bit_cast(bf16x8, B.b1), acc, 0, 0, 0);
    acc = __builtin_amdgcn_mfma_f32_16x16x32_bf16(__builtin_bit_cast(bf16x8, B.row[3]), __builtin_bit_cast(bf16x8, B.b2), acc, 0, 0, 0);
    return acc;
}
__device__ __forceinline__ void phase_gates(const MegaArgs& a, LAS unsigned char* lds, int tid, int gw, int NGW, int lane) {
    unsigned char* ws = a.ws;
    const bf16_t* xm = (const bf16_t*)(ws + WS_XM);
    const bf16_t* gct = (const bf16_t*)(ws + WS_GCT); const bf16_t* gvt = (const bf16_t*)(ws + WS_GVT);
    const float* big = a.in[9]; const float* bfg = a.in[11];
    float* logi = (float*)(ws + WS_LOGI); float* logf = (float*)(ws + WS_LOGF);
    LAS float* cwl = (LAS float*)lds;
    for (int i = tid; i < 5 * 1024; i += NWAVES * 64) cwl[i] = (i < 4096) ? a.in[3][i] : a.in[4][i - 4096];
    __syncthreads();
    const int tok = lane & 15, kq = lane >> 4;
    for (int tile = gw; tile < NTOK / 16; tile += NGW) {
        const int t = tile * 16 + tok, s = t & (SEQ - 1);
        f32x4 acc = (f32x4){0.f, 0.f, 0.f, 0.f};
        GateBuf A, B;
        gate_load(xm, gct, gvt, t, s, tok, 8 * kq, A);
        for (int ks = 0; ks < 32; ks += 2) {
            gate_load(xm, gct, gvt, t, s, tok, 32 * (ks + 1) + 8 * kq, B);
            acc = gate_step(cwl, 32 * ks + 8 * kq, A, acc);
            if (ks + 2 < 32) gate_load(xm, gct, gvt, t, s, tok, 32 * (ks + 2) + 8 * kq, A);
            acc = gate_step(cwl, 32 * (ks + 1) + 8 * kq, B, acc);
        }
        const int col = lane & 15;
        if (col < 8) {
            const int hh = col & 3;
#pragma unroll
            for (int r = 0; r < 4; ++r) {
                const int tt = tile * 16 + 4 * kq + r;
                if (col < 4) logi[(size_t)hh * NTOK + tt] = acc[r] + big[hh];
                else logf[(size_t)hh * NTOK + tt] = logsigmoidf_(acc[r] + bfg[hh]);
            }
        }
    }
    __syncthreads();
}

__device__ __forceinline__ void phase_prep(const MegaArgs& a, LAS unsigned char* lds, int tid, int lane, int wave, int G) {
    unsigned char* ws = a.ws;
    const float* logi = (const float*)(ws + WS_LOGI); const float* logf = (const float*)(ws + WS_LOGF);
    float* Fcum = (float*)(ws + WS_FCUM); float* Uval = (float*)(ws + WS_UVAL); float* Mval = (float*)(ws + WS_MVAL);
    float* items = (float*)(ws + WS_ITEMS); float* dn = (float*)(ws + WS_DN);
    const bf16_t* xm = (const bf16_t*)(ws + WS_XM);
    bf16_t* qb = (bf16_t*)(ws + WS_QB); bf16_t* kb = (bf16_t*)(ws + WS_KB); bf16_t* aext = (bf16_t*)(ws + WS_AEXT); bf16_t* bext = (bf16_t*)(ws + WS_BEXT); bf16_t* kwt = (bf16_t*)(ws + WS_KWT);
    const float* cw = a.in[3]; const float* cb = a.in[4]; const float* wq = a.in[5]; const float* wk = a.in[6]; const float* wv = a.in[7];
    LAS float* gch = (LAS float*)lds;
    LAS float* umaxch = gch + 32;
    LAS float* wint_l = umaxch + 32;
    LAS float* wst_l = wint_l + 256;
    LAS float* dn_l = wst_l + 256;
    LAS float* wtl = dn_l + 8 * 256;
    for (int it = blockIdx.x; it < 512; it += G) {
        const int bh = it >> 5, c = it & 31, b = bh >> 2, h = bh & 3;
        const int tb = b * SEQ, t0 = tb + c * 256;
        {
            const int cc = tid >> 4, sub = tid & 15;
            const size_t gbase = (size_t)h * NTOK + tb + cc * 256 + 16 * sub;
            float F[16], u[16];
            {
                const f32x4* lfp = (const f32x4*)(logf + gbase); const f32x4* lip = (const f32x4*)(logi + gbase);
#pragma unroll
                for (int q4 = 0; q4 < 4; ++q4) { const f32x4 v = lfp[q4], w = lip[q4]; F[4 * q4] = v.x; F[4 * q4 + 1] = v.y; F[4 * q4 + 2] = v.z; F[4 * q4 + 3] = v.w; u[4 * q4] = w.x; u[4 * q4 + 1] = w.y; u[4 * q4 + 2] = w.z; u[4 * q4 + 3] = w.w; }
            }
#pragma unroll
            for (int jj = 1; jj < 16; ++jj) F[jj] += F[jj - 1];
            const float total = F[15];
            float incl = total;
#pragma unroll
            for (int o = 1; o < 16; o <<= 1) { const float v = __shfl_up(incl, o, 16); if (sub >= o) incl += v; }
            const float excl = incl - total;
            float um = -3.0e38f;
#pragma unroll
            for (int jj = 0; jj < 16; ++jj) { F[jj] += excl; u[jj] -= F[jj]; um = fmaxf(um, u[jj]); }
            float umx = um;
#pragma unroll
            for (int o = 1; o < 16; o <<= 1) umx = fmaxf(umx, __shfl_xor(umx, o, 16));
            const float gsum = __shfl(incl, 15, 16);
            if (sub == 0) { gch[cc] = gsum; umaxch[cc] = umx; }
            float cm[16]; cm[0] = u[0];
#pragma unroll
            for (int jj = 1; jj < 16; ++jj) cm[jj] = fmaxf(cm[jj - 1], u[jj]);
            float inclm = cm[15];
#pragma unroll
            for (int o = 1; o < 16; o <<= 1) { const float v = __shfl_up(inclm, o, 16); if (sub >= o) inclm = fmaxf(inclm, v); }
            float exclm = __shfl_up(inclm, 1, 16); if (sub == 0) exclm = -3.0e38f;
            __syncthreads();
            float m = 0.f;
            for (int c2 = 0; c2 < c; ++c2) m = gch[c2] + fmaxf(m, umaxch[c2]);
            const float mprev = m, g_c = gch[c], umax_c = umaxch[c], m_c = g_c + fmaxf(mprev, umax_c);
            if (tid == 0) { items[it] = __expf(g_c + mprev - m_c); items[512 + it] = __expf(g_c + umax_c - m_c); items[1024 + it] = mprev; }
            if (cc == c) {
#pragma unroll
                for (int jj = 0; jj < 16; ++jj) {
                    const float M = fmaxf(mprev, fmaxf(cm[jj], exclm));
                    Fcum[gbase + jj] = F[jj]; Uval[gbase + jj] = u[jj]; Mval[gbase + jj] = M;
                    wint_l[16 * sub + jj] = __expf(mprev - M); wst_l[16 * sub + jj] = __expf(u[jj] - umax_c);
                }
            }
            __syncthreads();
        }
        {
            const int ch = h * 256 + 4 * lane;
            float cwv[4][4];
            const f32x4 cbv = *(const f32x4*)(cb + ch);
#pragma unroll
            for (int kk = 0; kk < 4; ++kk) { const f32x4 w = *(const f32x4*)(cw + kk * DM + ch); cwv[kk][0] = w.x; cwv[kk][1] = w.y; cwv[kk][2] = w.z; cwv[kk][3] = w.w; }
            for (int i = tid; i < 768; i += NWAVES * 64) {
                const int mat = i >> 8, q4 = (i >> 6) & 3, ln = i & 63;
                const float* src = (mat == 0 ? wq : (mat == 1 ? wk : wv)) + (h * 64 + ln) * 16 + 4 * q4;
                *(LAS f32x4*)(wtl + 4 * i) = *(const f32x4*)src;
            }
            __syncthreads();
            const int i0 = 32 * wave;
            const __amdgpu_buffer_rsrc_t xrs = __builtin_amdgcn_make_buffer_rsrc((void*)xm, 0, NTOK * 2048, 0x00020000);
            u32x2 cur[11], nx[8];
#pragma unroll
            for (int r = 0; r < 11; ++r) {
                const int sp = c * 256 + i0 - 3 + r;
                cur[r] = (sp >= 0) ? (u32x2)__builtin_amdgcn_raw_buffer_load_b64(xrs, ch * 2, (t0 + i0 - 3 + r) * 2048, 0) : (u32x2){0u, 0u};
            }
            float dnacc[4] = {0.f, 0.f, 0.f, 0.f};
#pragma unroll 1
            for (int pb = 0; pb < 4; ++pb) {
                if (pb < 3) {
#pragma unroll
                    for (int r = 0; r < 8; ++r) nx[r] = (u32x2)__builtin_amdgcn_raw_buffer_load_b64(xrs, ch * 2, (t0 + i0 + 8 * (pb + 1) + r) * 2048, 0);
                }
                unsigned vtp[4][4], kwp[4][4];
                float vprev[4], kprev[4];
#pragma unroll
                for (int pp = 0; pp < 8; ++pp) {
                    const int i = i0 + pb * 8 + pp;
                    const f32x4 x0v = up4(cur[pp]), x1v = up4(cur[pp + 1]), x2v = up4(cur[pp + 2]), x3v = up4(cur[pp + 3]);
                    float x3[4]; x3[0] = x3v.x; x3[1] = x3v.y; x3[2] = x3v.z; x3[3] = x3v.w;
                    float xc[4];
#pragma unroll
                    for (int cc = 0; cc < 4; ++cc) xc[cc] = siluf_(cbv[cc] + cwv[0][cc] * x0v[cc] + cwv[1][cc] * x1v[cc] + cwv[2][cc] * x2v[cc] + cwv[3][cc] * x3v[cc]);
                    float qv[4], kv[4], vv[4];
                    {
                        f32x4 qa = (f32x4){0.f, 0.f, 0.f, 0.f}, ka = qa, va = qa;
#pragma unroll
                        for (int q4 = 0; q4 < 4; ++q4) {
                            qa = qa + *(const LAS f32x4*)(wtl + ((0 * 4 + q4) * 64 + lane) * 4) * xc[q4];
                            ka = ka + *(const LAS f32x4*)(wtl + ((1 * 4 + q4) * 64 + lane) * 4) * xc[q4];
                            va = va + *(const LAS f32x4*)(wtl + ((2 * 4 + q4) * 64 + lane) * 4) * x3[q4];
                        }
#pragma unroll
                        for (int o = 0; o < 4; ++o) { qv[o] = qa[o] * 0.0625f; kv[o] = ka[o]; vv[o] = va[o]; }
                    }
                    const float wi = wint_l[i], wsj = wst_l[i];
                    u32x2 o2;
                    o2.x = pk2(qv[0], qv[1]); o2.y = pk2(qv[2], qv[3]);
                    *(u32x2*)(qb + (size_t)(t0 + i) * DM + ch) = o2;
                    o2.x = pk2(kv[0], kv[1]); o2.y = pk2(kv[2], kv[3]);
                    *(u32x2*)(kb + (size_t)(t0 + i) * DM + ch) = o2;
                    o2.x = pk2(qv[0] * wi, qv[1] * wi); o2.y = pk2(qv[2] * wi, qv[3] * wi);
                    *(u32x2*)(aext + ((size_t)it * 256 + i) * 512 + 256 + 4 * lane) = o2;
#pragma unroll
                    for (int o = 0; o < 4; ++o) {
                        const float kwv = kv[o] * wsj;
                        dnacc[o] += kwv;
                        if (pp & 1) { vtp[o][pp >> 1] = pk2(vprev[o], vv[o]); kwp[o][pp >> 1] = pk2(kprev[o], kwv); }
                        else { vprev[o] = vv[o]; kprev[o] = kwv; }
                    }
                }
                const int j0 = i0 + pb * 8;
#pragma unroll
                for (int o = 0; o < 4; ++o) {
                    u32x4 w; w.x = vtp[o][0]; w.y = vtp[o][1]; w.z = vtp[o][2]; w.w = vtp[o][3];
                    *(u32x4*)(bext + ((size_t)it * 256 + 4 * lane + o) * 512 + j0) = w;
                    u32x4 w2; w2.x = kwp[o][0]; w2.y = kwp[o][1]; w2.z = kwp[o][2]; w2.w = kwp[o][3];
                    *(u32x4*)(kwt + ((size_t)it * 256 + 4 * lane + o) * 256 + j0) = w2;
                }
#pragma unroll
                for (int r = 0; r < 3; ++r) cur[r] = cur[8 + r];
#pragma unroll
                for (int r = 0; r < 8; ++r) cur[3 + r] = nx[r];
            }
#pragma unroll
            for (int o = 0; o < 4; ++o) dn_l[wave * 256 + 4 * lane + o] = dnacc[o];
            __syncthreads();
            if (tid < 256) {
                float s = 0.f;
#pragma unroll
                for (int w = 0; w < 8; ++w) s += dn_l[w * 256 + tid];
                dn[(size_t)it * 256 + tid] = s;
            }
            __syncthreads();
        }
    }
}

struct ItemOrder {
    const char* A; const char* B; size_t a_item_bytes, b_item_bytes; int per_token; int G, c;
    __device__ __forceinline__ bool next(int i, pg8::Unit& u) const {
        const int it = i * G + c; if (it >= 512) return false;
        u.pm = it; u.pn = 0; u.aux = i; u.gidx = nullptr;
        if (per_token) { const int bh = it >> 5, cc = it & 31, b = bh >> 2, h = bh & 3; const size_t off = ((size_t)(b * SEQ + cc * 256) * DM + h * 256) * 2; u.A = A + off; u.B = B + off; }
        else { u.A = A + (size_t)it * a_item_bytes; u.B = B + (size_t)it * b_item_bytes; }
        return true;
    }
};
struct EpiP {
    const float* Uval; const float* Mval; bf16_t* aext;
    __device__ __forceinline__ void operator()(const f32x4 (&acc)[2][2][4][2], const pg8::Unit& un, int wr, int wc, int fr, int fq) const {
        const int it = un.pm, bh = it >> 5, cc = it & 31, b = bh >> 2, h = bh & 3;
        const size_t gb = (size_t)h * NTOK + b * SEQ + cc * 256;
        const int jb = wc * 32 + 8 * fq;
#pragma unroll
        for (int bj = 0; bj < 2; ++bj) {
            f32x4 uj[2];
#pragma unroll
            for (int n = 0; n < 2; ++n) uj[n] = *(const f32x4*)(Uval + gb + bj * 128 + jb + 4 * n);
#pragma unroll
            for (int ai = 0; ai < 2; ++ai)
#pragma unroll
                for (int m = 0; m < 4; ++m) {
                    const int i = ai * 128 + wr * 64 + m * 16 + fr;
                    const float Mi = Mval[gb + i];
                    f32x4 o[2];
#pragma unroll
                    for (int n = 0; n < 2; ++n)
#pragma unroll
                        for (int jj = 0; jj < 4; ++jj) {
                            const int j = bj * 128 + jb + 4 * n + jj;
                            o[n][jj] = (j <= i) ? acc[ai][bj][m][n][jj] * __expf(uj[n][jj] - Mi) : 0.f;
                        }
                    u32x4 w; w.x = pg8::cvt_pk_bf16(o[0][0], o[0][1]); w.y = pg8::cvt_pk_bf16(o[0][2], o[0][3]); w.z = pg8::cvt_pk_bf16(o[1][0], o[1][1]); w.w = pg8::cvt_pk_bf16(o[1][2], o[1][3]);
                    *(u32x4*)(aext + ((size_t)it * 256 + i) * 512 + bj * 128 + jb) = w;
                    asm volatile("" ::: "memory");
                }
        }
    }
};
struct EpiDC {
    bf16_t* dct;
    __device__ __forceinline__ void operator()(const f32x4 (&acc)[2][2][4][2], const pg8::Unit& un, int wr, int wc, int fr, int fq) const {
        const int it = un.pm; const int cb0 = wc * 32 + 8 * fq;
#pragma unroll
        for (int ai = 0; ai < 2; ++ai)
#pragma unroll
            for (int m = 0; m < 4; ++m) {
                const int r = ai * 128 + wr * 64 + m * 16 + fr;
#pragma unroll
                for (int bj = 0; bj < 2; ++bj) {
                    const f32x4 v0 = acc[ai][bj][m][0], v1 = acc[ai][bj][m][1];
                    u32x4 w; w.x = pg8::cvt_pk_bf16(v0[0], v0[1]); w.y = pg8::cvt_pk_bf16(v0[2], v0[3]); w.z = pg8::cvt_pk_bf16(v1[0], v1[1]); w.w = pg8::cvt_pk_bf16(v1[2], v1[3]);
                    *(u32x4*)(dct + ((size_t)it * 256 + r) * 256 + bj * 128 + cb0) = w;
                }
            }
    }
};
struct EpiO {
    LAS const float* rinv; bf16_t* hm;
    __device__ __forceinline__ void operator()(const f32x4 (&acc)[2][2][4][2], const pg8::Unit& un, int wr, int wc, int fr, int fq) const {
        const int it = un.pm, bh = it >> 5, cc = it & 31, b = bh >> 2, h = bh & 3;
        const size_t t0 = (size_t)b * SEQ + cc * 256; const int eb = wc * 32 + 8 * fq;
#pragma unroll
        for (int ai = 0; ai < 2; ++ai)
#pragma unroll
            for (int m = 0; m < 4; ++m) {
                const int i = ai * 128 + wr * 64 + m * 16 + fr;
                const float ri = rinv[un.aux * 256 + i];
#pragma unroll
                for (int bj = 0; bj < 2; ++bj) {
                    const f32x4 v0 = acc[ai][bj][m][0] * ri, v1 = acc[ai][bj][m][1] * ri;
                    u32x4 w; w.x = pg8::cvt_pk_bf16(v0[0], v0[1]); w.y = pg8::cvt_pk_bf16(v0[2], v0[3]); w.z = pg8::cvt_pk_bf16(v1[0], v1[1]); w.w = pg8::cvt_pk_bf16(v1[2], v1[3]);
                    *(u32x4*)(hm + (t0 + i) * DM + h * 256 + bj * 128 + eb) = w;
                }
            }
    }
};

__device__ __forceinline__ void phase_scan(const MegaArgs& a, int tid) {
    unsigned char* ws = a.ws;
    const float* items = (const float*)(ws + WS_ITEMS); const bf16_t* dct = (const bf16_t*)(ws + WS_DCT); bf16_t* bext = (bf16_t*)(ws + WS_BEXT);
    const float* dn = (const float*)(ws + WS_DN); float* nprev = (float*)(ws + WS_NPREV);
    int tid_o = tid; asm volatile("" : "+v"(tid_o));
    const int gid = blockIdx.x * (NWAVES * 64) + tid_o;
    if (gid < 16 * 256 * 32) {
        const int bh = gid >> 13, e = (gid >> 5) & 255, d8 = gid & 31;
        float st[8];
#pragma unroll
        for (int i = 0; i < 8; ++i) st[i] = 0.f;
        for (int c = 0; c < 32; ++c) {
            const int it = bh * 32 + c;
            u32x4 w; w.x = pk2(st[0], st[1]); w.y = pk2(st[2], st[3]); w.z = pk2(st[4], st[5]); w.w = pk2(st[6], st[7]);
            *(u32x4*)(bext + ((size_t)it * 256 + e) * 512 + 256 + 8 * d8) = w;
            const u32x4 r = *(const u32x4*)(dct + ((size_t)it * 256 + e) * 256 + 8 * d8);
            float dv[8]; unpack8(r, dv);
            const float dec = items[it], sc = items[512 + it];
#pragma unroll
            for (int i = 0; i < 8; ++i) st[i] = dec * st[i] + sc * dv[i];
        }
    }
    if (gid < 16 * 256) {
        const int bh = gid >> 8, d = gid & 255;
        float st = 0.f;
        for (int c = 0; c < 32; ++c) {
            const int it = bh * 32 + c;
            nprev[(size_t)it * 256 + d] = st;
            st = items[it] * st + items[512 + it] * dn[(size_t)it * 256 + d];
        }
    }
}

__device__ __forceinline__ void g3_rinv(const MegaArgs& a, LAS unsigned char* lds, int tid, int G) {
    unsigned char* ws = a.ws;
    const bf16_t* aext = (const bf16_t*)(ws + WS_AEXT); const float* nprev = (const float*)(ws + WS_NPREV);
    const float* Fcum = (const float*)(ws + WS_FCUM); const float* Mval = (const float*)(ws + WS_MVAL);
    LAS float* rinv = (LAS float*)(lds + RINV_OFF);
    for (int ui = 0; ui < 2; ++ui) {
        const int it = ui * G + blockIdx.x; if (it >= 512) break;
        const int bh = it >> 5, cc = it & 31, b = bh >> 2, h = bh & 3;
        const int i = tid >> 1, part = tid & 1;
        const u32x4* rowp = (const u32x4*)(aext + ((size_t)it * 256 + i) * 512 + part * 256);
        float s = 0.f;
        if (part == 0) {
            for (int q = 0; q < 32; ++q) { float f[8]; unpack8(rowp[q], f); s += ((f[0] + f[1]) + (f[2] + f[3])) + ((f[4] + f[5]) + (f[6] + f[7])); }
        } else {
            const f32x4* np = (const f32x4*)(nprev + (size_t)it * 256);
            for (int q = 0; q < 32; ++q) { float f[8]; unpack8(rowp[q], f); const f32x4 n0 = np[2 * q], n1 = np[2 * q + 1];
                s += (f[0] * n0.x + f[1] * n0.y + f[2] * n0.z + f[3] * n0.w) + (f[4] * n1.x + f[5] * n1.y + f[6] * n1.z + f[7] * n1.w); }
        }
        s += __shfl_xor(s, 1);
        const size_t gi = (size_t)h * NTOK + b * SEQ + cc * 256 + i;
        const float mi = Fcum[gi] + Mval[gi];
        if (part == 0) rinv[ui * 256 + i] = 1.0f / fmaxf(fabsf(s), __expf(-mi));
    }
    __syncthreads();
}

__global__ void __launch_bounds__(NWAVES * 64, 2) mega_fwd(MegaArgs args) {
    extern __shared__ __attribute__((aligned(16))) unsigned char lds_raw[];
    LAS unsigned char* lds = (LAS unsigned char*)lds_raw;
    const int wave = __builtin_amdgcn_readfirstlane(threadIdx.x >> 6);
#define lane lane_id()
#define tid ((wave << 6) | lane_id())
    const int G = gridDim.x;
    const int gw = blockIdx.x * NWAVES + wave, NGW = G * NWAVES;
    unsigned char* ws = args.ws;
    unsigned* ctl = (unsigned*)(ws + WS_CTL);
    for (int u = tid; u < (LDS_BYTES - LDSCTL_OFF) / 4; u += NWAVES * 64) ((LAS unsigned*)(lds + LDSCTL_OFF))[u] = 0u;
    __syncthreads();
    XcdBarrier bar = xcd_barrier_post(ctl + CW_BAR + args.li * XCD_BAR_WORDS, (volatile LAS unsigned*)(lds + LDSCTL_OFF + 64), wave);
    const int lo = args.ph_lo, hi = args.ph_hi;
#define IN(k) (lo <= (k) && (k) < hi)
#define BOTH(k) (IN(k) && IN((k) + 1))

    if (IN(0)) { p0_prologue(args, lds, gw, NGW, wave, lane); p0_gate_tables(args, gw, NGW, lane); if (BOTH(0)) xcd_barrier(bar); }

    if (IN(1)) {
        pg8::DenseOrder S; S.init(ws + WS_R1, ws + WS_BTIN, NTOK, DPROJ, DM, DM, G, (int)blockIdx.x);
        EpiInProj E{(const float*)(ws + WS_RSTD1), (bf16_t*)(ws + WS_XM), (bf16_t*)(ws + WS_SZ), (bf16_t*)(ws + WS_U)};
        pg8::gemm_phase<EpiInProj, pg8::DenseOrder, false>(lds, wave, DM, DM, DM, S, E);
        if (BOTH(1)) xcd_barrier(bar);
    }

    if (IN(2)) { phase_gates(args, lds, tid, gw, NGW, lane); if (BOTH(2)) xcd_barrier(bar); }
    if (IN(3)) { phase_prep(args, lds, tid, lane, wave, G); if (BOTH(3)) xcd_barrier(bar); }
    if (IN(4)) {
        {
            ItemOrder S; S.A = (const char*)(ws + WS_QB); S.B = (const char*)(ws + WS_KB); S.a_item_bytes = 0; S.b_item_bytes = 0; S.per_token = 1; S.G = G; S.c = (int)blockIdx.x;
            EpiP E{(const float*)(ws + WS_UVAL), (const float*)(ws + WS_MVAL), (bf16_t*)(ws + WS_AEXT)};
            pg8::gemm_phase<EpiP, ItemOrder, false>(lds, wave, 256, DM, DM, S, E);
        }
        {
            ItemOrder S; S.A = (const char*)(ws + WS_BEXT); S.B = (const char*)(ws + WS_KWT); S.a_item_bytes = (size_t)256 * 512 * 2; S.b_item_bytes = (size_t)256 * 256 * 2; S.per_token = 0; S.G = G; S.c = (int)blockIdx.x;
            EpiDC E{(bf16_t*)(ws + WS_DCT)};
            pg8::gemm_phase<EpiDC, ItemOrder, false>(lds, wave, 256, 512, 256, S, E);
        }
        if (BOTH(4)) xcd_barrier(bar);
    }
    if (IN(5)) { phase_scan(args, tid); phase_conv31(args, lds, tid, lane, wave, G); if (BOTH(5)) xcd_barrier(bar); }
    if (IN(6)) {
        g3_rinv(args, lds, tid, G);
        ItemOrder S; S.A = (const char*)(ws + WS_AEXT); S.B = (const char*)(ws + WS_BEXT); S.a_item_bytes = (size_t)256 * 512 * 2; S.b_item_bytes = (size_t)256 * 512 * 2; S.per_token = 0; S.G = G; S.c = (int)blockIdx.x;
        EpiO E{(LAS const float*)(lds + RINV_OFF), (bf16_t*)(ws + WS_HM)};
        pg8::gemm_phase<EpiO, ItemOrder, false>(lds, wave, 512, 512, 512, S, E);
        if (BOTH(6)) xcd_barrier(bar);
    }
    if (IN(7)) { phase_ym(args, lds, tid, gw, NGW, lane); if (BOTH(7)) xcd_barrier(bar); }
    if (IN(8)) {
        pg8::DenseOrder S; S.init(ws + WS_YMIX, ws + WS_BTOUT, NTOK, DM, 2048, 2048, G, (int)blockIdx.x);
        EpiOutProj E{args.in[0], args.out, ws + WS_HBF};
        pg8::gemm_phase<EpiOutProj, pg8::DenseOrder, false>(lds, wave, 2048, 2048, 2048, S, E);
        if (BOTH(8)) xcd_barrier(bar);
    }
    if (IN(9)) { phase_router(args, lds, tid, lane, wave); if (BOTH(9)) xcd_barrier(bar); }
    if (IN(10)) { phase_slots(args, lds, tid); if (BOTH(10)) xcd_barrier(bar); }
    if (IN(11)) {
        const int T = __builtin_amdgcn_readfirstlane(__hip_atomic_load((const int*)(ws + WS_TILEEXP) + 2048, __ATOMIC_RELAXED, __HIP_MEMORY_SCOPE_AGENT));
        MoeOrder S; S.A = (const char*)(ws + WS_HBF); S.Bt = (const char*)(ws + WS_BT1); S.gidx = (const int*)(ws + WS_STOK); S.tile_exp = (const int*)(ws + WS_TILEEXP);
        S.a_tile_bytes = 0; S.b_exp_bytes = (size_t)2048 * 1024; S.b_tile_bytes = (size_t)256 * 1024; S.T = T; S.nN = 8; S.group = 4; S.c = (int)blockIdx.x;
        EpiMoe1 E{(const float*)(ws + WS_SRSTD), args.in[23], ws + WS_ACT};
        pg8::gemm_phase<EpiMoe1, MoeOrder, true, true>(lds, wave, DM / 2, DM / 2, DM / 2, S, E, 0x7A7A7A7A, 0x7F7F7F7F);
        if (BOTH(11)) xcd_barrier(bar);
    }
    if (IN(12)) {
        const int T = __builtin_amdgcn_readfirstlane(__hip_atomic_load((const int*)(ws + WS_TILEEXP) + 2048, __ATOMIC_RELAXED, __HIP_MEMORY_SCOPE_AGENT));
        MoeOrder S; S.A = (const char*)(ws + WS_ACT); S.Bt = (const char*)(ws + WS_BT2); S.gidx = nullptr; S.tile_exp = (const int*)(ws + WS_TILEEXP);
        S.a_tile_bytes = (size_t)256 * 1024; S.b_exp_bytes = (size_t)1024 * 1024; S.b_tile_bytes = (size_t)256 * 1024; S.T = T; S.nN = 4; S.group = 8; S.c = (int)blockIdx.x;
        EpiMoe2 E{(const float*)(ws + WS_SGATE), args.in[25], (bf16_t*)(ws + WS_YROWS)};
        pg8::gemm_phase<EpiMoe2, MoeOrder, false, true>(lds, wave, DM / 2, DM / 2, DM / 2, S, E, 0x7A7A7A7A, 0x7F7F7F7F);
        if (BOTH(12)) xcd_barrier(bar);
    }
    if (IN(13)) { phase_final(args, gw, NGW, lane); }
#undef IN
#undef BOTH
#undef lane
#undef tid
}

static int g_grid = 0;
static bool mega_setup(size_t ws_size) {
    if (g_grid == 0) {
        int dev = 0, cus = 0, per_cu = 0;
        if (ws_size < WS_NEED) { g_grid = -1; return false; }
        if (hipGetDevice(&dev) != hipSuccess || hipDeviceGetAttribute(&cus, hipDeviceAttributeMultiprocessorCount, dev) != hipSuccess) { g_grid = -1; return false; }
        if (hipFuncSetAttribute((const void*)mega_fwd, hipFuncAttributeMaxDynamicSharedMemorySize, LDS_BYTES) != hipSuccess) { g_grid = -1; return false; }
        (void)hipOccupancyMaxActiveBlocksPerMultiprocessor(&per_cu, (const void*)mega_fwd, NWAVES * 64, LDS_BYTES);
        (void)hipGetLastError();
        g_grid = cus;
    }
    return g_grid > 0;
}
static void mega_launch(const MegaArgs& base, int lo, int hi, int li, hipStream_t stream) {
    MegaArgs a = base; a.ph_lo = lo; a.ph_hi = hi; a.li = li; a.pad = 0;
    hipLaunchKernelGGL(mega_fwd, dim3(g_grid), dim3(NWAVES * 64), LDS_BYTES, stream, a);
}

extern "C" void kernel_launch(void* const* d_in, const int* in_sizes, int n_in, void* d_out, int out_size, void* d_ws,
                              size_t ws_size, hipStream_t stream) {
    const float* mconv_w = (const float*)d_in[3];
    const float* mconv_b = (const float*)d_in[4];
    const float* w_q = (const float*)d_in[5];
    const float* w_k = (const float*)d_in[6];
    const float* w_v = (const float*)d_in[7];
    const float* w_ig = (const float*)d_in[8];
    const float* b_ig = (const float*)d_in[9];
    const float* w_fg = (const float*)d_in[10];
    const float* b_fg = (const float*)d_in[11];
    const float* mnorm_w = (const float*)d_in[12];
    const float* mskip = (const float*)d_in[13];
    const float* cdw_w = (const float*)d_in[14];
    const float* cdw_b = (const float*)d_in[15];
    const float* cnorm_w = (const float*)d_in[16];
    const float* cnorm_b = (const float*)d_in[17];
    const float* w_out = (const float*)d_in[18];
    const float* nffn_w = (const float*)d_in[19];
    const float* w_router = (const float*)d_in[20];
    const float* b_router = (const float*)d_in[21];
    const float* w1 = (const float*)d_in[22];
    const float* b1 = (const float*)d_in[23];
    const float* w2 = (const float*)d_in[24];
    const float* b2 = (const float*)d_in[25];
    const float* final_w = (const float*)d_in[26];
    const float* x = (const float*)d_in[0];
    float* out = (float*)d_out;
    if (!mega_setup(ws_size)) return;
    unsigned char* ws = (unsigned char*)d_ws;
    (void)hipMemsetAsync(ws + WS_CTL, 0, CTL_ZERO_BYTES, stream);
    MegaArgs a{};
    for (int i = 0; i < 27; ++i) a.in[i] = (const float*)d_in[i];
    a.out = out; a.ws = ws;

    bf16_t* xm = (bf16_t*)(ws + WS_XM);
    bf16_t* szb = (bf16_t*)(ws + WS_SZ);
    bf16_t* ub = (bf16_t*)(ws + WS_U);
    bf16_t* hm = (bf16_t*)(ws + WS_R1);
    bf16_t* ymix = (bf16_t*)(ws + WS_YMIX);
    float* logi = (float*)(ws + WS_LOGI);
    float* logf = (float*)(ws + WS_LOGF);
    int* topi = (int*)(ws + WS_TOPI);
    float* topg = (float*)(ws + WS_TOPG);
    int* slot_tok = (int*)(ws + WS_STOK);
    float* slot_gate = (float*)(ws + WS_SGATE);
    int* estart = (int*)(ws + WS_ESTART);
    bf16_t* act = (bf16_t*)(ws + WS_ACT);
    bf16_t* a2 = (bf16_t*)(ws + WS_R1);

#ifndef PROBE_K
    mega_launch(a, 0, 14, 0, stream);
#else
    mega_launch(a, 0, PROBE_K + 1, 0, stream);
    mega_launch(a, PROBE_K, PROBE_K + 1, 1, stream);
    if (PROBE_K + 1 < 14) mega_launch(a, PROBE_K + 1, 14, 2, stream);
#endif
}
```

```cpp
#include <hip/hip_runtime.h>
#include <stdint.h>

#define NTOK 32768
#define SEQ 8192
#define DM 1024
#define DPROJ 4096
#define NEXP 32
#define NASSIGN (NTOK * 4)
#define EPSV 1e-5f

typedef unsigned short bf16_t;

__device__ __forceinline__ float bf2f(bf16_t h) { return __uint_as_float(((uint32_t)h) << 16); }
__device__ __forceinline__ bf16_t f2bf(float f) {
    uint32_t u = __float_as_uint(f);
    u += 0x7FFFu + ((u >> 16) & 1u);
    return (bf16_t)(u >> 16);
}
__device__ __forceinline__ float sigmoidf_(float x) { return __builtin_amdgcn_rcpf(1.0f + __expf(-x)); }
__device__ __forceinline__ float siluf_(float x) { return x * sigmoidf_(x); }
__device__ __forceinline__ float logsigmoidf_(float x) { return fminf(x, 0.0f) - log1pf(__expf(-fabsf(x))); }

template <int CTRL> __device__ __forceinline__ float dpp_mov_f(float v) { return __builtin_bit_cast(float, __builtin_amdgcn_update_dpp(0, __builtin_bit_cast(int, v), CTRL, 0xf, 0xf, false)); }
__device__ __forceinline__ float wave_sum(float v) {
    v += dpp_mov_f<0xB1>(v); v += dpp_mov_f<0x4E>(v); v += dpp_mov_f<0x124>(v); v += dpp_mov_f<0x128>(v);
    v += __builtin_bit_cast(float, __builtin_amdgcn_ds_swizzle(__builtin_bit_cast(int, v), 0x401F));
    const auto rr = __builtin_amdgcn_permlane32_swap(__float_as_uint(v), __float_as_uint(v), false, false);
    return __uint_as_float(rr[0]) + __uint_as_float(rr[1]);
}
__device__ __forceinline__ float block_sum256(float v, float* red) {
    v = wave_sum(v);
    __syncthreads();
    if ((threadIdx.x & 63) == 0) red[threadIdx.x >> 6] = v;
    __syncthreads();
    return red[0] + red[1] + red[2] + red[3];
}

template <int NB, class AF, class BF>
__device__ __forceinline__ void tile_gemm(float (&acc)[NB][4][4], int K, AF af, BF bf, float* As, float* Bs) {
    const int tid = threadIdx.x;
    const int ty = tid >> 4, tx = tid & 15;
    for (int k0 = 0; k0 < K; k0 += 16) {
#pragma unroll
        for (int i = 0; i < 4; i++) {
            int idx = tid + i * 256;
            int r = idx >> 4, kk = idx & 15;
            As[kk * 68 + r] = af(r, k0 + kk);
        }
#pragma unroll
        for (int b = 0; b < NB; b++) {
#pragma unroll
            for (int i = 0; i < 4; i++) {
                int idx = tid + i * 256;
                int kk = idx >> 6, c = idx & 63;
                Bs[(b * 16 + kk) * 64 + c] = bf(b, k0 + kk, c);
            }
        }
        __syncthreads();
#pragma unroll
        for (int kk = 0; kk < 16; kk++) {
            float a[4];
#pragma unroll
            for (int i = 0; i < 4; i++) a[i] = As[kk * 68 + ty * 4 + i];
#pragma unroll
            for (int b = 0; b < NB; b++) {
                float bb[4];
#pragma unroll
                for (int j = 0; j < 4; j++) bb[j] = Bs[(b * 16 + kk) * 64 + tx * 4 + j];
#pragma unroll
                for (int i = 0; i < 4; i++)
#pragma unroll
                    for (int j = 0; j < 4; j++) acc[b][i][j] += a[i] * bb[j];
            }
        }
        __syncthreads();
    }
}

struct PreOut { float xc[4], q[4], k[4], v[4]; };
__device__ __forceinline__ PreOut mlstm_pre(const bf16_t* __restrict__ proj, int t, int n, const float* __restrict__ cw,
                                            const float* __restrict__ cb, const float* __restrict__ wq,
                                            const float* __restrict__ wk, const float* __restrict__ wv) {
    PreOut o;
    const int s = t & (SEQ - 1);
    float xm[4][4];
#pragma unroll
    for (int kk = 0; kk < 4; kk++) {
        const int sp = s - 3 + kk;
        if (sp >= 0) {
            const uint2 raw = *(const uint2*)(proj + (size_t)(t - 3 + kk) * DM + 4 * n);
            xm[kk][0] = bf2f((bf16_t)(raw.x & 0xFFFF)); xm[kk][1] = bf2f((bf16_t)(raw.x >> 16));
            xm[kk][2] = bf2f((bf16_t)(raw.y & 0xFFFF)); xm[kk][3] = bf2f((bf16_t)(raw.y >> 16));
        } else {
            xm[kk][0] = xm[kk][1] = xm[kk][2] = xm[kk][3] = 0.f;
        }
    }
#pragma unroll
    for (int c = 0; c < 4; c++) {
        float a = cb[4 * n + c];
#pragma unroll
        for (int kk = 0; kk < 4; kk++) a += cw[kk * DM + 4 * n + c] * xm[kk][c];
        o.xc[c] = siluf_(a);
    }
#pragma unroll
    for (int oo = 0; oo < 4; oo++) {
        float aq = 0.f, ak = 0.f, av = 0.f;
#pragma unroll
        for (int i = 0; i < 4; i++) {
            aq += o.xc[i] * wq[n * 16 + i * 4 + oo];
            ak += o.xc[i] * wk[n * 16 + i * 4 + oo];
            av += xm[3][i] * wv[n * 16 + i * 4 + oo];
        }
        o.q[oo] = aq; o.k[oo] = ak; o.v[oo] = av;
    }
    return o;
}

__global__ __launch_bounds__(256) void k_gates(const bf16_t* __restrict__ proj, const float* __restrict__ cw,
                                               const float* __restrict__ cb, const float* __restrict__ wq,
                                               const float* __restrict__ wk, const float* __restrict__ wv,
                                               const float* __restrict__ wig, const float* __restrict__ big,
                                               const float* __restrict__ wfg, const float* __restrict__ bfg,
                                               float* __restrict__ logi, float* __restrict__ logf) {
    __shared__ float red[4];
    const int t = blockIdx.x, n = threadIdx.x;
    PreOut p = mlstm_pre(proj, t, n, cw, cb, wq, wk, wv);
    float pi[4], pf[4];
#pragma unroll
    for (int h = 0; h < 4; h++) {
        float ai = 0.f, af = 0.f;
#pragma unroll
        for (int o = 0; o < 4; o++) {
            const int c = 4 * n + o;
            ai += p.q[o] * wig[(size_t)c * 4 + h] + p.k[o] * wig[(size_t)(1024 + c) * 4 + h] + p.v[o] * wig[(size_t)(2048 + c) * 4 + h];
            af += p.q[o] * wfg[(size_t)c * 4 + h] + p.k[o] * wfg[(size_t)(1024 + c) * 4 + h] + p.v[o] * wfg[(size_t)(2048 + c) * 4 + h];
        }
        pi[h] = ai; pf[h] = af;
    }
#pragma unroll
    for (int h = 0; h < 4; h++) {
        float si = block_sum256(pi[h], red);
        float sf = block_sum256(pf[h], red);
        if (threadIdx.x == 0) {
            logi[(size_t)t * 4 + h] = si + big[h];
            logf[(size_t)t * 4 + h] = logsigmoidf_(sf + bfg[h]);
        }
    }
}

#define MS_QK_STRIDE 258
#define MLSTM_LDS (2 * 64 * MS_QK_STRIDE * 2 + 64 * 32 * 4 + 64 * 65 * 4 + 256 * 32 * 4 + 256 * 4 + 8 * 64 * 4)
__global__ __launch_bounds__(256) void k_mlstm(const bf16_t* __restrict__ proj, const float* __restrict__ logi,
                                               const float* __restrict__ logf, const float* __restrict__ cw,
                                               const float* __restrict__ cb, const float* __restrict__ wq,
                                               const float* __restrict__ wk, const float* __restrict__ wv,
                                               bf16_t* __restrict__ hm) {
    extern __shared__ __attribute__((aligned(16))) unsigned char smem[];
    bf16_t* qs = (bf16_t*)smem;
    bf16_t* ks = qs + 64 * MS_QK_STRIDE;
    float* vs = (float*)(ks + 64 * MS_QK_STRIDE);
    float* Ss = vs + 64 * 32;
    float* Cs = Ss + 64 * 65;
    float* nvec = Cs + 256 * 32;
    float* bcum = nvec + 256;
    float* li = bcum + 64;
    float* lf = li + 64;
    float* mrow = lf + 64;
    float* winter = mrow + 64;
    float* wst = winter + 64;
    float* den = wst + 64;

    const int tid = threadIdx.x;
    const int bh = blockIdx.x >> 3, sl = blockIdx.x & 7;
    const int b = bh >> 2, h = bh & 3;
    for (int i = tid; i < 256 * 32; i += 256) Cs[i] = 0.f;
    nvec[tid] = 0.f;
    float m_prev = 0.f;
    __syncthreads();

    for (int c = 0; c < SEQ / 64; c++) {
        const int t0 = b * SEQ + c * 64;
        for (int it = 0; it < 16; it++) {
            const int idx = tid + it * 256;
            const int r = idx >> 6, n = idx & 63;
            PreOut p = mlstm_pre(proj, t0 + r, h * 64 + n, cw, cb, wq, wk, wv);
#pragma unroll
            for (int o = 0; o < 4; o++) {
                qs[r * MS_QK_STRIDE + 4 * n + o] = f2bf(p.q[o] * 0.0625f);
                ks[r * MS_QK_STRIDE + 4 * n + o] = f2bf(p.k[o]);
            }
            if ((n >> 3) == sl) {
#pragma unroll
                for (int o = 0; o < 4; o++) vs[r * 32 + (4 * n + o - 32 * sl)] = p.v[o];
            }
        }
        if (tid < 64) {
            li[tid] = logi[(size_t)(t0 + tid) * 4 + h];
            lf[tid] = logf[(size_t)(t0 + tid) * 4 + h];
        }
        __syncthreads();
        if (tid == 0) {
            float a = 0.f;
            for (int j = 0; j < 64; j++) { a += lf[j]; bcum[j] = a; }
        }
        __syncthreads();
        {
            const int j = tid & 63, ig = tid >> 6;
            for (int ii = 0; ii < 16; ii++) {
                const int i = ig * 16 + ii;
                const uint32_t* qp = (const uint32_t*)(qs + i * MS_QK_STRIDE);
                const uint32_t* kp = (const uint32_t*)(ks + j * MS_QK_STRIDE);
                float a = 0.f;
                for (int d2 = 0; d2 < 128; d2++) {
                    const uint32_t qq = qp[d2], kk = kp[d2];
                    a += __uint_as_float(qq << 16) * __uint_as_float(kk << 16);
                    a += __uint_as_float(qq & 0xFFFF0000u) * __uint_as_float(kk & 0xFFFF0000u);
                }
                Ss[i * 65 + j] = (j <= i) ? a : 0.f;
            }
        }
        if (tid < 64) {
            const int i = tid;
            float mx = bcum[i] + m_prev;
            for (int j = 0; j <= i; j++) mx = fmaxf(mx, bcum[i] - bcum[j] + li[j]);
            mrow[i] = mx;
            winter[i] = __expf(bcum[i] + m_prev - mx);
        }
        __syncthreads();
        {
            const int j = tid & 63, ig = tid >> 6;
            for (int ii = 0; ii < 16; ii++) {
                const int i = ig * 16 + ii;
                if (j <= i) Ss[i * 65 + j] *= __expf(bcum[i] - bcum[j] + li[j] - mrow[i]);
            }
        }
        __syncthreads();
        if (tid < 64) {
            const int i = tid;
            float a = 0.f;
            for (int d = 0; d < 256; d++) a += bf2f(qs[i * MS_QK_STRIDE + d]) * nvec[d];
            float s = 0.f;
            for (int j = 0; j < 64; j++) s += Ss[i * 65 + j];
            den[i] = winter[i] * a + s;
        }
        __syncthreads();
        {
            const int e = tid & 31, ig = tid >> 5;
            for (int ii = 0; ii < 8; ii++) {
                const int i = ig * 8 + ii;
                float a1 = 0.f;
                for (int d = 0; d < 256; d++) a1 += bf2f(qs[i * MS_QK_STRIDE + d]) * Cs[d * 32 + e];
                float a2 = 0.f;
                for (int j = 0; j < 64; j++) a2 += Ss[i * 65 + j] * vs[j * 32 + e];
                const float num = winter[i] * a1 + a2;
                const float hv = num / fmaxf(fabsf(den[i]), __expf(-mrow[i]));
                hm[(size_t)(t0 + i) * DM + h * 256 + sl * 32 + e] = f2bf(hv);
            }
        }
        const float g = bcum[63];
        float m_new = g + m_prev;
        for (int j = 0; j < 64; j++) m_new = fmaxf(m_new, g - bcum[j] + li[j]);
        const float decay = __expf(g + m_prev - m_new);
        __syncthreads();
        if (tid < 64) wst[tid] = __expf(g - bcum[tid] + li[tid] - m_new);
        __syncthreads();
        {
            const int e = tid & 31, dg = tid >> 5;
            for (int dd = 0; dd < 32; dd++) {
                const int d = dg * 32 + dd;
                float a = 0.f;
                for (int j = 0; j < 64; j++) a += wst[j] * bf2f(ks[j * MS_QK_STRIDE + d]) * vs[j * 32 + e];
                Cs[d * 32 + e] = decay * Cs[d * 32 + e] + a;
            }
            const int d = tid;
            float a = 0.f;
            for (int j = 0; j < 64; j++) a += wst[j] * bf2f(ks[j * MS_QK_STRIDE + d]);
            nvec[d] = decay * nvec[d] + a;
        }
        m_prev = m_new;
        __syncthreads();
    }
}

__global__ __launch_bounds__(256) void k_conv31(const bf16_t* __restrict__ proj, const float* __restrict__ cw,
                                                const float* __restrict__ cb, const float* __restrict__ nw,
                                                const float* __restrict__ nb, bf16_t* __restrict__ ymix) {
    __shared__ float red[4];
    const int t = blockIdx.x, n = threadIdx.x;
    const int s = t & (SEQ - 1);
    float acc[4];
#pragma unroll
    for (int c = 0; c < 4; c++) acc[c] = cb[4 * n + c];
    for (int k = 0; k < 31; k++) {
        const int sp = s - 30 + k;
        if (sp >= 0) {
            const uint2 ra = *(const uint2*)(proj + (size_t)(t - 30 + k) * DM + 4 * n);
            float ga[4];
            ga[0] = bf2f((bf16_t)(ra.x & 0xFFFF)); ga[1] = bf2f((bf16_t)(ra.x >> 16));
            ga[2] = bf2f((bf16_t)(ra.y & 0xFFFF)); ga[3] = bf2f((bf16_t)(ra.y >> 16));
#pragma unroll
            for (int c = 0; c < 4; c++) acc[c] += cw[k * DM + 4 * n + c] * ga[c];
        }
    }
    const float mean = block_sum256(acc[0] + acc[1] + acc[2] + acc[3], red) * (1.0f / DM);
    float vs = 0.f;
#pragma unroll
    for (int c = 0; c < 4; c++) { const float d = acc[c] - mean; vs += d * d; }
    const float var = block_sum256(vs, red) * (1.0f / DM);
    const float rs = rsqrtf(var + EPSV);
#pragma unroll
    for (int c = 0; c < 4; c++) {
        const float y = (acc[c] - mean) * rs * nw[4 * n + c] + nb[4 * n + c];
        ymix[(size_t)t * 2048 + 1024 + 4 * n + c] = f2bf(siluf_(y));
    }
}

__global__ __launch_bounds__(256) void k_ym(const bf16_t* __restrict__ proj, const bf16_t* __restrict__ szb, const bf16_t* __restrict__ hm,
                                            const float* __restrict__ cw, const float* __restrict__ cb,
                                            const float* __restrict__ wq, const float* __restrict__ wk,
                                            const float* __restrict__ wv, const float* __restrict__ mnw,
                                            const float* __restrict__ skip, bf16_t* __restrict__ ymix) {
    const int t = blockIdx.x, n = threadIdx.x;
    PreOut p = mlstm_pre(proj, t, n, cw, cb, wq, wk, wv);
    float hv[4];
#pragma unroll
    for (int c = 0; c < 4; c++) hv[c] = bf2f(hm[(size_t)t * DM + 4 * n + c]);
    const float mean = wave_sum(hv[0] + hv[1] + hv[2] + hv[3]) * (1.0f / 256.0f);
    float vs = 0.f;
#pragma unroll
    for (int c = 0; c < 4; c++) { const float d = hv[c] - mean; vs += d * d; }
    const float var = wave_sum(vs) * (1.0f / 256.0f);
    const float rs = rsqrtf(var + EPSV);
#pragma unroll
    for (int c = 0; c < 4; c++) {
        const int ch = 4 * n + c;
        const float hn = (hv[c] - mean) * rs * mnw[ch];
        const float z = bf2f(szb[(size_t)t * DM + ch]);
        const float y = (hn + skip[ch] * p.xc[c]) * z;
        ymix[(size_t)t * 2048 + ch] = f2bf(y);
    }
}

__global__ __launch_bounds__(256) void k_outproj(const bf16_t* __restrict__ ymix, const float* __restrict__ w_out,
                                                 const float* __restrict__ x, float* __restrict__ hout) {
    __shared__ float As[16 * 68];
    __shared__ float Bs[16 * 64];
    const int col0 = blockIdx.x * 64, row0 = blockIdx.y * 64;
    float acc[1][4][4];
#pragma unroll
    for (int i = 0; i < 4; i++)
#pragma unroll
        for (int j = 0; j < 4; j++) acc[0][i][j] = 0.f;
    auto af = [&](int r, int k) -> float { return bf2f(ymix[(size_t)(row0 + r) * 2048 + k]); };
    auto bf = [&](int b, int k, int c) -> float { return w_out[(size_t)k * DM + col0 + c]; };
    tile_gemm<1>(acc, 2048, af, bf, As, Bs);
    const int ty = threadIdx.x >> 4, tx = threadIdx.x & 15;
#pragma unroll
    for (int i = 0; i < 4; i++)
#pragma unroll
        for (int j = 0; j < 4; j++) {
            const size_t o = (size_t)(row0 + ty * 4 + i) * DM + col0 + tx * 4 + j;
            hout[o] = x[o] + acc[0][i][j];
        }
}

__global__ __launch_bounds__(256) void k_router(const float* __restrict__ hbuf, const float* __restrict__ nfw,
                                                const float* __restrict__ wr, const float* __restrict__ br,
                                                bf16_t* __restrict__ a2, int* __restrict__ topi, float* __restrict__ topg) {
    __shared__ float av[DM];
    __shared__ float part[8][32];
    __shared__ float lg[32];
    __shared__ float red[4];
    const int t = blockIdx.x, tid = threadIdx.x;
    const float4 v = *(const float4*)(hbuf + (size_t)t * DM + tid * 4);
    const float ss = block_sum256(v.x * v.x + v.y * v.y + v.z * v.z + v.w * v.w, red);
    const float rs = rsqrtf(ss * (1.0f / DM) + EPSV);
    const float vv[4] = {v.x, v.y, v.z, v.w};
#pragma unroll
    for (int c = 0; c < 4; c++) {
        const float a = vv[c] * rs * nfw[tid * 4 + c];
        av[tid * 4 + c] = a;
        a2[(size_t)t * DM + tid * 4 + c] = f2bf(a);
    }
    __syncthreads();
    {
        const int e = tid & 31, pp = tid >> 5;
        float a = 0.f;
        for (int k = pp * 128; k < pp * 128 + 128; k++) a += av[k] * wr[(size_t)k * 32 + e];
        part[pp][e] = a;
    }
    __syncthreads();
    if (tid < 32) {
        float a = br[tid];
#pragma unroll
        for (int pp = 0; pp < 8; pp++) a += part[pp][tid];
        lg[tid] = a;
    }
    __syncthreads();
    if (tid == 0) {
        int sel[4]; float val[4];
        unsigned used = 0u;
#pragma unroll
        for (int r = 0; r < 4; r++) {
            int bi = -1; float bv = 0.f;
            for (int e = 0; e < 32; e++) {
                if (used & (1u << e)) continue;
                const float x = lg[e];
                if (bi < 0 || x > bv) { bi = e; bv = x; }
            }
            used |= 1u << bi;
            sel[r] = bi; val[r] = bv;
        }
        float ex[4], sum = 0.f;
#pragma unroll
        for (int r = 0; r < 4; r++) { ex[r] = __expf(val[r] - val[0]); sum += ex[r]; }
#pragma unroll
        for (int r = 0; r < 4; r++) {
            topi[(size_t)t * 4 + r] = sel[r];
            topg[(size_t)t * 4 + r] = ex[r] / sum;
        }
    }
}

__global__ __launch_bounds__(1024) void k_sort(const int* __restrict__ topi, const float* __restrict__ topg,
                                               int* __restrict__ estart, int* __restrict__ slot_tok,
                                               float* __restrict__ slot_gate) {
    extern __shared__ __attribute__((aligned(16))) unsigned char smem[];
    int* cnt = (int*)smem;
    __shared__ int es[33];
    __shared__ int tot[32];
    const int tid = threadIdx.x;
    for (int e = 0; e < 32; e++) cnt[tid * 32 + e] = 0;
    const int a0 = tid * 128;
    for (int a = a0; a < a0 + 128; a++) cnt[tid * 32 + topi[a]]++;
    __syncthreads();
    if (tid < 32) {
        int run = 0;
        for (int i = 0; i < 1024; i++) { const int c = cnt[i * 32 + tid]; cnt[i * 32 + tid] = run; run += c; }
        tot[tid] = run;
    }
    __syncthreads();
    if (tid == 0) {
        int run = 0;
        for (int e = 0; e < 32; e++) { es[e] = run; estart[e] = run; run += tot[e]; }
        es[32] = run; estart[32] = run;
    }
    __syncthreads();
    for (int a = a0; a < a0 + 128; a++) {
        const int e = topi[a];
        const int slot = es[e] + cnt[tid * 32 + e];
        cnt[tid * 32 + e]++;
        slot_tok[slot] = a >> 2;
        slot_gate[slot] = topg[a];
    }
}

__device__ __forceinline__ bool moe_tile(const int* __restrict__ estart, int rt, int& e_out, int& slot0, int& nrows) {
    for (int e = 0; e < NEXP; e++) {
        const int s0 = estart[e], s1 = estart[e + 1];
        const int nt = (s1 - s0 + 63) >> 6;
        if (rt < nt) {
            e_out = e; slot0 = s0 + rt * 64; nrows = min(64, s1 - slot0);
            return true;
        }
        rt -= nt;
    }
    return false;
}

__global__ __launch_bounds__(256) void k_moe1(const bf16_t* __restrict__ a2, const int* __restrict__ estart,
                                              const int* __restrict__ slot_tok, const float* __restrict__ w1,
                                              const float* __restrict__ b1, bf16_t* __restrict__ act) {
    __shared__ float As[16 * 68];
    __shared__ float Bs[2 * 16 * 64];
    __shared__ int toks[64];
    int e, slot0, nrows;
    if (!moe_tile(estart, blockIdx.y, e, slot0, nrows)) return;
    const int col0 = blockIdx.x * 64;
    if (threadIdx.x < 64) toks[threadIdx.x] = (threadIdx.x < nrows) ? slot_tok[slot0 + threadIdx.x] : -1;
    __syncthreads();
    float acc[2][4][4];
#pragma unroll
    for (int b = 0; b < 2; b++)
#pragma unroll
        for (int i = 0; i < 4; i++)
#pragma unroll
            for (int j = 0; j < 4; j++) acc[b][i][j] = 0.f;
    const float* w1e = w1 + (size_t)e * 1024 * 2048;
    auto af = [&](int r, int k) -> float { const int tk = toks[r]; return tk >= 0 ? bf2f(a2[(size_t)tk * DM + k]) : 0.f; };
    auto bf = [&](int b, int k, int c) -> float { return w1e[(size_t)k * 2048 + b * 1024 + col0 + c]; };
    tile_gemm<2>(acc, DM, af, bf, As, Bs);
    const int ty = threadIdx.x >> 4, tx = threadIdx.x & 15;
#pragma unroll
    for (int i = 0; i < 4; i++) {
        const int r = ty * 4 + i;
        if (r < nrows) {
#pragma unroll
            for (int j = 0; j < 4; j++) {
                const int col = col0 + tx * 4 + j;
                const float g = acc[0][i][j] + b1[(size_t)e * 2048 + col];
                const float l = acc[1][i][j] + b1[(size_t)e * 2048 + 1024 + col];
                const float xg = fminf(g, 7.0f);
                const float xl = fminf(fmaxf(l, -7.0f), 7.0f);
                act[(size_t)(slot0 + r) * DM + col] = f2bf(xg * sigmoidf_(1.702f * xg) * (xl + 1.0f));
            }
        }
    }
}

__global__ __launch_bounds__(256) void k_moe2(const bf16_t* __restrict__ act, const int* __restrict__ estart,
                                              const int* __restrict__ slot_tok, const float* __restrict__ slot_gate,
                                              const float* __restrict__ w2, const float* __restrict__ b2,
                                              float* __restrict__ hout) {
    __shared__ float As[16 * 68];
    __shared__ float Bs[16 * 64];
    int e, slot0, nrows;
    if (!moe_tile(estart, blockIdx.y, e, slot0, nrows)) return;
    const int col0 = blockIdx.x * 64;
    float acc[1][4][4];
#pragma unroll
    for (int i = 0; i < 4; i++)
#pragma unroll
        for (int j = 0; j < 4; j++) acc[0][i][j] = 0.f;
    const float* w2e = w2 + (size_t)e * 1024 * 1024;
    auto af = [&](int r, int k) -> float { return r < nrows ? bf2f(act[(size_t)(slot0 + r) * DM + k]) : 0.f; };
    auto bf = [&](int b, int k, int c) -> float { return w2e[(size_t)k * DM + col0 + c]; };
    tile_gemm<1>(acc, DM, af, bf, As, Bs);
    const int ty = threadIdx.x >> 4, tx = threadIdx.x & 15;
#pragma unroll
    for (int i = 0; i < 4; i++) {
        const int r = ty * 4 + i;
        if (r < nrows) {
            const int tk = slot_tok[slot0 + r];
            const float gt = slot_gate[slot0 + r];
#pragma unroll
            for (int j = 0; j < 4; j++) {
                const int col = col0 + tx * 4 + j;
                atomicAdd(&hout[(size_t)tk * DM + col], (acc[0][i][j] + b2[(size_t)e * DM + col]) * gt);
            }
        }
    }
}

__global__ __launch_bounds__(256) void k_final(float* __restrict__ hbuf, const float* __restrict__ fw) {
    const int row = blockIdx.x * 4 + (threadIdx.x >> 6);
    const int lane = threadIdx.x & 63;
    float4* p = (float4*)(hbuf + (size_t)row * DM);
    float4 v[4];
    float s = 0.f;
#pragma unroll
    for (int i = 0; i < 4; i++) { v[i] = p[lane + i * 64]; s += v[i].x * v[i].x + v[i].y * v[i].y + v[i].z * v[i].z + v[i].w * v[i].w; }
    s = wave_sum(s);
    const float rs = rsqrtf(s * (1.0f / DM) + EPSV);
#pragma unroll
    for (int i = 0; i < 4; i++) {
        const float4 w = *(const float4*)(fw + (lane + i * 64) * 4);
        float4 o; o.x = v[i].x * rs * w.x; o.y = v[i].y * rs * w.y; o.z = v[i].z * rs * w.z; o.w = v[i].w * rs * w.w;
        p[lane + i * 64] = o;
    }
}


#define LAS __attribute__((address_space(3)))
#define GAS __attribute__((address_space(1)))
typedef short bf16x8 __attribute__((ext_vector_type(8)));
typedef float f32x4 __attribute__((ext_vector_type(4)));
typedef float f32x2 __attribute__((ext_vector_type(2)));
typedef unsigned u32x4 __attribute__((ext_vector_type(4)));
typedef unsigned u32x2 __attribute__((ext_vector_type(2)));

__device__ __forceinline__ int lane_id() { int l = (int)__builtin_amdgcn_mbcnt_hi(~0u, __builtin_amdgcn_mbcnt_lo(~0u, 0u)); asm volatile("" : "+v"(l)); return l; }
namespace pg8 {
__device__ __forceinline__ const char* uni_ptr(const char* p) { const unsigned long long v = (unsigned long long)p; const unsigned lo = __builtin_amdgcn_readfirstlane((unsigned)v), hi = __builtin_amdgcn_readfirstlane((unsigned)(v >> 32)); return (const char*)(((unsigned long long)hi << 32) | lo); }
typedef int i32x4 __attribute__((ext_vector_type(4)));
typedef int i32x8 __attribute__((ext_vector_type(8)));
__device__ __forceinline__ void mfma8_tied(f32x4& acc, const i32x8 a, const i32x8 b, const int sa, const int sb) {
    asm volatile("v_mfma_scale_f32_16x16x128_f8f6f4 %0, %1, %2, %0, %3, %4 op_sel_hi:[0,0,0]" : "+v"(acc) : "v"(a), "v"(b), "v"(sa), "v"(sb));
}
__device__ __forceinline__ i32x8 cat8(const bf16x8 lo, const bf16x8 hi) { return __builtin_shufflevector(__builtin_bit_cast(i32x4, lo), __builtin_bit_cast(i32x4, hi), 0, 1, 2, 3, 4, 5, 6, 7); }
constexpr int BM = 256, BK = 64, HALF = 128, HTB = HALF * BK * 2, STAGE_BYTES = 8 * HTB, NXCD = 8, WGM = 8;
__host__ __device__ __forceinline__ int lds_byte(int r, int c) { const int st = (r >> 4) * 2 + (c >> 5), rr = r & 15, cc = c & 31, ob = rr * 64 + cc * 2; return st * 1024 + (ob ^ (((ob >> 9) & 1) << 5)); }
__host__ __device__ __forceinline__ void stage_rc(int b, int& R, int& C) { const int st = b / 1024, sb = b % 1024, swz = sb ^ (((sb >> 9) & 1) << 5); R = (st >> 1) * 16 + swz / 64; C = (st & 1) * 32 + (swz % 64) / 2; }
__host__ __device__ __forceinline__ int perm32(int rho) { const int n = rho >> 4, i = rho & 15; return 8 * (i >> 2) + 4 * n + (i & 3); }
__device__ __forceinline__ unsigned cvt_pk_bf16(float lo, float hi) { unsigned r; asm volatile("v_cvt_pk_bf16_f32 %0, %1, %2" : "=v"(r) : "v"(lo), "v"(hi)); return r; }

struct Unit { const char* A; const char* B; const int* gidx; int pm, pn, aux; };

template <class Epi, class Sched, bool GATHER, bool FP8 = false>
__device__ __forceinline__ void gemm_phase(LAS unsigned char* lds, const int wid, const int K, const int lda, const int ldb, const Sched& S, const Epi& E, const int scale_w = 0x7F7F7F7F, const int scale_a = 0x7F7F7F7F, const int stagger_ticks = 0) {
    const int lane = lane_id(), tid = (wid << 6) | lane, wr = wid >> 2, wc = wid & 3, fr = lane & 15, fq = lane >> 4;
    const int nt = K / BK;
    int Ra[2], Ca[2]; unsigned voffB[2];
#pragma unroll
    for (int i = 0; i < 2; ++i) { int R, C; stage_rc(tid * 16 + i * 8192, R, C); Ra[i] = R; Ca[i] = C; const int Rb = (R & ~31) + perm32(R & 31); voffB[i] = (unsigned)(Rb * ldb + C) * 2u; }
    const size_t kstep = (size_t)(BK * 2);
    const size_t hstepB = (size_t)HALF * ldb * 2;
    const unsigned ldsw = (unsigned)wid * 1024u;
    const unsigned ldsb = (unsigned)(size_t)lds;
    const int aoff = lds_byte(wr * 64 + fr, fq * 8), boff = lds_byte(wc * 32 + fr, fq * 8);
#define PG8_SA(b, h) (((b) * 2 + (h)) * HTB)
#define PG8_SB(b, h) ((4 + (b) * 2 + (h)) * HTB)
#define PG8_STAGE(bufoff, gbase, voff) do { const unsigned long long _ub = (unsigned long long)uni_ptr((const char*)(gbase)); _Pragma("unroll") for (int _i = 0; _i < 2; ++_i) { \
        unsigned _keep; const unsigned _ld = (unsigned)__builtin_amdgcn_readfirstlane((int)(ldsb + (unsigned)(bufoff) + ldsw + (unsigned)_i * 8192u)); \
        asm volatile("s_nop 4\n\ts_mov_b32 %0, m0\n\ts_mov_b32 m0, %3\n\ts_nop 0\n\tglobal_load_lds_dwordx4 %1, %2\n\ts_mov_b32 m0, %0" : "=&s"(_keep) : "v"((voff)[_i]), "s"(_ub), "s"(_ld) : "memory"); } } while (0)
#define PG8_LDA(dst, b, h) do { _Pragma("unroll") for (int m = 0; m < 4; ++m) _Pragma("unroll") for (int k = 0; k < 2; ++k) dst[m][k] = *(const LAS bf16x8*)(lds + PG8_SA(b, h) + aoff + m * 2048 + k * 1024); } while (0)
#define PG8_LDB(dst, b, h) do { _Pragma("unroll") for (int n = 0; n < 2; ++n) _Pragma("unroll") for (int k = 0; k < 2; ++k) dst[n][k] = *(const LAS bf16x8*)(lds + PG8_SB(b, h) + boff + n * 2048 + k * 1024); } while (0)
#define PG8_MMA(ai, bj, At, Bt) do { __builtin_amdgcn_s_setprio(1); _Pragma("unroll") for (int m = 0; m < 4; ++m) _Pragma("unroll") for (int n = 0; n < 2; ++n) { \
        if constexpr (FP8) { mfma8_tied(acc[ai][bj][m][n], cat8(Bt[n][0], Bt[n][1]), cat8(At[m][0], At[m][1]), scale_w, scale_a); } \
        else { _Pragma("unroll") for (int k = 0; k < 2; ++k) acc[ai][bj][m][n] = __builtin_amdgcn_mfma_f32_16x16x32_bf16(Bt[n][k], At[m][k], acc[ai][bj][m][n], 0, 0, 0); } } \
        __builtin_amdgcn_s_setprio(0); } while (0)
#define PG8_WAIT_V(n) asm volatile("s_waitcnt vmcnt(" #n ")" ::: "memory")
#define PG8_WAIT_L(n) asm volatile("s_waitcnt lgkmcnt(" #n ")" ::: "memory")
#define PG8_BAR __builtin_amdgcn_s_barrier()
#define PG8_SCHED __builtin_amdgcn_sched_barrier(0)
    if (stagger_ticks > 0 && ((blockIdx.x >> 3) & 1)) { const unsigned long long t0 = __builtin_amdgcn_s_memrealtime(); while (__builtin_amdgcn_s_memrealtime() - t0 < (unsigned long long)stagger_ticks) __builtin_amdgcn_s_sleep(8); }
    Unit cur, nxt; int ui = 0;
    if (!S.next(0, cur)) return;
    unsigned offA[2][2], offN[2][2];
#pragma unroll
    for (int h = 0; h < 2; ++h)
#pragma unroll
        for (int i = 0; i < 2; ++i) {
            const int rr = h * HALF + Ra[i];
            const int row = GATHER ? cur.gidx[rr] : rr;
            offA[h][i] = (unsigned)(row * lda + Ca[i]) * 2u; offN[h][i] = offA[h][i];
        }
    f32x4 acc[2][2][4][2];
#pragma unroll
    for (int a = 0; a < 2; ++a)
#pragma unroll
        for (int b = 0; b < 2; ++b)
#pragma unroll
            for (int m = 0; m < 4; ++m)
#pragma unroll
                for (int n = 0; n < 2; ++n) acc[a][b][m][n] = (f32x4){0.f, 0.f, 0.f, 0.f};
    bf16x8 At[4][2], B0[2][2], B1[2][2];
    const char* cA = cur.A; const char* cB = cur.B;
    PG8_STAGE(PG8_SB(0, 0), cB, voffB); PG8_STAGE(PG8_SB(0, 1), cB + hstepB, voffB); PG8_STAGE(PG8_SA(0, 0), cA, offA[0]); PG8_STAGE(PG8_SA(0, 1), cA, offA[1]);
    if (wr == 1) PG8_BAR;
    PG8_WAIT_V(2); PG8_BAR;
    PG8_STAGE(PG8_SB(1, 0), cB + kstep, voffB); PG8_STAGE(PG8_SA(1, 0), cA + kstep, offA[0]); PG8_STAGE(PG8_SB(1, 1), cB + hstepB + kstep, voffB);
    PG8_WAIT_V(6); PG8_BAR;
    for (;;) {
        const bool has_next = S.next(ui + 1, nxt);
        const char* nA = has_next ? nxt.A : cA; const char* nB = has_next ? nxt.B : cB;
        if constexpr (GATHER) {
            if (has_next) {
#pragma unroll
                for (int h = 0; h < 2; ++h)
#pragma unroll
                    for (int i = 0; i < 2; ++i) offN[h][i] = (unsigned)(nxt.gidx[h * HALF + Ra[i]] * lda + Ca[i]) * 2u;
            }
        }
#pragma unroll 1
        for (int t = 0; t < nt; t += 2) {
            const bool last = (t == nt - 2);
            const char* a1 = cA + (size_t)(t + 1) * kstep;
            const char* a2 = last ? nA : cA + (size_t)(t + 2) * kstep; const char* b2 = last ? nB : cB + (size_t)(t + 2) * kstep;
            const char* a3 = a2 + kstep; const char* b3 = b2 + kstep;
            unsigned o2[2][2];
#pragma unroll
            for (int h = 0; h < 2; ++h)
#pragma unroll
                for (int i = 0; i < 2; ++i) o2[h][i] = (GATHER && last) ? offN[h][i] : offA[h][i];
            PG8_LDB(B0, 0, 0); PG8_LDB(B1, 0, 1); PG8_SCHED; PG8_LDA(At, 0, 0); PG8_STAGE(PG8_SA(1, 1), a1, offA[1]);
            PG8_WAIT_V(8); PG8_WAIT_L(0); PG8_BAR; PG8_MMA(0, 0, At, B0); PG8_MMA(0, 1, At, B1); PG8_BAR; PG8_SCHED;
            PG8_LDA(At, 0, 1); PG8_STAGE(PG8_SB(0, 0), b2, voffB); PG8_STAGE(PG8_SB(0, 1), b2 + hstepB, voffB); PG8_STAGE(PG8_SA(0, 0), a2, o2[0]);
            PG8_WAIT_V(8); PG8_WAIT_L(0); PG8_BAR; PG8_MMA(1, 0, At, B0); PG8_MMA(1, 1, At, B1); PG8_BAR; PG8_SCHED;
            PG8_LDB(B0, 1, 0); PG8_LDB(B1, 1, 1); PG8_SCHED; PG8_LDA(At, 1, 0); PG8_STAGE(PG8_SA(0, 1), a2, o2[1]);
            PG8_WAIT_V(8); PG8_WAIT_L(0); PG8_BAR; PG8_MMA(0, 0, At, B0); PG8_MMA(0, 1, At, B1); PG8_BAR; PG8_SCHED;
            PG8_LDA(At, 1, 1); PG8_STAGE(PG8_SB(1, 0), b3, voffB); PG8_STAGE(PG8_SB(1, 1), b3 + hstepB, voffB); PG8_STAGE(PG8_SA(1, 0), a3, o2[0]);
            PG8_WAIT_V(8); PG8_WAIT_L(0); PG8_BAR; PG8_MMA(1, 0, At, B0); PG8_MMA(1, 1, At, B1); PG8_BAR; PG8_SCHED;
        }
        if (wr == 0) PG8_BAR;
        if constexpr (FP8) asm volatile("s_nop 15\n\ts_nop 15" ::: "memory");
        E(acc, cur, wr, wc, fr, fq);
        if (!has_next) break;
#pragma unroll
        for (int a = 0; a < 2; ++a)
#pragma unroll
            for (int b = 0; b < 2; ++b)
#pragma unroll
                for (int m = 0; m < 4; ++m)
#pragma unroll
                    for (int n = 0; n < 2; ++n) acc[a][b][m][n] = (f32x4){0.f, 0.f, 0.f, 0.f};
        cur = nxt; cA = nA; cB = nB; ++ui;
        if constexpr (GATHER) {
#pragma unroll
            for (int h = 0; h < 2; ++h)
#pragma unroll
                for (int i = 0; i < 2; ++i) offA[h][i] = offN[h][i];
        }
        if (wr == 1) PG8_BAR;
    }
    PG8_WAIT_V(0);
    PG8_BAR;
#undef PG8_SA
#undef PG8_SB
#undef PG8_STAGE
#undef PG8_LDA
#undef PG8_LDB
#undef PG8_MMA
#undef PG8_WAIT_V
#undef PG8_WAIT_L
#undef PG8_BAR
#undef PG8_SCHED
}

struct DenseOrder {
    const char* A; const char* Bt; size_t a_tile_bytes, b_tile_bytes; int nM, nN, nwg, G, c;
    __device__ void init(const void* A_, const void* Bt_, int M, int N, int lda, int ldb, int G_, int c_) {
        A = (const char*)A_; Bt = (const char*)Bt_; nM = M / BM; nN = N / BM; nwg = nM * nN; G = G_; c = c_;
        a_tile_bytes = (size_t)BM * lda * 2; b_tile_bytes = (size_t)BM * ldb * 2;
    }
    __device__ __forceinline__ bool next(int i, Unit& u) const {
        const long L = (long)i * G + c; if (L >= nwg) return false;
        int wgid = (int)L; { const int q = nwg / NXCD, r = nwg % NXCD, xcd = wgid % NXCD, off = wgid / NXCD; wgid = (xcd < r ? xcd * (q + 1) : r * (q + 1) + (xcd - r) * q) + off; }
        const int nig = WGM * nN, gid = wgid / nig, fm = gid * WGM, gsz = (nM - fm) < WGM ? (nM - fm) : WGM;
        u.pm = fm + ((wgid % nig) % gsz); u.pn = (wgid % nig) / gsz; u.aux = 0; u.gidx = nullptr;
        u.A = A + (size_t)u.pm * a_tile_bytes; u.B = Bt + (size_t)u.pn * b_tile_bytes; return true;
    }
};
}

#define XB_TMO      128
#define XB_XCNT(j)  (256  + 64 * (j))
#define XB_XSUB(j)  (1280 + 64 * (j))
#define XB_XGEN(j)  (2304 + 64 * (j))
#define XB_TOP      3328
#define XB_TOPGEN   3392
#define XCD_BAR_WORDS 3456
#define XB_SPIN_CAP (1u << 18)

__device__ __forceinline__ unsigned xb_ld(unsigned* p)              { return __hip_atomic_load(p, __ATOMIC_RELAXED, __HIP_MEMORY_SCOPE_AGENT); }
__device__ __forceinline__ unsigned xb_add(unsigned* p, unsigned v) { return __hip_atomic_fetch_add(p, v, __ATOMIC_RELAXED, __HIP_MEMORY_SCOPE_AGENT); }
__device__ __forceinline__ unsigned xb_xcc_id() { return (unsigned)__builtin_amdgcn_s_getreg((3 << 11) | 20) & 0xFu; }
#define XB_SPIN(cond, bar) do { unsigned _sp = 0; while (cond) { __builtin_amdgcn_s_sleep(1); \
    if ((++_sp & 255u) == 0u) { if (xb_ld(&(bar)[XB_TMO])) break; if (_sp > XB_SPIN_CAP) { atomicAdd(&(bar)[XB_TMO], 1u); break; } } } } while (0)

struct XcdBarrier {
    unsigned* bar; unsigned x; int w;
    volatile LAS unsigned* st;
};
__device__ __forceinline__ XcdBarrier xcd_barrier_post(unsigned* bar, volatile LAS unsigned* st, int wave) {
    XcdBarrier b; b.bar = bar; b.x = xb_xcc_id(); b.st = st; b.w = wave;
    if (wave == 0 && lane_id() == 0) (void)xb_add(&bar[XB_XCNT(b.x)], 1u);
    return b;
}
__device__ __forceinline__ void xcd_barrier_complete(unsigned* bar, unsigned x, unsigned& nloc, unsigned& nx) {
    const unsigned G = gridDim.x * gridDim.y * gridDim.z;
    unsigned sum, cnt, mine, sp = 0u;
    for (;;) {
        sum = 0u; cnt = 0u; mine = 0u;
#pragma unroll
        for (unsigned j = 0; j < 16; ++j) { const unsigned c = xb_ld(&bar[XB_XCNT(j)]); sum += c; cnt += (c > 0u) ? 1u : 0u; mine = (j == x) ? c : mine; }
        if (sum == G) break;
        __builtin_amdgcn_s_sleep(1);
        if ((++sp & 255u) == 0u) { if (xb_ld(&bar[XB_TMO])) break; if (sp > XB_SPIN_CAP) { atomicAdd(&bar[XB_TMO], 1u); break; } }
    }
    nloc = mine > 0u ? mine : 1u; nx = cnt > 0u ? cnt : 1u;
}
__device__ __forceinline__ void xcd_barrier(const XcdBarrier& b) {
    asm volatile("s_waitcnt vmcnt(0)" ::: "memory");
    __syncthreads();
    if (b.w == 0 && lane_id() == 0) {
        unsigned* bar = b.bar;
        __builtin_amdgcn_s_waitcnt(0);
        unsigned nloc = b.st[0], nx = b.st[1];
        if (nloc == 0u) { xcd_barrier_complete(bar, b.x, nloc, nx); b.st[0] = nloc; b.st[1] = nx; }
        const unsigned old = xb_add(&bar[XB_XSUB(b.x)], 1u);
        const unsigned gen = old / nloc;
        if (old + 1u == (gen + 1u) * nloc) {
            __builtin_amdgcn_fence(__ATOMIC_RELEASE, "agent");
            asm volatile("s_waitcnt vmcnt(0)" ::: "memory");
            const unsigned og = xb_add(&bar[XB_TOP], 1u);
            const unsigned tg = og / nx;
            if (og + 1u == (tg + 1u) * nx) xb_add(&bar[XB_TOPGEN], 1u);
            else XB_SPIN(xb_ld(&bar[XB_TOPGEN]) == tg, bar);
            __builtin_amdgcn_fence(__ATOMIC_ACQUIRE, "agent");
            xb_add(&bar[XB_XGEN(b.x)], 1u);
            asm volatile("s_waitcnt vmcnt(0)" ::: "memory");
        } else {
            XB_SPIN(xb_ld(&bar[XB_XGEN(b.x)]) == gen, bar);
            __builtin_amdgcn_fence(__ATOMIC_ACQUIRE, "agent");
            asm volatile("s_waitcnt vmcnt(0)" ::: "memory");
        }
    }
    __syncthreads();
}

constexpr size_t MiB = 1u << 20;
constexpr size_t WS_CTL = 0, CTL_ZERO_BYTES = 1 * MiB;
constexpr size_t WS_SMALL = 1 * MiB;
constexpr size_t WS_RSTD1 = WS_SMALL;
constexpr size_t WS_LOGI = WS_SMALL + 1 * MiB;
constexpr size_t WS_LOGF = WS_SMALL + 2 * MiB;
constexpr size_t WS_TOPI = WS_SMALL + 3 * MiB;
constexpr size_t WS_TOPG = WS_SMALL + 4 * MiB;
constexpr size_t WS_STOK = WS_SMALL + 5 * MiB;
constexpr size_t WS_SGATE = WS_SMALL + 6 * MiB;
constexpr size_t WS_ESTART = WS_SMALL + 7 * MiB;
constexpr size_t WS_BTIN = 17 * MiB;
constexpr size_t WS_BTOUT = 25 * MiB;
constexpr size_t WS_BT1 = 29 * MiB;
constexpr size_t WS_BT2 = 157 * MiB;
constexpr size_t WS_R1 = 221 * MiB;
constexpr size_t WS_XM = 285 * MiB;
constexpr size_t WS_SZ = 349 * MiB;
constexpr size_t WS_U = 413 * MiB;
constexpr size_t WS_Q = 477 * MiB;
constexpr size_t WS_YMIX = 477 * MiB;
constexpr size_t WS_ACT = 285 * MiB;
constexpr size_t WS_NEED = 925 * MiB;

constexpr int NWAVES = 8;
constexpr int RING_BYTES = 131072;
constexpr int LDSCTL_OFF = RING_BYTES;
constexpr int LDS_BYTES = 147456;
constexpr int CW_BAR = 4096;

struct MegaArgs {
    const float* in[27];
    float* out;
    unsigned char* ws;
    int ph_lo, ph_hi, li, pad;
};

__device__ __forceinline__ unsigned pk2(float lo, float hi) { return pg8::cvt_pk_bf16(lo, hi); }

__device__ __forceinline__ void unpack8(const u32x4 r, float (&f)[8]) {
    f[0] = __uint_as_float(r.x << 16); f[1] = __uint_as_float(r.x & 0xFFFF0000u); f[2] = __uint_as_float(r.y << 16); f[3] = __uint_as_float(r.y & 0xFFFF0000u);
    f[4] = __uint_as_float(r.z << 16); f[5] = __uint_as_float(r.z & 0xFFFF0000u); f[6] = __uint_as_float(r.w << 16); f[7] = __uint_as_float(r.w & 0xFFFF0000u);
}

__device__ __forceinline__ f32x4 up4(const u32x2 r) { f32x4 v; v.x = __uint_as_float(r.x << 16); v.y = __uint_as_float(r.x & 0xFFFF0000u); v.z = __uint_as_float(r.y << 16); v.w = __uint_as_float(r.y & 0xFFFF0000u); return v; }

__device__ __forceinline__ void p0_transpose_item(const float* W, int K, int N, bf16_t* WT, const float* ksc, int k0, int n0s, int n0d, LAS float* scr, int lane) {
    const int kr = lane >> 4, nq = lane & 15;
    f32x4 v[16];
#pragma unroll
    for (int i = 0; i < 16; ++i) v[i] = *(const f32x4*)(W + (size_t)(k0 + 4 * i + kr) * N + n0s + 4 * nq);
    if (ksc) {
#pragma unroll
        for (int i = 0; i < 16; ++i) v[i] = v[i] * ksc[k0 + 4 * i + kr];
    }
    const int c = lane >> 4, nl = lane & 15;
#pragma unroll
    for (int half = 0; half < 2; ++half) {
#pragma unroll
        for (int ii = 0; ii < 8; ++ii) *(LAS f32x4*)(scr + (4 * ii + kr) * 68 + 4 * nq) = v[8 * half + ii];
        asm volatile("s_waitcnt lgkmcnt(0)" ::: "memory");
#pragma unroll
        for (int j = 0; j < 4; ++j) { const int n = nl + 16 * j; const LAS float* sp = scr + (8 * c) * 68 + n;
            u32x4 o; o.x = pk2(sp[0 * 68], sp[1 * 68]); o.y = pk2(sp[2 * 68], sp[3 * 68]); o.z = pk2(sp[4 * 68], sp[5 * 68]); o.w = pk2(sp[6 * 68], sp[7 * 68]);
            *(u32x4*)(WT + (size_t)(n0d + n) * K + k0 + 32 * half + 8 * c) = o; }
        asm volatile("s_waitcnt lgkmcnt(0)" ::: "memory");
    }
}
__device__ __forceinline__ unsigned pk4_fp8(float a, float b, float c, float d) { int w = __builtin_amdgcn_cvt_pk_fp8_f32(a, b, 0, false); w = __builtin_amdgcn_cvt_pk_fp8_f32(c, d, w, true); return (unsigned)w; }
__device__ __forceinline__ void p0_transpose_item8(const float* W, int K, int N, unsigned char* WT, const float* ksc, float mul, int k0, int n0s, int n0d, LAS float* scr, int lane) {
    const int kr = lane >> 4, nq = lane & 15;
    f32x4 v[16];
#pragma unroll
    for (int i = 0; i < 16; ++i) v[i] = *(const f32x4*)(W + (size_t)(k0 + 4 * i + kr) * N + n0s + 4 * nq);
#pragma unroll
    for (int i = 0; i < 16; ++i) v[i] = v[i] * (ksc ? ksc[k0 + 4 * i + kr] * mul : mul);
    const int c = lane >> 4, nl = lane & 15;
#pragma unroll
    for (int half = 0; half < 2; ++half) {
#pragma unroll
        for (int ii = 0; ii < 8; ++ii) *(LAS f32x4*)(scr + (4 * ii + kr) * 68 + 4 * nq) = v[8 * half + ii];
        asm volatile("s_waitcnt lgkmcnt(0)" ::: "memory");
#pragma unroll
        for (int j = 0; j < 4; ++j) { const int n = nl + 16 * j; const LAS float* sp = scr + (8 * c) * 68 + n;
            u32x2 o; o.x = pk4_fp8(sp[0 * 68], sp[1 * 68], sp[2 * 68], sp[3 * 68]); o.y = pk4_fp8(sp[4 * 68], sp[5 * 68], sp[6 * 68], sp[7 * 68]);
            *(u32x2*)(WT + (size_t)(n0d + n) * K + k0 + 32 * half + 8 * c) = o; }
        asm volatile("s_waitcnt lgkmcnt(0)" ::: "memory");
    }
}
__device__ __forceinline__ int inproj_src_col(int nd) { if (nd < 2048) return nd; const int pn = (nd >> 8) - 8, lc = nd & 255; return 2048 + (lc >> 7) * 1024 + 128 * pn + (lc & 127); }
__device__ __forceinline__ int w1_src_col(int nd) { const int pn = nd >> 8, lc = nd & 255; return (lc >> 7) * 1024 + 128 * pn + (lc & 127); }

__device__ __forceinline__ void p0_prologue(const MegaArgs& a, LAS unsigned char* lds, int gw, int NGW, int wave, int lane) {
    LAS float* scr = (LAS float*)(lds + wave * 16384);
    unsigned char* ws = a.ws;
    const float* x = a.in[0];
    {
        bf16_t* xbf = (bf16_t*)(ws + WS_R1); float* rstd1 = (float*)(ws + WS_RSTD1);
        for (int m = gw; m < NTOK; m += NGW) {
            const f32x4* xr = (const f32x4*)(x + (size_t)m * DM) + lane;
            f32x4 v[4]; float s = 0.f;
#pragma unroll
            for (int j = 0; j < 4; ++j) { v[j] = xr[64 * j]; s += (v[j].x * v[j].x + v[j].y * v[j].y) + (v[j].z * v[j].z + v[j].w * v[j].w); }
            s = wave_sum(s);
            if (lane == 0) rstd1[m] = rsqrtf(s * (1.0f / DM) + EPSV);
            unsigned long long* o8 = (unsigned long long*)(xbf + (size_t)m * DM) + lane;
#pragma unroll
            for (int j = 0; j < 4; ++j) o8[64 * j] = (unsigned long long)pk2(v[j].x, v[j].y) | ((unsigned long long)pk2(v[j].z, v[j].w) << 32);
        }
    }
    constexpr int I_IN = (1024 / 64) * (4096 / 64);
    constexpr int I_OUT = (2048 / 64) * (1024 / 64);
    constexpr int I_W1 = 32 * (1024 / 64) * (2048 / 64);
    constexpr int I_W2 = 32 * (1024 / 64) * (1024 / 64);
    constexpr int NITEMS = I_IN + I_OUT + I_W1 + I_W2;
    for (int it = gw; it < NITEMS; it += NGW) {
        int r = it;
        if (r < I_IN) { const int kb = r / 64, nb = r % 64; p0_transpose_item(a.in[2], 1024, 4096, (bf16_t*)(ws + WS_BTIN), a.in[1], 64 * kb, inproj_src_col(64 * nb), 64 * nb, scr, lane); continue; }
        r -= I_IN;
        if (r < I_OUT) { const int kb = r / 16, nb = r % 16; p0_transpose_item(a.in[18], 2048, 1024, (bf16_t*)(ws + WS_BTOUT), nullptr, 64 * kb, 64 * nb, 64 * nb, scr, lane); continue; }
        r -= I_OUT;
        if (r < I_W1) { const int e = r / 512, rr = r % 512, kb = rr / 32, nb = rr % 32;
            p0_transpose_item8(a.in[22] + (size_t)e * 1024 * 2048, 1024, 2048, ws + WS_BT1 + (size_t)e * 2048 * 1024, a.in[19], 32.0f, 64 * kb, w1_src_col(64 * nb), 64 * nb, scr, lane); continue; }
        r -= I_W1;
        { const int e = r / 256, rr = r % 256, kb = rr / 16, nb = rr % 16;
            p0_transpose_item8(a.in[24] + (size_t)e * 1024 * 1024, 1024, 1024, ws + WS_BT2 + (size_t)e * 1024 * 1024, nullptr, 32.0f, 64 * kb, 64 * nb, 64 * nb, scr, lane); }
    }
}

struct EpiInProj {
    const float* rstd; bf16_t* xm; bf16_t* sz; bf16_t* u; int variant;
    __device__ __forceinline__ void operator()(const f32x4 (&acc)[2][2][4][2], const pg8::Unit& un, int wr, int wc, int fr, int fq) const {
        const int row0 = un.pm * 256 + wr * 64 + fr;
        const int cl = wc * 32 + 8 * fq;
#pragma unroll
        for (int ai = 0; ai < 2; ++ai)
#pragma unroll
            for (int m = 0; m < 4; ++m) {
                const int row = row0 + ai * 128 + m * 16;
                const float rs = rstd[row];
                if (un.pn < 8) {
                    bf16_t* dst = (un.pn < 4 ? xm : sz) + (size_t)row * DM + (un.pn & 3) * 256 + cl;
#pragma unroll
                    for (int bj = 0; bj < 2; ++bj) {
                        f32x4 v0 = acc[ai][bj][m][0] * rs, v1 = acc[ai][bj][m][1] * rs;
                        if (un.pn >= 4) {
#pragma unroll
                            for (int j = 0; j < 4; ++j) { v0[j] = siluf_(v0[j]); v1[j] = siluf_(v1[j]); }
                        }
                        u32x4 w; w.x = pg8::cvt_pk_bf16(v0[0], v0[1]); w.y = pg8::cvt_pk_bf16(v0[2], v0[3]); w.z = pg8::cvt_pk_bf16(v1[0], v1[1]); w.w = pg8::cvt_pk_bf16(v1[2], v1[3]);
                        if (!(variant & 4)) *(u32x4*)(dst + bj * 128) = w;
                    }
                } else {
                    bf16_t* dst = u + (size_t)row * DM + (un.pn - 8) * 128 + cl;
                    f32x4 o0, o1;
#pragma unroll
                    for (int j = 0; j < 4; ++j) {
                        o0[j] = (acc[ai][0][m][0][j] * rs) * sigmoidf_(acc[ai][1][m][0][j] * rs);
                        o1[j] = (acc[ai][0][m][1][j] * rs) * sigmoidf_(acc[ai][1][m][1][j] * rs);
                    }
                    u32x4 w; w.x = pg8::cvt_pk_bf16(o0[0], o0[1]); w.y = pg8::cvt_pk_bf16(o0[2], o0[3]); w.z = pg8::cvt_pk_bf16(o1[0], o1[1]); w.w = pg8::cvt_pk_bf16(o1[2], o1[3]);
                    if (!(variant & 4)) *(u32x4*)dst = w;
                }
            }
    }
};

constexpr size_t WS_WGCNT = WS_SMALL + 8 * MiB;
constexpr size_t WS_ASGE = WS_SMALL + 9 * MiB;
constexpr size_t WS_ASGR = WS_SMALL + 10 * MiB;
constexpr size_t WS_ASGG = WS_SMALL + 11 * MiB;
constexpr size_t WS_RSTD2 = WS_SMALL + 12 * MiB;
constexpr size_t WS_SRSTD = WS_SMALL + 13 * MiB;
constexpr size_t WS_TOKSLOT = WS_SMALL + 14 * MiB;
constexpr size_t WS_TILEEXP = WS_SMALL + 15 * MiB;
constexpr size_t WS_HBF = WS_R1;
constexpr size_t WS_YROWS = 605 * MiB;
constexpr size_t WS_HB16 = 750 * MiB;
constexpr int NSLOT = NASSIGN + NEXP * 256;
constexpr int TOK_PER_WG = NTOK / 256;

constexpr size_t WS_WRH = WS_SMALL + 576 * 1024;
constexpr size_t WS_WRL = WS_SMALL + 640 * 1024;
__device__ __forceinline__ void p0_router_tables(const MegaArgs& a, int gw, int NGW, int lane) {
    const float* nfw = a.in[19]; const float* wr = a.in[20];
    bf16_t* wh = (bf16_t*)(a.ws + WS_WRH); bf16_t* wl = (bf16_t*)(a.ws + WS_WRL);
    for (int idx = gw * 64 + lane; idx < 32 * 1024; idx += NGW * 64) {
        const int e = idx >> 10, k = idx & 1023;
        const float w = nfw[k] * wr[(size_t)k * 32 + e];
        const bf16_t hi = f2bf(w);
        wh[idx] = hi; wl[idx] = f2bf(w - bf2f(hi));
    }
}
struct RtBuf { u32x4 hraw; u32x4 bh0, bh1, bl0, bl1; };
__device__ __forceinline__ void rt_load(const bf16_t* hrow, const bf16_t* wh, const bf16_t* wl, int col, int k0, RtBuf& B) {
    B.hraw = *(const u32x4*)(hrow + k0);
    B.bh0 = *(const u32x4*)(wh + (size_t)col * 1024 + k0); B.bh1 = *(const u32x4*)(wh + (size_t)(col + 16) * 1024 + k0);
    B.bl0 = *(const u32x4*)(wl + (size_t)col * 1024 + k0); B.bl1 = *(const u32x4*)(wl + (size_t)(col + 16) * 1024 + k0);
}
__device__ __forceinline__ void rt_step(const RtBuf& B, f32x4& acc0, f32x4& acc1, float& ssq) {
    float v[8]; unpack8(B.hraw, v);
#pragma unroll
    for (int i = 0; i < 8; ++i) ssq += v[i] * v[i];
    const bf16x8 ah = __builtin_bit_cast(bf16x8, B.hraw);
    acc0 = __builtin_amdgcn_mfma_f32_16x16x32_bf16(ah, __builtin_bit_cast(bf16x8, B.bh0), acc0, 0, 0, 0);
    acc0 = __builtin_amdgcn_mfma_f32_16x16x32_bf16(ah, __builtin_bit_cast(bf16x8, B.bl0), acc0, 0, 0, 0);
    acc1 = __builtin_amdgcn_mfma_f32_16x16x32_bf16(ah, __builtin_bit_cast(bf16x8, B.bh1), acc1, 0, 0, 0);
    acc1 = __builtin_amdgcn_mfma_f32_16x16x32_bf16(ah, __builtin_bit_cast(bf16x8, B.bl1), acc1, 0, 0, 0);
}
template <int CTRL> __device__ __forceinline__ void argmax_step(float& v, int& i) {
    const float ov = dpp_mov_f<CTRL>(v); const int oi = __builtin_amdgcn_update_dpp(0, i, CTRL, 0xf, 0xf, false);
    const bool take = (ov > v) || (ov == v && oi < i);
    v = take ? ov : v; i = take ? oi : i;
}
__device__ __forceinline__ void phase_router(const MegaArgs& a, LAS unsigned char* lds, int tid, int lane, int wave) {
    unsigned char* ws = a.ws;
    const bf16_t* hbuf = (const bf16_t*)(ws + WS_HB16);
    const float* br = a.in[21];
    const bf16_t* wh = (const bf16_t*)(ws + WS_WRH); const bf16_t* wl = (const bf16_t*)(ws + WS_WRL);
    float* rstd2 = (float*)(ws + WS_RSTD2);
    int* wgcnt = (int*)(ws + WS_WGCNT); int* asg_e = (int*)(ws + WS_ASGE); int* asg_r = (int*)(ws + WS_ASGR); float* asg_g = (float*)(ws + WS_ASGG);
    LAS int* topi_l = (LAS int*)lds;
    LAS float* topg_l = (LAS float*)(lds + 2048);
    LAS int* rank_l = (LAS int*)(lds + 4096);
    LAS float* rstd_l = (LAS float*)(lds + 6144);
    const int b = blockIdx.x;
    const int col = lane & 15, kq = lane >> 4;
    {
        const int t = b * TOK_PER_WG + wave * 16 + col;
        const bf16_t* hrow = hbuf + (size_t)t * DM + 8 * kq;
        f32x4 acc0 = (f32x4){0.f, 0.f, 0.f, 0.f}, acc1 = acc0; float ssq = 0.f;
        RtBuf A, B;
        rt_load(hrow, wh + 8 * kq, wl + 8 * kq, col, 0, A);
        for (int ks = 0; ks < 32; ks += 2) {
            rt_load(hrow, wh + 8 * kq, wl + 8 * kq, col, 32 * (ks + 1), B);
            rt_step(A, acc0, acc1, ssq);
            if (ks + 2 < 32) rt_load(hrow, wh + 8 * kq, wl + 8 * kq, col, 32 * (ks + 2), A);
            rt_step(B, acc0, acc1, ssq);
        }
        ssq += __builtin_bit_cast(float, __builtin_amdgcn_ds_swizzle(__builtin_bit_cast(int, ssq), 0x401F));
        { const auto rr = __builtin_amdgcn_permlane32_swap(__float_as_uint(ssq), __float_as_uint(ssq), false, false); ssq = __uint_as_float(rr[0]) + __uint_as_float(rr[1]); }
        const float rs = rsqrtf(ssq * (1.0f / DM) + EPSV);
        if (kq == 0) { rstd_l[wave * 16 + col] = rs; rstd2[t] = rs; }
        asm volatile("s_waitcnt lgkmcnt(0)" ::: "memory");
        const float b0 = br[col], b1 = br[col + 16];
#pragma unroll
        for (int r = 0; r < 4; ++r) {
            const float rsr = rstd_l[wave * 16 + 4 * kq + r];
            float v0 = acc0[r] * rsr + b0, v1 = acc1[r] * rsr + b1;
            int sel[4]; float val[4];
#pragma unroll
            for (int it = 0; it < 4; ++it) {
                float bv = (v1 > v0) ? v1 : v0; int bi = (v1 > v0) ? col + 16 : col;
                argmax_step<0xB1>(bv, bi); argmax_step<0x4E>(bv, bi); argmax_step<0x124>(bv, bi); argmax_step<0x128>(bv, bi);
                sel[it] = bi; val[it] = bv;
                if (bi == col) v0 = -3.0e38f;
                if (bi == col + 16) v1 = -3.0e38f;
            }
            float ex[4], sum = 0.f;
#pragma unroll
            for (int it = 0; it < 4; ++it) { ex[it] = __expf(val[it] - val[0]); sum += ex[it]; }
            const float inv = 1.0f / sum;
            if (col == 0) {
                const int tw = wave * 16 + 4 * kq + r;
#pragma unroll
                for (int it = 0; it < 4; ++it) { topi_l[tw * 4 + it] = sel[it]; topg_l[tw * 4 + it] = ex[it] * inv; }
            }
        }
    }
    __syncthreads();
    if (wave == 0) {
        int base = 0;
        for (int ch = 0; ch < 8; ++ch) {
            const int E = topi_l[ch * 64 + lane];
            int myrank = 0;
#pragma unroll
            for (int e = 0; e < 32; ++e) {
                const unsigned long long m = __ballot(E == e);
                const int be = __builtin_amdgcn_readlane(base, e);
                if (E == e) myrank = be + __builtin_popcountll(m & ((1ull << lane) - 1ull));
                if (lane == e) base += __builtin_popcountll(m);
            }
            rank_l[ch * 64 + lane] = myrank;
        }
        if (lane < 32) wgcnt[b * 32 + lane] = base;
    }
    __syncthreads();
    {
        int i = tid; asm volatile("" : "+v"(i));
        const int aidx = b * TOK_PER_WG * 4 + i;
        asg_e[aidx] = topi_l[i]; asg_r[aidx] = rank_l[i]; asg_g[aidx] = topg_l[i];
    }
}

__device__ __forceinline__ void phase_slots(const MegaArgs& a, LAS unsigned char* lds, int tid) {
    unsigned char* ws = a.ws;
    const int* wgcnt = (const int*)(ws + WS_WGCNT); const int* asg_e = (const int*)(ws + WS_ASGE); const int* asg_r = (const int*)(ws + WS_ASGR); const float* asg_g = (const float*)(ws + WS_ASGG);
    const float* rstd2 = (const float*)(ws + WS_RSTD2);
    int* slot_tok = (int*)(ws + WS_STOK); float* slot_gate = (float*)(ws + WS_SGATE); float* slot_rstd = (float*)(ws + WS_SRSTD);
    int* tok_slot = (int*)(ws + WS_TOKSLOT); int* tile_exp = (int*)(ws + WS_TILEEXP);
    LAS int* tot = (LAS int*)lds; LAS int* bef = tot + 32; LAS int* tstart = bef + 32;
    const int b = blockIdx.x;
    if (tid < 32) {
        int t = 0, bf = 0;
        for (int bb = 0; bb < 256; ++bb) { const int c = wgcnt[bb * 32 + tid]; t += c; if (bb < b) bf += c; }
        tot[tid] = t; bef[tid] = bf;
    }
    __syncthreads();
    if (tid == 0) { int ts = 0; for (int e = 0; e < 32; ++e) { tstart[e] = ts; ts += (tot[e] + 255) >> 8; } tstart[32] = ts; }
    __syncthreads();
    {
        int tid_o = tid; asm volatile("" : "+v"(tid_o));
        const int aidx = b * TOK_PER_WG * 4 + tid_o;
        const int e = asg_e[aidx];
        const int slot = 256 * tstart[e] + bef[e] + asg_r[aidx];
        const int tk = aidx >> 2;
        slot_tok[slot] = tk; slot_gate[slot] = asg_g[aidx]; slot_rstd[slot] = rstd2[tk]; tok_slot[aidx] = slot;
    }
    if (b < 32) {
        const int e = b; const int s0 = 256 * tstart[e] + tot[e], s1 = 256 * tstart[e + 1];
        for (int s = s0 + tid; s < s1; s += NWAVES * 64) { slot_tok[s] = 0; slot_gate[s] = 0.f; slot_rstd[s] = 0.f; }
    }
    if (b == 0) {
        if (tid < 32) for (int t = tstart[tid]; t < tstart[tid + 1]; ++t) tile_exp[t] = tid;
        if (tid == 0) tile_exp[2048] = tstart[32];
    }
}

struct MoeOrder {
    const char* A; const char* Bt; const int* gidx; const int* tile_exp; size_t a_tile_bytes, b_exp_bytes, b_tile_bytes; int T, nN, group, c;
    __device__ __forceinline__ bool next(int i, pg8::Unit& u) const {
        const int x = c & 7, j = c >> 3;
        const int tile = (i * 8 + x) * group + (j % group);
        if (tile >= T) return false;
        const int e = __builtin_amdgcn_readfirstlane(tile_exp[tile]);
        u.pm = tile; u.pn = j / group; u.aux = e;
        u.gidx = gidx ? gidx + 256 * tile : nullptr;
        u.A = gidx ? A : A + (size_t)tile * a_tile_bytes;
        u.B = Bt + (size_t)e * b_exp_bytes + (size_t)u.pn * b_tile_bytes;
        return true;
    }
};

struct EpiMoe1 {
    const float* srstd; const float* b1; unsigned char* act; int variant;
    __device__ __forceinline__ void operator()(const f32x4 (&acc)[2][2][4][2], const pg8::Unit& un, int wr, int wc, int fr, int fq) const {
        if (variant & 8) return;
        const int e = un.aux;
        const int cl = un.pn * 128 + wc * 32 + 8 * fq;
        f32x4 bg[2], bl[2];
#pragma unroll
        for (int n = 0; n < 2; ++n) { bg[n] = *(const f32x4*)(b1 + (size_t)e * 2048 + cl + 4 * n); bl[n] = *(const f32x4*)(b1 + (size_t)e * 2048 + 1024 + cl + 4 * n); }
        const int slot0 = un.pm * 256 + wr * 64 + fr;
#pragma unroll
        for (int ai = 0; ai < 2; ++ai)
#pragma unroll
            for (int m = 0; m < 4; ++m) {
                const int slot = slot0 + ai * 128 + m * 16;
                const float rs = srstd[slot];
                f32x4 o[2];
#pragma unroll
                for (int n = 0; n < 2; ++n)
#pragma unroll
                    for (int j = 0; j < 4; ++j) {
                        const float g = acc[ai][0][m][n][j] * rs + bg[n][j];
                        const float l = acc[ai][1][m][n][j] * rs + bl[n][j];
                        const float xg = fminf(g, 7.0f);
                        const float xl = fminf(fmaxf(l, -7.0f), 7.0f);
                        o[n][j] = xg * sigmoidf_(1.702f * xg) * (xl + 1.0f);
                    }
                u32x2 w; w.x = pk4_fp8(o[0][0], o[0][1], o[0][2], o[0][3]); w.y = pk4_fp8(o[1][0], o[1][1], o[1][2], o[1][3]);
                *(u32x2*)(act + (size_t)slot * DM + cl) = w;
            }
    }
};
struct EpiMoe2 {
    const float* sgate; const float* b2; unsigned char* yrows;
    __device__ __forceinline__ void operator()(const f32x4 (&acc)[2][2][4][2], const pg8::Unit& un, int wr, int wc, int fr, int fq) const {
        const int e = un.aux;
        const int c0 = un.pn * 256 + wc * 32 + 8 * fq;
        f32x4 bv[2][2];
#pragma unroll
        for (int bj = 0; bj < 2; ++bj)
#pragma unroll
            for (int n = 0; n < 2; ++n) bv[bj][n] = *(const f32x4*)(b2 + (size_t)e * DM + c0 + bj * 128 + 4 * n);
        const int slot0 = un.pm * 256 + wr * 64 + fr;
#pragma unroll
        for (int ai = 0; ai < 2; ++ai)
#pragma unroll
            for (int m = 0; m < 4; ++m) {
                const int slot = slot0 + ai * 128 + m * 16;
                const float gt = sgate[slot] * 16.0f;
#pragma unroll
                for (int bj = 0; bj < 2; ++bj) {
                    const f32x4 v0 = (acc[ai][bj][m][0] + bv[bj][0]) * gt, v1 = (acc[ai][bj][m][1] + bv[bj][1]) * gt;
                    u32x2 w; w.x = pk4_fp8(v0[0], v0[1], v0[2], v0[3]); w.y = pk4_fp8(v1[0], v1[1], v1[2], v1[3]);
                    *(u32x2*)(yrows + (size_t)slot * DM + c0 + bj * 128) = w;
                }
            }
    }
};

struct FinBuf { u32x2 h[4]; unsigned y[4][4]; };
__device__ __forceinline__ void fin_load(const bf16_t* hbuf, const unsigned char* yrows, const int* tok_slot, int t, int lane, FinBuf& B) {
    const u32x2* hp = (const u32x2*)(hbuf + (size_t)t * DM) + lane;
#pragma unroll
    for (int j = 0; j < 4; ++j) B.h[j] = hp[64 * j];
#pragma unroll
    for (int r = 0; r < 4; ++r) {
        const int slot = __builtin_amdgcn_readfirstlane(__hip_atomic_load(tok_slot + t * 4 + r, __ATOMIC_RELAXED, __HIP_MEMORY_SCOPE_AGENT));
        const unsigned* yp = (const unsigned*)(yrows + (size_t)slot * DM) + lane;
#pragma unroll
        for (int j = 0; j < 4; ++j) B.y[r][j] = yp[64 * j];
    }
}
__device__ __forceinline__ void fin_compute(float* obuf, const float* fw, int t, int lane, const FinBuf& B) {
    f32x4 v[4];
#pragma unroll
    for (int j = 0; j < 4; ++j) {
        v[j] = up4(B.h[j]);
#pragma unroll
        for (int r = 0; r < 4; ++r) {
            const unsigned w = B.y[r][j];
            const f32x2 lo = __builtin_amdgcn_cvt_pk_f32_fp8(w, false), hi = __builtin_amdgcn_cvt_pk_f32_fp8(w, true);
            v[j].x += lo.x * 0.0625f; v[j].y += lo.y * 0.0625f; v[j].z += hi.x * 0.0625f; v[j].w += hi.y * 0.0625f;
        }
    }
    float s = 0.f;
#pragma unroll
    for (int j = 0; j < 4; ++j) s += (v[j].x * v[j].x + v[j].y * v[j].y) + (v[j].z * v[j].z + v[j].w * v[j].w);
    s = wave_sum(s);
    const float rs = rsqrtf(s * (1.0f / DM) + EPSV);
    f32x4* hp = (f32x4*)(obuf + (size_t)t * DM) + lane;
#pragma unroll
    for (int j = 0; j < 4; ++j) {
        const f32x4 w = *((const f32x4*)fw + lane + 64 * j);
        hp[64 * j] = v[j] * rs * w;
    }
}
__device__ __forceinline__ void phase_final(const MegaArgs& a, int gw, int NGW, int lane) {
    unsigned char* ws = a.ws;
    float* obuf = a.out; const float* fw = a.in[26]; const bf16_t* hbuf = (const bf16_t*)(ws + WS_HB16);
    const unsigned char* yrows = ws + WS_YROWS; const int* tok_slot = (const int*)(ws + WS_TOKSLOT);
    FinBuf A, B;
    int t = gw;
    if (t < NTOK) fin_load(hbuf, yrows, tok_slot, t, lane, A);
    for (; t < NTOK; t += 2 * NGW) {
        const int t2 = t + NGW;
        if (t2 < NTOK) fin_load(hbuf, yrows, tok_slot, t2, lane, B);
        fin_compute(obuf, fw, t, lane, A);
        if (t2 < NTOK) {
            const int t3 = t2 + NGW;
            if (t3 < NTOK) fin_load(hbuf, yrows, tok_slot, t3, lane, A);
            fin_compute(obuf, fw, t2, lane, B);
        }
    }
}

constexpr int CT = 16;
constexpr int CONV_RED_OFF = LDSCTL_OFF + 4096;
__device__ __forceinline__ void conv_load_rows(const __amdgpu_buffer_rsrc_t urs, int t0, int tid, unsigned (&R)[CT + 30]) {
    const int s0 = t0 & (SEQ - 1);
#pragma unroll
    for (int r = 0; r < CT + 30; ++r) {
        const int sp = s0 - 30 + r;
        R[r] = (sp >= 0) ? (unsigned)__builtin_amdgcn_raw_buffer_load_b32(urs, tid * 4, (t0 - 30 + r) * 2048, 0) : 0u;
    }
}
__device__ __forceinline__ void phase_conv31(const MegaArgs& a, LAS unsigned char* lds, int tid, int lane, int wave, int G) {
    unsigned char* ws = a.ws;
    const __amdgpu_buffer_rsrc_t urs = __builtin_amdgcn_make_buffer_rsrc((void*)(ws + WS_U), 0, NTOK * 2048, 0x00020000);
    const float* cw = a.in[14]; const float* cb = a.in[15]; const float* nw = a.in[16]; const float* nb = a.in[17];
    unsigned* ymix = (unsigned*)(ws + WS_YMIX);
    LAS float* wl = (LAS float*)lds;
    LAS float* red = (LAS float*)(lds + CONV_RED_OFF);
    for (int i = tid; i < 31 * 256; i += NWAVES * 64) *(LAS f32x4*)(wl + 4 * i) = *(const f32x4*)(cw + 4 * i);
    const f32x2 bias = *(const f32x2*)(cb + 2 * tid);
    const f32x2 gw2 = *(const f32x2*)(nw + 2 * tid);
    const f32x2 gb2 = *(const f32x2*)(nb + 2 * tid);
    __syncthreads();
    unsigned R[CT + 30];
    int it = blockIdx.x;
    if (it < NTOK / CT) conv_load_rows(urs, it * CT, tid, R);
    for (; it < NTOK / CT; it += G) {
        const int t0 = it * CT;
        f32x2 uf[CT + 30];
#pragma unroll
        for (int r = 0; r < CT + 30; ++r) { uf[r].x = __uint_as_float(R[r] << 16); uf[r].y = __uint_as_float(R[r] & 0xFFFF0000u); }
        if (it + G < NTOK / CT) conv_load_rows(urs, (it + G) * CT, tid, R);
        f32x2 acc[CT];
#pragma unroll
        for (int t = 0; t < CT; ++t) acc[t] = bias;
#pragma unroll
        for (int k = 0; k < 31; ++k) {
            const f32x2 w = *(const LAS f32x2*)(wl + k * 1024 + 2 * tid);
#pragma unroll
            for (int t = 0; t < CT; ++t) acc[t] = __builtin_elementwise_fma(w, uf[t + k], acc[t]);
        }
        float acc0[CT], acc1[CT];
#pragma unroll
        for (int t = 0; t < CT; ++t) { acc0[t] = acc[t].x; acc1[t] = acc[t].y; }
        float sm[CT], sq[CT];
#pragma unroll
        for (int t = 0; t < CT; ++t) { sm[t] = acc0[t] + acc1[t]; sq[t] = acc0[t] * acc0[t] + acc1[t] * acc1[t]; }
#pragma unroll
        for (int t = 0; t < CT; ++t) { sm[t] = wave_sum(sm[t]); sq[t] = wave_sum(sq[t]); }
        __syncthreads();
        if (lane == 0) {
#pragma unroll
            for (int t = 0; t < CT; ++t) { red[wave * 32 + t] = sm[t]; red[wave * 32 + CT + t] = sq[t]; }
        }
        __syncthreads();
#pragma unroll
        for (int t = 0; t < CT; ++t) {
            float s2 = 0.f, q = 0.f;
#pragma unroll
            for (int w = 0; w < 8; ++w) { s2 += red[w * 32 + t]; q += red[w * 32 + CT + t]; }
            const float mean = s2 * (1.0f / DM);
            const float var = fmaxf(q * (1.0f / DM) - mean * mean, 0.f);
            const float rs = rsqrtf(var + EPSV);
            const float y0 = siluf_((acc0[t] - mean) * rs * gw2.x + gb2.x);
            const float y1 = siluf_((acc1[t] - mean) * rs * gw2.y + gb2.y);
            ymix[(size_t)(t0 + t) * 1024 + 512 + tid] = pk2(y0, y1);
        }
    }
    __syncthreads();
}

struct YmBuf { u32x2 X[4][4]; u32x2 H[4]; u32x2 Z[4]; };
__device__ __forceinline__ void ym_load(const bf16_t* xm, const bf16_t* hm, const bf16_t* szb, int t, int lane, YmBuf& B) {
    const int s = t & (SEQ - 1);
#pragma unroll
    for (int j = 0; j < 4; ++j) {
        const int ch = 4 * lane + 256 * j;
#pragma unroll
        for (int kk = 0; kk < 4; ++kk) B.X[j][kk] = (s - 3 + kk >= 0) ? *(const u32x2*)(xm + (size_t)(t - 3 + kk) * DM + ch) : (u32x2){0u, 0u};
        B.H[j] = *(const u32x2*)(hm + (size_t)t * DM + ch);
        B.Z[j] = *(const u32x2*)(szb + (size_t)t * DM + ch);
    }
}
__device__ __forceinline__ void ym_compute(const LAS float* wts, bf16_t* ymix, int t, int lane, const YmBuf& B) {
#pragma unroll
    for (int j = 0; j < 4; ++j) {
        const int ch = 4 * lane + 256 * j;
        f32x4 xc = *(const LAS f32x4*)(wts + 4 * 1024 + ch);
#pragma unroll
        for (int kk = 0; kk < 4; ++kk) xc = xc + *(const LAS f32x4*)(wts + kk * 1024 + ch) * up4(B.X[j][kk]);
        xc.x = siluf_(xc.x); xc.y = siluf_(xc.y); xc.z = siluf_(xc.z); xc.w = siluf_(xc.w);
        const f32x4 hv = up4(B.H[j]);
        const float mean = wave_sum((hv.x + hv.y) + (hv.z + hv.w)) * (1.0f / 256.0f);
        const f32x4 d = hv - mean;
        const float var = wave_sum((d.x * d.x + d.y * d.y) + (d.z * d.z + d.w * d.w)) * (1.0f / 256.0f);
        const float rs = rsqrtf(var + EPSV);
        const f32x4 nwv = *(const LAS f32x4*)(wts + 5 * 1024 + ch), sk = *(const LAS f32x4*)(wts + 6 * 1024 + ch);
        const f32x4 y = (d * rs * nwv + sk * xc) * up4(B.Z[j]);
        u32x2 o; o.x = pk2(y.x, y.y); o.y = pk2(y.z, y.w);
        *(u32x2*)(ymix + (size_t)t * 2048 + ch) = o;
    }
}
__device__ __forceinline__ void phase_ym(const MegaArgs& a, LAS unsigned char* lds, int tid, int gw, int NGW, int lane) {
    unsigned char* ws = a.ws;
    const bf16_t* xm = (const bf16_t*)(ws + WS_XM); const bf16_t* szb = (const bf16_t*)(ws + WS_SZ); const bf16_t* hm = (const bf16_t*)(ws + WS_R1);
    bf16_t* ymix = (bf16_t*)(ws + WS_YMIX);
    LAS float* wts = (LAS float*)lds;
    for (int i = tid; i < 7 * 1024; i += NWAVES * 64) {
        const int r = i >> 10, c = i & 1023;
        wts[i] = (r < 4) ? a.in[3][r * DM + c] : (r == 4 ? a.in[4][c] : (r == 5 ? a.in[12][c] : a.in[13][c]));
    }
    __syncthreads();
    YmBuf A, B;
    int t = gw;
    if (t < NTOK) ym_load(xm, hm, szb, t, lane, A);
    for (; t < NTOK; t += 2 * NGW) {
        const int t2 = t + NGW;
        if (t2 < NTOK) ym_load(xm, hm, szb, t2, lane, B);
        ym_compute(wts, ymix, t, lane, A);
        if (t2 < NTOK) {
            const int t3 = t2 + NGW;
            if (t3 < NTOK) ym_load(xm, hm, szb, t3, lane, A);
            ym_compute(wts, ymix, t2, lane, B);
        }
    }
    __syncthreads();
}

struct EpiOutProj {
    const float* x; bf16_t* hb; unsigned char* hq;
    __device__ __forceinline__ void operator()(const f32x4 (&acc)[2][2][4][2], const pg8::Unit& un, int wr, int wc, int fr, int fq) const {
        const int row0 = un.pm * 256 + wr * 64 + fr;
        const int c0 = un.pn * 256 + wc * 32 + 8 * fq;
#pragma unroll
        for (int ai = 0; ai < 2; ++ai)
#pragma unroll
            for (int m = 0; m < 4; ++m) {
                const size_t off = (size_t)(row0 + ai * 128 + m * 16) * DM + c0;
#pragma unroll
                for (int bj = 0; bj < 2; ++bj) {
                    const f32x4 x0 = *(const f32x4*)(x + off + bj * 128), x1 = *(const f32x4*)(x + off + bj * 128 + 4);
                    const f32x4 v0 = acc[ai][bj][m][0] + x0, v1 = acc[ai][bj][m][1] + x1;
                    u32x4 wb; wb.x = pg8::cvt_pk_bf16(v0[0], v0[1]); wb.y = pg8::cvt_pk_bf16(v0[2], v0[3]); wb.z = pg8::cvt_pk_bf16(v1[0], v1[1]); wb.w = pg8::cvt_pk_bf16(v1[2], v1[3]);
                    *(u32x4*)(hb + off + bj * 128) = wb;
                    u32x2 w; w.x = pk4_fp8(v0[0], v0[1], v0[2], v0[3]); w.y = pk4_fp8(v1[0], v1[1], v1[2], v1[3]);
                    *(u32x2*)(hq + off + bj * 128) = w;
                }
            }
    }
};

constexpr size_t WS_GCT = WS_SMALL + 512 * 1024;
constexpr size_t WS_GVT = WS_GCT + 32 * 1024;
constexpr size_t WS_FCUM = WS_SMALL + 3 * MiB;
constexpr size_t WS_UVAL = WS_SMALL + 4 * MiB;
constexpr size_t WS_MVAL = WS_SMALL + 7 * MiB;
constexpr size_t WS_ITEMS = WS_SMALL + 8 * MiB;
constexpr size_t WS_DN = WS_SMALL + 9 * MiB;
constexpr size_t WS_NPREV = WS_SMALL + 10 * MiB;
constexpr size_t WS_QB = 477 * MiB;
constexpr size_t WS_KB = 541 * MiB;
constexpr size_t WS_AEXT = 605 * MiB;
constexpr size_t WS_BEXT = 733 * MiB;
constexpr size_t WS_DCT = 861 * MiB;
constexpr size_t WS_KWT = WS_R1;
constexpr size_t WS_HM = WS_R1;
constexpr int RINV_OFF = LDSCTL_OFF + 1024;

__device__ __forceinline__ void p0_gate_tables(const MegaArgs& a, int gw, int NGW, int lane) {
    const float* wq = a.in[5]; const float* wk = a.in[6]; const float* wv = a.in[7]; const float* wig = a.in[8]; const float* wfg = a.in[10];
    bf16_t* gct = (bf16_t*)(a.ws + WS_GCT);
    for (int idx = gw * 64 + lane; idx < 2 * 16 * 1024; idx += NGW * 64) {
        const int tbl = idx >> 14, col = (idx >> 10) & 15, ch = idx & 1023;
        float v = 0.f;
        if (col < 8) {
            const float* Wg = (col < 4) ? wig : wfg; const int hh = col & 3, n = ch >> 2, i = ch & 3;
#pragma unroll
            for (int o = 0; o < 4; ++o) {
                if (tbl == 0) v += wq[n * 16 + i * 4 + o] * Wg[(size_t)(4 * n + o) * 4 + hh] + wk[n * 16 + i * 4 + o] * Wg[(size_t)(1024 + 4 * n + o) * 4 + hh];
                else v += wv[n * 16 + i * 4 + o] * Wg[(size_t)(2048 + 4 * n + o) * 4 + hh];
            }
        }
        gct[idx] = f2bf(v);
    }
}

struct GateBuf { u32x4 row[4]; u32x4 b1, b2; };
__device__ __forceinline__ void gate_load(const bf16_t* xm, const bf16_t* gct, const bf16_t* gvt, int t, int s, int tok, int ch0, GateBuf& B) {
#pragma unroll
    for (int kk = 0; kk < 4; ++kk) B.row[kk] = (s - 3 + kk >= 0) ? *(const u32x4*)(xm + (size_t)(t - 3 + kk) * DM + ch0) : (u32x4){0u, 0u, 0u, 0u};
    B.b1 = *(const u32x4*)(gct + (size_t)tok * 1024 + ch0);
    B.b2 = *(const u32x4*)(gvt + (size_t)tok * 1024 + ch0);
}
__device__ __forceinline__ f32x4 gate_step(const LAS float* cwl, int ch0, const GateBuf& B, f32x4 acc) {
    float xc[8];
    {
        const f32x4 b0 = *(const LAS f32x4*)(cwl + 4 * 1024 + ch0), b1 = *(const LAS f32x4*)(cwl + 4 * 1024 + ch0 + 4);
        xc[0] = b0.x; xc[1] = b0.y; xc[2] = b0.z; xc[3] = b0.w; xc[4] = b1.x; xc[5] = b1.y; xc[6] = b1.z; xc[7] = b1.w;
    }
#pragma unroll
    for (int kk = 0; kk < 4; ++kk) {
        float xf[8]; unpack8(B.row[kk], xf);
        const f32x4 w0 = *(const LAS f32x4*)(cwl + kk * 1024 + ch0), w1 = *(const LAS f32x4*)(cwl + kk * 1024 + ch0 + 4);
        xc[0] += w0.x * xf[0]; xc[1] += w0.y * xf[1]; xc[2] += w0.z * xf[2]; xc[3] += w0.w * xf[3];
        xc[4] += w1.x * xf[4]; xc[5] += w1.y * xf[5]; xc[6] += w1.z * xf[6]; xc[7] += w1.w * xf[7];
    }
#pragma unroll
    for (int i = 0; i < 8; ++i) xc[i] = siluf_(xc[i]);
    u32x4 a1; a1.x = pk2(xc[0], xc[1]); a1.y = pk2(xc[2], xc[3]); a1.z = pk2(xc[4], xc[5]); a1.w = pk2(xc[6], xc[7]);
    acc = __builtin_amdgcn_mfma_f32_16x16x32_bf16(__builtin_bit_cast(bf16x8, a1), __builtin_bit_cast(bf16x8, B.b1), acc, 0, 0, 0);
    acc = __builtin_amdgcn_mfma_f32_16x16x32_bf16(__builtin_bit_cast(bf16x8, B.row[3]), __builtin_bit_cast(bf16x8, B.b2), acc, 0, 0, 0);
    return acc;
}
__device__ __forceinline__ void phase_gates(const MegaArgs& a, LAS unsigned char* lds, int tid, int gw, int NGW, int lane) {
    unsigned char* ws = a.ws;
    const bf16_t* xm = (const bf16_t*)(ws + WS_XM);
    const bf16_t* gct = (const bf16_t*)(ws + WS_GCT); const bf16_t* gvt = (const bf16_t*)(ws + WS_GVT);
    const float* big = a.in[9]; const float* bfg = a.in[11];
    float* logi = (float*)(ws + WS_LOGI); float* logf = (float*)(ws + WS_LOGF);
    LAS float* cwl = (LAS float*)lds;
    for (int i = tid; i < 5 * 1024; i += NWAVES * 64) cwl[i] = (i < 4096) ? a.in[3][i] : a.in[4][i - 4096];
    __syncthreads();
    const int tok = lane & 15, kq = lane >> 4;
    for (int tile = gw; tile < NTOK / 16; tile += NGW) {
        const int t = tile * 16 + tok, s = t & (SEQ - 1);
        f32x4 acc = (f32x4){0.f, 0.f, 0.f, 0.f};
        GateBuf A, B;
        gate_load(xm, gct, gvt, t, s, tok, 8 * kq, A);
        for (int ks = 0; ks < 32; ks += 2) {
            gate_load(xm, gct, gvt, t, s, tok, 32 * (ks + 1) + 8 * kq, B);
            acc = gate_step(cwl, 32 * ks + 8 * kq, A, acc);
            if (ks + 2 < 32) gate_load(xm, gct, gvt, t, s, tok, 32 * (ks + 2) + 8 * kq, A);
            acc = gate_step(cwl, 32 * (ks + 1) + 8 * kq, B, acc);
        }
        const int col = lane & 15;
        if (col < 8) {
            const int hh = col & 3;
#pragma unroll
            for (int r = 0; r < 4; ++r) {
                const int tt = tile * 16 + 4 * kq + r;
                if (col < 4) logi[(size_t)hh * NTOK + tt] = acc[r] + big[hh];
                else logf[(size_t)hh * NTOK + tt] = logsigmoidf_(acc[r] + bfg[hh]);
            }
        }
    }
    __syncthreads();
}

__device__ __forceinline__ void phase_prep(const MegaArgs& a, LAS unsigned char* lds, int tid, int lane, int wave, int G) {
    unsigned char* ws = a.ws;
    const float* logi = (const float*)(ws + WS_LOGI); const float* logf = (const float*)(ws + WS_LOGF);
    float* Fcum = (float*)(ws + WS_FCUM); float* Uval = (float*)(ws + WS_UVAL); float* Mval = (float*)(ws + WS_MVAL);
    float* items = (float*)(ws + WS_ITEMS); float* dn = (float*)(ws + WS_DN);
    const bf16_t* xm = (const bf16_t*)(ws + WS_XM);
    bf16_t* qb = (bf16_t*)(ws + WS_QB); bf16_t* kb = (bf16_t*)(ws + WS_KB); bf16_t* aext = (bf16_t*)(ws + WS_AEXT); bf16_t* bext = (bf16_t*)(ws + WS_BEXT); bf16_t* kwt = (bf16_t*)(ws + WS_KWT);
    const float* cw = a.in[3]; const float* cb = a.in[4]; const float* wq = a.in[5]; const float* wk = a.in[6]; const float* wv = a.in[7];
    LAS float* gch = (LAS float*)lds;
    LAS float* umaxch = gch + 32;
    LAS float* wint_l = umaxch + 32;
    LAS float* wst_l = wint_l + 256;
    LAS float* dn_l = wst_l + 256;
    LAS float* wtl = dn_l + 8 * 256;
    for (int it = blockIdx.x; it < 512; it += G) {
        const int bh = it >> 5, c = it & 31, b = bh >> 2, h = bh & 3;
        const int tb = b * SEQ, t0 = tb + c * 256;
        {
            const int cc = tid >> 4, sub = tid & 15;
            const size_t gbase = (size_t)h * NTOK + tb + cc * 256 + 16 * sub;
            float F[16], u[16];
            {
                const f32x4* lfp = (const f32x4*)(logf + gbase); const f32x4* lip = (const f32x4*)(logi + gbase);
#pragma unroll
                for (int q4 = 0; q4 < 4; ++q4) { const f32x4 v = lfp[q4], w = lip[q4]; F[4 * q4] = v.x; F[4 * q4 + 1] = v.y; F[4 * q4 + 2] = v.z; F[4 * q4 + 3] = v.w; u[4 * q4] = w.x; u[4 * q4 + 1] = w.y; u[4 * q4 + 2] = w.z; u[4 * q4 + 3] = w.w; }
            }
#pragma unroll
            for (int jj = 1; jj < 16; ++jj) F[jj] += F[jj - 1];
            const float total = F[15];
            float incl = total;
#pragma unroll
            for (int o = 1; o < 16; o <<= 1) { const float v = __shfl_up(incl, o, 16); if (sub >= o) incl += v; }
            const float excl = incl - total;
            float um = -3.0e38f;
#pragma unroll
            for (int jj = 0; jj < 16; ++jj) { F[jj] += excl; u[jj] -= F[jj]; um = fmaxf(um, u[jj]); }
            float umx = um;
#pragma unroll
            for (int o = 1; o < 16; o <<= 1) umx = fmaxf(umx, __shfl_xor(umx, o, 16));
            const float gsum = __shfl(incl, 15, 16);
            if (sub == 0) { gch[cc] = gsum; umaxch[cc] = umx; }
            float cm[16]; cm[0] = u[0];
#pragma unroll
            for (int jj = 1; jj < 16; ++jj) cm[jj] = fmaxf(cm[jj - 1], u[jj]);
            float inclm = cm[15];
#pragma unroll
            for (int o = 1; o < 16; o <<= 1) { const float v = __shfl_up(inclm, o, 16); if (sub >= o) inclm = fmaxf(inclm, v); }
            float exclm = __shfl_up(inclm, 1, 16); if (sub == 0) exclm = -3.0e38f;
            __syncthreads();
            float m = 0.f;
            for (int c2 = 0; c2 < c; ++c2) m = gch[c2] + fmaxf(m, umaxch[c2]);
            const float mprev = m, g_c = gch[c], umax_c = umaxch[c], m_c = g_c + fmaxf(mprev, umax_c);
            if (tid == 0) { items[it] = __expf(g_c + mprev - m_c); items[512 + it] = __expf(g_c + umax_c - m_c); items[1024 + it] = mprev; }
            if (cc == c) {
#pragma unroll
                for (int jj = 0; jj < 16; ++jj) {
                    const float M = fmaxf(mprev, fmaxf(cm[jj], exclm));
                    Fcum[gbase + jj] = F[jj]; Uval[gbase + jj] = u[jj]; Mval[gbase + jj] = M;
                    wint_l[16 * sub + jj] = __expf(mprev - M); wst_l[16 * sub + jj] = __expf(u[jj] - umax_c);
                }
            }
            __syncthreads();
        }
        {
            const int ch = h * 256 + 4 * lane;
            float cwv[4][4];
            const f32x4 cbv = *(const f32x4*)(cb + ch);
#pragma unroll
            for (int kk = 0; kk < 4; ++kk) { const f32x4 w = *(const f32x4*)(cw + kk * DM + ch); cwv[kk][0] = w.x; cwv[kk][1] = w.y; cwv[kk][2] = w.z; cwv[kk][3] = w.w; }
            for (int i = tid; i < 768; i += NWAVES * 64) {
                const int mat = i >> 8, q4 = (i >> 6) & 3, ln = i & 63;
                const float* src = (mat == 0 ? wq : (mat == 1 ? wk : wv)) + (h * 64 + ln) * 16 + 4 * q4;
                *(LAS f32x4*)(wtl + 4 * i) = *(const f32x4*)src;
            }
            __syncthreads();
            const int i0 = 32 * wave;
            const __amdgpu_buffer_rsrc_t xrs = __builtin_amdgcn_make_buffer_rsrc((void*)xm, 0, NTOK * 2048, 0x00020000);
            u32x2 cur[11], nx[8];
#pragma unroll
            for (int r = 0; r < 11; ++r) {
                const int sp = c * 256 + i0 - 3 + r;
                cur[r] = (sp >= 0) ? (u32x2)__builtin_amdgcn_raw_buffer_load_b64(xrs, ch * 2, (t0 + i0 - 3 + r) * 2048, 0) : (u32x2){0u, 0u};
            }
            float dnacc[4] = {0.f, 0.f, 0.f, 0.f};
#pragma unroll 1
            for (int pb = 0; pb < 4; ++pb) {
                if (pb < 3) {
#pragma unroll
                    for (int r = 0; r < 8; ++r) nx[r] = (u32x2)__builtin_amdgcn_raw_buffer_load_b64(xrs, ch * 2, (t0 + i0 + 8 * (pb + 1) + r) * 2048, 0);
                }
#pragma unroll
                for (int pp = 0; pp < 8; ++pp) {
                    const int i = i0 + pb * 8 + pp;
                    const f32x4 x0v = up4(cur[pp]), x1v = up4(cur[pp + 1]), x2v = up4(cur[pp + 2]), x3v = up4(cur[pp + 3]);
                    float x3[4]; x3[0] = x3v.x; x3[1] = x3v.y; x3[2] = x3v.z; x3[3] = x3v.w;
                    float xc[4];
#pragma unroll
                    for (int cc = 0; cc < 4; ++cc) xc[cc] = siluf_(cbv[cc] + cwv[0][cc] * x0v[cc] + cwv[1][cc] * x1v[cc] + cwv[2][cc] * x2v[cc] + cwv[3][cc] * x3v[cc]);
                    float qv[4], kv[4], vv[4];
                    {
                        f32x4 qa = (f32x4){0.f, 0.f, 0.f, 0.f}, ka = qa, va = qa;
#pragma unroll
                        for (int q4 = 0; q4 < 4; ++q4) {
                            qa = qa + *(const LAS f32x4*)(wtl + ((0 * 4 + q4) * 64 + lane) * 4) * xc[q4];
                            ka = ka + *(const LAS f32x4*)(wtl + ((1 * 4 + q4) * 64 + lane) * 4) * xc[q4];
                            va = va + *(const LAS f32x4*)(wtl + ((2 * 4 + q4) * 64 + lane) * 4) * x3[q4];
                        }
#pragma unroll
                        for (int o = 0; o < 4; ++o) { qv[o] = qa[o] * 0.0625f; kv[o] = ka[o]; vv[o] = va[o]; }
                    }
                    const float wi = wint_l[i], wsj = wst_l[i];
                    u32x2 o2;
                    o2.x = pk2(qv[0], qv[1]); o2.y = pk2(qv[2], qv[3]);
                    if (!(a.pad & 2)) *(u32x2*)(qb + (size_t)(t0 + i) * DM + ch) = o2;
                    o2.x = pk2(kv[0], kv[1]); o2.y = pk2(kv[2], kv[3]);
                    if (!(a.pad & 2)) *(u32x2*)(kb + (size_t)(t0 + i) * DM + ch) = o2;
                    o2.x = pk2(qv[0] * wi, qv[1] * wi); o2.y = pk2(qv[2] * wi, qv[3] * wi);
                    if (!(a.pad & 2)) *(u32x2*)(aext + ((size_t)it * 256 + i) * 512 + 256 + 4 * lane) = o2;
                    {
                        float kwv[4];
#pragma unroll
                        for (int o = 0; o < 4; ++o) { kwv[o] = kv[o] * wsj; dnacc[o] += kwv[o]; }
                        o2.x = pk2(vv[0], vv[1]); o2.y = pk2(vv[2], vv[3]);
                        if (!(a.pad & 2)) *(u32x2*)(bext + ((size_t)it * 256 + i) * 512 + 256 + 4 * lane) = o2;
                        o2.x = pk2(kwv[0], kwv[1]); o2.y = pk2(kwv[2], kwv[3]);
                        if (!(a.pad & 2)) *(u32x2*)(aext + ((size_t)it * 256 + i) * 512 + 4 * lane) = o2;
                    }
                }
#pragma unroll
                for (int r = 0; r < 3; ++r) cur[r] = cur[8 + r];
#pragma unroll
                for (int r = 0; r < 8; ++r) cur[3 + r] = nx[r];
            }
#pragma unroll
            for (int o = 0; o < 4; ++o) dn_l[wave * 256 + 4 * lane + o] = dnacc[o];
            __syncthreads();
            if (tid < 256) {
                float s = 0.f;
#pragma unroll
                for (int w = 0; w < 8; ++w) s += dn_l[w * 256 + tid];
                dn[(size_t)it * 256 + tid] = s;
            }
            __syncthreads();
        }
    }
}

__device__ __forceinline__ void tr_subtile(const bf16_t* src, int lds_src, bf16_t* dst, int lds_dst, LAS unsigned short* tile, int lane) {
    const int rr = lane >> 3, pc = lane & 7;
    u32x4 v[8];
#pragma unroll
    for (int s2 = 0; s2 < 8; ++s2) v[s2] = *(const u32x4*)(src + (size_t)(rr + 8 * s2) * lds_src + 8 * pc);
#pragma unroll
    for (int s2 = 0; s2 < 8; ++s2) {
        LAS unsigned* tp = (LAS unsigned*)(tile + (rr + 8 * s2) * 66 + 8 * pc);
        tp[0] = v[s2].x; tp[1] = v[s2].y; tp[2] = v[s2].z; tp[3] = v[s2].w;
    }
    asm volatile("s_waitcnt lgkmcnt(0)" ::: "memory");
#pragma unroll
    for (int s2 = 0; s2 < 8; ++s2) {
        const int c = rr + 8 * s2;
        const LAS unsigned short* tp = tile + (8 * pc) * 66 + c;
        u32x4 o;
        o.x = (unsigned)tp[0 * 66] | ((unsigned)tp[1 * 66] << 16); o.y = (unsigned)tp[2 * 66] | ((unsigned)tp[3 * 66] << 16);
        o.z = (unsigned)tp[4 * 66] | ((unsigned)tp[5 * 66] << 16); o.w = (unsigned)tp[6 * 66] | ((unsigned)tp[7 * 66] << 16);
        *(u32x4*)(dst + (size_t)c * lds_dst + 8 * pc) = o;
    }
    asm volatile("s_waitcnt lgkmcnt(0)" ::: "memory");
}
__device__ __forceinline__ void phase_transposes(const MegaArgs& a, LAS unsigned char* lds, int wave, int lane, int G) {
    unsigned char* ws = a.ws;
    bf16_t* aext = (bf16_t*)(ws + WS_AEXT); bf16_t* bext = (bf16_t*)(ws + WS_BEXT); bf16_t* kwt = (bf16_t*)(ws + WS_KWT);
    LAS unsigned short* tile = (LAS unsigned short*)(lds + wave * 16384);
    for (int it = blockIdx.x; it < 512; it += G) {
        for (int job = wave; job < 32; job += NWAVES) {
            const int arr = job >> 4, sj = (job >> 2) & 3, sc = job & 3;
            if (arr == 0) tr_subtile(bext + ((size_t)it * 256 + 64 * sj) * 512 + 256 + 64 * sc, 512, bext + ((size_t)it * 256 + 64 * sc) * 512 + 64 * sj, 512, tile, lane);
            else          tr_subtile(aext + ((size_t)it * 256 + 64 * sj) * 512 + 64 * sc, 512, kwt + ((size_t)it * 256 + 64 * sc) * 256 + 64 * sj, 256, tile, lane);
        }
    }
    asm volatile("s_waitcnt vmcnt(0)" ::: "memory");
    __syncthreads();
}

struct ItemOrder {
    const char* A; const char* B; size_t a_item_bytes, b_item_bytes; int per_token; int G, c;
    __device__ __forceinline__ bool next(int i, pg8::Unit& u) const {
        const int it = i * G + c; if (it >= 512) return false;
        u.pm = it; u.pn = 0; u.aux = i; u.gidx = nullptr;
        if (per_token) { const int bh = it >> 5, cc = it & 31, b = bh >> 2, h = bh & 3; const size_t off = ((size_t)(b * SEQ + cc * 256) * DM + h * 256) * 2; u.A = A + off; u.B = B + off; }
        else { u.A = A + (size_t)it * a_item_bytes; u.B = B + (size_t)it * b_item_bytes; }
        return true;
    }
};
struct EpiP {
    const float* Uval; const float* Mval; bf16_t* aext;
    __device__ __forceinline__ void operator()(const f32x4 (&acc)[2][2][4][2], const pg8::Unit& un, int wr, int wc, int fr, int fq) const {
        const int it = un.pm, bh = it >> 5, cc = it & 31, b = bh >> 2, h = bh & 3;
        const size_t gb = (size_t)h * NTOK + b * SEQ + cc * 256;
        const int jb = wc * 32 + 8 * fq;
#pragma unroll
        for (int bj = 0; bj < 2; ++bj) {
            f32x4 uj[2];
#pragma unroll
            for (int n = 0; n < 2; ++n) uj[n] = *(const f32x4*)(Uval + gb + bj * 128 + jb + 4 * n);
#pragma unroll
            for (int ai = 0; ai < 2; ++ai)
#pragma unroll
                for (int m = 0; m < 4; ++m) {
                    const int i = ai * 128 + wr * 64 + m * 16 + fr;
                    const float Mi = Mval[gb + i];
                    f32x4 o[2];
#pragma unroll
                    for (int n = 0; n < 2; ++n)
#pragma unroll
                        for (int jj = 0; jj < 4; ++jj) {
                            const int j = bj * 128 + jb + 4 * n + jj;
                            o[n][jj] = (j <= i) ? acc[ai][bj][m][n][jj] * __expf(uj[n][jj] - Mi) : 0.f;
                        }
                    u32x4 w; w.x = pg8::cvt_pk_bf16(o[0][0], o[0][1]); w.y = pg8::cvt_pk_bf16(o[0][2], o[0][3]); w.z = pg8::cvt_pk_bf16(o[1][0], o[1][1]); w.w = pg8::cvt_pk_bf16(o[1][2], o[1][3]);
                    *(u32x4*)(aext + ((size_t)it * 256 + i) * 512 + bj * 128 + jb) = w;
                    asm volatile("" ::: "memory");
                }
        }
    }
};
struct EpiDC {
    bf16_t* dct;
    __device__ __forceinline__ void operator()(const f32x4 (&acc)[2][2][4][2], const pg8::Unit& un, int wr, int wc, int fr, int fq) const {
        const int it = un.pm; const int cb0 = wc * 32 + 8 * fq;
#pragma unroll
        for (int ai = 0; ai < 2; ++ai)
#pragma unroll
            for (int m = 0; m < 4; ++m) {
                const int r = ai * 128 + wr * 64 + m * 16 + fr;
#pragma unroll
                for (int bj = 0; bj < 2; ++bj) {
                    const f32x4 v0 = acc[ai][bj][m][0], v1 = acc[ai][bj][m][1];
                    u32x4 w; w.x = pg8::cvt_pk_bf16(v0[0], v0[1]); w.y = pg8::cvt_pk_bf16(v0[2], v0[3]); w.z = pg8::cvt_pk_bf16(v1[0], v1[1]); w.w = pg8::cvt_pk_bf16(v1[2], v1[3]);
                    *(u32x4*)(dct + ((size_t)it * 256 + r) * 256 + bj * 128 + cb0) = w;
                }
            }
    }
};
struct EpiO {
    LAS const float* rinv; bf16_t* hm;
    __device__ __forceinline__ void operator()(const f32x4 (&acc)[2][2][4][2], const pg8::Unit& un, int wr, int wc, int fr, int fq) const {
        const int it = un.pm, bh = it >> 5, cc = it & 31, b = bh >> 2, h = bh & 3;
        const size_t t0 = (size_t)b * SEQ + cc * 256; const int eb = wc * 32 + 8 * fq;
#pragma unroll
        for (int ai = 0; ai < 2; ++ai)
#pragma unroll
            for (int m = 0; m < 4; ++m) {
                const int i = ai * 128 + wr * 64 + m * 16 + fr;
                const float ri = rinv[un.aux * 256 + i];
#pragma unroll
                for (int bj = 0; bj < 2; ++bj) {
                    const f32x4 v0 = acc[ai][bj][m][0] * ri, v1 = acc[ai][bj][m][1] * ri;
                    u32x4 w; w.x = pg8::cvt_pk_bf16(v0[0], v0[1]); w.y = pg8::cvt_pk_bf16(v0[2], v0[3]); w.z = pg8::cvt_pk_bf16(v1[0], v1[1]); w.w = pg8::cvt_pk_bf16(v1[2], v1[3]);
                    *(u32x4*)(hm + (t0 + i) * DM + h * 256 + bj * 128 + eb) = w;
                }
            }
    }
};

__device__ __forceinline__ void phase_scan(const MegaArgs& a, int tid) {
    unsigned char* ws = a.ws;
    const float* items = (const float*)(ws + WS_ITEMS); const bf16_t* dct = (const bf16_t*)(ws + WS_DCT); bf16_t* bext = (bf16_t*)(ws + WS_BEXT);
    const float* dn = (const float*)(ws + WS_DN); float* nprev = (float*)(ws + WS_NPREV);
    int tid_o = tid; asm volatile("" : "+v"(tid_o));
    const int gid = blockIdx.x * (NWAVES * 64) + tid_o;
    if (gid < 16 * 256 * 32) {
        const int bh = gid >> 13, e = (gid >> 5) & 255, d8 = gid & 31;
        float st[8];
#pragma unroll
        for (int i = 0; i < 8; ++i) st[i] = 0.f;
        for (int c = 0; c < 32; ++c) {
            const int it = bh * 32 + c;
            u32x4 w; w.x = pk2(st[0], st[1]); w.y = pk2(st[2], st[3]); w.z = pk2(st[4], st[5]); w.w = pk2(st[6], st[7]);
            *(u32x4*)(bext + ((size_t)it * 256 + e) * 512 + 256 + 8 * d8) = w;
            const u32x4 r = *(const u32x4*)(dct + ((size_t)it * 256 + e) * 256 + 8 * d8);
            float dv[8]; unpack8(r, dv);
            const float dec = items[it], sc = items[512 + it];
#pragma unroll
            for (int i = 0; i < 8; ++i) st[i] = dec * st[i] + sc * dv[i];
        }
    }
    if (gid < 16 * 256) {
        const int bh = gid >> 8, d = gid & 255;
        float st = 0.f;
        for (int c = 0; c < 32; ++c) {
            const int it = bh * 32 + c;
            nprev[(size_t)it * 256 + d] = st;
            st = items[it] * st + items[512 + it] * dn[(size_t)it * 256 + d];
        }
    }
}

__device__ __forceinline__ void g3_rinv(const MegaArgs& a, LAS unsigned char* lds, int tid, int G) {
    unsigned char* ws = a.ws;
    const bf16_t* aext = (const bf16_t*)(ws + WS_AEXT); const float* nprev = (const float*)(ws + WS_NPREV);
    const float* Fcum = (const float*)(ws + WS_FCUM); const float* Mval = (const float*)(ws + WS_MVAL);
    LAS float* rinv = (LAS float*)(lds + RINV_OFF);
    for (int ui = 0; ui < 2; ++ui) {
        const int it = ui * G + blockIdx.x; if (it >= 512) break;
        const int bh = it >> 5, cc = it & 31, b = bh >> 2, h = bh & 3;
        const int i = tid >> 1, part = tid & 1;
        const u32x4* rowp = (const u32x4*)(aext + ((size_t)it * 256 + i) * 512 + part * 256);
        float s = 0.f;
        if (part == 0) {
            for (int q = 0; q < 32; ++q) { float f[8]; unpack8(rowp[q], f); s += ((f[0] + f[1]) + (f[2] + f[3])) + ((f[4] + f[5]) + (f[6] + f[7])); }
        } else {
            const f32x4* np = (const f32x4*)(nprev + (size_t)it * 256);
            for (int q = 0; q < 32; ++q) { float f[8]; unpack8(rowp[q], f); const f32x4 n0 = np[2 * q], n1 = np[2 * q + 1];
                s += (f[0] * n0.x + f[1] * n0.y + f[2] * n0.z + f[3] * n0.w) + (f[4] * n1.x + f[5] * n1.y + f[6] * n1.z + f[7] * n1.w); }
        }
        s += __shfl_xor(s, 1);
        const size_t gi = (size_t)h * NTOK + b * SEQ + cc * 256 + i;
        const float mi = Fcum[gi] + Mval[gi];
        if (part == 0) rinv[ui * 256 + i] = 1.0f / fmaxf(fabsf(s), __expf(-mi));
    }
    __syncthreads();
}

#ifndef STAG1
#define STAG1 0
#endif
#ifndef STAG12
#define STAG12 0
#endif
__global__ void __launch_bounds__(NWAVES * 64, 2) mega_fwd(MegaArgs args) {
    extern __shared__ __attribute__((aligned(16))) unsigned char lds_raw[];
    LAS unsigned char* lds = (LAS unsigned char*)lds_raw;
    const int wave = __builtin_amdgcn_readfirstlane(threadIdx.x >> 6);
#define lane lane_id()
#define tid ((wave << 6) | lane_id())
    const int G = gridDim.x;
    const int gw = blockIdx.x * NWAVES + wave, NGW = G * NWAVES;
    unsigned char* ws = args.ws;
    unsigned* ctl = (unsigned*)(ws + WS_CTL);
    for (int u = tid; u < (LDS_BYTES - LDSCTL_OFF) / 4; u += NWAVES * 64) ((LAS unsigned*)(lds + LDSCTL_OFF))[u] = 0u;
    __syncthreads();
    XcdBarrier bar = xcd_barrier_post(ctl + CW_BAR + args.li * XCD_BAR_WORDS, (volatile LAS unsigned*)(lds + LDSCTL_OFF + 64), wave);
    const int lo = args.ph_lo, hi = args.ph_hi;
#define IN(k) (lo <= (k) && (k) < hi)
#define BOTH(k) (IN(k) && IN((k) + 1))

    if (IN(0)) { p0_prologue(args, lds, gw, NGW, wave, lane); p0_gate_tables(args, gw, NGW, lane); p0_router_tables(args, gw, NGW, lane); if (BOTH(0)) xcd_barrier(bar); }

    if (IN(1)) {
        pg8::DenseOrder S; S.init(ws + WS_R1, ws + WS_BTIN, NTOK, DPROJ, DM, DM, G, (int)blockIdx.x);
        EpiInProj E{(const float*)(ws + WS_RSTD1), (bf16_t*)(ws + WS_XM), (bf16_t*)(ws + WS_SZ), (bf16_t*)(ws + WS_U), args.pad};
        pg8::gemm_phase<EpiInProj, pg8::DenseOrder, false>(lds, wave, DM, DM, DM, S, E, 0x7F7F7F7F, 0x7F7F7F7F, STAG1);
        if (BOTH(1)) xcd_barrier(bar);
    }

    if (IN(2)) { phase_gates(args, lds, tid, gw, NGW, lane); if (BOTH(2)) xcd_barrier(bar); }
    if (IN(3)) { phase_prep(args, lds, tid, lane, wave, G); if (BOTH(3)) xcd_barrier(bar); }
    if (IN(4)) {
        phase_transposes(args, lds, wave, lane, G);
        {
            ItemOrder S; S.A = (const char*)(ws + WS_QB); S.B = (const char*)(ws + WS_KB); S.a_item_bytes = 0; S.b_item_bytes = 0; S.per_token = 1; S.G = G; S.c = (int)blockIdx.x;
            EpiP E{(const float*)(ws + WS_UVAL), (const float*)(ws + WS_MVAL), (bf16_t*)(ws + WS_AEXT)};
            pg8::gemm_phase<EpiP, ItemOrder, false>(lds, wave, 256, DM, DM, S, E);
        }
        {
            ItemOrder S; S.A = (const char*)(ws + WS_BEXT); S.B = (const char*)(ws + WS_KWT); S.a_item_bytes = (size_t)256 * 512 * 2; S.b_item_bytes = (size_t)256 * 256 * 2; S.per_token = 0; S.G = G; S.c = (int)blockIdx.x;
            EpiDC E{(bf16_t*)(ws + WS_DCT)};
            pg8::gemm_phase<EpiDC, ItemOrder, false>(lds, wave, 256, 512, 256, S, E);
        }
        if (BOTH(4)) xcd_barrier(bar);
    }
    if (IN(5)) { phase_scan(args, tid); phase_conv31(args, lds, tid, lane, wave, G); if (BOTH(5)) xcd_barrier(bar); }
    if (IN(6)) {
        g3_rinv(args, lds, tid, G);
        ItemOrder S; S.A = (const char*)(ws + WS_AEXT); S.B = (const char*)(ws + WS_BEXT); S.a_item_bytes = (size_t)256 * 512 * 2; S.b_item_bytes = (size_t)256 * 512 * 2; S.per_token = 0; S.G = G; S.c = (int)blockIdx.x;
        EpiO E{(LAS const float*)(lds + RINV_OFF), (bf16_t*)(ws + WS_HM)};
        pg8::gemm_phase<EpiO, ItemOrder, false>(lds, wave, 512, 512, 512, S, E);
        if (BOTH(6)) xcd_barrier(bar);
    }
    if (IN(7)) { phase_ym(args, lds, tid, gw, NGW, lane); if (BOTH(7)) xcd_barrier(bar); }
    if (IN(8)) {
        pg8::DenseOrder S; S.init(ws + WS_YMIX, ws + WS_BTOUT, NTOK, DM, 2048, 2048, G, (int)blockIdx.x);
        EpiOutProj E{args.in[0], (bf16_t*)(ws + WS_HB16), ws + WS_HBF};
        pg8::gemm_phase<EpiOutProj, pg8::DenseOrder, false>(lds, wave, 2048, 2048, 2048, S, E);
        if (BOTH(8)) xcd_barrier(bar);
    }
    if (IN(9)) { phase_router(args, lds, tid, lane, wave); if (BOTH(9)) xcd_barrier(bar); }
    if (IN(10)) { phase_slots(args, lds, tid); if (BOTH(10)) xcd_barrier(bar); }
    if (IN(11)) {
        const int T = __builtin_amdgcn_readfirstlane(__hip_atomic_load((const int*)(ws + WS_TILEEXP) + 2048, __ATOMIC_RELAXED, __HIP_MEMORY_SCOPE_AGENT));
        MoeOrder S; S.A = (const char*)(ws + WS_HBF); S.Bt = (const char*)(ws + WS_BT1); S.gidx = (const int*)(ws + WS_STOK); S.tile_exp = (const int*)(ws + WS_TILEEXP);
        S.a_tile_bytes = 0; S.b_exp_bytes = (size_t)2048 * 1024; S.b_tile_bytes = (size_t)256 * 1024; S.T = T; S.nN = 8; S.group = 4; S.c = (int)blockIdx.x;
        EpiMoe1 E{(const float*)(ws + WS_SRSTD), args.in[23], ws + WS_ACT, args.pad};
        pg8::gemm_phase<EpiMoe1, MoeOrder, true, true>(lds, wave, DM / 2, DM / 2, DM / 2, S, E, 0x7A7A7A7A, 0x7F7F7F7F);
        if (BOTH(11)) xcd_barrier(bar);
    }
    if (IN(12)) {
        const int T = __builtin_amdgcn_readfirstlane(__hip_atomic_load((const int*)(ws + WS_TILEEXP) + 2048, __ATOMIC_RELAXED, __HIP_MEMORY_SCOPE_AGENT));
        MoeOrder S; S.A = (const char*)(ws + WS_ACT); S.Bt = (const char*)(ws + WS_BT2); S.gidx = nullptr; S.tile_exp = (const int*)(ws + WS_TILEEXP);
        S.a_tile_bytes = (size_t)256 * 1024; S.b_exp_bytes = (size_t)1024 * 1024; S.b_tile_bytes = (size_t)256 * 1024; S.T = T; S.nN = 4; S.group = 8; S.c = (int)blockIdx.x;
        EpiMoe2 E{(const float*)(ws + WS_SGATE), args.in[25], ws + WS_YROWS};
        pg8::gemm_phase<EpiMoe2, MoeOrder, false, true>(lds, wave, DM / 2, DM / 2, DM / 2, S, E, 0x7A7A7A7A, 0x7F7F7F7F, STAG12);
        if (BOTH(12)) xcd_barrier(bar);
    }
    if (IN(13)) { phase_final(args, gw, NGW, lane); }
#undef IN
#undef BOTH
#undef lane
#undef tid
}

static int g_grid = 0;
static bool mega_setup(size_t ws_size) {
    if (g_grid == 0) {
        int dev = 0, cus = 0, per_cu = 0;
        if (ws_size < WS_NEED) { g_grid = -1; return false; }
        if (hipGetDevice(&dev) != hipSuccess || hipDeviceGetAttribute(&cus, hipDeviceAttributeMultiprocessorCount, dev) != hipSuccess) { g_grid = -1; return false; }
        if (hipFuncSetAttribute((const void*)mega_fwd, hipFuncAttributeMaxDynamicSharedMemorySize, LDS_BYTES) != hipSuccess) { g_grid = -1; return false; }
        (void)hipOccupancyMaxActiveBlocksPerMultiprocessor(&per_cu, (const void*)mega_fwd, NWAVES * 64, LDS_BYTES);
        (void)hipGetLastError();
        g_grid = cus;
    }
    return g_grid > 0;
}
static void mega_launch(const MegaArgs& base, int lo, int hi, int li, hipStream_t stream, int variant = 0) {
    MegaArgs a = base; a.ph_lo = lo; a.ph_hi = hi; a.li = li; a.pad = variant;
    hipLaunchKernelGGL(mega_fwd, dim3(g_grid), dim3(NWAVES * 64), LDS_BYTES, stream, a);
}

extern "C" void kernel_launch(void* const* d_in, const int* in_sizes, int n_in, void* d_out, int out_size, void* d_ws,
                              size_t ws_size, hipStream_t stream) {
    const float* mconv_w = (const float*)d_in[3];
    const float* mconv_b = (const float*)d_in[4];
    const float* w_q = (const float*)d_in[5];
    const float* w_k = (const float*)d_in[6];
    const float* w_v = (const float*)d_in[7];
    const float* w_ig = (const float*)d_in[8];
    const float* b_ig = (const float*)d_in[9];
    const float* w_fg = (const float*)d_in[10];
    const float* b_fg = (const float*)d_in[11];
    const float* mnorm_w = (const float*)d_in[12];
    const float* mskip = (const float*)d_in[13];
    const float* cdw_w = (const float*)d_in[14];
    const float* cdw_b = (const float*)d_in[15];
    const float* cnorm_w = (const float*)d_in[16];
    const float* cnorm_b = (const float*)d_in[17];
    const float* w_out = (const float*)d_in[18];
    const float* nffn_w = (const float*)d_in[19];
    const float* w_router = (const float*)d_in[20];
    const float* b_router = (const float*)d_in[21];
    const float* w1 = (const float*)d_in[22];
    const float* b1 = (const float*)d_in[23];
    const float* w2 = (const float*)d_in[24];
    const float* b2 = (const float*)d_in[25];
    const float* final_w = (const float*)d_in[26];
    const float* x = (const float*)d_in[0];
    float* out = (float*)d_out;
    if (!mega_setup(ws_size)) return;
    unsigned char* ws = (unsigned char*)d_ws;
    (void)hipMemsetAsync(ws + WS_CTL, 0, CTL_ZERO_BYTES, stream);
    MegaArgs a{};
    for (int i = 0; i < 27; ++i) a.in[i] = (const float*)d_in[i];
    a.out = out; a.ws = ws;

    bf16_t* xm = (bf16_t*)(ws + WS_XM);
    bf16_t* szb = (bf16_t*)(ws + WS_SZ);
    bf16_t* ub = (bf16_t*)(ws + WS_U);
    bf16_t* hm = (bf16_t*)(ws + WS_R1);
    bf16_t* ymix = (bf16_t*)(ws + WS_YMIX);
    float* logi = (float*)(ws + WS_LOGI);
    float* logf = (float*)(ws + WS_LOGF);
    int* topi = (int*)(ws + WS_TOPI);
    float* topg = (float*)(ws + WS_TOPG);
    int* slot_tok = (int*)(ws + WS_STOK);
    float* slot_gate = (float*)(ws + WS_SGATE);
    int* estart = (int*)(ws + WS_ESTART);
    bf16_t* act = (bf16_t*)(ws + WS_ACT);
    bf16_t* a2 = (bf16_t*)(ws + WS_R1);

#ifndef PROBE_K
    mega_launch(a, 0, 14, 0, stream);
#else
    mega_launch(a, 0, PROBE_K + 1, 0, stream);
#ifndef PROBE_V
#define PROBE_V 0
#endif
    mega_launch(a, PROBE_K, PROBE_K + 1, 1, stream, PROBE_V);
    if (PROBE_K + 1 < 14) mega_launch(a, PROBE_K + 1, 14, 2, stream);
#endif
}
```

```cpp
#include <hip/hip_runtime.h>
#include <stdint.h>

#define NTOK 32768
#define SEQ 8192
#define DM 1024
#define DPROJ 4096
#define NEXP 32
#define NASSIGN (NTOK * 4)
#define EPSV 1e-5f

typedef unsigned short bf16_t;

__device__ __forceinline__ float bf2f(bf16_t h) { return __uint_as_float(((uint32_t)h) << 16); }
__device__ __forceinline__ bf16_t f2bf(float f) {
    uint32_t u = __float_as_uint(f);
    u += 0x7FFFu + ((u >> 16) & 1u);
    return (bf16_t)(u >> 16);
}
__device__ __forceinline__ float sigmoidf_(float x) { return __builtin_amdgcn_rcpf(1.0f + __expf(-x)); }
__device__ __forceinline__ float siluf_(float x) { return x * sigmoidf_(x); }
__device__ __forceinline__ float logsigmoidf_(float x) { return fminf(x, 0.0f) - log1pf(__expf(-fabsf(x))); }

template <int CTRL> __device__ __forceinline__ float dpp_mov_f(float v) { return __builtin_bit_cast(float, __builtin_amdgcn_update_dpp(0, __builtin_bit_cast(int, v), CTRL, 0xf, 0xf, false)); }
__device__ __forceinline__ float wave_sum(float v) {
    v += dpp_mov_f<0xB1>(v); v += dpp_mov_f<0x4E>(v); v += dpp_mov_f<0x124>(v); v += dpp_mov_f<0x128>(v);
    v += __builtin_bit_cast(float, __builtin_amdgcn_ds_swizzle(__builtin_bit_cast(int, v), 0x401F));
    const auto rr = __builtin_amdgcn_permlane32_swap(__float_as_uint(v), __float_as_uint(v), false, false);
    return __uint_as_float(rr[0]) + __uint_as_float(rr[1]);
}
__device__ __forceinline__ float block_sum256(float v, float* red) {
    v = wave_sum(v);
    __syncthreads();
    if ((threadIdx.x & 63) == 0) red[threadIdx.x >> 6] = v;
    __syncthreads();
    return red[0] + red[1] + red[2] + red[3];
}

template <int NB, class AF, class BF>
__device__ __forceinline__ void tile_gemm(float (&acc)[NB][4][4], int K, AF af, BF bf, float* As, float* Bs) {
    const int tid = threadIdx.x;
    const int ty = tid >> 4, tx = tid & 15;
    for (int k0 = 0; k0 < K; k0 += 16) {
#pragma unroll
        for (int i = 0; i < 4; i++) {
            int idx = tid + i * 256;
            int r = idx >> 4, kk = idx & 15;
            As[kk * 68 + r] = af(r, k0 + kk);
        }
#pragma unroll
        for (int b = 0; b < NB; b++) {
#pragma unroll
            for (int i = 0; i < 4; i++) {
                int idx = tid + i * 256;
                int kk = idx >> 6, c = idx & 63;
                Bs[(b * 16 + kk) * 64 + c] = bf(b, k0 + kk, c);
            }
        }
        __syncthreads();
#pragma unroll
        for (int kk = 0; kk < 16; kk++) {
            float a[4];
#pragma unroll
            for (int i = 0; i < 4; i++) a[i] = As[kk * 68 + ty * 4 + i];
#pragma unroll
            for (int b = 0; b < NB; b++) {
                float bb[4];
#pragma unroll
                for (int j = 0; j < 4; j++) bb[j] = Bs[(b * 16 + kk) * 64 + tx * 4 + j];
#pragma unroll
                for (int i = 0; i < 4; i++)
#pragma unroll
                    for (int j = 0; j < 4; j++) acc[b][i][j] += a[i] * bb[j];
            }
        }
        __syncthreads();
    }
}

struct PreOut { float xc[4], q[4], k[4], v[4]; };
__device__ __forceinline__ PreOut mlstm_pre(const bf16_t* __restrict__ proj, int t, int n, const float* __restrict__ cw,
                                            const float* __restrict__ cb, const float* __restrict__ wq,
                                            const float* __restrict__ wk, const float* __restrict__ wv) {
    PreOut o;
    const int s = t & (SEQ - 1);
    float xm[4][4];
#pragma unroll
    for (int kk = 0; kk < 4; kk++) {
        const int sp = s - 3 + kk;
        if (sp >= 0) {
            const uint2 raw = *(const uint2*)(proj + (size_t)(t - 3 + kk) * DM + 4 * n);
            xm[kk][0] = bf2f((bf16_t)(raw.x & 0xFFFF)); xm[kk][1] = bf2f((bf16_t)(raw.x >> 16));
            xm[kk][2] = bf2f((bf16_t)(raw.y & 0xFFFF)); xm[kk][3] = bf2f((bf16_t)(raw.y >> 16));
        } else {
            xm[kk][0] = xm[kk][1] = xm[kk][2] = xm[kk][3] = 0.f;
        }
    }
#pragma unroll
    for (int c = 0; c < 4; c++) {
        float a = cb[4 * n + c];
#pragma unroll
        for (int kk = 0; kk < 4; kk++) a += cw[kk * DM + 4 * n + c] * xm[kk][c];
        o.xc[c] = siluf_(a);
    }
#pragma unroll
    for (int oo = 0; oo < 4; oo++) {
        float aq = 0.f, ak = 0.f, av = 0.f;
#pragma unroll
        for (int i = 0; i < 4; i++) {
            aq += o.xc[i] * wq[n * 16 + i * 4 + oo];
            ak += o.xc[i] * wk[n * 16 + i * 4 + oo];
            av += xm[3][i] * wv[n * 16 + i * 4 + oo];
        }
        o.q[oo] = aq; o.k[oo] = ak; o.v[oo] = av;
    }
    return o;
}

__global__ __launch_bounds__(256) void k_gates(const bf16_t* __restrict__ proj, const float* __restrict__ cw,
                                               const float* __restrict__ cb, const float* __restrict__ wq,
                                               const float* __restrict__ wk, const float* __restrict__ wv,
                                               const float* __restrict__ wig, const float* __restrict__ big,
                                               const float* __restrict__ wfg, const float* __restrict__ bfg,
                                               float* __restrict__ logi, float* __restrict__ logf) {
    __shared__ float red[4];
    const int t = blockIdx.x, n = threadIdx.x;
    PreOut p = mlstm_pre(proj, t, n, cw, cb, wq, wk, wv);
    float pi[4], pf[4];
#pragma unroll
    for (int h = 0; h < 4; h++) {
        float ai = 0.f, af = 0.f;
#pragma unroll
        for (int o = 0; o < 4; o++) {
            const int c = 4 * n + o;
            ai += p.q[o] * wig[(size_t)c * 4 + h] + p.k[o] * wig[(size_t)(1024 + c) * 4 + h] + p.v[o] * wig[(size_t)(2048 + c) * 4 + h];
            af += p.q[o] * wfg[(size_t)c * 4 + h] + p.k[o] * wfg[(size_t)(1024 + c) * 4 + h] + p.v[o] * wfg[(size_t)(2048 + c) * 4 + h];
        }
        pi[h] = ai; pf[h] = af;
    }
#pragma unroll
    for (int h = 0; h < 4; h++) {
        float si = block_sum256(pi[h], red);
        float sf = block_sum256(pf[h], red);
        if (threadIdx.x == 0) {
            logi[(size_t)t * 4 + h] = si + big[h];
            logf[(size_t)t * 4 + h] = logsigmoidf_(sf + bfg[h]);
        }
    }
}

#define MS_QK_STRIDE 258
#define MLSTM_LDS (2 * 64 * MS_QK_STRIDE * 2 + 64 * 32 * 4 + 64 * 65 * 4 + 256 * 32 * 4 + 256 * 4 + 8 * 64 * 4)
__global__ __launch_bounds__(256) void k_mlstm(const bf16_t* __restrict__ proj, const float* __restrict__ logi,
                                               const float* __restrict__ logf, const float* __restrict__ cw,
                                               const float* __restrict__ cb, const float* __restrict__ wq,
                                               const float* __restrict__ wk, const float* __restrict__ wv,
                                               bf16_t* __restrict__ hm) {
    extern __shared__ __attribute__((aligned(16))) unsigned char smem[];
    bf16_t* qs = (bf16_t*)smem;
    bf16_t* ks = qs + 64 * MS_QK_STRIDE;
    float* vs = (float*)(ks + 64 * MS_QK_STRIDE);
    float* Ss = vs + 64 * 32;
    float* Cs = Ss + 64 * 65;
    float* nvec = Cs + 256 * 32;
    float* bcum = nvec + 256;
    float* li = bcum + 64;
    float* lf = li + 64;
    float* mrow = lf + 64;
    float* winter = mrow + 64;
    float* wst = winter + 64;
    float* den = wst + 64;

    const int tid = threadIdx.x;
    const int bh = blockIdx.x >> 3, sl = blockIdx.x & 7;
    const int b = bh >> 2, h = bh & 3;
    for (int i = tid; i < 256 * 32; i += 256) Cs[i] = 0.f;
    nvec[tid] = 0.f;
    float m_prev = 0.f;
    __syncthreads();

    for (int c = 0; c < SEQ / 64; c++) {
        const int t0 = b * SEQ + c * 64;
        for (int it = 0; it < 16; it++) {
            const int idx = tid + it * 256;
            const int r = idx >> 6, n = idx & 63;
            PreOut p = mlstm_pre(proj, t0 + r, h * 64 + n, cw, cb, wq, wk, wv);
#pragma unroll
            for (int o = 0; o < 4; o++) {
                qs[r * MS_QK_STRIDE + 4 * n + o] = f2bf(p.q[o] * 0.0625f);
                ks[r * MS_QK_STRIDE + 4 * n + o] = f2bf(p.k[o]);
            }
            if ((n >> 3) == sl) {
#pragma unroll
                for (int o = 0; o < 4; o++) vs[r * 32 + (4 * n + o - 32 * sl)] = p.v[o];
            }
        }
        if (tid < 64) {
            li[tid] = logi[(size_t)(t0 + tid) * 4 + h];
            lf[tid] = logf[(size_t)(t0 + tid) * 4 + h];
        }
        __syncthreads();
        if (tid == 0) {
            float a = 0.f;
            for (int j = 0; j < 64; j++) { a += lf[j]; bcum[j] = a; }
        }
        __syncthreads();
        {
            const int j = tid & 63, ig = tid >> 6;
            for (int ii = 0; ii < 16; ii++) {
                const int i = ig * 16 + ii;
                const uint32_t* qp = (const uint32_t*)(qs + i * MS_QK_STRIDE);
                const uint32_t* kp = (const uint32_t*)(ks + j * MS_QK_STRIDE);
                float a = 0.f;
                for (int d2 = 0; d2 < 128; d2++) {
                    const uint32_t qq = qp[d2], kk = kp[d2];
                    a += __uint_as_float(qq << 16) * __uint_as_float(kk << 16);
                    a += __uint_as_float(qq & 0xFFFF0000u) * __uint_as_float(kk & 0xFFFF0000u);
                }
                Ss[i * 65 + j] = (j <= i) ? a : 0.f;
            }
        }
        if (tid < 64) {
            const int i = tid;
            float mx = bcum[i] + m_prev;
            for (int j = 0; j <= i; j++) mx = fmaxf(mx, bcum[i] - bcum[j] + li[j]);
            mrow[i] = mx;
            winter[i] = __expf(bcum[i] + m_prev - mx);
        }
        __syncthreads();
        {
            const int j = tid & 63, ig = tid >> 6;
            for (int ii = 0; ii < 16; ii++) {
                const int i = ig * 16 + ii;
                if (j <= i) Ss[i * 65 + j] *= __expf(bcum[i] - bcum[j] + li[j] - mrow[i]);
            }
        }
        __syncthreads();
        if (tid < 64) {
            const int i = tid;
            float a = 0.f;
            for (int d = 0; d < 256; d++) a += bf2f(qs[i * MS_QK_STRIDE + d]) * nvec[d];
            float s = 0.f;
            for (int j = 0; j < 64; j++) s += Ss[i * 65 + j];
            den[i] = winter[i] * a + s;
        }
        __syncthreads();
        {
            const int e = tid & 31, ig = tid >> 5;
            for (int ii = 0; ii < 8; ii++) {
                const int i = ig * 8 + ii;
                float a1 = 0.f;
                for (int d = 0; d < 256; d++) a1 += bf2f(qs[i * MS_QK_STRIDE + d]) * Cs[d * 32 + e];
                float a2 = 0.f;
                for (int j = 0; j < 64; j++) a2 += Ss[i * 65 + j] * vs[j * 32 + e];
                const float num = winter[i] * a1 + a2;
                const float hv = num / fmaxf(fabsf(den[i]), __expf(-mrow[i]));
                hm[(size_t)(t0 + i) * DM + h * 256 + sl * 32 + e] = f2bf(hv);
            }
        }
        const float g = bcum[63];
        float m_new = g + m_prev;
        for (int j = 0; j < 64; j++) m_new = fmaxf(m_new, g - bcum[j] + li[j]);
        const float decay = __expf(g + m_prev - m_new);
        __syncthreads();
        if (tid < 64) wst[tid] = __expf(g - bcum[tid] + li[tid] - m_new);
        __syncthreads();
        {
            const int e = tid & 31, dg = tid >> 5;
            for (int dd = 0; dd < 32; dd++) {
                const int d = dg * 32 + dd;
                float a = 0.f;
                for (int j = 0; j < 64; j++) a += wst[j] * bf2f(ks[j * MS_QK_STRIDE + d]) * vs[j * 32 + e];
                Cs[d * 32 + e] = decay * Cs[d * 32 + e] + a;
            }
            const int d = tid;
            float a = 0.f;
            for (int j = 0; j < 64; j++) a += wst[j] * bf2f(ks[j * MS_QK_STRIDE + d]);
            nvec[d] = decay * nvec[d] + a;
        }
        m_prev = m_new;
        __syncthreads();
    }
}

__global__ __launch_bounds__(256) void k_conv31(const bf16_t* __restrict__ proj, const float* __restrict__ cw,
                                                const float* __restrict__ cb, const float* __restrict__ nw,
                                                const float* __restrict__ nb, bf16_t* __restrict__ ymix) {
    __shared__ float red[4];
    const int t = blockIdx.x, n = threadIdx.x;
    const int s = t & (SEQ - 1);
    float acc[4];
#pragma unroll
    for (int c = 0; c < 4; c++) acc[c] = cb[4 * n + c];
    for (int k = 0; k < 31; k++) {
        const int sp = s - 30 + k;
        if (sp >= 0) {
            const uint2 ra = *(const uint2*)(proj + (size_t)(t - 30 + k) * DM + 4 * n);
            float ga[4];
            ga[0] = bf2f((bf16_t)(ra.x & 0xFFFF)); ga[1] = bf2f((bf16_t)(ra.x >> 16));
            ga[2] = bf2f((bf16_t)(ra.y & 0xFFFF)); ga[3] = bf2f((bf16_t)(ra.y >> 16));
#pragma unroll
            for (int c = 0; c < 4; c++) acc[c] += cw[k * DM + 4 * n + c] * ga[c];
        }
    }
    const float mean = block_sum256(acc[0] + acc[1] + acc[2] + acc[3], red) * (1.0f / DM);
    float vs = 0.f;
#pragma unroll
    for (int c = 0; c < 4; c++) { const float d = acc[c] - mean; vs += d * d; }
    const float var = block_sum256(vs, red) * (1.0f / DM);
    const float rs = rsqrtf(var + EPSV);
#pragma unroll
    for (int c = 0; c < 4; c++) {
        const float y = (acc[c] - mean) * rs * nw[4 * n + c] + nb[4 * n + c];
        ymix[(size_t)t * 2048 + 1024 + 4 * n + c] = f2bf(siluf_(y));
    }
}

__global__ __launch_bounds__(256) void k_ym(const bf16_t* __restrict__ proj, const bf16_t* __restrict__ szb, const bf16_t* __restrict__ hm,
                                            const float* __restrict__ cw, const float* __restrict__ cb,
                                            const float* __restrict__ wq, const float* __restrict__ wk,
                                            const float* __restrict__ wv, const float* __restrict__ mnw,
                                            const float* __restrict__ skip, bf16_t* __restrict__ ymix) {
    const int t = blockIdx.x, n = threadIdx.x;
    PreOut p = mlstm_pre(proj, t, n, cw, cb, wq, wk, wv);
    float hv[4];
#pragma unroll
    for (int c = 0; c < 4; c++) hv[c] = bf2f(hm[(size_t)t * DM + 4 * n + c]);
    const float mean = wave_sum(hv[0] + hv[1] + hv[2] + hv[3]) * (1.0f / 256.0f);
    float vs = 0.f;
#pragma unroll
    for (int c = 0; c < 4; c++) { const float d = hv[c] - mean; vs += d * d; }
    const float var = wave_sum(vs) * (1.0f / 256.0f);
    const float rs = rsqrtf(var + EPSV);
#pragma unroll
    for (int c = 0; c < 4; c++) {
        const int ch = 4 * n + c;
        const float hn = (hv[c] - mean) * rs * mnw[ch];
        const float z = bf2f(szb[(size_t)t * DM + ch]);
        const float y = (hn + skip[ch] * p.xc[c]) * z;
        ymix[(size_t)t * 2048 + ch] = f2bf(y);
    }
}

__global__ __launch_bounds__(256) void k_outproj(const bf16_t* __restrict__ ymix, const float* __restrict__ w_out,
                                                 const float* __restrict__ x, float* __restrict__ hout) {
    __shared__ float As[16 * 68];
    __shared__ float Bs[16 * 64];
    const int col0 = blockIdx.x * 64, row0 = blockIdx.y * 64;
    float acc[1][4][4];
#pragma unroll
    for (int i = 0; i < 4; i++)
#pragma unroll
        for (int j = 0; j < 4; j++) acc[0][i][j] = 0.f;
    auto af = [&](int r, int k) -> float { return bf2f(ymix[(size_t)(row0 + r) * 2048 + k]); };
    auto bf = [&](int b, int k, int c) -> float { return w_out[(size_t)k * DM + col0 + c]; };
    tile_gemm<1>(acc, 2048, af, bf, As, Bs);
    const int ty = threadIdx.x >> 4, tx = threadIdx.x & 15;
#pragma unroll
    for (int i = 0; i < 4; i++)
#pragma unroll
        for (int j = 0; j < 4; j++) {
            const size_t o = (size_t)(row0 + ty * 4 + i) * DM + col0 + tx * 4 + j;
            hout[o] = x[o] + acc[0][i][j];
        }
}

__global__ __launch_bounds__(256) void k_router(const float* __restrict__ hbuf, const float* __restrict__ nfw,
                                                const float* __restrict__ wr, const float* __restrict__ br,
                                                bf16_t* __restrict__ a2, int* __restrict__ topi, float* __restrict__ topg) {
    __shared__ float av[DM];
    __shared__ float part[8][32];
    __shared__ float lg[32];
    __shared__ float red[4];
    const int t = blockIdx.x, tid = threadIdx.x;
    const float4 v = *(const float4*)(hbuf + (size_t)t * DM + tid * 4);
    const float ss = block_sum256(v.x * v.x + v.y * v.y + v.z * v.z + v.w * v.w, red);
    const float rs = rsqrtf(ss * (1.0f / DM) + EPSV);
    const float vv[4] = {v.x, v.y, v.z, v.w};
#pragma unroll
    for (int c = 0; c < 4; c++) {
        const float a = vv[c] * rs * nfw[tid * 4 + c];
        av[tid * 4 + c] = a;
        a2[(size_t)t * DM + tid * 4 + c] = f2bf(a);
    }
    __syncthreads();
    {
        const int e = tid & 31, pp = tid >> 5;
        float a = 0.f;
        for (int k = pp * 128; k < pp * 128 + 128; k++) a += av[k] * wr[(size_t)k * 32 + e];
        part[pp][e] = a;
    }
    __syncthreads();
    if (tid < 32) {
        float a = br[tid];
#pragma unroll
        for (int pp = 0; pp < 8; pp++) a += part[pp][tid];
        lg[tid] = a;
    }
    __syncthreads();
    if (tid == 0) {
        int sel[4]; float val[4];
        unsigned used = 0u;
#pragma unroll
        for (int r = 0; r < 4; r++) {
            int bi = -1; float bv = 0.f;
            for (int e = 0; e < 32; e++) {
                if (used & (1u << e)) continue;
                const float x = lg[e];
                if (bi < 0 || x > bv) { bi = e; bv = x; }
            }
            used |= 1u << bi;
            sel[r] = bi; val[r] = bv;
        }
        float ex[4], sum = 0.f;
#pragma unroll
        for (int r = 0; r < 4; r++) { ex[r] = __expf(val[r] - val[0]); sum += ex[r]; }
#pragma unroll
        for (int r = 0; r < 4; r++) {
            topi[(size_t)t * 4 + r] = sel[r];
            topg[(size_t)t * 4 + r] = ex[r] / sum;
        }
    }
}

__global__ __launch_bounds__(1024) void k_sort(const int* __restrict__ topi, const float* __restrict__ topg,
                                               int* __restrict__ estart, int* __restrict__ slot_tok,
                                               float* __restrict__ slot_gate) {
    extern __shared__ __attribute__((aligned(16))) unsigned char smem[];
    int* cnt = (int*)smem;
    __shared__ int es[33];
    __shared__ int tot[32];
    const int tid = threadIdx.x;
    for (int e = 0; e < 32; e++) cnt[tid * 32 + e] = 0;
    const int a0 = tid * 128;
    for (int a = a0; a < a0 + 128; a++) cnt[tid * 32 + topi[a]]++;
    __syncthreads();
    if (tid < 32) {
        int run = 0;
        for (int i = 0; i < 1024; i++) { const int c = cnt[i * 32 + tid]; cnt[i * 32 + tid] = run; run += c; }
        tot[tid] = run;
    }
    __syncthreads();
    if (tid == 0) {
        int run = 0;
        for (int e = 0; e < 32; e++) { es[e] = run; estart[e] = run; run += tot[e]; }
        es[32] = run; estart[32] = run;
    }
    __syncthreads();
    for (int a = a0; a < a0 + 128; a++) {
        const int e = topi[a];
        const int slot = es[e] + cnt[tid * 32 + e];
        cnt[tid * 32 + e]++;
        slot_tok[slot] = a >> 2;
        slot_gate[slot] = topg[a];
    }
}

__device__ __forceinline__ bool moe_tile(const int* __restrict__ estart, int rt, int& e_out, int& slot0, int& nrows) {
    for (int e = 0; e < NEXP; e++) {
        const int s0 = estart[e], s1 = estart[e + 1];
        const int nt = (s1 - s0 + 63) >> 6;
        if (rt < nt) {
            e_out = e; slot0 = s0 + rt * 64; nrows = min(64, s1 - slot0);
            return true;
        }
        rt -= nt;
    }
    return false;
}

__global__ __launch_bounds__(256) void k_moe1(const bf16_t* __restrict__ a2, const int* __restrict__ estart,
                                              const int* __restrict__ slot_tok, const float* __restrict__ w1,
                                              const float* __restrict__ b1, bf16_t* __restrict__ act) {
    __shared__ float As[16 * 68];
    __shared__ float Bs[2 * 16 * 64];
    __shared__ int toks[64];
    int e, slot0, nrows;
    if (!moe_tile(estart, blockIdx.y, e, slot0, nrows)) return;
    const int col0 = blockIdx.x * 64;
    if (threadIdx.x < 64) toks[threadIdx.x] = (threadIdx.x < nrows) ? slot_tok[slot0 + threadIdx.x] : -1;
    __syncthreads();
    float acc[2][4][4];
#pragma unroll
    for (int b = 0; b < 2; b++)
#pragma unroll
        for (int i = 0; i < 4; i++)
#pragma unroll
            for (int j = 0; j < 4; j++) acc[b][i][j] = 0.f;
    const float* w1e = w1 + (size_t)e * 1024 * 2048;
    auto af = [&](int r, int k) -> float { const int tk = toks[r]; return tk >= 0 ? bf2f(a2[(size_t)tk * DM + k]) : 0.f; };
    auto bf = [&](int b, int k, int c) -> float { return w1e[(size_t)k * 2048 + b * 1024 + col0 + c]; };
    tile_gemm<2>(acc, DM, af, bf, As, Bs);
    const int ty = threadIdx.x >> 4, tx = threadIdx.x & 15;
#pragma unroll
    for (int i = 0; i < 4; i++) {
        const int r = ty * 4 + i;
        if (r < nrows) {
#pragma unroll
            for (int j = 0; j < 4; j++) {
                const int col = col0 + tx * 4 + j;
                const float g = acc[0][i][j] + b1[(size_t)e * 2048 + col];
                const float l = acc[1][i][j] + b1[(size_t)e * 2048 + 1024 + col];
                const float xg = fminf(g, 7.0f);
                const float xl = fminf(fmaxf(l, -7.0f), 7.0f);
                act[(size_t)(slot0 + r) * DM + col] = f2bf(xg * sigmoidf_(1.702f * xg) * (xl + 1.0f));
            }
        }
    }
}

__global__ __launch_bounds__(256) void k_moe2(const bf16_t* __restrict__ act, const int* __restrict__ estart,
                                              const int* __restrict__ slot_tok, const float* __restrict__ slot_gate,
                                              const float* __restrict__ w2, const float* __restrict__ b2,
                                              float* __restrict__ hout) {
    __shared__ float As[16 * 68];
    __shared__ float Bs[16 * 64];
    int e, slot0, nrows;
    if (!moe_tile(estart, blockIdx.y, e, slot0, nrows)) return;
    const int col0 = blockIdx.x * 64;
    float acc[1][4][4];
#pragma unroll
    for (int i = 0; i < 4; i++)
#pragma unroll
        for (int j = 0; j < 4; j++) acc[0][i][j] = 0.f;
    const float* w2e = w2 + (size_t)e * 1024 * 1024;
    auto af = [&](int r, int k) -> float { return r < nrows ? bf2f(act[(size_t)(slot0 + r) * DM + k]) : 0.f; };
    auto bf = [&](int b, int k, int c) -> float { return w2e[(size_t)k * DM + col0 + c]; };
    tile_gemm<1>(acc, DM, af, bf, As, Bs);
    const int ty = threadIdx.x >> 4, tx = threadIdx.x & 15;
#pragma unroll
    for (int i = 0; i < 4; i++) {
        const int r = ty * 4 + i;
        if (r < nrows) {
            const int tk = slot_tok[slot0 + r];
            const float gt = slot_gate[slot0 + r];
#pragma unroll
            for (int j = 0; j < 4; j++) {
                const int col = col0 + tx * 4 + j;
                atomicAdd(&hout[(size_t)tk * DM + col], (acc[0][i][j] + b2[(size_t)e * DM + col]) * gt);
            }
        }
    }
}

__global__ __launch_bounds__(256) void k_final(float* __restrict__ hbuf, const float* __restrict__ fw) {
    const int row = blockIdx.x * 4 + (threadIdx.x >> 6);
    const int lane = threadIdx.x & 63;
    float4* p = (float4*)(hbuf + (size_t)row * DM);
    float4 v[4];
    float s = 0.f;
#pragma unroll
    for (int i = 0; i < 4; i++) { v[i] = p[lane + i * 64]; s += v[i].x * v[i].x + v[i].y * v[i].y + v[i].z * v[i].z + v[i].w * v[i].w; }
    s = wave_sum(s);
    const float rs = rsqrtf(s * (1.0f / DM) + EPSV);
#pragma unroll
    for (int i = 0; i < 4; i++) {
        const float4 w = *(const float4*)(fw + (lane + i * 64) * 4);
        float4 o; o.x = v[i].x * rs * w.x; o.y = v[i].y * rs * w.y; o.z = v[i].z * rs * w.z; o.w = v[i].w * rs * w.w;
        p[lane + i * 64] = o;
    }
}


#define LAS __attribute__((address_space(3)))
#define GAS __attribute__((address_space(1)))
typedef short bf16x8 __attribute__((ext_vector_type(8)));
typedef float f32x4 __attribute__((ext_vector_type(4)));
typedef float f32x2 __attribute__((ext_vector_type(2)));
typedef unsigned u32x4 __attribute__((ext_vector_type(4)));
typedef unsigned u32x2 __attribute__((ext_vector_type(2)));

__device__ __forceinline__ int lane_id() { int l = (int)__builtin_amdgcn_mbcnt_hi(~0u, __builtin_amdgcn_mbcnt_lo(~0u, 0u)); asm volatile("" : "+v"(l)); return l; }
namespace pg8 {
__device__ __forceinline__ const char* uni_ptr(const char* p) { const unsigned long long v = (unsigned long long)p; const unsigned lo = __builtin_amdgcn_readfirstlane((unsigned)v), hi = __builtin_amdgcn_readfirstlane((unsigned)(v >> 32)); return (const char*)(((unsigned long long)hi << 32) | lo); }
typedef int i32x4 __attribute__((ext_vector_type(4)));
typedef int i32x8 __attribute__((ext_vector_type(8)));
__device__ __forceinline__ void mfma8_tied(f32x4& acc, const i32x8 a, const i32x8 b, const int sa, const int sb) {
    asm volatile("v_mfma_scale_f32_16x16x128_f8f6f4 %0, %1, %2, %0, %3, %4 op_sel_hi:[0,0,0]" : "+v"(acc) : "v"(a), "v"(b), "v"(sa), "v"(sb));
}
__device__ __forceinline__ i32x8 cat8(const bf16x8 lo, const bf16x8 hi) { return __builtin_shufflevector(__builtin_bit_cast(i32x4, lo), __builtin_bit_cast(i32x4, hi), 0, 1, 2, 3, 4, 5, 6, 7); }
constexpr int BM = 256, BK = 64, HALF = 128, HTB = HALF * BK * 2, STAGE_BYTES = 8 * HTB, NXCD = 8, WGM = 8;
__host__ __device__ __forceinline__ int lds_byte(int r, int c) { const int st = (r >> 4) * 2 + (c >> 5), rr = r & 15, cc = c & 31, ob = rr * 64 + cc * 2; return st * 1024 + (ob ^ (((ob >> 9) & 1) << 5)); }
__host__ __device__ __forceinline__ void stage_rc(int b, int& R, int& C) { const int st = b / 1024, sb = b % 1024, swz = sb ^ (((sb >> 9) & 1) << 5); R = (st >> 1) * 16 + swz / 64; C = (st & 1) * 32 + (swz % 64) / 2; }
__host__ __device__ __forceinline__ int perm32(int rho) { const int n = rho >> 4, i = rho & 15; return 8 * (i >> 2) + 4 * n + (i & 3); }
__device__ __forceinline__ unsigned cvt_pk_bf16(float lo, float hi) { unsigned r; asm volatile("v_cvt_pk_bf16_f32 %0, %1, %2" : "=v"(r) : "v"(lo), "v"(hi)); return r; }

struct Unit { const char* A; const char* B; const int* gidx; int pm, pn, aux; };

template <class Epi, class Sched, bool GATHER, bool FP8 = false>
__device__ __forceinline__ void gemm_phase(LAS unsigned char* lds, const int wid, const int K, const int lda, const int ldb, const Sched& S, const Epi& E, const int scale_w = 0x7F7F7F7F, const int scale_a = 0x7F7F7F7F, const int stagger_ticks = 0) {
    const int lane = lane_id(), tid = (wid << 6) | lane, wr = wid >> 2, wc = wid & 3, fr = lane & 15, fq = lane >> 4;
    const int nt = K / BK;
    int Ra[2], Ca[2]; unsigned voffB[2];
#pragma unroll
    for (int i = 0; i < 2; ++i) { int R, C; stage_rc(tid * 16 + i * 8192, R, C); Ra[i] = R; Ca[i] = C; const int Rb = (R & ~31) + perm32(R & 31); voffB[i] = (unsigned)(Rb * ldb + C) * 2u; }
    const size_t kstep = (size_t)(BK * 2);
    const size_t hstepB = (size_t)HALF * ldb * 2;
    const unsigned ldsw = (unsigned)wid * 1024u;
    const unsigned ldsb = (unsigned)(size_t)lds;
    const int aoff = lds_byte(wr * 64 + fr, fq * 8), boff = lds_byte(wc * 32 + fr, fq * 8);
#define PG8_SA(b, h) (((b) * 2 + (h)) * HTB)
#define PG8_SB(b, h) ((4 + (b) * 2 + (h)) * HTB)
#define PG8_STAGE(bufoff, gbase, voff) do { const unsigned long long _ub = (unsigned long long)uni_ptr((const char*)(gbase)); _Pragma("unroll") for (int _i = 0; _i < 2; ++_i) { \
        unsigned _keep; const unsigned _ld = (unsigned)__builtin_amdgcn_readfirstlane((int)(ldsb + (unsigned)(bufoff) + ldsw + (unsigned)_i * 8192u)); \
        asm volatile("s_nop 4\n\ts_mov_b32 %0, m0\n\ts_mov_b32 m0, %3\n\ts_nop 0\n\tglobal_load_lds_dwordx4 %1, %2\n\ts_mov_b32 m0, %0" : "=&s"(_keep) : "v"((voff)[_i]), "s"(_ub), "s"(_ld) : "memory"); } } while (0)
#define PG8_LDA(dst, b, h) do { _Pragma("unroll") for (int m = 0; m < 4; ++m) _Pragma("unroll") for (int k = 0; k < 2; ++k) dst[m][k] = *(const LAS bf16x8*)(lds + PG8_SA(b, h) + aoff + m * 2048 + k * 1024); } while (0)
#define PG8_LDB(dst, b, h) do { _Pragma("unroll") for (int n = 0; n < 2; ++n) _Pragma("unroll") for (int k = 0; k < 2; ++k) dst[n][k] = *(const LAS bf16x8*)(lds + PG8_SB(b, h) + boff + n * 2048 + k * 1024); } while (0)
#define PG8_MMA(ai, bj, At, Bt) do { __builtin_amdgcn_s_setprio(1); _Pragma("unroll") for (int m = 0; m < 4; ++m) _Pragma("unroll") for (int n = 0; n < 2; ++n) { \
        if constexpr (FP8) { mfma8_tied(acc[ai][bj][m][n], cat8(Bt[n][0], Bt[n][1]), cat8(At[m][0], At[m][1]), scale_w, scale_a); } \
        else { _Pragma("unroll") for (int k = 0; k < 2; ++k) acc[ai][bj][m][n] = __builtin_amdgcn_mfma_f32_16x16x32_bf16(Bt[n][k], At[m][k], acc[ai][bj][m][n], 0, 0, 0); } } \
        __builtin_amdgcn_s_setprio(0); } while (0)
#define PG8_WAIT_V(n) asm volatile("s_waitcnt vmcnt(" #n ")" ::: "memory")
#define PG8_WAIT_L(n) asm volatile("s_waitcnt lgkmcnt(" #n ")" ::: "memory")
#define PG8_BAR __builtin_amdgcn_s_barrier()
#define PG8_SCHED __builtin_amdgcn_sched_barrier(0)
    if (stagger_ticks > 0 && ((blockIdx.x >> 3) & 1)) { const unsigned long long t0 = __builtin_amdgcn_s_memrealtime(); while (__builtin_amdgcn_s_memrealtime() - t0 < (unsigned long long)stagger_ticks) __builtin_amdgcn_s_sleep(8); }
    Unit cur, nxt; int ui = 0;
    if (!S.next(0, cur)) return;
    unsigned offA[2][2], offN[2][2];
#pragma unroll
    for (int h = 0; h < 2; ++h)
#pragma unroll
        for (int i = 0; i < 2; ++i) {
            const int rr = h * HALF + Ra[i];
            const int row = GATHER ? cur.gidx[rr] : rr;
            offA[h][i] = (unsigned)(row * lda + Ca[i]) * 2u; offN[h][i] = offA[h][i];
        }
    f32x4 acc[2][2][4][2];
#pragma unroll
    for (int a = 0; a < 2; ++a)
#pragma unroll
        for (int b = 0; b < 2; ++b)
#pragma unroll
            for (int m = 0; m < 4; ++m)
#pragma unroll
                for (int n = 0; n < 2; ++n) acc[a][b][m][n] = (f32x4){0.f, 0.f, 0.f, 0.f};
    bf16x8 At[4][2], B0[2][2], B1[2][2];
    const char* cA = cur.A; const char* cB = cur.B;
    PG8_STAGE(PG8_SB(0, 0), cB, voffB); PG8_STAGE(PG8_SB(0, 1), cB + hstepB, voffB); PG8_STAGE(PG8_SA(0, 0), cA, offA[0]); PG8_STAGE(PG8_SA(0, 1), cA, offA[1]);
    if (wr == 1) PG8_BAR;
    PG8_WAIT_V(2); PG8_BAR;
    PG8_STAGE(PG8_SB(1, 0), cB + kstep, voffB); PG8_STAGE(PG8_SA(1, 0), cA + kstep, offA[0]); PG8_STAGE(PG8_SB(1, 1), cB + hstepB + kstep, voffB);
    PG8_WAIT_V(6); PG8_BAR;
    for (;;) {
        const bool has_next = S.next(ui + 1, nxt);
        const char* nA = has_next ? nxt.A : cA; const char* nB = has_next ? nxt.B : cB;
        if constexpr (GATHER) {
            if (has_next) {
#pragma unroll
                for (int h = 0; h < 2; ++h)
#pragma unroll
                    for (int i = 0; i < 2; ++i) offN[h][i] = (unsigned)(nxt.gidx[h * HALF + Ra[i]] * lda + Ca[i]) * 2u;
            }
        }
#pragma unroll 1
        for (int t = 0; t < nt; t += 2) {
            const bool last = (t == nt - 2);
            const char* a1 = cA + (size_t)(t + 1) * kstep;
            const char* a2 = last ? nA : cA + (size_t)(t + 2) * kstep; const char* b2 = last ? nB : cB + (size_t)(t + 2) * kstep;
            const char* a3 = a2 + kstep; const char* b3 = b2 + kstep;
            unsigned o2[2][2];
#pragma unroll
            for (int h = 0; h < 2; ++h)
#pragma unroll
                for (int i = 0; i < 2; ++i) o2[h][i] = (GATHER && last) ? offN[h][i] : offA[h][i];
            PG8_LDB(B0, 0, 0); PG8_LDB(B1, 0, 1); PG8_SCHED; PG8_LDA(At, 0, 0); PG8_STAGE(PG8_SA(1, 1), a1, offA[1]);
            PG8_WAIT_V(8); PG8_WAIT_L(0); PG8_BAR; PG8_MMA(0, 0, At, B0); PG8_MMA(0, 1, At, B1); PG8_BAR; PG8_SCHED;
            PG8_LDA(At, 0, 1); PG8_STAGE(PG8_SB(0, 0), b2, voffB); PG8_STAGE(PG8_SB(0, 1), b2 + hstepB, voffB); PG8_STAGE(PG8_SA(0, 0), a2, o2[0]);
            PG8_WAIT_V(8); PG8_WAIT_L(0); PG8_BAR; PG8_MMA(1, 0, At, B0); PG8_MMA(1, 1, At, B1); PG8_BAR; PG8_SCHED;
            PG8_LDB(B0, 1, 0); PG8_LDB(B1, 1, 1); PG8_SCHED; PG8_LDA(At, 1, 0); PG8_STAGE(PG8_SA(0, 1), a2, o2[1]);
            PG8_WAIT_V(8); PG8_WAIT_L(0); PG8_BAR; PG8_MMA(0, 0, At, B0); PG8_MMA(0, 1, At, B1); PG8_BAR; PG8_SCHED;
            PG8_LDA(At, 1, 1); PG8_STAGE(PG8_SB(1, 0), b3, voffB); PG8_STAGE(PG8_SB(1, 1), b3 + hstepB, voffB); PG8_STAGE(PG8_SA(1, 0), a3, o2[0]);
            PG8_WAIT_V(8); PG8_WAIT_L(0); PG8_BAR; PG8_MMA(1, 0, At, B0); PG8_MMA(1, 1, At, B1); PG8_BAR; PG8_SCHED;
        }
        if (wr == 0) PG8_BAR;
        if constexpr (FP8) asm volatile("s_nop 15\n\ts_nop 15" ::: "memory");
        E(acc, cur, wr, wc, fr, fq);
        if (!has_next) break;
#pragma unroll
        for (int a = 0; a < 2; ++a)
#pragma unroll
            for (int b = 0; b < 2; ++b)
#pragma unroll
                for (int m = 0; m < 4; ++m)
#pragma unroll
                    for (int n = 0; n < 2; ++n) acc[a][b][m][n] = (f32x4){0.f, 0.f, 0.f, 0.f};
        cur = nxt; cA = nA; cB = nB; ++ui;
        if constexpr (GATHER) {
#pragma unroll
            for (int h = 0; h < 2; ++h)
#pragma unroll
                for (int i = 0; i < 2; ++i) offA[h][i] = offN[h][i];
        }
        if (wr == 1) PG8_BAR;
    }
    PG8_WAIT_V(0);
    PG8_BAR;
#undef PG8_SA
#undef PG8_SB
#undef PG8_STAGE
#undef PG8_LDA
#undef PG8_LDB
#undef PG8_MMA
#undef PG8_WAIT_V
#undef PG8_WAIT_L
#undef PG8_BAR
#undef PG8_SCHED
}

struct DenseOrder {
    const char* A; const char* Bt; size_t a_tile_bytes, b_tile_bytes; int nM, nN, nwg, G, c;
    __device__ void init(const void* A_, const void* Bt_, int M, int N, int lda, int ldb, int G_, int c_) {
        A = (const char*)A_; Bt = (const char*)Bt_; nM = M / BM; nN = N / BM; nwg = nM * nN; G = G_; c = c_;
        a_tile_bytes = (size_t)BM * lda * 2; b_tile_bytes = (size_t)BM * ldb * 2;
    }
    __device__ __forceinline__ bool next(int i, Unit& u) const {
        const long L = (long)i * G + c; if (L >= nwg) return false;
        int wgid = (int)L; { const int q = nwg / NXCD, r = nwg % NXCD, xcd = wgid % NXCD, off = wgid / NXCD; wgid = (xcd < r ? xcd * (q + 1) : r * (q + 1) + (xcd - r) * q) + off; }
        const int nig = WGM * nN, gid = wgid / nig, fm = gid * WGM, gsz = (nM - fm) < WGM ? (nM - fm) : WGM;
        u.pm = fm + ((wgid % nig) % gsz); u.pn = (wgid % nig) / gsz; u.aux = 0; u.gidx = nullptr;
        u.A = A + (size_t)u.pm * a_tile_bytes; u.B = Bt + (size_t)u.pn * b_tile_bytes; return true;
    }
};
}

#ifndef OUTPROJ_FP8
#define OUTPROJ_FP8 0
#endif
#define XB_TMO      128
#define XB_XCNT(j)  (256  + 64 * (j))
#define XB_XSUB(j)  (1280 + 64 * (j))
#define XB_XGEN(j)  (2304 + 64 * (j))
#define XB_TOP      3328
#define XB_TOPGEN   3392
#define XCD_BAR_WORDS 3456
#define XB_SPIN_CAP (1u << 18)

__device__ __forceinline__ unsigned xb_ld(unsigned* p)              { return __hip_atomic_load(p, __ATOMIC_RELAXED, __HIP_MEMORY_SCOPE_AGENT); }
__device__ __forceinline__ unsigned xb_add(unsigned* p, unsigned v) { return __hip_atomic_fetch_add(p, v, __ATOMIC_RELAXED, __HIP_MEMORY_SCOPE_AGENT); }
__device__ __forceinline__ unsigned xb_xcc_id() { return (unsigned)__builtin_amdgcn_s_getreg((3 << 11) | 20) & 0xFu; }
#define XB_SPIN(cond, bar) do { unsigned _sp = 0; while (cond) { __builtin_amdgcn_s_sleep(1); \
    if ((++_sp & 255u) == 0u) { if (xb_ld(&(bar)[XB_TMO])) break; if (_sp > XB_SPIN_CAP) { atomicAdd(&(bar)[XB_TMO], 1u); break; } } } } while (0)

struct XcdBarrier {
    unsigned* bar; unsigned x; int w;
    volatile LAS unsigned* st;
};
__device__ __forceinline__ XcdBarrier xcd_barrier_post(unsigned* bar, volatile LAS unsigned* st, int wave) {
    XcdBarrier b; b.bar = bar; b.x = xb_xcc_id(); b.st = st; b.w = wave;
    if (wave == 0 && lane_id() == 0) (void)xb_add(&bar[XB_XCNT(b.x)], 1u);
    return b;
}
__device__ __forceinline__ void xcd_barrier_complete(unsigned* bar, unsigned x, unsigned& nloc, unsigned& nx) {
    const unsigned G = gridDim.x * gridDim.y * gridDim.z;
    unsigned sum, cnt, mine, sp = 0u;
    for (;;) {
        sum = 0u; cnt = 0u; mine = 0u;
#pragma unroll
        for (unsigned j = 0; j < 16; ++j) { const unsigned c = xb_ld(&bar[XB_XCNT(j)]); sum += c; cnt += (c > 0u) ? 1u : 0u; mine = (j == x) ? c : mine; }
        if (sum == G) break;
        __builtin_amdgcn_s_sleep(1);
        if ((++sp & 255u) == 0u) { if (xb_ld(&bar[XB_TMO])) break; if (sp > XB_SPIN_CAP) { atomicAdd(&bar[XB_TMO], 1u); break; } }
    }
    nloc = mine > 0u ? mine : 1u; nx = cnt > 0u ? cnt : 1u;
}
__device__ __forceinline__ void xcd_barrier(const XcdBarrier& b) {
    asm volatile("s_waitcnt vmcnt(0)" ::: "memory");
    __syncthreads();
    if (b.w == 0 && lane_id() == 0) {
        unsigned* bar = b.bar;
        __builtin_amdgcn_s_waitcnt(0);
        unsigned nloc = b.st[0], nx = b.st[1];
        if (nloc == 0u) { xcd_barrier_complete(bar, b.x, nloc, nx); b.st[0] = nloc; b.st[1] = nx; }
        const unsigned old = xb_add(&bar[XB_XSUB(b.x)], 1u);
        const unsigned gen = old / nloc;
        if (old + 1u == (gen + 1u) * nloc) {
            __builtin_amdgcn_fence(__ATOMIC_RELEASE, "agent");
            asm volatile("s_waitcnt vmcnt(0)" ::: "memory");
            const unsigned og = xb_add(&bar[XB_TOP], 1u);
            const unsigned tg = og / nx;
            if (og + 1u == (tg + 1u) * nx) xb_add(&bar[XB_TOPGEN], 1u);
            else XB_SPIN(xb_ld(&bar[XB_TOPGEN]) == tg, bar);
            __builtin_amdgcn_fence(__ATOMIC_ACQUIRE, "agent");
            xb_add(&bar[XB_XGEN(b.x)], 1u);
            asm volatile("s_waitcnt vmcnt(0)" ::: "memory");
        } else {
            XB_SPIN(xb_ld(&bar[XB_XGEN(b.x)]) == gen, bar);
            __builtin_amdgcn_fence(__ATOMIC_ACQUIRE, "agent");
            asm volatile("s_waitcnt vmcnt(0)" ::: "memory");
        }
    }
    __syncthreads();
}

constexpr size_t MiB = 1u << 20;
constexpr size_t WS_CTL = 0, CTL_ZERO_BYTES = 1 * MiB;
constexpr size_t WS_SMALL = 1 * MiB;
constexpr size_t WS_RSTD1 = WS_SMALL;
constexpr size_t WS_LOGI = WS_SMALL + 1 * MiB;
constexpr size_t WS_LOGF = WS_SMALL + 2 * MiB;
constexpr size_t WS_TOPI = WS_SMALL + 3 * MiB;
constexpr size_t WS_TOPG = WS_SMALL + 4 * MiB;
constexpr size_t WS_STOK = WS_SMALL + 5 * MiB;
constexpr size_t WS_SGATE = WS_SMALL + 6 * MiB;
constexpr size_t WS_ESTART = WS_SMALL + 7 * MiB;
constexpr size_t WS_BTIN = 17 * MiB;
constexpr size_t WS_BTOUT = 25 * MiB;
constexpr size_t WS_BT1 = 29 * MiB;
constexpr size_t WS_BT2 = 157 * MiB;
constexpr size_t WS_R1 = 221 * MiB;
constexpr size_t WS_XM = 285 * MiB;
constexpr size_t WS_SZ = 349 * MiB;
constexpr size_t WS_U = 413 * MiB;
constexpr size_t WS_Q = 477 * MiB;
constexpr size_t WS_YMIX = 477 * MiB;
constexpr size_t WS_ACT = 285 * MiB;
constexpr size_t WS_NEED = 925 * MiB;

constexpr int NWAVES = 8;
constexpr int RING_BYTES = 131072;
constexpr int LDSCTL_OFF = RING_BYTES;
constexpr int LDS_BYTES = 147456;
constexpr int CW_BAR = 4096;

struct MegaArgs {
    const float* in[27];
    float* out;
    unsigned char* ws;
    int ph_lo, ph_hi, li, pad;
};

__device__ __forceinline__ unsigned pk2(float lo, float hi) { return pg8::cvt_pk_bf16(lo, hi); }

__device__ __forceinline__ void unpack8(const u32x4 r, float (&f)[8]) {
    f[0] = __uint_as_float(r.x << 16); f[1] = __uint_as_float(r.x & 0xFFFF0000u); f[2] = __uint_as_float(r.y << 16); f[3] = __uint_as_float(r.y & 0xFFFF0000u);
    f[4] = __uint_as_float(r.z << 16); f[5] = __uint_as_float(r.z & 0xFFFF0000u); f[6] = __uint_as_float(r.w << 16); f[7] = __uint_as_float(r.w & 0xFFFF0000u);
}

__device__ __forceinline__ f32x4 up4(const u32x2 r) { f32x4 v; v.x = __uint_as_float(r.x << 16); v.y = __uint_as_float(r.x & 0xFFFF0000u); v.z = __uint_as_float(r.y << 16); v.w = __uint_as_float(r.y & 0xFFFF0000u); return v; }

__device__ __forceinline__ void p0_transpose_item(const float* W, int K, int N, bf16_t* WT, const float* ksc, int k0, int n0s, int n0d, LAS float* scr, int lane) {
    const int kr = lane >> 4, nq = lane & 15;
    f32x4 v[16];
#pragma unroll
    for (int i = 0; i < 16; ++i) v[i] = *(const f32x4*)(W + (size_t)(k0 + 4 * i + kr) * N + n0s + 4 * nq);
    if (ksc) {
#pragma unroll
        for (int i = 0; i < 16; ++i) v[i] = v[i] * ksc[k0 + 4 * i + kr];
    }
    const int c = lane >> 4, nl = lane & 15;
#pragma unroll
    for (int half = 0; half < 2; ++half) {
#pragma unroll
        for (int ii = 0; ii < 8; ++ii) *(LAS f32x4*)(scr + (4 * ii + kr) * 68 + 4 * nq) = v[8 * half + ii];
        asm volatile("s_waitcnt lgkmcnt(0)" ::: "memory");
#pragma unroll
        for (int j = 0; j < 4; ++j) { const int n = nl + 16 * j; const LAS float* sp = scr + (8 * c) * 68 + n;
            u32x4 o; o.x = pk2(sp[0 * 68], sp[1 * 68]); o.y = pk2(sp[2 * 68], sp[3 * 68]); o.z = pk2(sp[4 * 68], sp[5 * 68]); o.w = pk2(sp[6 * 68], sp[7 * 68]);
            *(u32x4*)(WT + (size_t)(n0d + n) * K + k0 + 32 * half + 8 * c) = o; }
        asm volatile("s_waitcnt lgkmcnt(0)" ::: "memory");
    }
}
__device__ __forceinline__ unsigned pk4_fp8(float a, float b, float c, float d) { int w = __builtin_amdgcn_cvt_pk_fp8_f32(a, b, 0, false); w = __builtin_amdgcn_cvt_pk_fp8_f32(c, d, w, true); return (unsigned)w; }
__device__ __forceinline__ void p0_transpose_item8(const float* W, int K, int N, unsigned char* WT, const float* ksc, float mul, int k0, int n0s, int n0d, LAS float* scr, int lane) {
    const int kr = lane >> 4, nq = lane & 15;
    f32x4 v[16];
#pragma unroll
    for (int i = 0; i < 16; ++i) v[i] = *(const f32x4*)(W + (size_t)(k0 + 4 * i + kr) * N + n0s + 4 * nq);
#pragma unroll
    for (int i = 0; i < 16; ++i) v[i] = v[i] * (ksc ? ksc[k0 + 4 * i + kr] * mul : mul);
    const int c = lane >> 4, nl = lane & 15;
#pragma unroll
    for (int half = 0; half < 2; ++half) {
#pragma unroll
        for (int ii = 0; ii < 8; ++ii) *(LAS f32x4*)(scr + (4 * ii + kr) * 68 + 4 * nq) = v[8 * half + ii];
        asm volatile("s_waitcnt lgkmcnt(0)" ::: "memory");
#pragma unroll
        for (int j = 0; j < 4; ++j) { const int n = nl + 16 * j; const LAS float* sp = scr + (8 * c) * 68 + n;
            u32x2 o; o.x = pk4_fp8(sp[0 * 68], sp[1 * 68], sp[2 * 68], sp[3 * 68]); o.y = pk4_fp8(sp[4 * 68], sp[5 * 68], sp[6 * 68], sp[7 * 68]);
            *(u32x2*)(WT + (size_t)(n0d + n) * K + k0 + 32 * half + 8 * c) = o; }
        asm volatile("s_waitcnt lgkmcnt(0)" ::: "memory");
    }
}
__device__ __forceinline__ int inproj_src_col(int nd) { if (nd < 2048) return nd; const int pn = (nd >> 8) - 8, lc = nd & 255; return 2048 + (lc >> 7) * 1024 + 128 * pn + (lc & 127); }
__device__ __forceinline__ int w1_src_col(int nd) { const int pn = nd >> 8, lc = nd & 255; return (lc >> 7) * 1024 + 128 * pn + (lc & 127); }

__device__ __forceinline__ void p0_prologue(const MegaArgs& a, LAS unsigned char* lds, int gw, int NGW, int wave, int lane) {
    LAS float* scr = (LAS float*)(lds + wave * 16384);
    unsigned char* ws = a.ws;
    const float* x = a.in[0];
    {
        bf16_t* xbf = (bf16_t*)(ws + WS_R1); float* rstd1 = (float*)(ws + WS_RSTD1);
        for (int m = gw; m < NTOK; m += NGW) {
            const f32x4* xr = (const f32x4*)(x + (size_t)m * DM) + lane;
            f32x4 v[4]; float s = 0.f;
#pragma unroll
            for (int j = 0; j < 4; ++j) { v[j] = xr[64 * j]; s += (v[j].x * v[j].x + v[j].y * v[j].y) + (v[j].z * v[j].z + v[j].w * v[j].w); }
            s = wave_sum(s);
            if (lane == 0) rstd1[m] = rsqrtf(s * (1.0f / DM) + EPSV);
            unsigned long long* o8 = (unsigned long long*)(xbf + (size_t)m * DM) + lane;
#pragma unroll
            for (int j = 0; j < 4; ++j) o8[64 * j] = (unsigned long long)pk2(v[j].x, v[j].y) | ((unsigned long long)pk2(v[j].z, v[j].w) << 32);
        }
    }
    constexpr int I_IN = (1024 / 64) * (4096 / 64);
    for (int it = gw; it < I_IN; it += NGW) { const int kb = it / 64, nb = it % 64; p0_transpose_item(a.in[2], 1024, 4096, (bf16_t*)(ws + WS_BTIN), a.in[1], 64 * kb, inproj_src_col(64 * nb), 64 * nb, scr, lane); }
}
__device__ __forceinline__ void p0b_weights(const MegaArgs& a, LAS unsigned char* lds, int gw, int NGW, int wave, int lane) {
    LAS float* scr = (LAS float*)(lds + wave * 16384);
    unsigned char* ws = a.ws;
    constexpr int I_OUT = (2048 / 64) * (1024 / 64);
    constexpr int I_W1 = 32 * (1024 / 64) * (2048 / 64);
    constexpr int I_W2 = 32 * (1024 / 64) * (1024 / 64);
    constexpr int NITEMS = I_OUT + I_W1 + I_W2;
    for (int it = gw; it < NITEMS; it += NGW) {
        int r = it;
        if (r < I_OUT) { const int kb = r / 16, nb = r % 16;
#if OUTPROJ_FP8
            p0_transpose_item8(a.in[18], 2048, 1024, ws + WS_BTOUT, nullptr, 32.0f, 64 * kb, 64 * nb, 64 * nb, scr, lane);
#else
            p0_transpose_item(a.in[18], 2048, 1024, (bf16_t*)(ws + WS_BTOUT), nullptr, 64 * kb, 64 * nb, 64 * nb, scr, lane);
#endif
            continue; }
        r -= I_OUT;
        if (r < I_W1) { const int e = r / 512, rr = r % 512, kb = rr / 32, nb = rr % 32;
            p0_transpose_item8(a.in[22] + (size_t)e * 1024 * 2048, 1024, 2048, ws + WS_BT1 + (size_t)e * 2048 * 1024, a.in[19], 32.0f, 64 * kb, w1_src_col(64 * nb), 64 * nb, scr, lane); continue; }
        r -= I_W1;
        { const int e = r / 256, rr = r % 256, kb = rr / 16, nb = rr % 16;
            p0_transpose_item8(a.in[24] + (size_t)e * 1024 * 1024, 1024, 1024, ws + WS_BT2 + (size_t)e * 1024 * 1024, nullptr, 32.0f, 64 * kb, 64 * nb, 64 * nb, scr, lane); }
    }
}

struct EpiInProj {
    const float* rstd; bf16_t* xm; bf16_t* sz; bf16_t* u; int variant;
    __device__ __forceinline__ void operator()(const f32x4 (&acc)[2][2][4][2], const pg8::Unit& un, int wr, int wc, int fr, int fq) const {
        if (variant & 8) return;
        const int row0 = un.pm * 256 + wr * 64 + fr;
        const int cl = wc * 32 + 8 * fq;
        float rsv[2][4];
#pragma unroll
        for (int ai = 0; ai < 2; ++ai)
#pragma unroll
            for (int m = 0; m < 4; ++m) rsv[ai][m] = rstd[row0 + ai * 128 + m * 16];
#pragma unroll
        for (int ai = 0; ai < 2; ++ai)
#pragma unroll
            for (int m = 0; m < 4; ++m) {
                const int row = row0 + ai * 128 + m * 16;
                const float rs = rsv[ai][m];
                if (un.pn < 8) {
                    bf16_t* dst = (un.pn < 4 ? xm : sz) + (size_t)row * DM + (un.pn & 3) * 256 + cl;
#pragma unroll
                    for (int bj = 0; bj < 2; ++bj) {
                        f32x4 v0 = acc[ai][bj][m][0] * rs, v1 = acc[ai][bj][m][1] * rs;
                        if (un.pn >= 4) {
#pragma unroll
                            for (int j = 0; j < 4; ++j) { v0[j] = siluf_(v0[j]); v1[j] = siluf_(v1[j]); }
                        }
                        u32x4 w; w.x = pg8::cvt_pk_bf16(v0[0], v0[1]); w.y = pg8::cvt_pk_bf16(v0[2], v0[3]); w.z = pg8::cvt_pk_bf16(v1[0], v1[1]); w.w = pg8::cvt_pk_bf16(v1[2], v1[3]);
                        if (!(variant & 4)) *(u32x4*)(dst + bj * 128) = w;
                    }
                } else {
                    bf16_t* dst = u + (size_t)row * DM + (un.pn - 8) * 128 + cl;
                    f32x4 o0, o1;
#pragma unroll
                    for (int j = 0; j < 4; ++j) {
                        o0[j] = (acc[ai][0][m][0][j] * rs) * sigmoidf_(acc[ai][1][m][0][j] * rs);
                        o1[j] = (acc[ai][0][m][1][j] * rs) * sigmoidf_(acc[ai][1][m][1][j] * rs);
                    }
                    u32x4 w; w.x = pg8::cvt_pk_bf16(o0[0], o0[1]); w.y = pg8::cvt_pk_bf16(o0[2], o0[3]); w.z = pg8::cvt_pk_bf16(o1[0], o1[1]); w.w = pg8::cvt_pk_bf16(o1[2], o1[3]);
                    if (!(variant & 4)) *(u32x4*)dst = w;
                }
            }
    }
};

constexpr size_t WS_WGCNT = WS_SMALL + 8 * MiB;
constexpr size_t WS_ASGE = WS_SMALL + 9 * MiB;
constexpr size_t WS_ASGR = WS_SMALL + 10 * MiB;
constexpr size_t WS_ASGG = WS_SMALL + 11 * MiB;
constexpr size_t WS_RSTD2 = WS_SMALL + 12 * MiB;
constexpr size_t WS_SRSTD = WS_SMALL + 13 * MiB;
constexpr size_t WS_TOKSLOT = WS_SMALL + 14 * MiB;
constexpr size_t WS_TILEEXP = WS_SMALL + 15 * MiB;
constexpr size_t WS_HBF = WS_R1;
constexpr size_t WS_YROWS = 605 * MiB;
constexpr size_t WS_HB16 = 750 * MiB;
constexpr int NSLOT = NASSIGN + NEXP * 256;
constexpr int TOK_PER_WG = NTOK / 256;

constexpr size_t WS_WRH = WS_SMALL + 576 * 1024;
constexpr size_t WS_WRL = WS_SMALL + 640 * 1024;
__device__ __forceinline__ void p0_router_tables(const MegaArgs& a, int gw, int NGW, int lane) {
    const float* nfw = a.in[19]; const float* wr = a.in[20];
    bf16_t* wh = (bf16_t*)(a.ws + WS_WRH); bf16_t* wl = (bf16_t*)(a.ws + WS_WRL);
    for (int idx = gw * 64 + lane; idx < 32 * 1024; idx += NGW * 64) {
        const int e = idx >> 10, k = idx & 1023;
        const float w = nfw[k] * wr[(size_t)k * 32 + e];
        const bf16_t hi = f2bf(w);
        wh[idx] = hi; wl[idx] = f2bf(w - bf2f(hi));
    }
}
constexpr int RT_LDS_OFF = LDSCTL_OFF + 5120;
struct RtGrp { u32x4 h[8]; };
__device__ __forceinline__ void rt_load_grp(const bf16_t* hrow, int k0, RtGrp& B) {
#pragma unroll
    for (int q = 0; q < 8; ++q) B.h[q] = *(const u32x4*)(hrow + k0 + 32 * q);
}
__device__ __forceinline__ void rt_step(const LAS bf16_t* whl, const LAS bf16_t* wll, int col, int kk, const u32x4 hraw, f32x4& acc0, f32x4& acc1, float& ssq) {
    float v[8]; unpack8(hraw, v);
#pragma unroll
    for (int i = 0; i < 8; ++i) ssq += v[i] * v[i];
    const bf16x8 ah = __builtin_bit_cast(bf16x8, hraw);
    const int ks = kk ^ (col << 3);
    const u32x4 bh0 = *(const LAS u32x4*)(whl + col * 1024 + ks), bh1 = *(const LAS u32x4*)(whl + (col + 16) * 1024 + ks);
    const u32x4 bl0 = *(const LAS u32x4*)(wll + col * 1024 + ks), bl1 = *(const LAS u32x4*)(wll + (col + 16) * 1024 + ks);
    acc0 = __builtin_amdgcn_mfma_f32_16x16x32_bf16(ah, __builtin_bit_cast(bf16x8, bh0), acc0, 0, 0, 0);
    acc0 = __builtin_amdgcn_mfma_f32_16x16x32_bf16(ah, __builtin_bit_cast(bf16x8, bl0), acc0, 0, 0, 0);
    acc1 = __builtin_amdgcn_mfma_f32_16x16x32_bf16(ah, __builtin_bit_cast(bf16x8, bh1), acc1, 0, 0, 0);
    acc1 = __builtin_amdgcn_mfma_f32_16x16x32_bf16(ah, __builtin_bit_cast(bf16x8, bl1), acc1, 0, 0, 0);
}
template <int CTRL> __device__ __forceinline__ void argmax_step(float& v, int& i) {
    const float ov = dpp_mov_f<CTRL>(v); const int oi = __builtin_amdgcn_update_dpp(0, i, CTRL, 0xf, 0xf, false);
    const bool take = (ov > v) || (ov == v && oi < i);
    v = take ? ov : v; i = take ? oi : i;
}
__device__ __forceinline__ void phase_router(const MegaArgs& a, LAS unsigned char* lds, int tid, int lane, int wave) {
    unsigned char* ws = a.ws;
    const bf16_t* hbuf = (const bf16_t*)(ws + WS_HB16);
    const float* br = a.in[21];
    const bf16_t* wh = (const bf16_t*)(ws + WS_WRH); const bf16_t* wl = (const bf16_t*)(ws + WS_WRL);
    float* rstd2 = (float*)(ws + WS_RSTD2);
    int* wgcnt = (int*)(ws + WS_WGCNT); int* asg_e = (int*)(ws + WS_ASGE); int* asg_r = (int*)(ws + WS_ASGR); float* asg_g = (float*)(ws + WS_ASGG);
    LAS int* topi_l = (LAS int*)(lds + RT_LDS_OFF);
    LAS float* topg_l = (LAS float*)(lds + RT_LDS_OFF + 2048);
    LAS int* rank_l = (LAS int*)(lds + RT_LDS_OFF + 4096);
    LAS float* rstd_l = (LAS float*)(lds + RT_LDS_OFF + 6144);
    LAS bf16_t* whl = (LAS bf16_t*)lds;
    LAS bf16_t* wll = (LAS bf16_t*)(lds + 65536);
    for (int i = tid; i < 8192; i += NWAVES * 64) { const int r = i >> 7, c8 = i & 127;
        *(LAS u32x4*)(lds + 16 * ((r << 7) + (c8 ^ (r & 15)))) = *(const u32x4*)((const unsigned char*)wh + 16 * (size_t)i); }
    __syncthreads();
    const int b = blockIdx.x;
    const int col = lane & 15, kq = lane >> 4;
    {
        const int t = b * TOK_PER_WG + wave * 16 + col;
        const bf16_t* hrow = hbuf + (size_t)t * DM + 8 * kq;
        f32x4 acc0 = (f32x4){0.f, 0.f, 0.f, 0.f}, acc1 = acc0; float ssq = 0.f;
        RtGrp A, B;
        rt_load_grp(hrow, 0, A);
        for (int g = 0; g < 4; g += 2) {
            rt_load_grp(hrow, 256 * (g + 1), B);
#pragma unroll
            for (int q = 0; q < 8; ++q) rt_step(whl, wll, col, 256 * g + 32 * q + 8 * kq, A.h[q], acc0, acc1, ssq);
            if (g + 2 < 4) rt_load_grp(hrow, 256 * (g + 2), A);
#pragma unroll
            for (int q = 0; q < 8; ++q) rt_step(whl, wll, col, 256 * (g + 1) + 32 * q + 8 * kq, B.h[q], acc0, acc1, ssq);
        }
        ssq += __builtin_bit_cast(float, __builtin_amdgcn_ds_swizzle(__builtin_bit_cast(int, ssq), 0x401F));
        { const auto rr = __builtin_amdgcn_permlane32_swap(__float_as_uint(ssq), __float_as_uint(ssq), false, false); ssq = __uint_as_float(rr[0]) + __uint_as_float(rr[1]); }
        const float rs = rsqrtf(ssq * (1.0f / DM) + EPSV);
        if (kq == 0) { rstd_l[wave * 16 + col] = rs; rstd2[t] = rs; }
        asm volatile("s_waitcnt lgkmcnt(0)" ::: "memory");
        const float b0 = br[col], b1 = br[col + 16];
#pragma unroll
        for (int r = 0; r < 4; ++r) {
            const float rsr = rstd_l[wave * 16 + 4 * kq + r];
            float v0 = acc0[r] * rsr + b0, v1 = acc1[r] * rsr + b1;
            int sel[4]; float val[4];
#pragma unroll
            for (int it = 0; it < 4; ++it) {
                float bv = (v1 > v0) ? v1 : v0; int bi = (v1 > v0) ? col + 16 : col;
                argmax_step<0xB1>(bv, bi); argmax_step<0x4E>(bv, bi); argmax_step<0x124>(bv, bi); argmax_step<0x128>(bv, bi);
                sel[it] = bi; val[it] = bv;
                if (bi == col) v0 = -3.0e38f;
                if (bi == col + 16) v1 = -3.0e38f;
            }
            float ex[4], sum = 0.f;
#pragma unroll
            for (int it = 0; it < 4; ++it) { ex[it] = __expf(val[it] - val[0]); sum += ex[it]; }
            const float inv = 1.0f / sum;
            if (col == 0) {
                const int tw = wave * 16 + 4 * kq + r;
#pragma unroll
                for (int it = 0; it < 4; ++it) { topi_l[tw * 4 + it] = sel[it]; topg_l[tw * 4 + it] = ex[it] * inv; }
            }
        }
    }
    __syncthreads();
    if (wave == 0) {
        int base = 0;
        for (int ch = 0; ch < 8; ++ch) {
            const int E = topi_l[ch * 64 + lane];
            int myrank = 0;
#pragma unroll
            for (int e = 0; e < 32; ++e) {
                const unsigned long long m = __ballot(E == e);
                const int be = __builtin_amdgcn_readlane(base, e);
                if (E == e) myrank = be + __builtin_popcountll(m & ((1ull << lane) - 1ull));
                if (lane == e) base += __builtin_popcountll(m);
            }
            rank_l[ch * 64 + lane] = myrank;
        }
        if (lane < 32) wgcnt[b * 32 + lane] = base;
    }
    __syncthreads();
    {
        int i = tid; asm volatile("" : "+v"(i));
        const int aidx = b * TOK_PER_WG * 4 + i;
        asg_e[aidx] = topi_l[i]; asg_r[aidx] = rank_l[i]; asg_g[aidx] = topg_l[i];
    }
}

__device__ __forceinline__ void phase_slots(const MegaArgs& a, LAS unsigned char* lds, int tid) {
    unsigned char* ws = a.ws;
    const int* wgcnt = (const int*)(ws + WS_WGCNT); const int* asg_e = (const int*)(ws + WS_ASGE); const int* asg_r = (const int*)(ws + WS_ASGR); const float* asg_g = (const float*)(ws + WS_ASGG);
    const float* rstd2 = (const float*)(ws + WS_RSTD2);
    int* slot_tok = (int*)(ws + WS_STOK); float* slot_gate = (float*)(ws + WS_SGATE); float* slot_rstd = (float*)(ws + WS_SRSTD);
    int* tok_slot = (int*)(ws + WS_TOKSLOT); int* tile_exp = (int*)(ws + WS_TILEEXP);
    LAS int* tot = (LAS int*)lds; LAS int* bef = tot + 32; LAS int* tstart = bef + 32;
    const int b = blockIdx.x;
    if (tid < 32) {
        int t = 0, bf = 0;
        for (int bb = 0; bb < 256; ++bb) { const int c = wgcnt[bb * 32 + tid]; t += c; if (bb < b) bf += c; }
        tot[tid] = t; bef[tid] = bf;
    }
    __syncthreads();
    if (tid == 0) { int ts = 0; for (int e = 0; e < 32; ++e) { tstart[e] = ts; ts += (tot[e] + 255) >> 8; } tstart[32] = ts; }
    __syncthreads();
    {
        int tid_o = tid; asm volatile("" : "+v"(tid_o));
        const int aidx = b * TOK_PER_WG * 4 + tid_o;
        const int e = asg_e[aidx];
        const int slot = 256 * tstart[e] + bef[e] + asg_r[aidx];
        const int tk = aidx >> 2;
        slot_tok[slot] = tk; slot_gate[slot] = asg_g[aidx]; slot_rstd[slot] = rstd2[tk]; tok_slot[aidx] = slot;
    }
    if (b < 32) {
        const int e = b; const int s0 = 256 * tstart[e] + tot[e], s1 = 256 * tstart[e + 1];
        for (int s = s0 + tid; s < s1; s += NWAVES * 64) { slot_tok[s] = 0; slot_gate[s] = 0.f; slot_rstd[s] = 0.f; }
    }
    if (b == 0) {
        if (tid < 32) for (int t = tstart[tid]; t < tstart[tid + 1]; ++t) tile_exp[t] = tid;
        if (tid == 0) tile_exp[2048] = tstart[32];
    }
}

struct MoeOrder {
    const char* A; const char* Bt; const int* gidx; const int* tile_exp; size_t a_tile_bytes, b_exp_bytes, b_tile_bytes; int T, nN, group, c;
    __device__ __forceinline__ bool next(int i, pg8::Unit& u) const {
        const int x = c & 7, j = c >> 3;
        const int tile = (i * 8 + x) * group + (j % group);
        if (tile >= T) return false;
        const int e = __builtin_amdgcn_readfirstlane(tile_exp[tile]);
        u.pm = tile; u.pn = j / group; u.aux = e;
        u.gidx = gidx ? gidx + 256 * tile : nullptr;
        u.A = gidx ? A : A + (size_t)tile * a_tile_bytes;
        u.B = Bt + (size_t)e * b_exp_bytes + (size_t)u.pn * b_tile_bytes;
        return true;
    }
};

struct EpiMoe1 {
    const float* srstd; const float* b1; unsigned char* act; int variant;
    __device__ __forceinline__ void operator()(const f32x4 (&acc)[2][2][4][2], const pg8::Unit& un, int wr, int wc, int fr, int fq) const {
        if (variant & 8) return;
        const int e = un.aux;
        const int cl = un.pn * 128 + wc * 32 + 8 * fq;
        f32x4 bg[2], bl[2];
#pragma unroll
        for (int n = 0; n < 2; ++n) { bg[n] = *(const f32x4*)(b1 + (size_t)e * 2048 + cl + 4 * n); bl[n] = *(const f32x4*)(b1 + (size_t)e * 2048 + 1024 + cl + 4 * n); }
        const int slot0 = un.pm * 256 + wr * 64 + fr;
        float rsv[2][4];
#pragma unroll
        for (int ai = 0; ai < 2; ++ai)
#pragma unroll
            for (int m = 0; m < 4; ++m) rsv[ai][m] = srstd[slot0 + ai * 128 + m * 16];
#pragma unroll
        for (int ai = 0; ai < 2; ++ai)
#pragma unroll
            for (int m = 0; m < 4; ++m) {
                const int slot = slot0 + ai * 128 + m * 16;
                const float rs = rsv[ai][m];
                f32x4 o[2];
#pragma unroll
                for (int n = 0; n < 2; ++n)
#pragma unroll
                    for (int j = 0; j < 4; ++j) {
                        const float g = acc[ai][0][m][n][j] * rs + bg[n][j];
                        const float l = acc[ai][1][m][n][j] * rs + bl[n][j];
                        const float xg = fminf(g, 7.0f);
                        const float xl = fminf(fmaxf(l, -7.0f), 7.0f);
                        o[n][j] = xg * sigmoidf_(1.702f * xg) * (xl + 1.0f);
                    }
                u32x2 w; w.x = pk4_fp8(o[0][0], o[0][1], o[0][2], o[0][3]); w.y = pk4_fp8(o[1][0], o[1][1], o[1][2], o[1][3]);
                *(u32x2*)(act + (size_t)slot * DM + cl) = w;
            }
    }
};
struct EpiMoe2 {
    const float* sgate; const float* b2; unsigned char* yrows;
    __device__ __forceinline__ void operator()(const f32x4 (&acc)[2][2][4][2], const pg8::Unit& un, int wr, int wc, int fr, int fq) const {
        const int e = un.aux;
        const int c0 = un.pn * 256 + wc * 32 + 8 * fq;
        f32x4 bv[2][2];
#pragma unroll
        for (int bj = 0; bj < 2; ++bj)
#pragma unroll
            for (int n = 0; n < 2; ++n) bv[bj][n] = *(const f32x4*)(b2 + (size_t)e * DM + c0 + bj * 128 + 4 * n);
        const int slot0 = un.pm * 256 + wr * 64 + fr;
        float gtv[2][4];
#pragma unroll
        for (int ai = 0; ai < 2; ++ai)
#pragma unroll
            for (int m = 0; m < 4; ++m) gtv[ai][m] = sgate[slot0 + ai * 128 + m * 16] * 16.0f;
#pragma unroll
        for (int ai = 0; ai < 2; ++ai)
#pragma unroll
            for (int m = 0; m < 4; ++m) {
                const int slot = slot0 + ai * 128 + m * 16;
                const float gt = gtv[ai][m];
#pragma unroll
                for (int bj = 0; bj < 2; ++bj) {
                    const f32x4 v0 = (acc[ai][bj][m][0] + bv[bj][0]) * gt, v1 = (acc[ai][bj][m][1] + bv[bj][1]) * gt;
                    u32x2 w; w.x = pk4_fp8(v0[0], v0[1], v0[2], v0[3]); w.y = pk4_fp8(v1[0], v1[1], v1[2], v1[3]);
                    *(u32x2*)(yrows + (size_t)slot * DM + c0 + bj * 128) = w;
                }
            }
    }
};

struct FinBuf { u32x2 h[4]; unsigned y[4][4]; };
__device__ __forceinline__ void fin_load(const bf16_t* hbuf, const unsigned char* yrows, const int* tok_slot, int t, int lane, FinBuf& B) {
    const u32x2* hp = (const u32x2*)(hbuf + (size_t)t * DM) + lane;
#pragma unroll
    for (int j = 0; j < 4; ++j) B.h[j] = hp[64 * j];
#pragma unroll
    for (int r = 0; r < 4; ++r) {
        const int slot = __builtin_amdgcn_readfirstlane(__hip_atomic_load(tok_slot + t * 4 + r, __ATOMIC_RELAXED, __HIP_MEMORY_SCOPE_AGENT));
        const unsigned* yp = (const unsigned*)(yrows + (size_t)slot * DM) + lane;
#pragma unroll
        for (int j = 0; j < 4; ++j) B.y[r][j] = yp[64 * j];
    }
}
__device__ __forceinline__ void fin_compute(float* obuf, const float* fw, int t, int lane, const FinBuf& B) {
    f32x4 v[4];
#pragma unroll
    for (int j = 0; j < 4; ++j) {
        v[j] = up4(B.h[j]);
#pragma unroll
        for (int r = 0; r < 4; ++r) {
            const unsigned w = B.y[r][j];
            const f32x2 lo = __builtin_amdgcn_cvt_pk_f32_fp8(w, false), hi = __builtin_amdgcn_cvt_pk_f32_fp8(w, true);
            v[j].x += lo.x * 0.0625f; v[j].y += lo.y * 0.0625f; v[j].z += hi.x * 0.0625f; v[j].w += hi.y * 0.0625f;
        }
    }
    float s = 0.f;
#pragma unroll
    for (int j = 0; j < 4; ++j) s += (v[j].x * v[j].x + v[j].y * v[j].y) + (v[j].z * v[j].z + v[j].w * v[j].w);
    s = wave_sum(s);
    const float rs = rsqrtf(s * (1.0f / DM) + EPSV);
    f32x4* hp = (f32x4*)(obuf + (size_t)t * DM) + lane;
#pragma unroll
    for (int j = 0; j < 4; ++j) {
        const f32x4 w = *((const f32x4*)fw + lane + 64 * j);
        hp[64 * j] = v[j] * rs * w;
    }
}
__device__ __forceinline__ void phase_final(const MegaArgs& a, int gw, int NGW, int lane) {
    unsigned char* ws = a.ws;
    float* obuf = a.out; const float* fw = a.in[26]; const bf16_t* hbuf = (const bf16_t*)(ws + WS_HB16);
    const unsigned char* yrows = ws + WS_YROWS; const int* tok_slot = (const int*)(ws + WS_TOKSLOT);
    FinBuf A, B;
    int t = gw;
    if (t < NTOK) fin_load(hbuf, yrows, tok_slot, t, lane, A);
    for (; t < NTOK; t += 2 * NGW) {
        const int t2 = t + NGW;
        if (t2 < NTOK) fin_load(hbuf, yrows, tok_slot, t2, lane, B);
        fin_compute(obuf, fw, t, lane, A);
        if (t2 < NTOK) {
            const int t3 = t2 + NGW;
            if (t3 < NTOK) fin_load(hbuf, yrows, tok_slot, t3, lane, A);
            fin_compute(obuf, fw, t2, lane, B);
        }
    }
}

#ifndef OUTPROJ_FP8
#define OUTPROJ_FP8 0
#endif
constexpr int CT = 16;
constexpr int CONV_RED_OFF = LDSCTL_OFF + 4096;
__device__ __forceinline__ void conv_load_rows(const __amdgpu_buffer_rsrc_t urs, int t0, int tid, unsigned (&R)[CT + 30]) {
    const int s0 = t0 & (SEQ - 1);
#pragma unroll
    for (int r = 0; r < CT + 30; ++r) {
        const int sp = s0 - 30 + r;
        R[r] = (sp >= 0) ? (unsigned)__builtin_amdgcn_raw_buffer_load_b32(urs, tid * 4, (t0 - 30 + r) * 2048, 0) : 0u;
    }
}
__device__ __forceinline__ void phase_conv31(const MegaArgs& a, LAS unsigned char* lds, int tid, int lane, int wave, int G) {
    unsigned char* ws = a.ws;
    const __amdgpu_buffer_rsrc_t urs = __builtin_amdgcn_make_buffer_rsrc((void*)(ws + WS_U), 0, NTOK * 2048, 0x00020000);
    const float* cw = a.in[14]; const float* cb = a.in[15]; const float* nw = a.in[16]; const float* nb = a.in[17];
#if OUTPROJ_FP8
    unsigned short* ymix = (unsigned short*)(ws + WS_YMIX);
#else
    unsigned* ymix = (unsigned*)(ws + WS_YMIX);
#endif
    LAS float* wl = (LAS float*)lds;
    LAS float* red = (LAS float*)(lds + CONV_RED_OFF);
    LAS float* stat = red + 32 * 32;
    for (int i = tid; i < 31 * 256; i += NWAVES * 64) *(LAS f32x4*)(wl + 4 * i) = *(const f32x4*)(cw + 4 * i);
    const f32x2 bias = *(const f32x2*)(cb + 2 * tid);
    const f32x2 gw2 = *(const f32x2*)(nw + 2 * tid);
    const f32x2 gb2 = *(const f32x2*)(nb + 2 * tid);
    __syncthreads();
    unsigned R[CT + 30];
    int it = blockIdx.x;
    if (it < NTOK / CT) conv_load_rows(urs, it * CT, tid, R);
    for (; it < NTOK / CT; it += G) {
        const int t0 = it * CT;
        f32x2 uf[CT + 30];
#pragma unroll
        for (int r = 0; r < CT + 30; ++r) { uf[r].x = __uint_as_float(R[r] << 16); uf[r].y = __uint_as_float(R[r] & 0xFFFF0000u); }
        if (it + G < NTOK / CT) conv_load_rows(urs, (it + G) * CT, tid, R);
        f32x2 acc[CT];
#pragma unroll
        for (int t = 0; t < CT; ++t) acc[t] = bias;
#pragma unroll
        for (int k = 0; k < 31; ++k) {
            const f32x2 w = *(const LAS f32x2*)(wl + k * 1024 + 2 * tid);
#pragma unroll
            for (int t = 0; t < CT; ++t) acc[t] = __builtin_elementwise_fma(w, uf[t + k], acc[t]);
        }
        float acc0[CT], acc1[CT];
#pragma unroll
        for (int t = 0; t < CT; ++t) { acc0[t] = acc[t].x; acc1[t] = acc[t].y; }
        float sm[CT], sq[CT];
#pragma unroll
        for (int t = 0; t < CT; ++t) { sm[t] = acc0[t] + acc1[t]; sq[t] = acc0[t] * acc0[t] + acc1[t] * acc1[t]; }
#pragma unroll
        for (int t = 0; t < CT; ++t) {
            sm[t] += dpp_mov_f<0xB1>(sm[t]); sm[t] += dpp_mov_f<0x4E>(sm[t]); sm[t] += dpp_mov_f<0x124>(sm[t]); sm[t] += dpp_mov_f<0x128>(sm[t]);
            sq[t] += dpp_mov_f<0xB1>(sq[t]); sq[t] += dpp_mov_f<0x4E>(sq[t]); sq[t] += dpp_mov_f<0x124>(sq[t]); sq[t] += dpp_mov_f<0x128>(sq[t]);
        }
        __syncthreads();
        if ((lane & 15) == 0) {
            const int pr = wave * 4 + (lane >> 4);
#pragma unroll
            for (int t = 0; t < CT; ++t) { red[pr * 32 + t] = sm[t]; red[pr * 32 + CT + t] = sq[t]; }
        }
        __syncthreads();
        if (wave == 0 && lane < 32) {
            float s2 = 0.f;
#pragma unroll
            for (int p2 = 0; p2 < 32; ++p2) s2 += red[p2 * 32 + lane];
            const float other = __shfl_xor(s2, 16);
            if (lane < 16) {
                const float mean = s2 * (1.0f / DM);
                const float var = fmaxf(other * (1.0f / DM) - mean * mean, 0.f);
                stat[2 * lane] = mean; stat[2 * lane + 1] = rsqrtf(var + EPSV);
            }
        }
        __syncthreads();
#pragma unroll
        for (int t = 0; t < CT; ++t) {
            const f32x2 ms = *(const LAS f32x2*)(stat + 2 * t);
            const float y0 = siluf_((acc0[t] - ms.x) * ms.y * gw2.x + gb2.x);
            const float y1 = siluf_((acc1[t] - ms.x) * ms.y * gw2.y + gb2.y);
#if OUTPROJ_FP8
            ymix[(size_t)(t0 + t) * 1024 + 512 + tid] = (unsigned short)__builtin_amdgcn_cvt_pk_fp8_f32(y0, y1, 0, false);
#else
            ymix[(size_t)(t0 + t) * 1024 + 512 + tid] = pk2(y0, y1);
#endif
        }
    }
    __syncthreads();
}

struct YmBuf { u32x2 X[4][4]; u32x2 H[4]; u32x2 Z[4]; };
__device__ __forceinline__ void ym_load(const bf16_t* xm, const bf16_t* hm, const bf16_t* szb, int t, int lane, YmBuf& B) {
    const int s = t & (SEQ - 1);
#pragma unroll
    for (int j = 0; j < 4; ++j) {
        const int ch = 4 * lane + 256 * j;
#pragma unroll
        for (int kk = 0; kk < 4; ++kk) B.X[j][kk] = (s - 3 + kk >= 0) ? *(const u32x2*)(xm + (size_t)(t - 3 + kk) * DM + ch) : (u32x2){0u, 0u};
        B.H[j] = *(const u32x2*)(hm + (size_t)t * DM + ch);
        B.Z[j] = *(const u32x2*)(szb + (size_t)t * DM + ch);
    }
}
__device__ __forceinline__ void ym_compute(const LAS float* wts, unsigned char* ymix, int t, int lane, const YmBuf& B) {
#pragma unroll
    for (int j = 0; j < 4; ++j) {
        const int ch = 4 * lane + 256 * j;
        f32x4 xc = *(const LAS f32x4*)(wts + 4 * 1024 + ch);
#pragma unroll
        for (int kk = 0; kk < 4; ++kk) xc = xc + *(const LAS f32x4*)(wts + kk * 1024 + ch) * up4(B.X[j][kk]);
        xc.x = siluf_(xc.x); xc.y = siluf_(xc.y); xc.z = siluf_(xc.z); xc.w = siluf_(xc.w);
        const f32x4 hv = up4(B.H[j]);
        const float mean = wave_sum((hv.x + hv.y) + (hv.z + hv.w)) * (1.0f / 256.0f);
        const f32x4 d = hv - mean;
        const float var = wave_sum((d.x * d.x + d.y * d.y) + (d.z * d.z + d.w * d.w)) * (1.0f / 256.0f);
        const float rs = rsqrtf(var + EPSV);
        const f32x4 nwv = *(const LAS f32x4*)(wts + 5 * 1024 + ch), sk = *(const LAS f32x4*)(wts + 6 * 1024 + ch);
        const f32x4 y = (d * rs * nwv + sk * xc) * up4(B.Z[j]);
#if OUTPROJ_FP8
        *(unsigned*)(ymix + (size_t)t * 2048 + ch) = pk4_fp8(y.x, y.y, y.z, y.w);
#else
        { u32x2 o; o.x = pk2(y.x, y.y); o.y = pk2(y.z, y.w); *(u32x2*)((bf16_t*)ymix + (size_t)t * 2048 + ch) = o; }
#endif
        __builtin_amdgcn_sched_barrier(0);
    }
}
__device__ __forceinline__ void phase_ym(const MegaArgs& a, LAS unsigned char* lds, int tid, int gw, int NGW, int lane) {
    unsigned char* ws = a.ws;
    const bf16_t* xm = (const bf16_t*)(ws + WS_XM); const bf16_t* szb = (const bf16_t*)(ws + WS_SZ); const bf16_t* hm = (const bf16_t*)(ws + WS_R1);
    unsigned char* ymix = ws + WS_YMIX;
    LAS float* wts = (LAS float*)lds;
    for (int i = tid; i < 7 * 1024; i += NWAVES * 64) {
        const int r = i >> 10, c = i & 1023;
        wts[i] = (r < 4) ? a.in[3][r * DM + c] : (r == 4 ? a.in[4][c] : (r == 5 ? a.in[12][c] : a.in[13][c]));
    }
    __syncthreads();
    YmBuf A, B;
    int t = gw;
    if (t < NTOK) ym_load(xm, hm, szb, t, lane, A);
    for (; t < NTOK; t += 2 * NGW) {
        const int t2 = t + NGW;
        if (t2 < NTOK) ym_load(xm, hm, szb, t2, lane, B);
        ym_compute(wts, ymix, t, lane, A);
        if (t2 < NTOK) {
            const int t3 = t2 + NGW;
            if (t3 < NTOK) ym_load(xm, hm, szb, t3, lane, A);
            ym_compute(wts, ymix, t2, lane, B);
        }
    }
    __syncthreads();
}

struct EpiOutProj {
    const float* x; bf16_t* hb; unsigned char* hq;
    __device__ __forceinline__ void operator()(const f32x4 (&acc)[2][2][4][2], const pg8::Unit& un, int wr, int wc, int fr, int fq) const {
        const int row0 = un.pm * 256 + wr * 64 + fr;
        const int c0 = un.pn * 256 + wc * 32 + 8 * fq;
#pragma unroll
        for (int ai = 0; ai < 2; ++ai)
#pragma unroll
            for (int mp = 0; mp < 2; ++mp) {
                f32x4 xv[2][2][2];
#pragma unroll
                for (int mm = 0; mm < 2; ++mm)
#pragma unroll
                    for (int bj = 0; bj < 2; ++bj) {
                        const float* xp = x + (size_t)(row0 + ai * 128 + (2 * mp + mm) * 16) * DM + c0 + bj * 128;
                        xv[mm][bj][0] = *(const f32x4*)xp; xv[mm][bj][1] = *(const f32x4*)(xp + 4);
                    }
#pragma unroll
                for (int mm = 0; mm < 2; ++mm) {
                    const int m = 2 * mp + mm;
                    const size_t off = (size_t)(row0 + ai * 128 + m * 16) * DM + c0;
#pragma unroll
                    for (int bj = 0; bj < 2; ++bj) {
                        const f32x4 v0 = acc[ai][bj][m][0] + xv[mm][bj][0], v1 = acc[ai][bj][m][1] + xv[mm][bj][1];
                        u32x4 wb; wb.x = pg8::cvt_pk_bf16(v0[0], v0[1]); wb.y = pg8::cvt_pk_bf16(v0[2], v0[3]); wb.z = pg8::cvt_pk_bf16(v1[0], v1[1]); wb.w = pg8::cvt_pk_bf16(v1[2], v1[3]);
                        *(u32x4*)(hb + off + bj * 128) = wb;
                        u32x2 w; w.x = pk4_fp8(v0[0], v0[1], v0[2], v0[3]); w.y = pk4_fp8(v1[0], v1[1], v1[2], v1[3]);
                        *(u32x2*)(hq + off + bj * 128) = w;
                    }
                }
            }
    }
};


constexpr size_t WS_GCT = WS_SMALL + 512 * 1024;
constexpr size_t WS_GVT = WS_GCT + 32 * 1024;
constexpr size_t WS_FCUM = WS_SMALL + 3 * MiB;
constexpr size_t WS_UVAL = WS_SMALL + 4 * MiB;
constexpr size_t WS_MVAL = WS_SMALL + 7 * MiB;
constexpr size_t WS_ITEMS = WS_SMALL + 8 * MiB;
constexpr size_t WS_DN = WS_SMALL + 9 * MiB;
constexpr size_t WS_NPREV = WS_SMALL + 10 * MiB;
constexpr size_t WS_QB = 477 * MiB;
constexpr size_t WS_KB = 541 * MiB;
constexpr size_t WS_AEXT = 605 * MiB;
constexpr size_t WS_BEXT = 733 * MiB;
constexpr size_t WS_DCT = 861 * MiB;
constexpr size_t WS_KWT = WS_R1;
constexpr size_t WS_HM = WS_R1;
constexpr int RINV_OFF = LDSCTL_OFF + 1024;

__device__ __forceinline__ void p0_gate_tables(const MegaArgs& a, int gw, int NGW, int lane) {
    const float* wq = a.in[5]; const float* wk = a.in[6]; const float* wv = a.in[7]; const float* wig = a.in[8]; const float* wfg = a.in[10];
    bf16_t* gct = (bf16_t*)(a.ws + WS_GCT);
    for (int idx = gw * 64 + lane; idx < 2 * 16 * 1024; idx += NGW * 64) {
        const int tbl = idx >> 14, col = (idx >> 10) & 15, ch = idx & 1023;
        float v = 0.f;
        if (col < 8) {
            const float* Wg = (col < 4) ? wig : wfg; const int hh = col & 3, n = ch >> 2, i = ch & 3;
#pragma unroll
            for (int o = 0; o < 4; ++o) {
                if (tbl == 0) v += wq[n * 16 + i * 4 + o] * Wg[(size_t)(4 * n + o) * 4 + hh] + wk[n * 16 + i * 4 + o] * Wg[(size_t)(1024 + 4 * n + o) * 4 + hh];
                else v += wv[n * 16 + i * 4 + o] * Wg[(size_t)(2048 + 4 * n + o) * 4 + hh];
            }
        }
        gct[idx] = f2bf(v);
    }
}

struct GateGrp { u32x4 row[4][4]; };
__device__ __forceinline__ void gate_load_grp(const bf16_t* xm, int t, int s, int chb, GateGrp& B) {
#pragma unroll
    for (int q = 0; q < 4; ++q)
#pragma unroll
        for (int kk = 0; kk < 4; ++kk) B.row[q][kk] = (s - 3 + kk >= 0) ? *(const u32x4*)(xm + (size_t)(t - 3 + kk) * DM + chb + 32 * q) : (u32x4){0u, 0u, 0u, 0u};
}
__device__ __forceinline__ f32x4 gate_step(const LAS float* cwl, const LAS bf16_t* gtl, int tok, int ch0, const u32x4 (&row)[4], f32x4 acc) {
    float xc[8];
    {
        const f32x4 b0 = *(const LAS f32x4*)(cwl + 4 * 1024 + ch0), b1 = *(const LAS f32x4*)(cwl + 4 * 1024 + ch0 + 4);
        xc[0] = b0.x; xc[1] = b0.y; xc[2] = b0.z; xc[3] = b0.w; xc[4] = b1.x; xc[5] = b1.y; xc[6] = b1.z; xc[7] = b1.w;
    }
#pragma unroll
    for (int kk = 0; kk < 4; ++kk) {
        float xf[8]; unpack8(row[kk], xf);
        const f32x4 w0 = *(const LAS f32x4*)(cwl + kk * 1024 + ch0), w1 = *(const LAS f32x4*)(cwl + kk * 1024 + ch0 + 4);
        xc[0] += w0.x * xf[0]; xc[1] += w0.y * xf[1]; xc[2] += w0.z * xf[2]; xc[3] += w0.w * xf[3];
        xc[4] += w1.x * xf[4]; xc[5] += w1.y * xf[5]; xc[6] += w1.z * xf[6]; xc[7] += w1.w * xf[7];
    }
#pragma unroll
    for (int i = 0; i < 8; ++i) xc[i] = siluf_(xc[i]);
    u32x4 a1; a1.x = pk2(xc[0], xc[1]); a1.y = pk2(xc[2], xc[3]); a1.z = pk2(xc[4], xc[5]); a1.w = pk2(xc[6], xc[7]);
    const u32x4 b1 = *(const LAS u32x4*)(gtl + tok * 1032 + ch0);
    const u32x4 b2 = *(const LAS u32x4*)(gtl + (16 + tok) * 1032 + ch0);
    acc = __builtin_amdgcn_mfma_f32_16x16x32_bf16(__builtin_bit_cast(bf16x8, a1), __builtin_bit_cast(bf16x8, b1), acc, 0, 0, 0);
    acc = __builtin_amdgcn_mfma_f32_16x16x32_bf16(__builtin_bit_cast(bf16x8, row[3]), __builtin_bit_cast(bf16x8, b2), acc, 0, 0, 0);
    return acc;
}
__device__ __forceinline__ void phase_gates(const MegaArgs& a, LAS unsigned char* lds, int tid, int gw, int NGW, int lane) {
    unsigned char* ws = a.ws;
    const bf16_t* xm = (const bf16_t*)(ws + WS_XM);
    const bf16_t* gct = (const bf16_t*)(ws + WS_GCT);
    const float* big = a.in[9]; const float* bfg = a.in[11];
    float* logi = (float*)(ws + WS_LOGI); float* logf = (float*)(ws + WS_LOGF);
    LAS float* cwl = (LAS float*)lds;
    LAS bf16_t* gtl = (LAS bf16_t*)(lds + 20480);
    for (int i = tid; i < 5 * 1024; i += NWAVES * 64) cwl[i] = (i < 4096) ? a.in[3][i] : a.in[4][i - 4096];
    for (int i = tid; i < 32 * 128; i += NWAVES * 64) { const int r = i >> 7, c8 = i & 127; *(LAS u32x4*)(gtl + r * 1032 + 8 * c8) = *(const u32x4*)(gct + (size_t)r * 1024 + 8 * c8); }
    __syncthreads();
    const int tok = lane & 15, kq = lane >> 4;
    for (int tile = gw; tile < NTOK / 16; tile += NGW) {
        const int t = tile * 16 + tok, s = t & (SEQ - 1);
        f32x4 acc = (f32x4){0.f, 0.f, 0.f, 0.f};
        GateGrp A, B;
        gate_load_grp(xm, t, s, 8 * kq, A);
        for (int g = 0; g < 8; g += 2) {
            gate_load_grp(xm, t, s, 128 * (g + 1) + 8 * kq, B);
#pragma unroll
            for (int q = 0; q < 4; ++q) acc = gate_step(cwl, gtl, tok, 128 * g + 32 * q + 8 * kq, A.row[q], acc);
            if (g + 2 < 8) gate_load_grp(xm, t, s, 128 * (g + 2) + 8 * kq, A);
#pragma unroll
            for (int q = 0; q < 4; ++q) acc = gate_step(cwl, gtl, tok, 128 * (g + 1) + 32 * q + 8 * kq, B.row[q], acc);
        }
        const int col = lane & 15;
        if (col < 8) {
            const int hh = col & 3;
#pragma unroll
            for (int r = 0; r < 4; ++r) {
                const int tt = tile * 16 + 4 * kq + r;
                if (col < 4) logi[(size_t)hh * NTOK + tt] = acc[r] + big[hh];
                else logf[(size_t)hh * NTOK + tt] = logsigmoidf_(acc[r] + bfg[hh]);
            }
        }
    }
    __syncthreads();
}

__device__ __forceinline__ void phase_prep(const MegaArgs& a, LAS unsigned char* lds, int tid, int lane, int wave, int G) {
    unsigned char* ws = a.ws;
    const float* logi = (const float*)(ws + WS_LOGI); const float* logf = (const float*)(ws + WS_LOGF);
    float* Fcum = (float*)(ws + WS_FCUM); float* Uval = (float*)(ws + WS_UVAL); float* Mval = (float*)(ws + WS_MVAL);
    float* items = (float*)(ws + WS_ITEMS); float* dn = (float*)(ws + WS_DN);
    const bf16_t* xm = (const bf16_t*)(ws + WS_XM);
    bf16_t* qb = (bf16_t*)(ws + WS_QB); bf16_t* kb = (bf16_t*)(ws + WS_KB); bf16_t* aext = (bf16_t*)(ws + WS_AEXT); bf16_t* bext = (bf16_t*)(ws + WS_BEXT); bf16_t* kwt = (bf16_t*)(ws + WS_KWT);
    const float* cw = a.in[3]; const float* cb = a.in[4]; const float* wq = a.in[5]; const float* wk = a.in[6]; const float* wv = a.in[7];
    LAS float* gch = (LAS float*)lds;
    LAS float* umaxch = gch + 32;
    LAS float* wint_l = umaxch + 32;
    LAS float* wst_l = wint_l + 256;
    LAS float* dn_l = wst_l + 256;
    LAS float* wtl = dn_l + 8 * 256;
    for (int it = blockIdx.x; it < 512; it += G) {
        const int bh = it >> 5, c = it & 31, b = bh >> 2, h = bh & 3;
        const int tb = b * SEQ, t0 = tb + c * 256;
        {
            const int cc = tid >> 4, sub = tid & 15;
            const size_t gbase = (size_t)h * NTOK + tb + cc * 256 + 16 * sub;
            float F[16], u[16];
            {
                const f32x4* lfp = (const f32x4*)(logf + gbase); const f32x4* lip = (const f32x4*)(logi + gbase);
#pragma unroll
                for (int q4 = 0; q4 < 4; ++q4) { const f32x4 v = lfp[q4], w = lip[q4]; F[4 * q4] = v.x; F[4 * q4 + 1] = v.y; F[4 * q4 + 2] = v.z; F[4 * q4 + 3] = v.w; u[4 * q4] = w.x; u[4 * q4 + 1] = w.y; u[4 * q4 + 2] = w.z; u[4 * q4 + 3] = w.w; }
            }
#pragma unroll
            for (int jj = 1; jj < 16; ++jj) F[jj] += F[jj - 1];
            const float total = F[15];
            float incl = total;
#pragma unroll
            for (int o = 1; o < 16; o <<= 1) { const float v = __shfl_up(incl, o, 16); if (sub >= o) incl += v; }
            const float excl = incl - total;
            float um = -3.0e38f;
#pragma unroll
            for (int jj = 0; jj < 16; ++jj) { F[jj] += excl; u[jj] -= F[jj]; um = fmaxf(um, u[jj]); }
            float umx = um;
#pragma unroll
            for (int o = 1; o < 16; o <<= 1) umx = fmaxf(umx, __shfl_xor(umx, o, 16));
            const float gsum = __shfl(incl, 15, 16);
            if (sub == 0) { gch[cc] = gsum; umaxch[cc] = umx; }
            float cm[16]; cm[0] = u[0];
#pragma unroll
            for (int jj = 1; jj < 16; ++jj) cm[jj] = fmaxf(cm[jj - 1], u[jj]);
            float inclm = cm[15];
#pragma unroll
            for (int o = 1; o < 16; o <<= 1) { const float v = __shfl_up(inclm, o, 16); if (sub >= o) inclm = fmaxf(inclm, v); }
            float exclm = __shfl_up(inclm, 1, 16); if (sub == 0) exclm = -3.0e38f;
            __syncthreads();
            float m = 0.f;
            for (int c2 = 0; c2 < c; ++c2) m = gch[c2] + fmaxf(m, umaxch[c2]);
            const float mprev = m, g_c = gch[c], umax_c = umaxch[c], m_c = g_c + fmaxf(mprev, umax_c);
            if (tid == 0) { items[it] = __expf(g_c + mprev - m_c); items[512 + it] = __expf(g_c + umax_c - m_c); items[1024 + it] = mprev; }
            if (cc == c) {
#pragma unroll
                for (int jj = 0; jj < 16; ++jj) {
                    const float M = fmaxf(mprev, fmaxf(cm[jj], exclm));
                    Fcum[gbase + jj] = F[jj]; Uval[gbase + jj] = u[jj]; Mval[gbase + jj] = M;
                    wint_l[16 * sub + jj] = __expf(mprev - M); wst_l[16 * sub + jj] = __expf(u[jj] - umax_c);
                }
            }
            __syncthreads();
        }
        {
            const int ch = h * 256 + 4 * lane;
            float cwv[4][4];
            const f32x4 cbv = *(const f32x4*)(cb + ch);
#pragma unroll
            for (int kk = 0; kk < 4; ++kk) { const f32x4 w = *(const f32x4*)(cw + kk * DM + ch); cwv[kk][0] = w.x; cwv[kk][1] = w.y; cwv[kk][2] = w.z; cwv[kk][3] = w.w; }
            for (int i = tid; i < 768; i += NWAVES * 64) {
                const int mat = i >> 8, q4 = (i >> 6) & 3, ln = i & 63;
                const float* src = (mat == 0 ? wq : (mat == 1 ? wk : wv)) + (h * 64 + ln) * 16 + 4 * q4;
                *(LAS f32x4*)(wtl + 4 * i) = *(const f32x4*)src;
            }
            __syncthreads();
            const int i0 = 32 * wave;
            const __amdgpu_buffer_rsrc_t xrs = __builtin_amdgcn_make_buffer_rsrc((void*)xm, 0, NTOK * 2048, 0x00020000);
            u32x2 cur[11], nx[8];
#pragma unroll
            for (int r = 0; r < 11; ++r) {
                const int sp = c * 256 + i0 - 3 + r;
                cur[r] = (sp >= 0) ? (u32x2)__builtin_amdgcn_raw_buffer_load_b64(xrs, ch * 2, (t0 + i0 - 3 + r) * 2048, 0) : (u32x2){0u, 0u};
            }
            float dnacc[4] = {0.f, 0.f, 0.f, 0.f};
#pragma unroll 1
            for (int pb = 0; pb < 4; ++pb) {
                if (pb < 3) {
#pragma unroll
                    for (int r = 0; r < 8; ++r) nx[r] = (u32x2)__builtin_amdgcn_raw_buffer_load_b64(xrs, ch * 2, (t0 + i0 + 8 * (pb + 1) + r) * 2048, 0);
                }
#pragma unroll
                for (int pp = 0; pp < 8; ++pp) {
                    const int i = i0 + pb * 8 + pp;
                    const f32x4 x0v = up4(cur[pp]), x1v = up4(cur[pp + 1]), x2v = up4(cur[pp + 2]), x3v = up4(cur[pp + 3]);
                    float x3[4]; x3[0] = x3v.x; x3[1] = x3v.y; x3[2] = x3v.z; x3[3] = x3v.w;
                    float xc[4];
#pragma unroll
                    for (int cc = 0; cc < 4; ++cc) xc[cc] = siluf_(cbv[cc] + cwv[0][cc] * x0v[cc] + cwv[1][cc] * x1v[cc] + cwv[2][cc] * x2v[cc] + cwv[3][cc] * x3v[cc]);
                    float qv[4], kv[4], vv[4];
                    {
                        f32x4 qa = (f32x4){0.f, 0.f, 0.f, 0.f}, ka = qa, va = qa;
#pragma unroll
                        for (int q4 = 0; q4 < 4; ++q4) {
                            qa = qa + *(const LAS f32x4*)(wtl + ((0 * 4 + q4) * 64 + lane) * 4) * xc[q4];
                            ka = ka + *(const LAS f32x4*)(wtl + ((1 * 4 + q4) * 64 + lane) * 4) * xc[q4];
                            va = va + *(const LAS f32x4*)(wtl + ((2 * 4 + q4) * 64 + lane) * 4) * x3[q4];
                        }
#pragma unroll
                        for (int o = 0; o < 4; ++o) { qv[o] = qa[o] * 0.0625f; kv[o] = ka[o]; vv[o] = va[o]; }
                    }
                    const float wi = wint_l[i], wsj = wst_l[i];
                    u32x2 o2;
                    o2.x = pk2(qv[0], qv[1]); o2.y = pk2(qv[2], qv[3]);
                    if (!(a.pad & 2)) *(u32x2*)(qb + (size_t)(t0 + i) * DM + ch) = o2;
                    o2.x = pk2(kv[0], kv[1]); o2.y = pk2(kv[2], kv[3]);
                    if (!(a.pad & 2)) *(u32x2*)(kb + (size_t)(t0 + i) * DM + ch) = o2;
                    o2.x = pk2(qv[0] * wi, qv[1] * wi); o2.y = pk2(qv[2] * wi, qv[3] * wi);
                    if (!(a.pad & 2)) *(u32x2*)(aext + ((size_t)it * 256 + i) * 512 + 256 + 4 * lane) = o2;
                    {
                        float kwv[4];
#pragma unroll
                        for (int o = 0; o < 4; ++o) { kwv[o] = kv[o] * wsj; dnacc[o] += kwv[o]; }
                        o2.x = pk2(vv[0], vv[1]); o2.y = pk2(vv[2], vv[3]);
                        if (!(a.pad & 2)) *(u32x2*)(bext + ((size_t)it * 256 + i) * 512 + 256 + 4 * lane) = o2;
                        o2.x = pk2(kwv[0], kwv[1]); o2.y = pk2(kwv[2], kwv[3]);
                        if (!(a.pad & 2)) *(u32x2*)(aext + ((size_t)it * 256 + i) * 512 + 4 * lane) = o2;
                    }
                }
#pragma unroll
                for (int r = 0; r < 3; ++r) cur[r] = cur[8 + r];
#pragma unroll
                for (int r = 0; r < 8; ++r) cur[3 + r] = nx[r];
            }
#pragma unroll
            for (int o = 0; o < 4; ++o) dn_l[wave * 256 + 4 * lane + o] = dnacc[o];
            __syncthreads();
            if (tid < 256) {
                float s = 0.f;
#pragma unroll
                for (int w = 0; w < 8; ++w) s += dn_l[w * 256 + tid];
                dn[(size_t)it * 256 + tid] = s;
            }
            __syncthreads();
        }
    }
}

__device__ __forceinline__ void tr_subtile(const bf16_t* src, int lds_src, bf16_t* dst, int lds_dst, LAS unsigned short* tile, int lane) {
    const int rr = lane >> 3, pc = lane & 7;
    u32x4 v[8];
#pragma unroll
    for (int s2 = 0; s2 < 8; ++s2) v[s2] = *(const u32x4*)(src + (size_t)(rr + 8 * s2) * lds_src + 8 * pc);
#pragma unroll
    for (int s2 = 0; s2 < 8; ++s2) {
        LAS unsigned* tp = (LAS unsigned*)(tile + (rr + 8 * s2) * 66 + 8 * pc);
        tp[0] = v[s2].x; tp[1] = v[s2].y; tp[2] = v[s2].z; tp[3] = v[s2].w;
    }
    asm volatile("s_waitcnt lgkmcnt(0)" ::: "memory");
#pragma unroll
    for (int s2 = 0; s2 < 8; ++s2) {
        const int c = rr + 8 * s2;
        const LAS unsigned short* tp = tile + (8 * pc) * 66 + c;
        u32x4 o;
        o.x = (unsigned)tp[0 * 66] | ((unsigned)tp[1 * 66] << 16); o.y = (unsigned)tp[2 * 66] | ((unsigned)tp[3 * 66] << 16);
        o.z = (unsigned)tp[4 * 66] | ((unsigned)tp[5 * 66] << 16); o.w = (unsigned)tp[6 * 66] | ((unsigned)tp[7 * 66] << 16);
        *(u32x4*)(dst + (size_t)c * lds_dst + 8 * pc) = o;
    }
    asm volatile("s_waitcnt lgkmcnt(0)" ::: "memory");
}
__device__ __forceinline__ void phase_transposes(const MegaArgs& a, LAS unsigned char* lds, int wave, int lane, int G) {
    unsigned char* ws = a.ws;
    bf16_t* aext = (bf16_t*)(ws + WS_AEXT); bf16_t* bext = (bf16_t*)(ws + WS_BEXT); bf16_t* kwt = (bf16_t*)(ws + WS_KWT);
    LAS unsigned short* tile = (LAS unsigned short*)(lds + wave * 16384);
    for (int it = blockIdx.x; it < 512; it += G) {
        for (int job = wave; job < 32; job += NWAVES) {
            const int arr = job >> 4, sj = (job >> 2) & 3, sc = job & 3;
            if (arr == 0) tr_subtile(bext + ((size_t)it * 256 + 64 * sj) * 512 + 256 + 64 * sc, 512, bext + ((size_t)it * 256 + 64 * sc) * 512 + 64 * sj, 512, tile, lane);
            else          tr_subtile(aext + ((size_t)it * 256 + 64 * sj) * 512 + 64 * sc, 512, kwt + ((size_t)it * 256 + 64 * sc) * 256 + 64 * sj, 256, tile, lane);
        }
    }
    asm volatile("s_waitcnt vmcnt(0)" ::: "memory");
    __syncthreads();
}

struct ItemOrder {
    const char* A; const char* B; size_t a_item_bytes, b_item_bytes; int per_token; int G, c;
    __device__ __forceinline__ bool next(int i, pg8::Unit& u) const {
        const int it = i * G + c; if (it >= 512) return false;
        u.pm = it; u.pn = 0; u.aux = i; u.gidx = nullptr;
        if (per_token) { const int bh = it >> 5, cc = it & 31, b = bh >> 2, h = bh & 3; const size_t off = ((size_t)(b * SEQ + cc * 256) * DM + h * 256) * 2; u.A = A + off; u.B = B + off; }
        else { u.A = A + (size_t)it * a_item_bytes; u.B = B + (size_t)it * b_item_bytes; }
        return true;
    }
};
struct EpiP {
    const float* Uval; const float* Mval; bf16_t* aext;
    __device__ __forceinline__ void operator()(const f32x4 (&acc)[2][2][4][2], const pg8::Unit& un, int wr, int wc, int fr, int fq) const {
        const int it = un.pm, bh = it >> 5, cc = it & 31, b = bh >> 2, h = bh & 3;
        const size_t gb = (size_t)h * NTOK + b * SEQ + cc * 256;
        const int jb = wc * 32 + 8 * fq;
        float Mv[2][4];
#pragma unroll
        for (int ai = 0; ai < 2; ++ai)
#pragma unroll
            for (int m = 0; m < 4; ++m) Mv[ai][m] = Mval[gb + ai * 128 + wr * 64 + m * 16 + fr];
#pragma unroll
        for (int bj = 0; bj < 2; ++bj) {
            f32x4 uj[2];
#pragma unroll
            for (int n = 0; n < 2; ++n) uj[n] = *(const f32x4*)(Uval + gb + bj * 128 + jb + 4 * n);
#pragma unroll
            for (int ai = 0; ai < 2; ++ai)
#pragma unroll
                for (int m = 0; m < 4; ++m) {
                    const int i = ai * 128 + wr * 64 + m * 16 + fr;
                    const float Mi = Mv[ai][m];
                    f32x4 o[2];
#pragma unroll
                    for (int n = 0; n < 2; ++n)
#pragma unroll
                        for (int jj = 0; jj < 4; ++jj) {
                            const int j = bj * 128 + jb + 4 * n + jj;
                            o[n][jj] = (j <= i) ? acc[ai][bj][m][n][jj] * __expf(uj[n][jj] - Mi) : 0.f;
                        }
                    u32x4 w; w.x = pg8::cvt_pk_bf16(o[0][0], o[0][1]); w.y = pg8::cvt_pk_bf16(o[0][2], o[0][3]); w.z = pg8::cvt_pk_bf16(o[1][0], o[1][1]); w.w = pg8::cvt_pk_bf16(o[1][2], o[1][3]);
                    *(u32x4*)(aext + ((size_t)it * 256 + i) * 512 + bj * 128 + jb) = w;
                    asm volatile("" ::: "memory");
                }
        }
    }
};
struct EpiDC {
    bf16_t* dct;
    __device__ __forceinline__ void operator()(const f32x4 (&acc)[2][2][4][2], const pg8::Unit& un, int wr, int wc, int fr, int fq) const {
        const int it = un.pm; const int cb0 = wc * 32 + 8 * fq;
#pragma unroll
        for (int ai = 0; ai < 2; ++ai)
#pragma unroll
            for (int m = 0; m < 4; ++m) {
                const int r = ai * 128 + wr * 64 + m * 16 + fr;
#pragma unroll
                for (int bj = 0; bj < 2; ++bj) {
                    const f32x4 v0 = acc[ai][bj][m][0], v1 = acc[ai][bj][m][1];
                    u32x4 w; w.x = pg8::cvt_pk_bf16(v0[0], v0[1]); w.y = pg8::cvt_pk_bf16(v0[2], v0[3]); w.z = pg8::cvt_pk_bf16(v1[0], v1[1]); w.w = pg8::cvt_pk_bf16(v1[2], v1[3]);
                    *(u32x4*)(dct + ((size_t)it * 256 + r) * 256 + bj * 128 + cb0) = w;
                }
            }
    }
};
struct EpiO {
    LAS const float* rinv; bf16_t* hm;
    __device__ __forceinline__ void operator()(const f32x4 (&acc)[2][2][4][2], const pg8::Unit& un, int wr, int wc, int fr, int fq) const {
        const int it = un.pm, bh = it >> 5, cc = it & 31, b = bh >> 2, h = bh & 3;
        const size_t t0 = (size_t)b * SEQ + cc * 256; const int eb = wc * 32 + 8 * fq;
#pragma unroll
        for (int ai = 0; ai < 2; ++ai)
#pragma unroll
            for (int m = 0; m < 4; ++m) {
                const int i = ai * 128 + wr * 64 + m * 16 + fr;
                const float ri = rinv[un.aux * 256 + i];
#pragma unroll
                for (int bj = 0; bj < 2; ++bj) {
                    const f32x4 v0 = acc[ai][bj][m][0] * ri, v1 = acc[ai][bj][m][1] * ri;
                    u32x4 w; w.x = pg8::cvt_pk_bf16(v0[0], v0[1]); w.y = pg8::cvt_pk_bf16(v0[2], v0[3]); w.z = pg8::cvt_pk_bf16(v1[0], v1[1]); w.w = pg8::cvt_pk_bf16(v1[2], v1[3]);
                    *(u32x4*)(hm + (t0 + i) * DM + h * 256 + bj * 128 + eb) = w;
                }
            }
    }
};

__device__ __forceinline__ void phase_scan(const MegaArgs& a, int tid) {
    unsigned char* ws = a.ws;
    const float* items = (const float*)(ws + WS_ITEMS); const bf16_t* dct = (const bf16_t*)(ws + WS_DCT); bf16_t* bext = (bf16_t*)(ws + WS_BEXT);
    const float* dn = (const float*)(ws + WS_DN); float* nprev = (float*)(ws + WS_NPREV);
    int tid_o = tid; asm volatile("" : "+v"(tid_o));
    const int gid = blockIdx.x * (NWAVES * 64) + tid_o;
    if (gid < 16 * 256 * 32) {
        const int bh = gid >> 13, e = (gid >> 5) & 255, d8 = gid & 31;
        float st[8];
#pragma unroll
        for (int i = 0; i < 8; ++i) st[i] = 0.f;
        u32x4 rA[4], rB[4]; float decA[4], scA[4], decB[4], scB[4];
#define SCAN_LOAD(R, D, S, c0) do { _Pragma("unroll") for (int q = 0; q < 4; ++q) { const int it_ = bh * 32 + (c0) + q; R[q] = *(const u32x4*)(dct + ((size_t)it_ * 256 + e) * 256 + 8 * d8); D[q] = items[it_]; S[q] = items[512 + it_]; } } while (0)
#define SCAN_STEP(R, D, S, c0) do { _Pragma("unroll") for (int q = 0; q < 4; ++q) { const int it_ = bh * 32 + (c0) + q; \
            u32x4 w; w.x = pk2(st[0], st[1]); w.y = pk2(st[2], st[3]); w.z = pk2(st[4], st[5]); w.w = pk2(st[6], st[7]); \
            *(u32x4*)(bext + ((size_t)it_ * 256 + e) * 512 + 256 + 8 * d8) = w; \
            float dv[8]; unpack8(R[q], dv); \
            _Pragma("unroll") for (int i = 0; i < 8; ++i) st[i] = D[q] * st[i] + S[q] * dv[i]; } } while (0)
        SCAN_LOAD(rA, decA, scA, 0);
        for (int c0 = 0; c0 < 32; c0 += 8) {
            SCAN_LOAD(rB, decB, scB, c0 + 4);
            SCAN_STEP(rA, decA, scA, c0);
            if (c0 + 8 < 32) SCAN_LOAD(rA, decA, scA, c0 + 8);
            SCAN_STEP(rB, decB, scB, c0 + 4);
        }
#undef SCAN_LOAD
#undef SCAN_STEP
    }
    if (gid < 16 * 256) {
        const int bh = gid >> 8, d = gid & 255;
        float dnv[32], dcv[32], scv[32];
#pragma unroll
        for (int c = 0; c < 32; ++c) { const int it = bh * 32 + c; dnv[c] = dn[(size_t)it * 256 + d]; dcv[c] = items[it]; scv[c] = items[512 + it]; }
        float st = 0.f;
#pragma unroll
        for (int c = 0; c < 32; ++c) { const int it = bh * 32 + c; nprev[(size_t)it * 256 + d] = st; st = dcv[c] * st + scv[c] * dnv[c]; }
    }
}

__device__ __forceinline__ void g3_rinv(const MegaArgs& a, LAS unsigned char* lds, int wave, int lane, int G) {
    unsigned char* ws = a.ws;
    const bf16_t* aext = (const bf16_t*)(ws + WS_AEXT); const float* nprev = (const float*)(ws + WS_NPREV);
    const float* Fcum = (const float*)(ws + WS_FCUM); const float* Mval = (const float*)(ws + WS_MVAL);
    LAS float* rinv = (LAS float*)(lds + RINV_OFF);
    const int l16 = lane & 15, rsub = lane >> 4;
    for (int ui = 0; ui < 2; ++ui) {
        const int it = ui * G + blockIdx.x; if (it >= 512) break;
        const int bh = it >> 5, cc = it & 31, b = bh >> 2, h = bh & 3;
        f32x4 nv[2][2];
#pragma unroll
        for (int pz = 0; pz < 2; ++pz) { const f32x4* np = (const f32x4*)(nprev + (size_t)it * 256 + 8 * (l16 + 16 * pz)); nv[pz][0] = np[0]; nv[pz][1] = np[1]; }
        u32x4 pc[8][4];
#pragma unroll
        for (int ps = 0; ps < 8; ++ps) {
            const u32x4* rowp = (const u32x4*)(aext + ((size_t)it * 256 + 32 * ps + 4 * wave + rsub) * 512);
#pragma unroll
            for (int q = 0; q < 4; ++q) pc[ps][q] = rowp[l16 + 16 * q];
        }
#pragma unroll
        for (int ps = 0; ps < 8; ++ps) {
            float s = 0.f;
#pragma unroll
            for (int q = 0; q < 2; ++q) { float f[8]; unpack8(pc[ps][q], f); s += ((f[0] + f[1]) + (f[2] + f[3])) + ((f[4] + f[5]) + (f[6] + f[7])); }
#pragma unroll
            for (int q = 0; q < 2; ++q) { float f[8]; unpack8(pc[ps][2 + q], f); const f32x4 n0 = nv[q][0], n1 = nv[q][1];
                s += (f[0] * n0.x + f[1] * n0.y + f[2] * n0.z + f[3] * n0.w) + (f[4] * n1.x + f[5] * n1.y + f[6] * n1.z + f[7] * n1.w); }
            s += dpp_mov_f<0xB1>(s); s += dpp_mov_f<0x4E>(s); s += dpp_mov_f<0x124>(s); s += dpp_mov_f<0x128>(s);
            const int i = 32 * ps + 4 * wave + rsub;
            const size_t gi = (size_t)h * NTOK + b * SEQ + cc * 256 + i;
            if (l16 == 0) { const float mi = Fcum[gi] + Mval[gi]; rinv[ui * 256 + i] = 1.0f / fmaxf(fabsf(s), __expf(-mi)); }
        }
    }
    __syncthreads();
}

#ifndef STAG1
#define STAG1 0
#endif
#ifndef STAG12
#define STAG12 0
#endif
__global__ void __launch_bounds__(NWAVES * 64, 2) mega_fwd(MegaArgs args) {
    extern __shared__ __attribute__((aligned(16))) unsigned char lds_raw[];
    LAS unsigned char* lds = (LAS unsigned char*)lds_raw;
    const int wave = __builtin_amdgcn_readfirstlane(threadIdx.x >> 6);
#define lane lane_id()
#define tid ((wave << 6) | lane_id())
    const int G = gridDim.x;
    const int gw = blockIdx.x * NWAVES + wave, NGW = G * NWAVES;
    unsigned char* ws = args.ws;
    unsigned* ctl = (unsigned*)(ws + WS_CTL);
    for (int u = tid; u < (LDS_BYTES - LDSCTL_OFF) / 4; u += NWAVES * 64) ((LAS unsigned*)(lds + LDSCTL_OFF))[u] = 0u;
    __syncthreads();
    XcdBarrier bar = xcd_barrier_post(ctl + CW_BAR + args.li * XCD_BAR_WORDS, (volatile LAS unsigned*)(lds + LDSCTL_OFF + 64), wave);
    const int lo = args.ph_lo, hi = args.ph_hi;
#define IN(k) (lo <= (k) && (k) < hi)
#define BOTH(k) (IN(k) && IN((k) + 1))

    if (IN(0)) { p0_prologue(args, lds, gw, NGW, wave, lane); p0b_weights(args, lds, gw, NGW, wave, lane); p0_gate_tables(args, gw, NGW, lane); p0_router_tables(args, gw, NGW, lane); if (BOTH(0)) xcd_barrier(bar); }

    if (IN(1)) {
        const int NG1 = G;
        if ((int)blockIdx.x < NG1) {
            pg8::DenseOrder S; S.init(ws + WS_R1, ws + WS_BTIN, NTOK, DPROJ, DM, DM, NG1, (int)blockIdx.x);
            EpiInProj E{(const float*)(ws + WS_RSTD1), (bf16_t*)(ws + WS_XM), (bf16_t*)(ws + WS_SZ), (bf16_t*)(ws + WS_U), args.pad};
            pg8::gemm_phase<EpiInProj, pg8::DenseOrder, false>(lds, wave, DM, DM, DM, S, E, 0x7F7F7F7F, 0x7F7F7F7F, STAG1);
        } else {
            p0b_weights(args, lds, ((int)blockIdx.x - NG1) * NWAVES + wave, (G - NG1) * NWAVES, wave, lane);
        }
        if (BOTH(1)) xcd_barrier(bar);
    }
    if (IN(2)) { phase_gates(args, lds, tid, gw, NGW, lane); if (BOTH(2)) xcd_barrier(bar); }
    if (IN(3)) { phase_prep(args, lds, tid, lane, wave, G); if (BOTH(3)) xcd_barrier(bar); }
    if (IN(4)) {
        phase_transposes(args, lds, wave, lane, G);
        {
            ItemOrder S; S.A = (const char*)(ws + WS_QB); S.B = (const char*)(ws + WS_KB); S.a_item_bytes = 0; S.b_item_bytes = 0; S.per_token = 1; S.G = G; S.c = (int)blockIdx.x;
            EpiP E{(const float*)(ws + WS_UVAL), (const float*)(ws + WS_MVAL), (bf16_t*)(ws + WS_AEXT)};
            pg8::gemm_phase<EpiP, ItemOrder, false>(lds, wave, 256, DM, DM, S, E);
        }
        {
            ItemOrder S; S.A = (const char*)(ws + WS_BEXT); S.B = (const char*)(ws + WS_KWT); S.a_item_bytes = (size_t)256 * 512 * 2; S.b_item_bytes = (size_t)256 * 256 * 2; S.per_token = 0; S.G = G; S.c = (int)blockIdx.x;
            EpiDC E{(bf16_t*)(ws + WS_DCT)};
            pg8::gemm_phase<EpiDC, ItemOrder, false>(lds, wave, 256, 512, 256, S, E);
        }
        if (BOTH(4)) xcd_barrier(bar);
    }
    if (IN(5)) {
        if ((blockIdx.x >> 3) & 1) { phase_conv31(args, lds, tid, lane, wave, G); phase_scan(args, tid); }
        else { phase_scan(args, tid); phase_conv31(args, lds, tid, lane, wave, G); }
        if (BOTH(5)) xcd_barrier(bar);
    }
    if (IN(6)) {
        g3_rinv(args, lds, wave, lane, G);
        ItemOrder S; S.A = (const char*)(ws + WS_AEXT); S.B = (const char*)(ws + WS_BEXT); S.a_item_bytes = (size_t)256 * 512 * 2; S.b_item_bytes = (size_t)256 * 512 * 2; S.per_token = 0; S.G = G; S.c = (int)blockIdx.x;
        EpiO E{(LAS const float*)(lds + RINV_OFF), (bf16_t*)(ws + WS_HM)};
        pg8::gemm_phase<EpiO, ItemOrder, false>(lds, wave, 512, 512, 512, S, E);
        if (BOTH(6)) xcd_barrier(bar);
    }
    if (IN(7)) { phase_ym(args, lds, tid, gw, NGW, lane); if (BOTH(7)) xcd_barrier(bar); }
    if (IN(8)) {
        EpiOutProj E{args.in[0], (bf16_t*)(ws + WS_HB16), ws + WS_HBF};
#if OUTPROJ_FP8
        pg8::DenseOrder S; S.init(ws + WS_YMIX, ws + WS_BTOUT, NTOK, DM, 1024, 1024, G, (int)blockIdx.x);
        pg8::gemm_phase<EpiOutProj, pg8::DenseOrder, false, true>(lds, wave, 1024, 1024, 1024, S, E, 0x7A7A7A7A, 0x7F7F7F7F);
#else
        pg8::DenseOrder S; S.init(ws + WS_YMIX, ws + WS_BTOUT, NTOK, DM, 2048, 2048, G, (int)blockIdx.x);
        pg8::gemm_phase<EpiOutProj, pg8::DenseOrder, false>(lds, wave, 2048, 2048, 2048, S, E);
#endif
        if (BOTH(8)) xcd_barrier(bar);
    }
    if (IN(9)) { phase_router(args, lds, tid, lane, wave); if (BOTH(9)) xcd_barrier(bar); }
    if (IN(10)) { phase_slots(args, lds, tid); if (BOTH(10)) xcd_barrier(bar); }
    if (IN(11)) {
        const int T = __builtin_amdgcn_readfirstlane(__hip_atomic_load((const int*)(ws + WS_TILEEXP) + 2048, __ATOMIC_RELAXED, __HIP_MEMORY_SCOPE_AGENT));
        MoeOrder S; S.A = (const char*)(ws + WS_HBF); S.Bt = (const char*)(ws + WS_BT1); S.gidx = (const int*)(ws + WS_STOK); S.tile_exp = (const int*)(ws + WS_TILEEXP);
        S.a_tile_bytes = 0; S.b_exp_bytes = (size_t)2048 * 1024; S.b_tile_bytes = (size_t)256 * 1024; S.T = T; S.nN = 8; S.group = 4; S.c = (int)blockIdx.x;
        EpiMoe1 E{(const float*)(ws + WS_SRSTD), args.in[23], ws + WS_ACT, args.pad};
        pg8::gemm_phase<EpiMoe1, MoeOrder, true, true>(lds, wave, DM / 2, DM / 2, DM / 2, S, E, 0x7A7A7A7A, 0x7F7F7F7F);
        if (BOTH(11)) xcd_barrier(bar);
    }
    if (IN(12)) {
        const int T = __builtin_amdgcn_readfirstlane(__hip_atomic_load((const int*)(ws + WS_TILEEXP) + 2048, __ATOMIC_RELAXED, __HIP_MEMORY_SCOPE_AGENT));
        MoeOrder S; S.A = (const char*)(ws + WS_ACT); S.Bt = (const char*)(ws + WS_BT2); S.gidx = nullptr; S.tile_exp = (const int*)(ws + WS_TILEEXP);
        S.a_tile_bytes = (size_t)256 * 1024; S.b_exp_bytes = (size_t)1024 * 1024; S.b_tile_bytes = (size_t)256 * 1024; S.T = T; S.nN = 4; S.group = 8; S.c = (int)blockIdx.x;
        EpiMoe2 E{(const float*)(ws + WS_SGATE), args.in[25], ws + WS_YROWS};
        pg8::gemm_phase<EpiMoe2, MoeOrder, false, true>(lds, wave, DM / 2, DM / 2, DM / 2, S, E, 0x7A7A7A7A, 0x7F7F7F7F, STAG12);
        if (BOTH(12)) xcd_barrier(bar);
    }
    if (IN(13)) { phase_final(args, gw, NGW, lane); }
#undef IN
#undef BOTH
#undef lane
#undef tid
}

static int g_grid = 0;
static bool mega_setup(size_t ws_size) {
    if (g_grid == 0) {
        int dev = 0, cus = 0, per_cu = 0;
        if (ws_size < WS_NEED) { g_grid = -1; return false; }
        if (hipGetDevice(&dev) != hipSuccess || hipDeviceGetAttribute(&cus, hipDeviceAttributeMultiprocessorCount, dev) != hipSuccess) { g_grid = -1; return false; }
        if (hipFuncSetAttribute((const void*)mega_fwd, hipFuncAttributeMaxDynamicSharedMemorySize, LDS_BYTES) != hipSuccess) { g_grid = -1; return false; }
        (void)hipOccupancyMaxActiveBlocksPerMultiprocessor(&per_cu, (const void*)mega_fwd, NWAVES * 64, LDS_BYTES);
        (void)hipGetLastError();
        g_grid = cus;
    }
    return g_grid > 0;
}
static void mega_launch(const MegaArgs& base, int lo, int hi, int li, hipStream_t stream, int variant = 0) {
    MegaArgs a = base; a.ph_lo = lo; a.ph_hi = hi; a.li = li; a.pad = variant;
    hipLaunchKernelGGL(mega_fwd, dim3(g_grid), dim3(NWAVES * 64), LDS_BYTES, stream, a);
}

extern "C" void kernel_launch(void* const* d_in, const int* in_sizes, int n_in, void* d_out, int out_size, void* d_ws,
                              size_t ws_size, hipStream_t stream) {
    const float* mconv_w = (const float*)d_in[3];
    const float* mconv_b = (const float*)d_in[4];
    const float* w_q = (const float*)d_in[5];
    const float* w_k = (const float*)d_in[6];
    const float* w_v = (const float*)d_in[7];
    const float* w_ig = (const float*)d_in[8];
    const float* b_ig = (const float*)d_in[9];
    const float* w_fg = (const float*)d_in[10];
    const float* b_fg = (const float*)d_in[11];
    const float* mnorm_w = (const float*)d_in[12];
    const float* mskip = (const float*)d_in[13];
    const float* cdw_w = (const float*)d_in[14];
    const float* cdw_b = (const float*)d_in[15];
    const float* cnorm_w = (const float*)d_in[16];
    const float* cnorm_b = (const float*)d_in[17];
    const float* w_out = (const float*)d_in[18];
    const float* nffn_w = (const float*)d_in[19];
    const float* w_router = (const float*)d_in[20];
    const float* b_router = (const float*)d_in[21];
    const float* w1 = (const float*)d_in[22];
    const float* b1 = (const float*)d_in[23];
    const float* w2 = (const float*)d_in[24];
    const float* b2 = (const float*)d_in[25];
    const float* final_w = (const float*)d_in[26];
    const float* x = (const float*)d_in[0];
    float* out = (float*)d_out;
    if (!mega_setup(ws_size)) return;
    unsigned char* ws = (unsigned char*)d_ws;
    (void)hipMemsetAsync(ws + WS_CTL, 0, CTL_ZERO_BYTES, stream);
    MegaArgs a{};
    for (int i = 0; i < 27; ++i) a.in[i] = (const float*)d_in[i];
    a.out = out; a.ws = ws;

    bf16_t* xm = (bf16_t*)(ws + WS_XM);
    bf16_t* szb = (bf16_t*)(ws + WS_SZ);
    bf16_t* ub = (bf16_t*)(ws + WS_U);
    bf16_t* hm = (bf16_t*)(ws + WS_R1);
    bf16_t* ymix = (bf16_t*)(ws + WS_YMIX);
    float* logi = (float*)(ws + WS_LOGI);
    float* logf = (float*)(ws + WS_LOGF);
    int* topi = (int*)(ws + WS_TOPI);
    float* topg = (float*)(ws + WS_TOPG);
    int* slot_tok = (int*)(ws + WS_STOK);
    float* slot_gate = (float*)(ws + WS_SGATE);
    int* estart = (int*)(ws + WS_ESTART);
    bf16_t* act = (bf16_t*)(ws + WS_ACT);
    bf16_t* a2 = (bf16_t*)(ws + WS_R1);

#ifndef PROBE_K
    mega_launch(a, 0, 14, 0, stream);
#else
    mega_launch(a, 0, PROBE_K + 1, 0, stream);
#ifndef PROBE_V
#define PROBE_V 0
#endif
    mega_launch(a, PROBE_K, PROBE_K + 1, 1, stream, PROBE_V);
    if (PROBE_K + 1 < 14) mega_launch(a, PROBE_K + 1, 14, 2, stream);
#endif
}
```

```cpp
#include <hip/hip_runtime.h>
#include <stdint.h>

#define NTOK 32768
#define SEQ 8192
#define DM 1024
#define DPROJ 4096
#define NEXP 32
#define NASSIGN (NTOK * 4)
#define EPSV 1e-5f

typedef unsigned short bf16_t;

__device__ __forceinline__ float bf2f(bf16_t h) { return __uint_as_float(((uint32_t)h) << 16); }
__device__ __forceinline__ bf16_t f2bf(float f) {
    uint32_t u = __float_as_uint(f);
    u += 0x7FFFu + ((u >> 16) & 1u);
    return (bf16_t)(u >> 16);
}
__device__ __forceinline__ float sigmoidf_(float x) { return __builtin_amdgcn_rcpf(1.0f + __expf(-x)); }
__device__ __forceinline__ float siluf_(float x) { return x * sigmoidf_(x); }
__device__ __forceinline__ float logsigmoidf_(float x) { return fminf(x, 0.0f) - log1pf(__expf(-fabsf(x))); }

template <int CTRL> __device__ __forceinline__ float dpp_mov_f(float v) { return __builtin_bit_cast(float, __builtin_amdgcn_update_dpp(0, __builtin_bit_cast(int, v), CTRL, 0xf, 0xf, false)); }
__device__ __forceinline__ float wave_sum(float v) {
    v += dpp_mov_f<0xB1>(v); v += dpp_mov_f<0x4E>(v); v += dpp_mov_f<0x124>(v); v += dpp_mov_f<0x128>(v);
    v += __builtin_bit_cast(float, __builtin_amdgcn_ds_swizzle(__builtin_bit_cast(int, v), 0x401F));
    const auto rr = __builtin_amdgcn_permlane32_swap(__float_as_uint(v), __float_as_uint(v), false, false);
    return __uint_as_float(rr[0]) + __uint_as_float(rr[1]);
}
__device__ __forceinline__ float block_sum256(float v, float* red) {
    v = wave_sum(v);
    __syncthreads();
    if ((threadIdx.x & 63) == 0) red[threadIdx.x >> 6] = v;
    __syncthreads();
    return red[0] + red[1] + red[2] + red[3];
}


#define LAS __attribute__((address_space(3)))
#define GAS __attribute__((address_space(1)))
typedef short bf16x8 __attribute__((ext_vector_type(8)));
typedef float f32x4 __attribute__((ext_vector_type(4)));
typedef float f32x2 __attribute__((ext_vector_type(2)));
typedef unsigned u32x4 __attribute__((ext_vector_type(4)));
typedef unsigned u32x2 __attribute__((ext_vector_type(2)));

__device__ __forceinline__ int lane_id() { int l = (int)__builtin_amdgcn_mbcnt_hi(~0u, __builtin_amdgcn_mbcnt_lo(~0u, 0u)); asm volatile("" : "+v"(l)); return l; }
namespace pg8 {
__device__ __forceinline__ const char* uni_ptr(const char* p) { const unsigned long long v = (unsigned long long)p; const unsigned lo = __builtin_amdgcn_readfirstlane((unsigned)v), hi = __builtin_amdgcn_readfirstlane((unsigned)(v >> 32)); return (const char*)(((unsigned long long)hi << 32) | lo); }
typedef int i32x4 __attribute__((ext_vector_type(4)));
typedef int i32x8 __attribute__((ext_vector_type(8)));
__device__ __forceinline__ void mfma8_tied(f32x4& acc, const i32x8 a, const i32x8 b, const int sa, const int sb) {
    asm volatile("v_mfma_scale_f32_16x16x128_f8f6f4 %0, %1, %2, %0, %3, %4 op_sel_hi:[0,0,0]" : "+v"(acc) : "v"(a), "v"(b), "v"(sa), "v"(sb));
}
__device__ __forceinline__ i32x8 cat8(const bf16x8 lo, const bf16x8 hi) { return __builtin_shufflevector(__builtin_bit_cast(i32x4, lo), __builtin_bit_cast(i32x4, hi), 0, 1, 2, 3, 4, 5, 6, 7); }
constexpr int BM = 256, BK = 64, HALF = 128, HTB = HALF * BK * 2, STAGE_BYTES = 8 * HTB, NXCD = 8, WGM = 8;
__host__ __device__ __forceinline__ int lds_byte(int r, int c) { const int st = (r >> 4) * 2 + (c >> 5), rr = r & 15, cc = c & 31, ob = rr * 64 + cc * 2; return st * 1024 + (ob ^ (((ob >> 9) & 1) << 5)); }
__host__ __device__ __forceinline__ void stage_rc(int b, int& R, int& C) { const int st = b / 1024, sb = b % 1024, swz = sb ^ (((sb >> 9) & 1) << 5); R = (st >> 1) * 16 + swz / 64; C = (st & 1) * 32 + (swz % 64) / 2; }
__host__ __device__ __forceinline__ int perm32(int rho) { const int n = rho >> 4, i = rho & 15; return 8 * (i >> 2) + 4 * n + (i & 3); }
__device__ __forceinline__ unsigned cvt_pk_bf16(float lo, float hi) { unsigned r; asm volatile("v_cvt_pk_bf16_f32 %0, %1, %2" : "=v"(r) : "v"(lo), "v"(hi)); return r; }

struct Unit { const char* A; const char* B; const int* gidx; int pm, pn, aux; int gl; };

template <class Epi, class Sched, bool GATHER, bool FP8 = false>
__device__ __forceinline__ void gemm_phase(LAS unsigned char* lds, const int wid, const int K, const int lda, const int ldb, const Sched& S, const Epi& E, const int scale_w = 0x7F7F7F7F, const int scale_a = 0x7F7F7F7F, const int stagger_ticks = 0) {
    const int lane = lane_id(), tid = (wid << 6) | lane, wr = wid >> 2, wc = wid & 3, fr = lane & 15, fq = lane >> 4;
    const int nt = K / BK;
    int Ra[2], Ca[2]; unsigned voffB[2];
#pragma unroll
    for (int i = 0; i < 2; ++i) { int R, C; stage_rc(tid * 16 + i * 8192, R, C); Ra[i] = R; Ca[i] = C; const int Rb = (R & ~31) + perm32(R & 31); voffB[i] = (unsigned)(Rb * ldb + C) * 2u; }
    const size_t kstep = (size_t)(BK * 2);
    const size_t hstepB = (size_t)HALF * ldb * 2;
    const unsigned ldsw = (unsigned)wid * 1024u;
    const unsigned ldsb = (unsigned)(size_t)lds;
    const int aoff = lds_byte(wr * 64 + fr, fq * 8), boff = lds_byte(wc * 32 + fr, fq * 8);
#define PG8_SA(b, h) (((b) * 2 + (h)) * HTB)
#define PG8_SB(b, h) ((4 + (b) * 2 + (h)) * HTB)
#define PG8_STAGE(bufoff, gbase, voff) do { const unsigned long long _ub = (unsigned long long)uni_ptr((const char*)(gbase)); _Pragma("unroll") for (int _i = 0; _i < 2; ++_i) { \
        unsigned _keep; const unsigned _ld = (unsigned)__builtin_amdgcn_readfirstlane((int)(ldsb + (unsigned)(bufoff) + ldsw + (unsigned)_i * 8192u)); \
        asm volatile("s_nop 4\n\ts_mov_b32 %0, m0\n\ts_mov_b32 m0, %3\n\ts_nop 0\n\tglobal_load_lds_dwordx4 %1, %2\n\ts_mov_b32 m0, %0" : "=&s"(_keep) : "v"((voff)[_i]), "s"(_ub), "s"(_ld) : "memory"); } } while (0)
#define PG8_LDA(dst, b, h) do { _Pragma("unroll") for (int m = 0; m < 4; ++m) _Pragma("unroll") for (int k = 0; k < 2; ++k) dst[m][k] = *(const LAS bf16x8*)(lds + PG8_SA(b, h) + aoff + m * 2048 + k * 1024); } while (0)
#define PG8_LDB(dst, b, h) do { _Pragma("unroll") for (int n = 0; n < 2; ++n) _Pragma("unroll") for (int k = 0; k < 2; ++k) dst[n][k] = *(const LAS bf16x8*)(lds + PG8_SB(b, h) + boff + n * 2048 + k * 1024); } while (0)
#define PG8_MMA(ai, bj, At, Bt) do { __builtin_amdgcn_s_setprio(1); _Pragma("unroll") for (int m = 0; m < 4; ++m) _Pragma("unroll") for (int n = 0; n < 2; ++n) { \
        if constexpr (FP8) { mfma8_tied(acc[ai][bj][m][n], cat8(Bt[n][0], Bt[n][1]), cat8(At[m][0], At[m][1]), scale_w, scale_a); } \
        else { _Pragma("unroll") for (int k = 0; k < 2; ++k) acc[ai][bj][m][n] = __builtin_amdgcn_mfma_f32_16x16x32_bf16(Bt[n][k], At[m][k], acc[ai][bj][m][n], 0, 0, 0); } } \
        __builtin_amdgcn_s_setprio(0); } while (0)
#define PG8_WAIT_V(n) asm volatile("s_waitcnt vmcnt(" #n ")" ::: "memory")
#define PG8_WAIT_L(n) asm volatile("s_waitcnt lgkmcnt(" #n ")" ::: "memory")
#define PG8_BAR __builtin_amdgcn_s_barrier()
#define PG8_SCHED __builtin_amdgcn_sched_barrier(0)
    if (stagger_ticks > 0 && ((blockIdx.x >> 3) & 1)) { const unsigned long long t0 = __builtin_amdgcn_s_memrealtime(); while (__builtin_amdgcn_s_memrealtime() - t0 < (unsigned long long)stagger_ticks) __builtin_amdgcn_s_sleep(8); }
    Unit cur, nxt; int ui = 0;
    if (!S.next(0, cur)) return;
    unsigned offA[2][2], offN[2][2];
#pragma unroll
    for (int h = 0; h < 2; ++h)
#pragma unroll
        for (int i = 0; i < 2; ++i) {
            const int rr = h * HALF + Ra[i];
            const int row = GATHER ? cur.gidx[rr] : rr;
            offA[h][i] = (unsigned)(row * lda + Ca[i]) * 2u; offN[h][i] = offA[h][i];
        }
    f32x4 acc[2][2][4][2];
#pragma unroll
    for (int a = 0; a < 2; ++a)
#pragma unroll
        for (int b = 0; b < 2; ++b)
#pragma unroll
            for (int m = 0; m < 4; ++m)
#pragma unroll
                for (int n = 0; n < 2; ++n) acc[a][b][m][n] = (f32x4){0.f, 0.f, 0.f, 0.f};
    bf16x8 At[4][2], B0[2][2], B1[2][2];
    const char* cA = cur.A; const char* cB = cur.B;
    PG8_STAGE(PG8_SB(0, 0), cB, voffB); PG8_STAGE(PG8_SB(0, 1), cB + hstepB, voffB); PG8_STAGE(PG8_SA(0, 0), cA, offA[0]); PG8_STAGE(PG8_SA(0, 1), cA, offA[1]);
    if (wr == 1) PG8_BAR;
    PG8_WAIT_V(2); PG8_BAR;
    PG8_STAGE(PG8_SB(1, 0), cB + kstep, voffB); PG8_STAGE(PG8_SA(1, 0), cA + kstep, offA[0]); PG8_STAGE(PG8_SB(1, 1), cB + hstepB + kstep, voffB);
    PG8_WAIT_V(6); PG8_BAR;
    for (;;) {
        const bool has_next = S.next(ui + 1, nxt);
        const char* nA = has_next ? nxt.A : cA; const char* nB = has_next ? nxt.B : cB;
        if constexpr (GATHER) {
            if (has_next) {
#pragma unroll
                for (int h = 0; h < 2; ++h)
#pragma unroll
                    for (int i = 0; i < 2; ++i) offN[h][i] = (unsigned)(nxt.gidx[h * HALF + Ra[i]] * lda + Ca[i]) * 2u;
            }
        }
#pragma unroll 1
        for (int t = 0; t < nt; t += 2) {
            const bool last = (t == nt - 2);
            const char* a1 = cA + (size_t)(t + 1) * kstep;
            const char* a2 = last ? nA : cA + (size_t)(t + 2) * kstep; const char* b2 = last ? nB : cB + (size_t)(t + 2) * kstep;
            const char* a3 = a2 + kstep; const char* b3 = b2 + kstep;
            unsigned o2[2][2];
#pragma unroll
            for (int h = 0; h < 2; ++h)
#pragma unroll
                for (int i = 0; i < 2; ++i) o2[h][i] = (GATHER && last) ? offN[h][i] : offA[h][i];
            PG8_LDB(B0, 0, 0); PG8_LDB(B1, 0, 1); PG8_SCHED; PG8_LDA(At, 0, 0); PG8_STAGE(PG8_SA(1, 1), a1, offA[1]);
            PG8_WAIT_V(8); PG8_WAIT_L(0); PG8_BAR; PG8_MMA(0, 0, At, B0); PG8_MMA(0, 1, At, B1); PG8_BAR; PG8_SCHED;
            PG8_LDA(At, 0, 1); PG8_STAGE(PG8_SB(0, 0), b2, voffB); PG8_STAGE(PG8_SB(0, 1), b2 + hstepB, voffB); PG8_STAGE(PG8_SA(0, 0), a2, o2[0]);
            PG8_WAIT_V(8); PG8_WAIT_L(0); PG8_BAR; PG8_MMA(1, 0, At, B0); PG8_MMA(1, 1, At, B1); PG8_BAR; PG8_SCHED;
            PG8_LDB(B0, 1, 0); PG8_LDB(B1, 1, 1); PG8_SCHED; PG8_LDA(At, 1, 0); PG8_STAGE(PG8_SA(0, 1), a2, o2[1]);
            PG8_WAIT_V(8); PG8_WAIT_L(0); PG8_BAR; PG8_MMA(0, 0, At, B0); PG8_MMA(0, 1, At, B1); PG8_BAR; PG8_SCHED;
            PG8_LDA(At, 1, 1); PG8_STAGE(PG8_SB(1, 0), b3, voffB); PG8_STAGE(PG8_SB(1, 1), b3 + hstepB, voffB); PG8_STAGE(PG8_SA(1, 0), a3, o2[0]);
            PG8_WAIT_V(8); PG8_WAIT_L(0); PG8_BAR; PG8_MMA(1, 0, At, B0); PG8_MMA(1, 1, At, B1); PG8_BAR; PG8_SCHED;
        }
        if (wr == 0) PG8_BAR;
        if constexpr (FP8) asm volatile("s_nop 15\n\ts_nop 15" ::: "memory");
        E(acc, cur, wr, wc, fr, fq);
        if (!has_next) break;
#pragma unroll
        for (int a = 0; a < 2; ++a)
#pragma unroll
            for (int b = 0; b < 2; ++b)
#pragma unroll
                for (int m = 0; m < 4; ++m)
#pragma unroll
                    for (int n = 0; n < 2; ++n) acc[a][b][m][n] = (f32x4){0.f, 0.f, 0.f, 0.f};
        cur = nxt; cA = nA; cB = nB; ++ui;
        if constexpr (GATHER) {
#pragma unroll
            for (int h = 0; h < 2; ++h)
#pragma unroll
                for (int i = 0; i < 2; ++i) offA[h][i] = offN[h][i];
        }
        if (wr == 1) PG8_BAR;
    }
    PG8_WAIT_V(0);
    PG8_BAR;
#undef PG8_SA
#undef PG8_SB
#undef PG8_STAGE
#undef PG8_LDA
#undef PG8_LDB
#undef PG8_MMA
#undef PG8_WAIT_V
#undef PG8_WAIT_L
#undef PG8_BAR
#undef PG8_SCHED
}

struct DenseOrder {
    const char* A; const char* Bt; size_t a_tile_bytes, b_tile_bytes; int nM, nN, nwg, G, c;
    __device__ void init(const void* A_, const void* Bt_, int M, int N, int lda, int ldb, int G_, int c_) {
        A = (const char*)A_; Bt = (const char*)Bt_; nM = M / BM; nN = N / BM; nwg = nM * nN; G = G_; c = c_;
        a_tile_bytes = (size_t)BM * lda * 2; b_tile_bytes = (size_t)BM * ldb * 2;
    }
    __device__ __forceinline__ bool next(int i, Unit& u) const {
        const long L = (long)i * G + c; if (L >= nwg) return false;
        int wgid = (int)L; { const int q = nwg / NXCD, r = nwg % NXCD, xcd = wgid % NXCD, off = wgid / NXCD; wgid = (xcd < r ? xcd * (q + 1) : r * (q + 1) + (xcd - r) * q) + off; }
        const int nig = WGM * nN, gid = wgid / nig, fm = gid * WGM, gsz = (nM - fm) < WGM ? (nM - fm) : WGM;
        u.pm = fm + ((wgid % nig) % gsz); u.pn = (wgid % nig) / gsz; u.aux = 0; u.gidx = nullptr; u.gl = 0;
        u.A = A + (size_t)u.pm * a_tile_bytes; u.B = Bt + (size_t)u.pn * b_tile_bytes; return true;
    }
};
}

#ifndef OUTPROJ_FP8
#define OUTPROJ_FP8 0
#endif
#define XB_TMO      128
#define XB_XCNT(j)  (256  + 64 * (j))
#define XB_XSUB(j)  (1280 + 64 * (j))
#define XB_XGEN(j)  (2304 + 64 * (j))
#define XB_TOP      3328
#define XB_TOPGEN   3392
#define XCD_BAR_WORDS 3456
#define XB_SPIN_CAP (1u << 18)

__device__ __forceinline__ unsigned xb_ld(unsigned* p)              { return __hip_atomic_load(p, __ATOMIC_RELAXED, __HIP_MEMORY_SCOPE_AGENT); }
__device__ __forceinline__ unsigned xb_add(unsigned* p, unsigned v) { return __hip_atomic_fetch_add(p, v, __ATOMIC_RELAXED, __HIP_MEMORY_SCOPE_AGENT); }
__device__ __forceinline__ unsigned xb_xcc_id() { return (unsigned)__builtin_amdgcn_s_getreg((3 << 11) | 20) & 0xFu; }
#define XB_SPIN(cond, bar) do { unsigned _sp = 0; while (cond) { __builtin_amdgcn_s_sleep(1); \
    if ((++_sp & 255u) == 0u) { if (xb_ld(&(bar)[XB_TMO])) break; if (_sp > XB_SPIN_CAP) { atomicAdd(&(bar)[XB_TMO], 1u); break; } } } } while (0)

struct XcdBarrier {
    unsigned* bar; unsigned x; int w;
    volatile LAS unsigned* st;
};
__device__ __forceinline__ XcdBarrier xcd_barrier_post(unsigned* bar, volatile LAS unsigned* st, int wave) {
    XcdBarrier b; b.bar = bar; b.x = xb_xcc_id(); b.st = st; b.w = wave;
    if (wave == 0 && lane_id() == 0) (void)xb_add(&bar[XB_XCNT(b.x)], 1u);
    return b;
}
__device__ __forceinline__ void xcd_barrier_complete(unsigned* bar, unsigned x, unsigned& nloc, unsigned& nx) {
    const unsigned G = gridDim.x * gridDim.y * gridDim.z;
    unsigned sum, cnt, mine, sp = 0u;
    for (;;) {
        sum = 0u; cnt = 0u; mine = 0u;
#pragma unroll
        for (unsigned j = 0; j < 16; ++j) { const unsigned c = xb_ld(&bar[XB_XCNT(j)]); sum += c; cnt += (c > 0u) ? 1u : 0u; mine = (j == x) ? c : mine; }
        if (sum == G) break;
        __builtin_amdgcn_s_sleep(1);
        if ((++sp & 255u) == 0u) { if (xb_ld(&bar[XB_TMO])) break; if (sp > XB_SPIN_CAP) { atomicAdd(&bar[XB_TMO], 1u); break; } }
    }
    nloc = mine > 0u ? mine : 1u; nx = cnt > 0u ? cnt : 1u;
}
__device__ __forceinline__ void xcd_barrier(const XcdBarrier& b) {
    asm volatile("s_waitcnt vmcnt(0)" ::: "memory");
    __syncthreads();
    if (b.w == 0 && lane_id() == 0) {
        unsigned* bar = b.bar;
        __builtin_amdgcn_s_waitcnt(0);
        unsigned nloc = b.st[0], nx = b.st[1];
        if (nloc == 0u) { xcd_barrier_complete(bar, b.x, nloc, nx); b.st[0] = nloc; b.st[1] = nx; }
        const unsigned old = xb_add(&bar[XB_XSUB(b.x)], 1u);
        const unsigned gen = old / nloc;
        if (old + 1u == (gen + 1u) * nloc) {
            __builtin_amdgcn_fence(__ATOMIC_RELEASE, "agent");
            asm volatile("s_waitcnt vmcnt(0)" ::: "memory");
            const unsigned og = xb_add(&bar[XB_TOP], 1u);
            const unsigned tg = og / nx;
            if (og + 1u == (tg + 1u) * nx) xb_add(&bar[XB_TOPGEN], 1u);
            else XB_SPIN(xb_ld(&bar[XB_TOPGEN]) == tg, bar);
            __builtin_amdgcn_fence(__ATOMIC_ACQUIRE, "agent");
            xb_add(&bar[XB_XGEN(b.x)], 1u);
            asm volatile("s_waitcnt vmcnt(0)" ::: "memory");
        } else {
            XB_SPIN(xb_ld(&bar[XB_XGEN(b.x)]) == gen, bar);
            __builtin_amdgcn_fence(__ATOMIC_ACQUIRE, "agent");
            asm volatile("s_waitcnt vmcnt(0)" ::: "memory");
        }
    }
    __syncthreads();
}

constexpr size_t MiB = 1u << 20;
constexpr size_t WS_CTL = 0, CTL_ZERO_BYTES = 1 * MiB;
constexpr size_t WS_SMALL = 1 * MiB;
constexpr size_t WS_RSTD1 = WS_SMALL;
constexpr size_t WS_LOGI = WS_SMALL + 1 * MiB;
constexpr size_t WS_LOGF = WS_SMALL + 2 * MiB;
constexpr size_t WS_TOPI = WS_SMALL + 3 * MiB;
constexpr size_t WS_TOPG = WS_SMALL + 4 * MiB;
constexpr size_t WS_STOK = WS_SMALL + 5 * MiB;
constexpr size_t WS_SGATE = WS_SMALL + 6 * MiB;
constexpr size_t WS_ESTART = WS_SMALL + 7 * MiB;
constexpr size_t WS_BTIN = 17 * MiB;
constexpr size_t WS_BTOUT = 25 * MiB;
constexpr size_t WS_BT1 = 29 * MiB;
constexpr size_t WS_BT2 = 157 * MiB;
constexpr size_t WS_R1 = 221 * MiB;
constexpr size_t WS_XM = 285 * MiB;
constexpr size_t WS_SZ = 349 * MiB;
constexpr size_t WS_U = 413 * MiB;
constexpr size_t WS_Q = 477 * MiB;
constexpr size_t WS_YMIX = 477 * MiB;
constexpr size_t WS_ACT = 285 * MiB;
constexpr size_t WS_NEED = 925 * MiB;

constexpr int NWAVES = 8;
constexpr int RING_BYTES = 131072;
constexpr int LDSCTL_OFF = RING_BYTES;
constexpr int LDS_BYTES = 147456;
constexpr int CW_BAR = 4096;

struct MegaArgs {
    const float* in[27];
    float* out;
    unsigned char* ws;
    int ph_lo, ph_hi, li, pad;
};

__device__ __forceinline__ unsigned pk2(float lo, float hi) { return pg8::cvt_pk_bf16(lo, hi); }

__device__ __forceinline__ void unpack8(const u32x4 r, float (&f)[8]) {
    f[0] = __uint_as_float(r.x << 16); f[1] = __uint_as_float(r.x & 0xFFFF0000u); f[2] = __uint_as_float(r.y << 16); f[3] = __uint_as_float(r.y & 0xFFFF0000u);
    f[4] = __uint_as_float(r.z << 16); f[5] = __uint_as_float(r.z & 0xFFFF0000u); f[6] = __uint_as_float(r.w << 16); f[7] = __uint_as_float(r.w & 0xFFFF0000u);
}

__device__ __forceinline__ f32x4 up4(const u32x2 r) { f32x4 v; v.x = __uint_as_float(r.x << 16); v.y = __uint_as_float(r.x & 0xFFFF0000u); v.z = __uint_as_float(r.y << 16); v.w = __uint_as_float(r.y & 0xFFFF0000u); return v; }

__device__ __forceinline__ void p0_transpose_item(const float* W, int K, int N, bf16_t* WT, const float* ksc, int k0, int n0s, int n0d, LAS float* scr, int lane) {
    const int kr = lane >> 4, nq = lane & 15;
    f32x4 v[16];
#pragma unroll
    for (int i = 0; i < 16; ++i) v[i] = *(const f32x4*)(W + (size_t)(k0 + 4 * i + kr) * N + n0s + 4 * nq);
    if (ksc) {
#pragma unroll
        for (int i = 0; i < 16; ++i) v[i] = v[i] * ksc[k0 + 4 * i + kr];
    }
    const int c = lane >> 4, nl = lane & 15;
#pragma unroll
    for (int half = 0; half < 2; ++half) {
#pragma unroll
        for (int ii = 0; ii < 8; ++ii) *(LAS f32x4*)(scr + (4 * ii + kr) * 68 + 4 * nq) = v[8 * half + ii];
        asm volatile("s_waitcnt lgkmcnt(0)" ::: "memory");
#pragma unroll
        for (int j = 0; j < 4; ++j) { const int n = nl + 16 * j; const LAS float* sp = scr + (8 * c) * 68 + n;
            u32x4 o; o.x = pk2(sp[0 * 68], sp[1 * 68]); o.y = pk2(sp[2 * 68], sp[3 * 68]); o.z = pk2(sp[4 * 68], sp[5 * 68]); o.w = pk2(sp[6 * 68], sp[7 * 68]);
            *(u32x4*)(WT + (size_t)(n0d + n) * K + k0 + 32 * half + 8 * c) = o; }
        asm volatile("s_waitcnt lgkmcnt(0)" ::: "memory");
    }
}
__device__ __forceinline__ unsigned pk4_fp8(float a, float b, float c, float d) { int w = __builtin_amdgcn_cvt_pk_fp8_f32(a, b, 0, false); w = __builtin_amdgcn_cvt_pk_fp8_f32(c, d, w, true); return (unsigned)w; }
__device__ __forceinline__ void p0_transpose_item8(const float* W, int K, int N, unsigned char* WT, const float* ksc, float mul, int k0, int n0s, int n0d, LAS float* scr, int lane) {
    const int kr = lane >> 4, nq = lane & 15;
    f32x4 v[16];
#pragma unroll
    for (int i = 0; i < 16; ++i) v[i] = *(const f32x4*)(W + (size_t)(k0 + 4 * i + kr) * N + n0s + 4 * nq);
#pragma unroll
    for (int i = 0; i < 16; ++i) v[i] = v[i] * (ksc ? ksc[k0 + 4 * i + kr] * mul : mul);
    const int c = lane >> 4, nl = lane & 15;
#pragma unroll
    for (int half = 0; half < 2; ++half) {
#pragma unroll
        for (int ii = 0; ii < 8; ++ii) *(LAS f32x4*)(scr + (4 * ii + kr) * 68 + 4 * nq) = v[8 * half + ii];
        asm volatile("s_waitcnt lgkmcnt(0)" ::: "memory");
#pragma unroll
        for (int j = 0; j < 4; ++j) { const int n = nl + 16 * j; const LAS float* sp = scr + (8 * c) * 68 + n;
            u32x2 o; o.x = pk4_fp8(sp[0 * 68], sp[1 * 68], sp[2 * 68], sp[3 * 68]); o.y = pk4_fp8(sp[4 * 68], sp[5 * 68], sp[6 * 68], sp[7 * 68]);
            *(u32x2*)(WT + (size_t)(n0d + n) * K + k0 + 32 * half + 8 * c) = o; }
        asm volatile("s_waitcnt lgkmcnt(0)" ::: "memory");
    }
}
__device__ __forceinline__ int inproj_src_col(int nd) { if (nd < 2048) return nd; const int pn = (nd >> 8) - 8, lc = nd & 255; return 2048 + (lc >> 7) * 1024 + 128 * pn + (lc & 127); }
__device__ __forceinline__ int w1_src_col(int nd) { const int pn = nd >> 8, lc = nd & 255; return (lc >> 7) * 1024 + 128 * pn + (lc & 127); }

__device__ __forceinline__ void p0_prologue(const MegaArgs& a, LAS unsigned char* lds, int gw, int NGW, int wave, int lane) {
    LAS float* scr = (LAS float*)(lds + wave * 16384);
    unsigned char* ws = a.ws;
    const float* x = a.in[0];
    {
        bf16_t* xbf = (bf16_t*)(ws + WS_R1); float* rstd1 = (float*)(ws + WS_RSTD1);
        for (int m = gw; m < NTOK; m += NGW) {
            const f32x4* xr = (const f32x4*)(x + (size_t)m * DM) + lane;
            f32x4 v[4]; float s = 0.f;
#pragma unroll
            for (int j = 0; j < 4; ++j) { v[j] = xr[64 * j]; s += (v[j].x * v[j].x + v[j].y * v[j].y) + (v[j].z * v[j].z + v[j].w * v[j].w); }
            s = wave_sum(s);
            if (lane == 0) rstd1[m] = rsqrtf(s * (1.0f / DM) + EPSV);
            unsigned long long* o8 = (unsigned long long*)(xbf + (size_t)m * DM) + lane;
#pragma unroll
            for (int j = 0; j < 4; ++j) o8[64 * j] = (unsigned long long)pk2(v[j].x, v[j].y) | ((unsigned long long)pk2(v[j].z, v[j].w) << 32);
        }
    }
    constexpr int I_IN = (1024 / 64) * (4096 / 64);
    for (int it = gw; it < I_IN; it += NGW) { const int kb = it / 64, nb = it % 64; p0_transpose_item(a.in[2], 1024, 4096, (bf16_t*)(ws + WS_BTIN), a.in[1], 64 * kb, inproj_src_col(64 * nb), 64 * nb, scr, lane); }
}
__device__ __forceinline__ void p0b_weights(const MegaArgs& a, LAS unsigned char* lds, int gw, int NGW, int wave, int lane) {
    LAS float* scr = (LAS float*)(lds + wave * 16384);
    unsigned char* ws = a.ws;
    constexpr int I_OUT = (2048 / 64) * (1024 / 64);
    constexpr int I_W1 = 32 * (1024 / 64) * (2048 / 64);
    constexpr int I_W2 = 32 * (1024 / 64) * (1024 / 64);
    constexpr int NITEMS = I_OUT + I_W1 + I_W2;
    for (int it = gw; it < NITEMS; it += NGW) {
        int r = it;
        if (r < I_OUT) { const int kb = r / 16, nb = r % 16;
#if OUTPROJ_FP8
            p0_transpose_item8(a.in[18], 2048, 1024, ws + WS_BTOUT, nullptr, 32.0f, 64 * kb, 64 * nb, 64 * nb, scr, lane);
#else
            p0_transpose_item(a.in[18], 2048, 1024, (bf16_t*)(ws + WS_BTOUT), nullptr, 64 * kb, 64 * nb, 64 * nb, scr, lane);
#endif
            continue; }
        r -= I_OUT;
        if (r < I_W1) { const int e = r / 512, rr = r % 512, kb = rr / 32, nb = rr % 32;
            p0_transpose_item8(a.in[22] + (size_t)e * 1024 * 2048, 1024, 2048, ws + WS_BT1 + (size_t)e * 2048 * 1024, a.in[19], 32.0f, 64 * kb, w1_src_col(64 * nb), 64 * nb, scr, lane); continue; }
        r -= I_W1;
        { const int e = r / 256, rr = r % 256, kb = rr / 16, nb = rr % 16;
            p0_transpose_item8(a.in[24] + (size_t)e * 1024 * 1024, 1024, 1024, ws + WS_BT2 + (size_t)e * 1024 * 1024, nullptr, 32.0f, 64 * kb, 64 * nb, 64 * nb, scr, lane); }
    }
}

struct EpiInProj {
    const float* rstd; bf16_t* xm; bf16_t* sz; bf16_t* u; int variant;
    __device__ __forceinline__ void operator()(const f32x4 (&acc)[2][2][4][2], const pg8::Unit& un, int wr, int wc, int fr, int fq) const {
        if (variant & 8) return;
        const int row0 = un.pm * 256 + wr * 64 + fr;
        const int cl = wc * 32 + 8 * fq;
        float rsv[2][4];
#pragma unroll
        for (int ai = 0; ai < 2; ++ai)
#pragma unroll
            for (int m = 0; m < 4; ++m) rsv[ai][m] = rstd[row0 + ai * 128 + m * 16];
#pragma unroll
        for (int ai = 0; ai < 2; ++ai)
#pragma unroll
            for (int m = 0; m < 4; ++m) {
                const int row = row0 + ai * 128 + m * 16;
                const float rs = rsv[ai][m];
                if (un.pn < 8) {
                    bf16_t* dst = (un.pn < 4 ? xm : sz) + (size_t)row * DM + (un.pn & 3) * 256 + cl;
#pragma unroll
                    for (int bj = 0; bj < 2; ++bj) {
                        f32x4 v0 = acc[ai][bj][m][0] * rs, v1 = acc[ai][bj][m][1] * rs;
                        if (un.pn >= 4) {
#pragma unroll
                            for (int j = 0; j < 4; ++j) { v0[j] = siluf_(v0[j]); v1[j] = siluf_(v1[j]); }
                        }
                        u32x4 w; w.x = pg8::cvt_pk_bf16(v0[0], v0[1]); w.y = pg8::cvt_pk_bf16(v0[2], v0[3]); w.z = pg8::cvt_pk_bf16(v1[0], v1[1]); w.w = pg8::cvt_pk_bf16(v1[2], v1[3]);
                        if (!(variant & 4)) *(u32x4*)(dst + bj * 128) = w;
                    }
                } else {
                    bf16_t* dst = u + (size_t)row * DM + (un.pn - 8) * 128 + cl;
                    f32x4 o0, o1;
#pragma unroll
                    for (int j = 0; j < 4; ++j) {
                        o0[j] = (acc[ai][0][m][0][j] * rs) * sigmoidf_(acc[ai][1][m][0][j] * rs);
                        o1[j] = (acc[ai][0][m][1][j] * rs) * sigmoidf_(acc[ai][1][m][1][j] * rs);
                    }
                    u32x4 w; w.x = pg8::cvt_pk_bf16(o0[0], o0[1]); w.y = pg8::cvt_pk_bf16(o0[2], o0[3]); w.z = pg8::cvt_pk_bf16(o1[0], o1[1]); w.w = pg8::cvt_pk_bf16(o1[2], o1[3]);
                    if (!(variant & 4)) *(u32x4*)dst = w;
                }
            }
    }
};

constexpr size_t WS_WGCNT = WS_SMALL + 8 * MiB;
constexpr size_t WS_ASGE = WS_SMALL + 9 * MiB;
constexpr size_t WS_ASGR = WS_SMALL + 10 * MiB;
constexpr size_t WS_ASGG = WS_SMALL + 11 * MiB;
constexpr size_t WS_RSTD2 = WS_SMALL + 12 * MiB;
constexpr size_t WS_SRSTD = WS_SMALL + 13 * MiB;
constexpr size_t WS_TOKSLOT = WS_SMALL + 14 * MiB;
constexpr size_t WS_TILEEXP = WS_SMALL + 15 * MiB;
constexpr size_t WS_HBF = WS_R1;
constexpr size_t WS_YROWS = 605 * MiB;
constexpr size_t WS_HB16 = 750 * MiB;
constexpr int NSLOT = NASSIGN + NEXP * 256;
constexpr int TOK_PER_WG = NTOK / 256;

constexpr size_t WS_WRH = WS_SMALL + 576 * 1024;
constexpr size_t WS_WRL = WS_SMALL + 640 * 1024;
__device__ __forceinline__ void p0_router_tables(const MegaArgs& a, int gw, int NGW, int lane) {
    const float* nfw = a.in[19]; const float* wr = a.in[20];
    bf16_t* wh = (bf16_t*)(a.ws + WS_WRH); bf16_t* wl = (bf16_t*)(a.ws + WS_WRL);
    for (int idx = gw * 64 + lane; idx < 32 * 1024; idx += NGW * 64) {
        const int e = idx >> 10, k = idx & 1023;
        const float w = nfw[k] * wr[(size_t)k * 32 + e];
        const bf16_t hi = f2bf(w);
        wh[idx] = hi; wl[idx] = f2bf(w - bf2f(hi));
    }
}
constexpr int RT_LDS_OFF = LDSCTL_OFF + 5120;
struct RtGrp { u32x4 h[8]; };
__device__ __forceinline__ void rt_load_grp(const bf16_t* hrow, int k0, RtGrp& B) {
#pragma unroll
    for (int q = 0; q < 8; ++q) B.h[q] = *(const u32x4*)(hrow + k0 + 32 * q);
}
__device__ __forceinline__ void rt_step(const LAS bf16_t* whl, const LAS bf16_t* wll, int col, int kk, const u32x4 hraw, f32x4& acc0, f32x4& acc1, float& ssq) {
    float v[8]; unpack8(hraw, v);
#pragma unroll
    for (int i = 0; i < 8; ++i) ssq += v[i] * v[i];
    const bf16x8 ah = __builtin_bit_cast(bf16x8, hraw);
    const int ks = kk ^ (col << 3);
    const u32x4 bh0 = *(const LAS u32x4*)(whl + col * 1024 + ks), bh1 = *(const LAS u32x4*)(whl + (col + 16) * 1024 + ks);
    const u32x4 bl0 = *(const LAS u32x4*)(wll + col * 1024 + ks), bl1 = *(const LAS u32x4*)(wll + (col + 16) * 1024 + ks);
    acc0 = __builtin_amdgcn_mfma_f32_16x16x32_bf16(ah, __builtin_bit_cast(bf16x8, bh0), acc0, 0, 0, 0);
    acc0 = __builtin_amdgcn_mfma_f32_16x16x32_bf16(ah, __builtin_bit_cast(bf16x8, bl0), acc0, 0, 0, 0);
    acc1 = __builtin_amdgcn_mfma_f32_16x16x32_bf16(ah, __builtin_bit_cast(bf16x8, bh1), acc1, 0, 0, 0);
    acc1 = __builtin_amdgcn_mfma_f32_16x16x32_bf16(ah, __builtin_bit_cast(bf16x8, bl1), acc1, 0, 0, 0);
}
template <int CTRL> __device__ __forceinline__ void argmax_step(float& v, int& i) {
    const float ov = dpp_mov_f<CTRL>(v); const int oi = __builtin_amdgcn_update_dpp(0, i, CTRL, 0xf, 0xf, false);
    const bool take = (ov > v) || (ov == v && oi < i);
    v = take ? ov : v; i = take ? oi : i;
}
__device__ __forceinline__ void phase_router(const MegaArgs& a, LAS unsigned char* lds, int tid, int lane, int wave) {
    unsigned char* ws = a.ws;
    const bf16_t* hbuf = (const bf16_t*)(ws + WS_HB16);
    const float* br = a.in[21];
    const bf16_t* wh = (const bf16_t*)(ws + WS_WRH); const bf16_t* wl = (const bf16_t*)(ws + WS_WRL);
    float* rstd2 = (float*)(ws + WS_RSTD2);
    int* wgcnt = (int*)(ws + WS_WGCNT); int* asg_e = (int*)(ws + WS_ASGE); int* asg_r = (int*)(ws + WS_ASGR); float* asg_g = (float*)(ws + WS_ASGG);
    LAS int* topi_l = (LAS int*)(lds + RT_LDS_OFF);
    LAS float* topg_l = (LAS float*)(lds + RT_LDS_OFF + 2048);
    LAS int* rank_l = (LAS int*)(lds + RT_LDS_OFF + 4096);
    LAS float* rstd_l = (LAS float*)(lds + RT_LDS_OFF + 6144);
    LAS bf16_t* whl = (LAS bf16_t*)lds;
    LAS bf16_t* wll = (LAS bf16_t*)(lds + 65536);
    for (int i = tid; i < 8192; i += NWAVES * 64) { const int r = i >> 7, c8 = i & 127;
        *(LAS u32x4*)(lds + 16 * ((r << 7) + (c8 ^ (r & 15)))) = *(const u32x4*)((const unsigned char*)wh + 16 * (size_t)i); }
    __syncthreads();
    const int b = blockIdx.x;
    const int col = lane & 15, kq = lane >> 4;
    {
        const int t = b * TOK_PER_WG + wave * 16 + col;
        const bf16_t* hrow = hbuf + (size_t)t * DM + 8 * kq;
        f32x4 acc0 = (f32x4){0.f, 0.f, 0.f, 0.f}, acc1 = acc0; float ssq = 0.f;
        RtGrp A, B;
        rt_load_grp(hrow, 0, A);
        for (int g = 0; g < 4; g += 2) {
            rt_load_grp(hrow, 256 * (g + 1), B);
#pragma unroll
            for (int q = 0; q < 8; ++q) rt_step(whl, wll, col, 256 * g + 32 * q + 8 * kq, A.h[q], acc0, acc1, ssq);
            if (g + 2 < 4) rt_load_grp(hrow, 256 * (g + 2), A);
#pragma unroll
            for (int q = 0; q < 8; ++q) rt_step(whl, wll, col, 256 * (g + 1) + 32 * q + 8 * kq, B.h[q], acc0, acc1, ssq);
        }
        ssq += __builtin_bit_cast(float, __builtin_amdgcn_ds_swizzle(__builtin_bit_cast(int, ssq), 0x401F));
        { const auto rr = __builtin_amdgcn_permlane32_swap(__float_as_uint(ssq), __float_as_uint(ssq), false, false); ssq = __uint_as_float(rr[0]) + __uint_as_float(rr[1]); }
        const float rs = rsqrtf(ssq * (1.0f / DM) + EPSV);
        if (kq == 0) { rstd_l[wave * 16 + col] = rs; rstd2[t] = rs; }
        asm volatile("s_waitcnt lgkmcnt(0)" ::: "memory");
        const float b0 = br[col], b1 = br[col + 16];
#pragma unroll
        for (int r = 0; r < 4; ++r) {
            const float rsr = rstd_l[wave * 16 + 4 * kq + r];
            float v0 = acc0[r] * rsr + b0, v1 = acc1[r] * rsr + b1;
            int sel[4]; float val[4];
#pragma unroll
            for (int it = 0; it < 4; ++it) {
                float bv = (v1 > v0) ? v1 : v0; int bi = (v1 > v0) ? col + 16 : col;
                argmax_step<0xB1>(bv, bi); argmax_step<0x4E>(bv, bi); argmax_step<0x124>(bv, bi); argmax_step<0x128>(bv, bi);
                sel[it] = bi; val[it] = bv;
                if (bi == col) v0 = -3.0e38f;
                if (bi == col + 16) v1 = -3.0e38f;
            }
            float ex[4], sum = 0.f;
#pragma unroll
            for (int it = 0; it < 4; ++it) { ex[it] = __expf(val[it] - val[0]); sum += ex[it]; }
            const float inv = 1.0f / sum;
            if (col == 0) {
                const int tw = wave * 16 + 4 * kq + r;
#pragma unroll
                for (int it = 0; it < 4; ++it) { topi_l[tw * 4 + it] = sel[it]; topg_l[tw * 4 + it] = ex[it] * inv; }
            }
        }
    }
    __syncthreads();
    if (wave == 0) {
        int base = 0;
        for (int ch = 0; ch < 8; ++ch) {
            const int E = topi_l[ch * 64 + lane];
            int myrank = 0;
#pragma unroll
            for (int e = 0; e < 32; ++e) {
                const unsigned long long m = __ballot(E == e);
                const int be = __builtin_amdgcn_readlane(base, e);
                if (E == e) myrank = be + __builtin_popcountll(m & ((1ull << lane) - 1ull));
                if (lane == e) base += __builtin_popcountll(m);
            }
            rank_l[ch * 64 + lane] = myrank;
        }
        if (lane < 32) wgcnt[b * 32 + lane] = base;
    }
    __syncthreads();
    {
        int i = tid; asm volatile("" : "+v"(i));
        const int aidx = b * TOK_PER_WG * 4 + i;
        asg_e[aidx] = topi_l[i]; asg_r[aidx] = rank_l[i]; asg_g[aidx] = topg_l[i];
    }
}

__device__ __forceinline__ void phase_slots(const MegaArgs& a, LAS unsigned char* lds, int tid) {
    unsigned char* ws = a.ws;
    const int* wgcnt = (const int*)(ws + WS_WGCNT); const int* asg_e = (const int*)(ws + WS_ASGE); const int* asg_r = (const int*)(ws + WS_ASGR); const float* asg_g = (const float*)(ws + WS_ASGG);
    const float* rstd2 = (const float*)(ws + WS_RSTD2);
    int* slot_tok = (int*)(ws + WS_STOK); float* slot_gate = (float*)(ws + WS_SGATE); float* slot_rstd = (float*)(ws + WS_SRSTD);
    int* tok_slot = (int*)(ws + WS_TOKSLOT); int* tile_exp = (int*)(ws + WS_TILEEXP);
    LAS int* tot = (LAS int*)lds; LAS int* bef = tot + 32; LAS int* tstart = bef + 32;
    const int b = blockIdx.x;
    if (tid < 32) {
        int t = 0, bf = 0;
        for (int bb = 0; bb < 256; ++bb) { const int c = wgcnt[bb * 32 + tid]; t += c; if (bb < b) bf += c; }
        tot[tid] = t; bef[tid] = bf;
    }
    __syncthreads();
    if (tid == 0) { int ts = 0; for (int e = 0; e < 32; ++e) { tstart[e] = ts; ts += (tot[e] + 255) >> 8; } tstart[32] = ts; }
    __syncthreads();
    {
        int tid_o = tid; asm volatile("" : "+v"(tid_o));
        const int aidx = b * TOK_PER_WG * 4 + tid_o;
        const int e = asg_e[aidx];
        const int slot = 256 * tstart[e] + bef[e] + asg_r[aidx];
        const int tk = aidx >> 2;
        slot_tok[slot] = tk; slot_gate[slot] = asg_g[aidx]; slot_rstd[slot] = rstd2[tk]; tok_slot[aidx] = slot;
    }
    if (b < 32) {
        const int e = b; const int s0 = 256 * tstart[e] + tot[e], s1 = 256 * tstart[e + 1];
        for (int s = s0 + tid; s < s1; s += NWAVES * 64) { slot_tok[s] = 0; slot_gate[s] = 0.f; slot_rstd[s] = 0.f; }
    }
    if (b == 0) {
        if (tid < 32) for (int t = tstart[tid]; t < tstart[tid + 1]; ++t) tile_exp[t] = tid;
        if (tid == 0) tile_exp[2048] = tstart[32];
    }
}

struct MoeOrder {
    const char* A; const char* Bt; const int* gidx; const int* tile_exp; size_t a_tile_bytes, b_exp_bytes, b_tile_bytes; int T, nN, group, c;
    __device__ __forceinline__ bool next(int i, pg8::Unit& u) const {
        const int x = c & 7, j = c >> 3;
        const int tile = (i * 8 + x) * group + (j % group);
        if (tile >= T) return false;
        const int e = __builtin_amdgcn_readfirstlane(tile_exp[tile]);
        u.pm = tile; u.pn = j / group; u.aux = e; u.gl = 0;
        u.gidx = gidx ? gidx + 256 * tile : nullptr;
        u.A = gidx ? A : A + (size_t)tile * a_tile_bytes;
        u.B = Bt + (size_t)e * b_exp_bytes + (size_t)u.pn * b_tile_bytes;
        return true;
    }
};

struct EpiMoe1 {
    const float* srstd; const float* b1; unsigned char* act; int variant;
    __device__ __forceinline__ void operator()(const f32x4 (&acc)[2][2][4][2], const pg8::Unit& un, int wr, int wc, int fr, int fq) const {
        if (variant & 8) return;
        const int e = un.aux;
        const int cl = un.pn * 128 + wc * 32 + 8 * fq;
        f32x4 bg[2], bl[2];
#pragma unroll
        for (int n = 0; n < 2; ++n) { bg[n] = *(const f32x4*)(b1 + (size_t)e * 2048 + cl + 4 * n); bl[n] = *(const f32x4*)(b1 + (size_t)e * 2048 + 1024 + cl + 4 * n); }
        const int slot0 = un.pm * 256 + wr * 64 + fr;
        float rsv[2][4];
#pragma unroll
        for (int ai = 0; ai < 2; ++ai)
#pragma unroll
            for (int m = 0; m < 4; ++m) rsv[ai][m] = srstd[slot0 + ai * 128 + m * 16];
#pragma unroll
        for (int ai = 0; ai < 2; ++ai)
#pragma unroll
            for (int m = 0; m < 4; ++m) {
                const int slot = slot0 + ai * 128 + m * 16;
                const float rs = rsv[ai][m];
                f32x4 o[2];
#pragma unroll
                for (int n = 0; n < 2; ++n)
#pragma unroll
                    for (int j = 0; j < 4; ++j) {
                        const float g = acc[ai][0][m][n][j] * rs + bg[n][j];
                        const float l = acc[ai][1][m][n][j] * rs + bl[n][j];
                        const float xg = fminf(g, 7.0f);
                        const float xl = fminf(fmaxf(l, -7.0f), 7.0f);
                        o[n][j] = xg * sigmoidf_(1.702f * xg) * (xl + 1.0f);
                    }
                u32x2 w; w.x = pk4_fp8(o[0][0], o[0][1], o[0][2], o[0][3]); w.y = pk4_fp8(o[1][0], o[1][1], o[1][2], o[1][3]);
                *(u32x2*)(act + (size_t)slot * DM + cl) = w;
            }
    }
};
struct EpiMoe2 {
    const float* sgate; const float* b2; unsigned char* yrows;
    __device__ __forceinline__ void operator()(const f32x4 (&acc)[2][2][4][2], const pg8::Unit& un, int wr, int wc, int fr, int fq) const {
        const int e = un.aux;
        const int c0 = un.pn * 256 + wc * 32 + 8 * fq;
        f32x4 bv[2][2];
#pragma unroll
        for (int bj = 0; bj < 2; ++bj)
#pragma unroll
            for (int n = 0; n < 2; ++n) bv[bj][n] = *(const f32x4*)(b2 + (size_t)e * DM + c0 + bj * 128 + 4 * n);
        const int slot0 = un.pm * 256 + wr * 64 + fr;
        float gtv[2][4];
#pragma unroll
        for (int ai = 0; ai < 2; ++ai)
#pragma unroll
            for (int m = 0; m < 4; ++m) gtv[ai][m] = sgate[slot0 + ai * 128 + m * 16] * 16.0f;
#pragma unroll
        for (int ai = 0; ai < 2; ++ai)
#pragma unroll
            for (int m = 0; m < 4; ++m) {
                const int slot = slot0 + ai * 128 + m * 16;
                const float gt = gtv[ai][m];
#pragma unroll
                for (int bj = 0; bj < 2; ++bj) {
                    const f32x4 v0 = (acc[ai][bj][m][0] + bv[bj][0]) * gt, v1 = (acc[ai][bj][m][1] + bv[bj][1]) * gt;
                    u32x2 w; w.x = pk4_fp8(v0[0], v0[1], v0[2], v0[3]); w.y = pk4_fp8(v1[0], v1[1], v1[2], v1[3]);
                    *(u32x2*)(yrows + (size_t)slot * DM + c0 + bj * 128) = w;
                }
            }
    }
};

struct FinBuf { u32x2 h[4]; unsigned y[4][4]; };
__device__ __forceinline__ void fin_load(const bf16_t* hbuf, const unsigned char* yrows, const int slots, int kk, int t, int lane, FinBuf& B) {
    const u32x2* hp = (const u32x2*)(hbuf + (size_t)t * DM) + lane;
#pragma unroll
    for (int j = 0; j < 4; ++j) B.h[j] = hp[64 * j];
#pragma unroll
    for (int r = 0; r < 4; ++r) {
        const int slot = __builtin_amdgcn_readlane(slots, 4 * kk + r);
        const unsigned* yp = (const unsigned*)(yrows + (size_t)slot * DM) + lane;
#pragma unroll
        for (int j = 0; j < 4; ++j) B.y[r][j] = yp[64 * j];
    }
}
__device__ __forceinline__ void fin_compute(float* obuf, const float* fw, int t, int lane, const FinBuf& B) {
    f32x4 v[4];
#pragma unroll
    for (int j = 0; j < 4; ++j) {
        v[j] = up4(B.h[j]);
#pragma unroll
        for (int r = 0; r < 4; ++r) {
            const unsigned w = B.y[r][j];
            const f32x2 lo = __builtin_amdgcn_cvt_pk_f32_fp8(w, false), hi = __builtin_amdgcn_cvt_pk_f32_fp8(w, true);
            v[j].x += lo.x * 0.0625f; v[j].y += lo.y * 0.0625f; v[j].z += hi.x * 0.0625f; v[j].w += hi.y * 0.0625f;
        }
    }
    float s = 0.f;
#pragma unroll
    for (int j = 0; j < 4; ++j) s += (v[j].x * v[j].x + v[j].y * v[j].y) + (v[j].z * v[j].z + v[j].w * v[j].w);
    s = wave_sum(s);
    const float rs = rsqrtf(s * (1.0f / DM) + EPSV);
    f32x4* hp = (f32x4*)(obuf + (size_t)t * DM) + lane;
#pragma unroll
    for (int j = 0; j < 4; ++j) {
        const f32x4 w = *((const f32x4*)fw + lane + 64 * j);
        hp[64 * j] = v[j] * rs * w;
    }
}
__device__ __forceinline__ void phase_final(const MegaArgs& a, int gw, int NGW, int lane) {
    unsigned char* ws = a.ws;
    float* obuf = a.out; const float* fw = a.in[26]; const bf16_t* hbuf = (const bf16_t*)(ws + WS_HB16);
    const unsigned char* yrows = ws + WS_YROWS; const int* tok_slot = (const int*)(ws + WS_TOKSLOT);
    int slots = 0;
    { const int tk = gw + (lane >> 2) * NGW; if (tk < NTOK) slots = __hip_atomic_load(tok_slot + (size_t)tk * 4 + (lane & 3), __ATOMIC_RELAXED, __HIP_MEMORY_SCOPE_AGENT); }
    FinBuf A, B;
    int t = gw, kk = 0;
    if (t < NTOK) fin_load(hbuf, yrows, slots, 0, t, lane, A);
    for (; t < NTOK; t += 2 * NGW, kk += 2) {
        const int t2 = t + NGW;
        if (t2 < NTOK) fin_load(hbuf, yrows, slots, kk + 1, t2, lane, B);
        fin_compute(obuf, fw, t, lane, A);
        if (t2 < NTOK) {
            const int t3 = t2 + NGW;
            if (t3 < NTOK) fin_load(hbuf, yrows, slots, kk + 2, t3, lane, A);
            fin_compute(obuf, fw, t2, lane, B);
        }
    }
}

#ifndef OUTPROJ_FP8
#define OUTPROJ_FP8 0
#endif
constexpr int CT = 16;
constexpr int CONV_RED_OFF = LDSCTL_OFF + 4096;
__device__ __forceinline__ void conv_load_rows(const __amdgpu_buffer_rsrc_t urs, int t0, int tid, unsigned (&R)[CT + 30]) {
    const int s0 = t0 & (SEQ - 1);
#pragma unroll
    for (int r = 0; r < CT + 30; ++r) {
        const int sp = s0 - 30 + r;
        R[r] = (sp >= 0) ? (unsigned)__builtin_amdgcn_raw_buffer_load_b32(urs, tid * 4, (t0 - 30 + r) * 2048, 0) : 0u;
    }
}
__device__ __forceinline__ void phase_conv31(const MegaArgs& a, LAS unsigned char* lds, int tid, int lane, int wave, int G) {
    unsigned char* ws = a.ws;
    const __amdgpu_buffer_rsrc_t urs = __builtin_amdgcn_make_buffer_rsrc((void*)(ws + WS_U), 0, NTOK * 2048, 0x00020000);
    const float* cw = a.in[14]; const float* cb = a.in[15]; const float* nw = a.in[16]; const float* nb = a.in[17];
#if OUTPROJ_FP8
    unsigned short* ymix = (unsigned short*)(ws + WS_YMIX);
#else
    unsigned* ymix = (unsigned*)(ws + WS_YMIX);
#endif
    LAS float* wl = (LAS float*)lds;
    LAS float* red = (LAS float*)(lds + CONV_RED_OFF);
    LAS float* stat = red + 32 * 32;
    for (int i = tid; i < 31 * 256; i += NWAVES * 64) *(LAS f32x4*)(wl + 4 * i) = *(const f32x4*)(cw + 4 * i);
    const f32x2 bias = *(const f32x2*)(cb + 2 * tid);
    const f32x2 gw2 = *(const f32x2*)(nw + 2 * tid);
    const f32x2 gb2 = *(const f32x2*)(nb + 2 * tid);
    __syncthreads();
    unsigned R[CT + 30];
    int it = blockIdx.x;
    if (it < NTOK / CT) conv_load_rows(urs, it * CT, tid, R);
    for (; it < NTOK / CT; it += G) {
        const int t0 = it * CT;
        f32x2 uf[CT + 30];
#pragma unroll
        for (int r = 0; r < CT + 30; ++r) { uf[r].x = __uint_as_float(R[r] << 16); uf[r].y = __uint_as_float(R[r] & 0xFFFF0000u); }
        if (it + G < NTOK / CT) conv_load_rows(urs, (it + G) * CT, tid, R);
        f32x2 acc[CT];
#pragma unroll
        for (int t = 0; t < CT; ++t) acc[t] = bias;
#pragma unroll
        for (int k = 0; k < 31; ++k) {
            const f32x2 w = *(const LAS f32x2*)(wl + k * 1024 + 2 * tid);
#pragma unroll
            for (int t = 0; t < CT; ++t) acc[t] = __builtin_elementwise_fma(w, uf[t + k], acc[t]);
        }
        float acc0[CT], acc1[CT];
#pragma unroll
        for (int t = 0; t < CT; ++t) { acc0[t] = acc[t].x; acc1[t] = acc[t].y; }
        float sm[CT], sq[CT];
#pragma unroll
        for (int t = 0; t < CT; ++t) { sm[t] = acc0[t] + acc1[t]; sq[t] = acc0[t] * acc0[t] + acc1[t] * acc1[t]; }
#pragma unroll
        for (int t = 0; t < CT; ++t) {
            sm[t] += dpp_mov_f<0xB1>(sm[t]); sm[t] += dpp_mov_f<0x4E>(sm[t]); sm[t] += dpp_mov_f<0x124>(sm[t]); sm[t] += dpp_mov_f<0x128>(sm[t]);
            sq[t] += dpp_mov_f<0xB1>(sq[t]); sq[t] += dpp_mov_f<0x4E>(sq[t]); sq[t] += dpp_mov_f<0x124>(sq[t]); sq[t] += dpp_mov_f<0x128>(sq[t]);
        }
        __syncthreads();
        if ((lane & 15) == 0) {
            const int pr = wave * 4 + (lane >> 4);
#pragma unroll
            for (int t = 0; t < CT; ++t) { red[pr * 32 + t] = sm[t]; red[pr * 32 + CT + t] = sq[t]; }
        }
        __syncthreads();
        if (wave == 0 && lane < 32) {
            float s2 = 0.f;
#pragma unroll
            for (int p2 = 0; p2 < 32; ++p2) s2 += red[p2 * 32 + lane];
            const float other = __shfl_xor(s2, 16);
            if (lane < 16) {
                const float mean = s2 * (1.0f / DM);
                const float var = fmaxf(other * (1.0f / DM) - mean * mean, 0.f);
                stat[2 * lane] = mean; stat[2 * lane + 1] = rsqrtf(var + EPSV);
            }
        }
        __syncthreads();
#pragma unroll
        for (int t = 0; t < CT; ++t) {
            const f32x2 ms = *(const LAS f32x2*)(stat + 2 * t);
            const float y0 = siluf_((acc0[t] - ms.x) * ms.y * gw2.x + gb2.x);
            const float y1 = siluf_((acc1[t] - ms.x) * ms.y * gw2.y + gb2.y);
#if OUTPROJ_FP8
            ymix[(size_t)(t0 + t) * 1024 + 512 + tid] = (unsigned short)__builtin_amdgcn_cvt_pk_fp8_f32(y0, y1, 0, false);
#else
            ymix[(size_t)(t0 + t) * 1024 + 512 + tid] = pk2(y0, y1);
#endif
        }
    }
    __syncthreads();
}

struct YmBuf { u32x2 X[4][4]; u32x2 H[4]; u32x2 Z[4]; };
__device__ __forceinline__ void ym_load(const bf16_t* xm, const bf16_t* hm, const bf16_t* szb, int t, int lane, YmBuf& B) {
    const int s = t & (SEQ - 1);
#pragma unroll
    for (int j = 0; j < 4; ++j) {
        const int ch = 4 * lane + 256 * j;
#pragma unroll
        for (int kk = 0; kk < 4; ++kk) B.X[j][kk] = (s - 3 + kk >= 0) ? *(const u32x2*)(xm + (size_t)(t - 3 + kk) * DM + ch) : (u32x2){0u, 0u};
        B.H[j] = *(const u32x2*)(hm + (size_t)t * DM + ch);
        B.Z[j] = *(const u32x2*)(szb + (size_t)t * DM + ch);
    }
}
__device__ __forceinline__ void ym_compute(const LAS float* wts, unsigned char* ymix, int t, int lane, const YmBuf& B) {
#pragma unroll
    for (int j = 0; j < 4; ++j) {
        const int ch = 4 * lane + 256 * j;
        f32x4 xc = *(const LAS f32x4*)(wts + 4 * 1024 + ch);
#pragma unroll
        for (int kk = 0; kk < 4; ++kk) xc = xc + *(const LAS f32x4*)(wts + kk * 1024 + ch) * up4(B.X[j][kk]);
        xc.x = siluf_(xc.x); xc.y = siluf_(xc.y); xc.z = siluf_(xc.z); xc.w = siluf_(xc.w);
        const f32x4 hv = up4(B.H[j]);
        const float mean = wave_sum((hv.x + hv.y) + (hv.z + hv.w)) * (1.0f / 256.0f);
        const f32x4 d = hv - mean;
        const float var = wave_sum((d.x * d.x + d.y * d.y) + (d.z * d.z + d.w * d.w)) * (1.0f / 256.0f);
        const float rs = rsqrtf(var + EPSV);
        const f32x4 nwv = *(const LAS f32x4*)(wts + 5 * 1024 + ch), sk = *(const LAS f32x4*)(wts + 6 * 1024 + ch);
        const f32x4 y = (d * rs * nwv + sk * xc) * up4(B.Z[j]);
#if OUTPROJ_FP8
        *(unsigned*)(ymix + (size_t)t * 2048 + ch) = pk4_fp8(y.x, y.y, y.z, y.w);
#else
        { u32x2 o; o.x = pk2(y.x, y.y); o.y = pk2(y.z, y.w); *(u32x2*)((bf16_t*)ymix + (size_t)t * 2048 + ch) = o; }
#endif
        __builtin_amdgcn_sched_barrier(0);
    }
}
__device__ __forceinline__ void phase_ym(const MegaArgs& a, LAS unsigned char* lds, int tid, int gw, int NGW, int lane) {
    unsigned char* ws = a.ws;
    const bf16_t* xm = (const bf16_t*)(ws + WS_XM); const bf16_t* szb = (const bf16_t*)(ws + WS_SZ); const bf16_t* hm = (const bf16_t*)(ws + WS_R1);
    unsigned char* ymix = ws + WS_YMIX;
    LAS float* wts = (LAS float*)lds;
    for (int i = tid; i < 7 * 1024; i += NWAVES * 64) {
        const int r = i >> 10, c = i & 1023;
        wts[i] = (r < 4) ? a.in[3][r * DM + c] : (r == 4 ? a.in[4][c] : (r == 5 ? a.in[12][c] : a.in[13][c]));
    }
    __syncthreads();
    YmBuf A, B;
    int t = gw;
    if (t < NTOK) ym_load(xm, hm, szb, t, lane, A);
    for (; t < NTOK; t += 2 * NGW) {
        const int t2 = t + NGW;
        if (t2 < NTOK) ym_load(xm, hm, szb, t2, lane, B);
        ym_compute(wts, ymix, t, lane, A);
        if (t2 < NTOK) {
            const int t3 = t2 + NGW;
            if (t3 < NTOK) ym_load(xm, hm, szb, t3, lane, A);
            ym_compute(wts, ymix, t2, lane, B);
        }
    }
    __syncthreads();
}

struct EpiOutProj {
    const float* x; bf16_t* hb; unsigned char* hq;
    __device__ __forceinline__ void operator()(const f32x4 (&acc)[2][2][4][2], const pg8::Unit& un, int wr, int wc, int fr, int fq) const {
        const int row0 = un.pm * 256 + wr * 64 + fr;
        const int c0 = un.pn * 256 + wc * 32 + 8 * fq;
#pragma unroll
        for (int ai = 0; ai < 2; ++ai)
#pragma unroll
            for (int mp = 0; mp < 2; ++mp) {
                f32x4 xv[2][2][2];
#pragma unroll
                for (int mm = 0; mm < 2; ++mm)
#pragma unroll
                    for (int bj = 0; bj < 2; ++bj) {
                        const float* xp = x + (size_t)(row0 + ai * 128 + (2 * mp + mm) * 16) * DM + c0 + bj * 128;
                        xv[mm][bj][0] = *(const f32x4*)xp; xv[mm][bj][1] = *(const f32x4*)(xp + 4);
                    }
#pragma unroll
                for (int mm = 0; mm < 2; ++mm) {
                    const int m = 2 * mp + mm;
                    const size_t off = (size_t)(row0 + ai * 128 + m * 16) * DM + c0;
#pragma unroll
                    for (int bj = 0; bj < 2; ++bj) {
                        const f32x4 v0 = acc[ai][bj][m][0] + xv[mm][bj][0], v1 = acc[ai][bj][m][1] + xv[mm][bj][1];
                        u32x4 wb; wb.x = pg8::cvt_pk_bf16(v0[0], v0[1]); wb.y = pg8::cvt_pk_bf16(v0[2], v0[3]); wb.z = pg8::cvt_pk_bf16(v1[0], v1[1]); wb.w = pg8::cvt_pk_bf16(v1[2], v1[3]);
                        *(u32x4*)(hb + off + bj * 128) = wb;
                        u32x2 w; w.x = pk4_fp8(v0[0], v0[1], v0[2], v0[3]); w.y = pk4_fp8(v1[0], v1[1], v1[2], v1[3]);
                        *(u32x2*)(hq + off + bj * 128) = w;
                    }
                }
            }
    }
};


constexpr size_t WS_GCT = WS_SMALL + 512 * 1024;
constexpr size_t WS_GVT = WS_GCT + 32 * 1024;
constexpr size_t WS_FCUM = WS_SMALL + 3 * MiB;
constexpr size_t WS_UVAL = WS_SMALL + 4 * MiB;
constexpr size_t WS_MVAL = WS_SMALL + 7 * MiB;
constexpr size_t WS_ITEMS = WS_SMALL + 8 * MiB;
constexpr size_t WS_DN = WS_SMALL + 9 * MiB;
constexpr size_t WS_NPREV = WS_SMALL + 10 * MiB;
constexpr size_t WS_QB = 477 * MiB;
constexpr size_t WS_KB = 541 * MiB;
constexpr size_t WS_AEXT = 605 * MiB;
constexpr size_t WS_BEXT = 733 * MiB;
constexpr size_t WS_DCT = 861 * MiB;
constexpr size_t WS_KWT = WS_R1;
constexpr size_t WS_HM = WS_R1;
constexpr int RINV_OFF = LDSCTL_OFF + 1024;

__device__ __forceinline__ void p0_gate_tables(const MegaArgs& a, int gw, int NGW, int lane) {
    const float* wq = a.in[5]; const float* wk = a.in[6]; const float* wv = a.in[7]; const float* wig = a.in[8]; const float* wfg = a.in[10];
    bf16_t* gct = (bf16_t*)(a.ws + WS_GCT);
    for (int idx = gw * 64 + lane; idx < 2 * 16 * 1024; idx += NGW * 64) {
        const int tbl = idx >> 14, col = (idx >> 10) & 15, ch = idx & 1023;
        float v = 0.f;
        if (col < 8) {
            const float* Wg = (col < 4) ? wig : wfg; const int hh = col & 3, n = ch >> 2, i = ch & 3;
#pragma unroll
            for (int o = 0; o < 4; ++o) {
                if (tbl == 0) v += wq[n * 16 + i * 4 + o] * Wg[(size_t)(4 * n + o) * 4 + hh] + wk[n * 16 + i * 4 + o] * Wg[(size_t)(1024 + 4 * n + o) * 4 + hh];
                else v += wv[n * 16 + i * 4 + o] * Wg[(size_t)(2048 + 4 * n + o) * 4 + hh];
            }
        }
        gct[idx] = f2bf(v);
    }
}

struct GateGrp { u32x4 row[4][4]; };
__device__ __forceinline__ void gate_load_grp(const bf16_t* xm, int t, int s, int chb, GateGrp& B) {
#pragma unroll
    for (int q = 0; q < 4; ++q)
#pragma unroll
        for (int kk = 0; kk < 4; ++kk) B.row[q][kk] = (s - 3 + kk >= 0) ? *(const u32x4*)(xm + (size_t)(t - 3 + kk) * DM + chb + 32 * q) : (u32x4){0u, 0u, 0u, 0u};
}
__device__ __forceinline__ f32x4 gate_step(const LAS float* cwl, const LAS bf16_t* gtl, int tok, int ch0, const u32x4 (&row)[4], f32x4 acc) {
    float xc[8];
    {
        const f32x4 b0 = *(const LAS f32x4*)(cwl + 4 * 1024 + ch0), b1 = *(const LAS f32x4*)(cwl + 4 * 1024 + ch0 + 4);
        xc[0] = b0.x; xc[1] = b0.y; xc[2] = b0.z; xc[3] = b0.w; xc[4] = b1.x; xc[5] = b1.y; xc[6] = b1.z; xc[7] = b1.w;
    }
#pragma unroll
    for (int kk = 0; kk < 4; ++kk) {
        float xf[8]; unpack8(row[kk], xf);
        const f32x4 w0 = *(const LAS f32x4*)(cwl + kk * 1024 + ch0), w1 = *(const LAS f32x4*)(cwl + kk * 1024 + ch0 + 4);
        xc[0] += w0.x * xf[0]; xc[1] += w0.y * xf[1]; xc[2] += w0.z * xf[2]; xc[3] += w0.w * xf[3];
        xc[4] += w1.x * xf[4]; xc[5] += w1.y * xf[5]; xc[6] += w1.z * xf[6]; xc[7] += w1.w * xf[7];
    }
#pragma unroll
    for (int i = 0; i < 8; ++i) xc[i] = siluf_(xc[i]);
    u32x4 a1; a1.x = pk2(xc[0], xc[1]); a1.y = pk2(xc[2], xc[3]); a1.z = pk2(xc[4], xc[5]); a1.w = pk2(xc[6], xc[7]);
    const u32x4 b1 = *(const LAS u32x4*)(gtl + tok * 1032 + ch0);
    const u32x4 b2 = *(const LAS u32x4*)(gtl + (16 + tok) * 1032 + ch0);
    acc = __builtin_amdgcn_mfma_f32_16x16x32_bf16(__builtin_bit_cast(bf16x8, a1), __builtin_bit_cast(bf16x8, b1), acc, 0, 0, 0);
    acc = __builtin_amdgcn_mfma_f32_16x16x32_bf16(__builtin_bit_cast(bf16x8, row[3]), __builtin_bit_cast(bf16x8, b2), acc, 0, 0, 0);
    return acc;
}
__device__ __forceinline__ void phase_gates(const MegaArgs& a, LAS unsigned char* lds, int tid, int gw, int NGW, int lane) {
    unsigned char* ws = a.ws;
    const bf16_t* xm = (const bf16_t*)(ws + WS_XM);
    const bf16_t* gct = (const bf16_t*)(ws + WS_GCT);
    const float* big = a.in[9]; const float* bfg = a.in[11];
    float* logi = (float*)(ws + WS_LOGI); float* logf = (float*)(ws + WS_LOGF);
    LAS float* cwl = (LAS float*)lds;
    LAS bf16_t* gtl = (LAS bf16_t*)(lds + 20480);
    for (int i = tid; i < 5 * 1024; i += NWAVES * 64) cwl[i] = (i < 4096) ? a.in[3][i] : a.in[4][i - 4096];
    for (int i = tid; i < 32 * 128; i += NWAVES * 64) { const int r = i >> 7, c8 = i & 127; *(LAS u32x4*)(gtl + r * 1032 + 8 * c8) = *(const u32x4*)(gct + (size_t)r * 1024 + 8 * c8); }
    __syncthreads();
    const int tok = lane & 15, kq = lane >> 4;
    for (int tile = gw; tile < NTOK / 16; tile += NGW) {
        const int t = tile * 16 + tok, s = t & (SEQ - 1);
        f32x4 acc = (f32x4){0.f, 0.f, 0.f, 0.f};
        GateGrp A, B;
        gate_load_grp(xm, t, s, 8 * kq, A);
        for (int g = 0; g < 8; g += 2) {
            gate_load_grp(xm, t, s, 128 * (g + 1) + 8 * kq, B);
#pragma unroll
            for (int q = 0; q < 4; ++q) acc = gate_step(cwl, gtl, tok, 128 * g + 32 * q + 8 * kq, A.row[q], acc);
            if (g + 2 < 8) gate_load_grp(xm, t, s, 128 * (g + 2) + 8 * kq, A);
#pragma unroll
            for (int q = 0; q < 4; ++q) acc = gate_step(cwl, gtl, tok, 128 * (g + 1) + 32 * q + 8 * kq, B.row[q], acc);
        }
        const int col = lane & 15;
        if (col < 8) {
            const int hh = col & 3;
#pragma unroll
            for (int r = 0; r < 4; ++r) {
                const int tt = tile * 16 + 4 * kq + r;
                if (col < 4) logi[(size_t)hh * NTOK + tt] = acc[r] + big[hh];
                else logf[(size_t)hh * NTOK + tt] = logsigmoidf_(acc[r] + bfg[hh]);
            }
        }
    }
    __syncthreads();
}

__device__ __forceinline__ void phase_prep(const MegaArgs& a, LAS unsigned char* lds, int tid, int lane, int wave, int G) {
    unsigned char* ws = a.ws;
    const float* logi = (const float*)(ws + WS_LOGI); const float* logf = (const float*)(ws + WS_LOGF);
    float* Fcum = (float*)(ws + WS_FCUM); float* Uval = (float*)(ws + WS_UVAL); float* Mval = (float*)(ws + WS_MVAL);
    float* items = (float*)(ws + WS_ITEMS); float* dn = (float*)(ws + WS_DN);
    const bf16_t* xm = (const bf16_t*)(ws + WS_XM);
    bf16_t* qb = (bf16_t*)(ws + WS_QB); bf16_t* kb = (bf16_t*)(ws + WS_KB); bf16_t* aext = (bf16_t*)(ws + WS_AEXT); bf16_t* bext = (bf16_t*)(ws + WS_BEXT); bf16_t* kwt = (bf16_t*)(ws + WS_KWT);
    const float* cw = a.in[3]; const float* cb = a.in[4]; const float* wq = a.in[5]; const float* wk = a.in[6]; const float* wv = a.in[7];
    LAS float* gch = (LAS float*)lds;
    LAS float* umaxch = gch + 32;
    LAS float* wint_l = umaxch + 32;
    LAS float* wst_l = wint_l + 256;
    LAS float* dn_l = wst_l + 256;
    LAS float* wtl = dn_l + 8 * 256;
    for (int it = blockIdx.x; it < 512; it += G) {
        const int bh = it >> 5, c = it & 31, b = bh >> 2, h = bh & 3;
        const int tb = b * SEQ, t0 = tb + c * 256;
        {
            const int cc = tid >> 4, sub = tid & 15;
            const size_t gbase = (size_t)h * NTOK + tb + cc * 256 + 16 * sub;
            float F[16], u[16];
            {
                const f32x4* lfp = (const f32x4*)(logf + gbase); const f32x4* lip = (const f32x4*)(logi + gbase);
#pragma unroll
                for (int q4 = 0; q4 < 4; ++q4) { const f32x4 v = lfp[q4], w = lip[q4]; F[4 * q4] = v.x; F[4 * q4 + 1] = v.y; F[4 * q4 + 2] = v.z; F[4 * q4 + 3] = v.w; u[4 * q4] = w.x; u[4 * q4 + 1] = w.y; u[4 * q4 + 2] = w.z; u[4 * q4 + 3] = w.w; }
            }
#pragma unroll
            for (int jj = 1; jj < 16; ++jj) F[jj] += F[jj - 1];
            const float total = F[15];
            float incl = total;
#pragma unroll
            for (int o = 1; o < 16; o <<= 1) { const float v = __shfl_up(incl, o, 16); if (sub >= o) incl += v; }
            const float excl = incl - total;
            float um = -3.0e38f;
#pragma unroll
            for (int jj = 0; jj < 16; ++jj) { F[jj] += excl; u[jj] -= F[jj]; um = fmaxf(um, u[jj]); }
            float umx = um;
#pragma unroll
            for (int o = 1; o < 16; o <<= 1) umx = fmaxf(umx, __shfl_xor(umx, o, 16));
            const float gsum = __shfl(incl, 15, 16);
            if (sub == 0) { gch[cc] = gsum; umaxch[cc] = umx; }
            float cm[16]; cm[0] = u[0];
#pragma unroll
            for (int jj = 1; jj < 16; ++jj) cm[jj] = fmaxf(cm[jj - 1], u[jj]);
            float inclm = cm[15];
#pragma unroll
            for (int o = 1; o < 16; o <<= 1) { const float v = __shfl_up(inclm, o, 16); if (sub >= o) inclm = fmaxf(inclm, v); }
            float exclm = __shfl_up(inclm, 1, 16); if (sub == 0) exclm = -3.0e38f;
            __syncthreads();
            float m = 0.f;
            for (int c2 = 0; c2 < c; ++c2) m = gch[c2] + fmaxf(m, umaxch[c2]);
            const float mprev = m, g_c = gch[c], umax_c = umaxch[c], m_c = g_c + fmaxf(mprev, umax_c);
            if (tid == 0) { items[it] = __expf(g_c + mprev - m_c); items[512 + it] = __expf(g_c + umax_c - m_c); items[1024 + it] = mprev; }
            if (cc == c) {
#pragma unroll
                for (int jj = 0; jj < 16; ++jj) {
                    const float M = fmaxf(mprev, fmaxf(cm[jj], exclm));
                    Fcum[gbase + jj] = F[jj]; Uval[gbase + jj] = u[jj]; Mval[gbase + jj] = M;
                    wint_l[16 * sub + jj] = __expf(mprev - M); wst_l[16 * sub + jj] = __expf(u[jj] - umax_c);
                }
            }
            __syncthreads();
        }
        {
            const int ch = h * 256 + 4 * lane;
            float cwv[4][4];
            const f32x4 cbv = *(const f32x4*)(cb + ch);
#pragma unroll
            for (int kk = 0; kk < 4; ++kk) { const f32x4 w = *(const f32x4*)(cw + kk * DM + ch); cwv[kk][0] = w.x; cwv[kk][1] = w.y; cwv[kk][2] = w.z; cwv[kk][3] = w.w; }
            for (int i = tid; i < 768; i += NWAVES * 64) {
                const int mat = i >> 8, q4 = (i >> 6) & 3, ln = i & 63;
                const float* src = (mat == 0 ? wq : (mat == 1 ? wk : wv)) + (h * 64 + ln) * 16 + 4 * q4;
                *(LAS f32x4*)(wtl + 4 * i) = *(const f32x4*)src;
            }
            __syncthreads();
            const __amdgpu_buffer_rsrc_t xrs = __builtin_amdgcn_make_buffer_rsrc((void*)xm, 0, NTOK * 2048, 0x00020000);
            LAS unsigned* tile_v = (LAS unsigned*)(lds + 24576);
            LAS unsigned* tile_k = tile_v + 64 * 129;
            u32x2 cur[11], nx[11];
#define PREP_LOAD(R, p_) do { _Pragma("unroll") for (int r = 0; r < 11; ++r) { const int sp = c * 256 + 64 * (p_) + 8 * wave - 3 + r; \
                R[r] = (sp >= 0) ? (u32x2)__builtin_amdgcn_raw_buffer_load_b64(xrs, ch * 2, (t0 + 64 * (p_) + 8 * wave - 3 + r) * 2048, 0) : (u32x2){0u, 0u}; } } while (0)
            PREP_LOAD(cur, 0);
            float dnacc[4] = {0.f, 0.f, 0.f, 0.f};
#pragma unroll 1
            for (int pb = 0; pb < 4; ++pb) {
                if (pb < 3) PREP_LOAD(nx, pb + 1);
#pragma unroll
                for (int pp = 0; pp < 8; ++pp) {
                    const int i = 64 * pb + 8 * wave + pp;
                    const f32x4 x0v = up4(cur[pp]), x1v = up4(cur[pp + 1]), x2v = up4(cur[pp + 2]), x3v = up4(cur[pp + 3]);
                    float x3[4]; x3[0] = x3v.x; x3[1] = x3v.y; x3[2] = x3v.z; x3[3] = x3v.w;
                    float xc[4];
#pragma unroll
                    for (int cc = 0; cc < 4; ++cc) xc[cc] = siluf_(cbv[cc] + cwv[0][cc] * x0v[cc] + cwv[1][cc] * x1v[cc] + cwv[2][cc] * x2v[cc] + cwv[3][cc] * x3v[cc]);
                    float qv[4], kv[4], vv[4];
                    {
                        f32x4 qa = (f32x4){0.f, 0.f, 0.f, 0.f}, ka = qa, va = qa;
#pragma unroll
                        for (int q4 = 0; q4 < 4; ++q4) {
                            qa = qa + *(const LAS f32x4*)(wtl + ((0 * 4 + q4) * 64 + lane) * 4) * xc[q4];
                            ka = ka + *(const LAS f32x4*)(wtl + ((1 * 4 + q4) * 64 + lane) * 4) * xc[q4];
                            va = va + *(const LAS f32x4*)(wtl + ((2 * 4 + q4) * 64 + lane) * 4) * x3[q4];
                        }
#pragma unroll
                        for (int o = 0; o < 4; ++o) { qv[o] = qa[o] * 0.0625f; kv[o] = ka[o]; vv[o] = va[o]; }
                    }
                    const float wi = wint_l[i], wsj = wst_l[i];
                    u32x2 o2;
                    o2.x = pk2(qv[0], qv[1]); o2.y = pk2(qv[2], qv[3]);
                    *(u32x2*)(qb + (size_t)(t0 + i) * DM + ch) = o2;
                    o2.x = pk2(kv[0], kv[1]); o2.y = pk2(kv[2], kv[3]);
                    *(u32x2*)(kb + (size_t)(t0 + i) * DM + ch) = o2;
                    o2.x = pk2(qv[0] * wi, qv[1] * wi); o2.y = pk2(qv[2] * wi, qv[3] * wi);
                    *(u32x2*)(aext + ((size_t)it * 256 + i) * 512 + 256 + 4 * lane) = o2;
                    float kwv[4];
#pragma unroll
                    for (int o = 0; o < 4; ++o) { kwv[o] = kv[o] * wsj; dnacc[o] += kwv[o]; }
                    const int tr = (8 * wave + pp) * 129 + 2 * lane;
                    tile_v[tr] = pk2(vv[0], vv[1]); tile_v[tr + 1] = pk2(vv[2], vv[3]);
                    tile_k[tr] = pk2(kwv[0], kwv[1]); tile_k[tr + 1] = pk2(kwv[2], kwv[3]);
                }
                __syncthreads();
#pragma unroll
                for (int kq = 0; kq < 4; ++kq) {
                    const int pid = tid + 512 * kq, chr = pid >> 3, jg = pid & 7;
                    const LAS unsigned short* tv = (const LAS unsigned short*)tile_v + (8 * jg) * 258 + chr;
                    const LAS unsigned short* tk = (const LAS unsigned short*)tile_k + (8 * jg) * 258 + chr;
                    u32x4 ov, ok;
                    ov.x = (unsigned)tv[0 * 258] | ((unsigned)tv[1 * 258] << 16); ov.y = (unsigned)tv[2 * 258] | ((unsigned)tv[3 * 258] << 16);
                    ov.z = (unsigned)tv[4 * 258] | ((unsigned)tv[5 * 258] << 16); ov.w = (unsigned)tv[6 * 258] | ((unsigned)tv[7 * 258] << 16);
                    ok.x = (unsigned)tk[0 * 258] | ((unsigned)tk[1 * 258] << 16); ok.y = (unsigned)tk[2 * 258] | ((unsigned)tk[3 * 258] << 16);
                    ok.z = (unsigned)tk[4 * 258] | ((unsigned)tk[5 * 258] << 16); ok.w = (unsigned)tk[6 * 258] | ((unsigned)tk[7 * 258] << 16);
                    *(u32x4*)(bext + ((size_t)it * 256 + chr) * 512 + 64 * pb + 8 * jg) = ov;
                    *(u32x4*)(kwt + ((size_t)it * 256 + chr) * 256 + 64 * pb + 8 * jg) = ok;
                }
                __syncthreads();
#pragma unroll
                for (int r = 0; r < 11; ++r) cur[r] = nx[r];
            }
#undef PREP_LOAD
#pragma unroll
            for (int o = 0; o < 4; ++o) dn_l[wave * 256 + 4 * lane + o] = dnacc[o];
            __syncthreads();
            if (tid < 256) {
                float s = 0.f;
#pragma unroll
                for (int w = 0; w < 8; ++w) s += dn_l[w * 256 + tid];
                dn[(size_t)it * 256 + tid] = s;
            }
            __syncthreads();
        }
    }
}

__device__ __forceinline__ void tr_subtile(const bf16_t* src, int lds_src, bf16_t* dst, int lds_dst, LAS unsigned short* tile, int lane) {
    const int rr = lane >> 3, pc = lane & 7;
    u32x4 v[8];
#pragma unroll
    for (int s2 = 0; s2 < 8; ++s2) v[s2] = *(const u32x4*)(src + (size_t)(rr + 8 * s2) * lds_src + 8 * pc);
#pragma unroll
    for (int s2 = 0; s2 < 8; ++s2) {
        LAS unsigned* tp = (LAS unsigned*)(tile + (rr + 8 * s2) * 66 + 8 * pc);
        tp[0] = v[s2].x; tp[1] = v[s2].y; tp[2] = v[s2].z; tp[3] = v[s2].w;
    }
    asm volatile("s_waitcnt lgkmcnt(0)" ::: "memory");
#pragma unroll
    for (int s2 = 0; s2 < 8; ++s2) {
        const int c = rr + 8 * s2;
        const LAS unsigned short* tp = tile + (8 * pc) * 66 + c;
        u32x4 o;
        o.x = (unsigned)tp[0 * 66] | ((unsigned)tp[1 * 66] << 16); o.y = (unsigned)tp[2 * 66] | ((unsigned)tp[3 * 66] << 16);
        o.z = (unsigned)tp[4 * 66] | ((unsigned)tp[5 * 66] << 16); o.w = (unsigned)tp[6 * 66] | ((unsigned)tp[7 * 66] << 16);
        *(u32x4*)(dst + (size_t)c * lds_dst + 8 * pc) = o;
    }
    asm volatile("s_waitcnt lgkmcnt(0)" ::: "memory");
}
__device__ __forceinline__ void phase_transposes(const MegaArgs& a, LAS unsigned char* lds, int wave, int lane, int G) {
    unsigned char* ws = a.ws;
    bf16_t* aext = (bf16_t*)(ws + WS_AEXT); bf16_t* bext = (bf16_t*)(ws + WS_BEXT); bf16_t* kwt = (bf16_t*)(ws + WS_KWT);
    LAS unsigned short* tile = (LAS unsigned short*)(lds + wave * 16384);
    for (int it = blockIdx.x; it < 512; it += G) {
        for (int job = wave; job < 32; job += NWAVES) {
            const int arr = job >> 4, sj = (job >> 2) & 3, sc = job & 3;
            if (arr == 0) tr_subtile(bext + ((size_t)it * 256 + 64 * sj) * 512 + 256 + 64 * sc, 512, bext + ((size_t)it * 256 + 64 * sc) * 512 + 64 * sj, 512, tile, lane);
            else          tr_subtile(aext + ((size_t)it * 256 + 64 * sj) * 512 + 64 * sc, 512, kwt + ((size_t)it * 256 + 64 * sc) * 256 + 64 * sj, 256, tile, lane);
        }
    }
    asm volatile("s_waitcnt vmcnt(0)" ::: "memory");
    __syncthreads();
}

struct ItemOrder {
    const char* A; const char* B; size_t a_item_bytes, b_item_bytes; int per_token; int G, c;
    __device__ __forceinline__ bool next(int i, pg8::Unit& u) const {
        const int it = i * G + c; if (it >= 512) return false;
        u.pm = it; u.pn = 0; u.aux = i; u.gidx = nullptr; u.gl = 0;
        if (per_token) { const int bh = it >> 5, cc = it & 31, b = bh >> 2, h = bh & 3; const size_t off = ((size_t)(b * SEQ + cc * 256) * DM + h * 256) * 2; u.A = A + off; u.B = B + off; }
        else { u.A = A + (size_t)it * a_item_bytes; u.B = B + (size_t)it * b_item_bytes; }
        return true;
    }
};
struct EpiP {
    const float* Uval; const float* Mval; bf16_t* aext;
    __device__ __forceinline__ void operator()(const f32x4 (&acc)[2][2][4][2], const pg8::Unit& un, int wr, int wc, int fr, int fq) const {
        const int it = un.pm, bh = it >> 5, cc = it & 31, b = bh >> 2, h = bh & 3;
        const size_t gb = (size_t)h * NTOK + b * SEQ + cc * 256;
        const int jb = wc * 32 + 8 * fq;
        float Mv[2][4];
#pragma unroll
        for (int ai = 0; ai < 2; ++ai)
#pragma unroll
            for (int m = 0; m < 4; ++m) Mv[ai][m] = Mval[gb + ai * 128 + wr * 64 + m * 16 + fr];
#pragma unroll
        for (int bj = 0; bj < 2; ++bj) {
            f32x4 uj[2];
#pragma unroll
            for (int n = 0; n < 2; ++n) uj[n] = *(const f32x4*)(Uval + gb + bj * 128 + jb + 4 * n);
#pragma unroll
            for (int ai = 0; ai < 2; ++ai)
#pragma unroll
                for (int m = 0; m < 4; ++m) {
                    const int i = ai * 128 + wr * 64 + m * 16 + fr;
                    const float Mi = Mv[ai][m];
                    f32x4 o[2];
#pragma unroll
                    for (int n = 0; n < 2; ++n)
#pragma unroll
                        for (int jj = 0; jj < 4; ++jj) {
                            const int j = bj * 128 + jb + 4 * n + jj;
                            o[n][jj] = (j <= i) ? acc[ai][bj][m][n][jj] * __expf(uj[n][jj] - Mi) : 0.f;
                        }
                    u32x4 w; w.x = pg8::cvt_pk_bf16(o[0][0], o[0][1]); w.y = pg8::cvt_pk_bf16(o[0][2], o[0][3]); w.z = pg8::cvt_pk_bf16(o[1][0], o[1][1]); w.w = pg8::cvt_pk_bf16(o[1][2], o[1][3]);
                    *(u32x4*)(aext + ((size_t)it * 256 + i) * 512 + bj * 128 + jb) = w;
                    asm volatile("" ::: "memory");
                }
        }
    }
};
struct EpiDC {
    bf16_t* dct;
    __device__ __forceinline__ void operator()(const f32x4 (&acc)[2][2][4][2], const pg8::Unit& un, int wr, int wc, int fr, int fq) const {
        const int it = un.pm; const int cb0 = wc * 32 + 8 * fq;
#pragma unroll
        for (int ai = 0; ai < 2; ++ai)
#pragma unroll
            for (int m = 0; m < 4; ++m) {
                const int r = ai * 128 + wr * 64 + m * 16 + fr;
#pragma unroll
                for (int bj = 0; bj < 2; ++bj) {
                    const f32x4 v0 = acc[ai][bj][m][0], v1 = acc[ai][bj][m][1];
                    u32x4 w; w.x = pg8::cvt_pk_bf16(v0[0], v0[1]); w.y = pg8::cvt_pk_bf16(v0[2], v0[3]); w.z = pg8::cvt_pk_bf16(v1[0], v1[1]); w.w = pg8::cvt_pk_bf16(v1[2], v1[3]);
                    *(u32x4*)(dct + ((size_t)it * 256 + r) * 256 + bj * 128 + cb0) = w;
                }
            }
    }
};
struct EpiO {
    LAS const float* rinv; bf16_t* hm;
    __device__ __forceinline__ void operator()(const f32x4 (&acc)[2][2][4][2], const pg8::Unit& un, int wr, int wc, int fr, int fq) const {
        const int it = un.pm, bh = it >> 5, cc = it & 31, b = bh >> 2, h = bh & 3;
        const size_t t0 = (size_t)b * SEQ + cc * 256; const int eb = wc * 32 + 8 * fq;
#pragma unroll
        for (int ai = 0; ai < 2; ++ai)
#pragma unroll
            for (int m = 0; m < 4; ++m) {
                const int i = ai * 128 + wr * 64 + m * 16 + fr;
                const float ri = rinv[un.aux * 256 + i];
#pragma unroll
                for (int bj = 0; bj < 2; ++bj) {
                    const f32x4 v0 = acc[ai][bj][m][0] * ri, v1 = acc[ai][bj][m][1] * ri;
                    u32x4 w; w.x = pg8::cvt_pk_bf16(v0[0], v0[1]); w.y = pg8::cvt_pk_bf16(v0[2], v0[3]); w.z = pg8::cvt_pk_bf16(v1[0], v1[1]); w.w = pg8::cvt_pk_bf16(v1[2], v1[3]);
                    *(u32x4*)(hm + (t0 + i) * DM + h * 256 + bj * 128 + eb) = w;
                }
            }
    }
};

__device__ __forceinline__ void phase_scan(const MegaArgs& a, int tid) {
    unsigned char* ws = a.ws;
    const float* items = (const float*)(ws + WS_ITEMS); const bf16_t* dct = (const bf16_t*)(ws + WS_DCT); bf16_t* bext = (bf16_t*)(ws + WS_BEXT);
    const float* dn = (const float*)(ws + WS_DN); float* nprev = (float*)(ws + WS_NPREV);
    int tid_o = tid; asm volatile("" : "+v"(tid_o));
    const int gid = blockIdx.x * (NWAVES * 64) + tid_o;
    if (gid < 16 * 256 * 32) {
        const int bh = gid >> 13, e = (gid >> 5) & 255, d8 = gid & 31;
        float st[8];
#pragma unroll
        for (int i = 0; i < 8; ++i) st[i] = 0.f;
        u32x4 rA[4], rB[4]; float decA[4], scA[4], decB[4], scB[4];
#define SCAN_LOAD(R, D, S, c0) do { _Pragma("unroll") for (int q = 0; q < 4; ++q) { const int it_ = bh * 32 + (c0) + q; R[q] = *(const u32x4*)(dct + ((size_t)it_ * 256 + e) * 256 + 8 * d8); D[q] = items[it_]; S[q] = items[512 + it_]; } } while (0)
#define SCAN_STEP(R, D, S, c0) do { _Pragma("unroll") for (int q = 0; q < 4; ++q) { const int it_ = bh * 32 + (c0) + q; \
            u32x4 w; w.x = pk2(st[0], st[1]); w.y = pk2(st[2], st[3]); w.z = pk2(st[4], st[5]); w.w = pk2(st[6], st[7]); \
            *(u32x4*)(bext + ((size_t)it_ * 256 + e) * 512 + 256 + 8 * d8) = w; \
            float dv[8]; unpack8(R[q], dv); \
            _Pragma("unroll") for (int i = 0; i < 8; ++i) st[i] = D[q] * st[i] + S[q] * dv[i]; } } while (0)
        SCAN_LOAD(rA, decA, scA, 0);
        for (int c0 = 0; c0 < 32; c0 += 8) {
            SCAN_LOAD(rB, decB, scB, c0 + 4);
            SCAN_STEP(rA, decA, scA, c0);
            if (c0 + 8 < 32) SCAN_LOAD(rA, decA, scA, c0 + 8);
            SCAN_STEP(rB, decB, scB, c0 + 4);
        }
#undef SCAN_LOAD
#undef SCAN_STEP
    }
    if (gid < 16 * 256) {
        const int bh = gid >> 8, d = gid & 255;
        float dnv[32], dcv[32], scv[32];
#pragma unroll
        for (int c = 0; c < 32; ++c) { const int it = bh * 32 + c; dnv[c] = dn[(size_t)it * 256 + d]; dcv[c] = items[it]; scv[c] = items[512 + it]; }
        float st = 0.f;
#pragma unroll
        for (int c = 0; c < 32; ++c) { const int it = bh * 32 + c; nprev[(size_t)it * 256 + d] = st; st = dcv[c] * st + scv[c] * dnv[c]; }
    }
}

__device__ __forceinline__ void g3_rinv(const MegaArgs& a, LAS unsigned char* lds, int wave, int lane, int G) {
    unsigned char* ws = a.ws;
    const bf16_t* aext = (const bf16_t*)(ws + WS_AEXT); const float* nprev = (const float*)(ws + WS_NPREV);
    const float* Fcum = (const float*)(ws + WS_FCUM); const float* Mval = (const float*)(ws + WS_MVAL);
    LAS float* rinv = (LAS float*)(lds + RINV_OFF);
    const int l16 = lane & 15, rsub = lane >> 4;
    for (int ui = 0; ui < 2; ++ui) {
        const int it = ui * G + blockIdx.x; if (it >= 512) break;
        const int bh = it >> 5, cc = it & 31, b = bh >> 2, h = bh & 3;
        f32x4 nv[2][2];
#pragma unroll
        for (int pz = 0; pz < 2; ++pz) { const f32x4* np = (const f32x4*)(nprev + (size_t)it * 256 + 8 * (l16 + 16 * pz)); nv[pz][0] = np[0]; nv[pz][1] = np[1]; }
        u32x4 pc[8][4];
#pragma unroll
        for (int ps = 0; ps < 8; ++ps) {
            const u32x4* rowp = (const u32x4*)(aext + ((size_t)it * 256 + 32 * ps + 4 * wave + rsub) * 512);
#pragma unroll
            for (int q = 0; q < 4; ++q) pc[ps][q] = rowp[l16 + 16 * q];
        }
#pragma unroll
        for (int ps = 0; ps < 8; ++ps) {
            float s = 0.f;
#pragma unroll
            for (int q = 0; q < 2; ++q) { float f[8]; unpack8(pc[ps][q], f); s += ((f[0] + f[1]) + (f[2] + f[3])) + ((f[4] + f[5]) + (f[6] + f[7])); }
#pragma unroll
            for (int q = 0; q < 2; ++q) { float f[8]; unpack8(pc[ps][2 + q], f); const f32x4 n0 = nv[q][0], n1 = nv[q][1];
                s += (f[0] * n0.x + f[1] * n0.y + f[2] * n0.z + f[3] * n0.w) + (f[4] * n1.x + f[5] * n1.y + f[6] * n1.z + f[7] * n1.w); }
            s += dpp_mov_f<0xB1>(s); s += dpp_mov_f<0x4E>(s); s += dpp_mov_f<0x124>(s); s += dpp_mov_f<0x128>(s);
            const int i = 32 * ps + 4 * wave + rsub;
            const size_t gi = (size_t)h * NTOK + b * SEQ + cc * 256 + i;
            if (l16 == 0) { const float mi = Fcum[gi] + Mval[gi]; rinv[ui * 256 + i] = 1.0f / fmaxf(fabsf(s), __expf(-mi)); }
        }
    }
    __syncthreads();
}

#ifndef STAG1
#define STAG1 0
#endif
#ifndef STAG12
#define STAG12 0
#endif
__global__ void __launch_bounds__(NWAVES * 64, 2) mega_fwd(MegaArgs args) {
    extern __shared__ __attribute__((aligned(16))) unsigned char lds_raw[];
    LAS unsigned char* lds = (LAS unsigned char*)lds_raw;
    const int wave = __builtin_amdgcn_readfirstlane(threadIdx.x >> 6);
#define lane lane_id()
#define tid ((wave << 6) | lane_id())
    const int G = gridDim.x;
    const int gw = blockIdx.x * NWAVES + wave, NGW = G * NWAVES;
    unsigned char* ws = args.ws;
    unsigned* ctl = (unsigned*)(ws + WS_CTL);
    for (int u = tid; u < (LDS_BYTES - LDSCTL_OFF) / 4; u += NWAVES * 64) ((LAS unsigned*)(lds + LDSCTL_OFF))[u] = 0u;
    __syncthreads();
    XcdBarrier bar = xcd_barrier_post(ctl + CW_BAR + args.li * XCD_BAR_WORDS, (volatile LAS unsigned*)(lds + LDSCTL_OFF + 64), wave);
    const int lo = args.ph_lo, hi = args.ph_hi;
#define IN(k) (lo <= (k) && (k) < hi)
#define BOTH(k) (IN(k) && IN((k) + 1))

    if (IN(0)) { p0_prologue(args, lds, gw, NGW, wave, lane); p0b_weights(args, lds, gw, NGW, wave, lane); p0_gate_tables(args, gw, NGW, lane); p0_router_tables(args, gw, NGW, lane); if (BOTH(0)) xcd_barrier(bar); }

    if (IN(1)) {
        const int NG1 = G;
        if ((int)blockIdx.x < NG1) {
            pg8::DenseOrder S; S.init(ws + WS_R1, ws + WS_BTIN, NTOK, DPROJ, DM, DM, NG1, (int)blockIdx.x);
            EpiInProj E{(const float*)(ws + WS_RSTD1), (bf16_t*)(ws + WS_XM), (bf16_t*)(ws + WS_SZ), (bf16_t*)(ws + WS_U), args.pad};
            pg8::gemm_phase<EpiInProj, pg8::DenseOrder, false>(lds, wave, DM, DM, DM, S, E, 0x7F7F7F7F, 0x7F7F7F7F, STAG1);
        } else {
            p0b_weights(args, lds, ((int)blockIdx.x - NG1) * NWAVES + wave, (G - NG1) * NWAVES, wave, lane);
        }
        if (BOTH(1)) xcd_barrier(bar);
    }
    if (IN(2)) { phase_gates(args, lds, tid, gw, NGW, lane); if (BOTH(2)) xcd_barrier(bar); }
    if (IN(3)) { phase_prep(args, lds, tid, lane, wave, G); if (BOTH(3)) xcd_barrier(bar); }
    if (IN(4)) {
        {
            ItemOrder S; S.A = (const char*)(ws + WS_QB); S.B = (const char*)(ws + WS_KB); S.a_item_bytes = 0; S.b_item_bytes = 0; S.per_token = 1; S.G = G; S.c = (int)blockIdx.x;
            EpiP E{(const float*)(ws + WS_UVAL), (const float*)(ws + WS_MVAL), (bf16_t*)(ws + WS_AEXT)};
            pg8::gemm_phase<EpiP, ItemOrder, false>(lds, wave, 256, DM, DM, S, E);
        }
        {
            ItemOrder S; S.A = (const char*)(ws + WS_BEXT); S.B = (const char*)(ws + WS_KWT); S.a_item_bytes = (size_t)256 * 512 * 2; S.b_item_bytes = (size_t)256 * 256 * 2; S.per_token = 0; S.G = G; S.c = (int)blockIdx.x;
            EpiDC E{(bf16_t*)(ws + WS_DCT)};
            pg8::gemm_phase<EpiDC, ItemOrder, false>(lds, wave, 256, 512, 256, S, E);
        }
        if (BOTH(4)) xcd_barrier(bar);
    }
    if (IN(5)) {
        if ((blockIdx.x >> 3) & 1) { phase_conv31(args, lds, tid, lane, wave, G); phase_scan(args, tid); }
        else { phase_scan(args, tid); phase_conv31(args, lds, tid, lane, wave, G); }
        if (BOTH(5)) xcd_barrier(bar);
    }
    if (IN(6)) {
        g3_rinv(args, lds, wave, lane, G);
        ItemOrder S; S.A = (const char*)(ws + WS_AEXT); S.B = (const char*)(ws + WS_BEXT); S.a_item_bytes = (size_t)256 * 512 * 2; S.b_item_bytes = (size_t)256 * 512 * 2; S.per_token = 0; S.G = G; S.c = (int)blockIdx.x;
        EpiO E{(LAS const float*)(lds + RINV_OFF), (bf16_t*)(ws + WS_HM)};
        pg8::gemm_phase<EpiO, ItemOrder, false>(lds, wave, 512, 512, 512, S, E);
        if (BOTH(6)) xcd_barrier(bar);
    }
    if (IN(7)) { phase_ym(args, lds, tid, gw, NGW, lane); if (BOTH(7)) xcd_barrier(bar); }
    if (IN(8)) {
        EpiOutProj E{args.in[0], (bf16_t*)(ws + WS_HB16), ws + WS_HBF};
#if OUTPROJ_FP8
        pg8::DenseOrder S; S.init(ws + WS_YMIX, ws + WS_BTOUT, NTOK, DM, 1024, 1024, G, (int)blockIdx.x);
        pg8::gemm_phase<EpiOutProj, pg8::DenseOrder, false, true>(lds, wave, 1024, 1024, 1024, S, E, 0x7A7A7A7A, 0x7F7F7F7F);
#else
        pg8::DenseOrder S; S.init(ws + WS_YMIX, ws + WS_BTOUT, NTOK, DM, 2048, 2048, G, (int)blockIdx.x);
        pg8::gemm_phase<EpiOutProj, pg8::DenseOrder, false>(lds, wave, 2048, 2048, 2048, S, E);
#endif
        if (BOTH(8)) xcd_barrier(bar);
    }
    if (IN(9)) { phase_router(args, lds, tid, lane, wave); if (BOTH(9)) xcd_barrier(bar); }
    if (IN(10)) { phase_slots(args, lds, tid); if (BOTH(10)) xcd_barrier(bar); }
    if (IN(11)) {
        const int T = __builtin_amdgcn_readfirstlane(__hip_atomic_load((const int*)(ws + WS_TILEEXP) + 2048, __ATOMIC_RELAXED, __HIP_MEMORY_SCOPE_AGENT));
        MoeOrder S; S.A = (const char*)(ws + WS_HBF); S.Bt = (const char*)(ws + WS_BT1); S.gidx = (const int*)(ws + WS_STOK); S.tile_exp = (const int*)(ws + WS_TILEEXP);
        S.a_tile_bytes = 0; S.b_exp_bytes = (size_t)2048 * 1024; S.b_tile_bytes = (size_t)256 * 1024; S.T = T; S.nN = 8; S.group = 4; S.c = (int)blockIdx.x;
        EpiMoe1 E{(const float*)(ws + WS_SRSTD), args.in[23], ws + WS_ACT, args.pad};
        pg8::gemm_phase<EpiMoe1, MoeOrder, true, true>(lds, wave, DM / 2, DM / 2, DM / 2, S, E, 0x7A7A7A7A, 0x7F7F7F7F);
        if (BOTH(11)) xcd_barrier(bar);
    }
    if (IN(12)) {
        const int T = __builtin_amdgcn_readfirstlane(__hip_atomic_load((const int*)(ws + WS_TILEEXP) + 2048, __ATOMIC_RELAXED, __HIP_MEMORY_SCOPE_AGENT));
        MoeOrder S; S.A = (const char*)(ws + WS_ACT); S.Bt = (const char*)(ws + WS_BT2); S.gidx = nullptr; S.tile_exp = (const int*)(ws + WS_TILEEXP);
        S.a_tile_bytes = (size_t)256 * 1024; S.b_exp_bytes = (size_t)1024 * 1024; S.b_tile_bytes = (size_t)256 * 1024; S.T = T; S.nN = 4; S.group = 8; S.c = (int)blockIdx.x;
        EpiMoe2 E{(const float*)(ws + WS_SGATE), args.in[25], ws + WS_YROWS};
        pg8::gemm_phase<EpiMoe2, MoeOrder, false, true>(lds, wave, DM / 2, DM / 2, DM / 2, S, E, 0x7A7A7A7A, 0x7F7F7F7F, STAG12);
        if (BOTH(12)) xcd_barrier(bar);
    }
    if (IN(13)) { phase_final(args, gw, NGW, lane); }
#undef IN
#undef BOTH
#undef lane
#undef tid
}

static int g_grid = 0;
static bool mega_setup(size_t ws_size) {
    if (g_grid == 0) {
        int dev = 0, cus = 0, per_cu = 0;
        if (ws_size < WS_NEED) { g_grid = -1; return false; }
        if (hipGetDevice(&dev) != hipSuccess || hipDeviceGetAttribute(&cus, hipDeviceAttributeMultiprocessorCount, dev) != hipSuccess) { g_grid = -1; return false; }
        if (hipFuncSetAttribute((const void*)mega_fwd, hipFuncAttributeMaxDynamicSharedMemorySize, LDS_BYTES) != hipSuccess) { g_grid = -1; return false; }
        (void)hipOccupancyMaxActiveBlocksPerMultiprocessor(&per_cu, (const void*)mega_fwd, NWAVES * 64, LDS_BYTES);
        (void)hipGetLastError();
        if (cus < 256) { g_grid = -1; return false; }
        g_grid = 256;
    }
    return g_grid > 0;
}
static void mega_launch(const MegaArgs& base, int lo, int hi, int li, hipStream_t stream, int variant = 0) {
    MegaArgs a = base; a.ph_lo = lo; a.ph_hi = hi; a.li = li; a.pad = variant;
    hipLaunchKernelGGL(mega_fwd, dim3(g_grid), dim3(NWAVES * 64), LDS_BYTES, stream, a);
}

extern "C" void kernel_launch(void* const* d_in, const int* in_sizes, int n_in, void* d_out, int out_size, void* d_ws,
                              size_t ws_size, hipStream_t stream) {
    if (n_in != 27 || out_size != NTOK * DM) return;
    if (!mega_setup(ws_size)) return;
    unsigned char* ws = (unsigned char*)d_ws;
    (void)hipMemsetAsync(ws + WS_CTL, 0, CTL_ZERO_BYTES, stream);
    MegaArgs a{};
    for (int i = 0; i < 27; ++i) a.in[i] = (const float*)d_in[i];
    a.out = (float*)d_out; a.ws = ws;

#ifndef PROBE_K
    mega_launch(a, 0, 14, 0, stream);
#else
    mega_launch(a, 0, PROBE_K + 1, 0, stream);
#ifndef PROBE_V
#define PROBE_V 0
#endif
    mega_launch(a, PROBE_K, PROBE_K + 1, 1, stream, PROBE_V);
    if (PROBE_K + 1 < 14) mega_launch(a, PROBE_K + 1, 14, 2, stream);
#endif
}
```

```cpp
#include <hip/hip_runtime.h>
#include <stdint.h>

#define NTOK 32768
#define SEQ 8192
#define DM 1024
#define DPROJ 4096
#define NEXP 32
#define NASSIGN (NTOK * 4)
#define EPSV 1e-5f

typedef unsigned short bf16_t;

__device__ __forceinline__ float bf2f(bf16_t h) { return __uint_as_float(((uint32_t)h) << 16); }
__device__ __forceinline__ bf16_t f2bf(float f) {
    uint32_t u = __float_as_uint(f);
    u += 0x7FFFu + ((u >> 16) & 1u);
    return (bf16_t)(u >> 16);
}
__device__ __forceinline__ float sigmoidf_(float x) { return __builtin_amdgcn_rcpf(1.0f + __expf(-x)); }
__device__ __forceinline__ float siluf_(float x) { return x * sigmoidf_(x); }
__device__ __forceinline__ float logsigmoidf_(float x) { return fminf(x, 0.0f) - log1pf(__expf(-fabsf(x))); }

template <int CTRL> __device__ __forceinline__ float dpp_mov_f(float v) { return __builtin_bit_cast(float, __builtin_amdgcn_update_dpp(0, __builtin_bit_cast(int, v), CTRL, 0xf, 0xf, false)); }
__device__ __forceinline__ float wave_sum(float v) {
    v += dpp_mov_f<0xB1>(v); v += dpp_mov_f<0x4E>(v); v += dpp_mov_f<0x124>(v); v += dpp_mov_f<0x128>(v);
    v += __builtin_bit_cast(float, __builtin_amdgcn_ds_swizzle(__builtin_bit_cast(int, v), 0x401F));
    const auto rr = __builtin_amdgcn_permlane32_swap(__float_as_uint(v), __float_as_uint(v), false, false);
    return __uint_as_float(rr[0]) + __uint_as_float(rr[1]);
}
__device__ __forceinline__ float block_sum256(float v, float* red) {
    v = wave_sum(v);
    __syncthreads();
    if ((threadIdx.x & 63) == 0) red[threadIdx.x >> 6] = v;
    __syncthreads();
    return red[0] + red[1] + red[2] + red[3];
}


#define LAS __attribute__((address_space(3)))
#define GAS __attribute__((address_space(1)))
typedef short bf16x8 __attribute__((ext_vector_type(8)));
typedef float f32x4 __attribute__((ext_vector_type(4)));
typedef float f32x2 __attribute__((ext_vector_type(2)));
typedef unsigned u32x4 __attribute__((ext_vector_type(4)));
typedef unsigned u32x2 __attribute__((ext_vector_type(2)));

__device__ __forceinline__ int lane_id() { int l = (int)__builtin_amdgcn_mbcnt_hi(~0u, __builtin_amdgcn_mbcnt_lo(~0u, 0u)); asm volatile("" : "+v"(l)); return l; }
namespace pg8 {
__device__ __forceinline__ const char* uni_ptr(const char* p) { const unsigned long long v = (unsigned long long)p; const unsigned lo = __builtin_amdgcn_readfirstlane((unsigned)v), hi = __builtin_amdgcn_readfirstlane((unsigned)(v >> 32)); return (const char*)(((unsigned long long)hi << 32) | lo); }
typedef int i32x4 __attribute__((ext_vector_type(4)));
typedef int i32x8 __attribute__((ext_vector_type(8)));
__device__ __forceinline__ void mfma8_tied(f32x4& acc, const i32x8 a, const i32x8 b, const int sa, const int sb) {
    asm volatile("v_mfma_scale_f32_16x16x128_f8f6f4 %0, %1, %2, %0, %3, %4 op_sel_hi:[0,0,0]" : "+v"(acc) : "v"(a), "v"(b), "v"(sa), "v"(sb));
}
__device__ __forceinline__ i32x8 cat8(const bf16x8 lo, const bf16x8 hi) { return __builtin_shufflevector(__builtin_bit_cast(i32x4, lo), __builtin_bit_cast(i32x4, hi), 0, 1, 2, 3, 4, 5, 6, 7); }
constexpr int BM = 256, BK = 64, HALF = 128, HTB = HALF * BK * 2, STAGE_BYTES = 8 * HTB, NXCD = 8, WGM = 8;
__host__ __device__ __forceinline__ int lds_byte(int r, int c) { const int st = (r >> 4) * 2 + (c >> 5), rr = r & 15, cc = c & 31, ob = rr * 64 + cc * 2; return st * 1024 + (ob ^ (((ob >> 9) & 1) << 5)); }
__host__ __device__ __forceinline__ void stage_rc(int b, int& R, int& C) { const int st = b / 1024, sb = b % 1024, swz = sb ^ (((sb >> 9) & 1) << 5); R = (st >> 1) * 16 + swz / 64; C = (st & 1) * 32 + (swz % 64) / 2; }
__host__ __device__ __forceinline__ int perm32(int rho) { const int n = rho >> 4, i = rho & 15; return 8 * (i >> 2) + 4 * n + (i & 3); }
__device__ __forceinline__ unsigned cvt_pk_bf16(float lo, float hi) { unsigned r; asm volatile("v_cvt_pk_bf16_f32 %0, %1, %2" : "=v"(r) : "v"(lo), "v"(hi)); return r; }

struct Unit { const char* A; const char* B; const int* gidx; int pm, pn, aux; int gl; };

template <class Epi, class Sched, bool GATHER, bool FP8 = false>
__device__ __forceinline__ void gemm_phase(LAS unsigned char* lds, const int wid, const int K, const int lda, const int ldb, const Sched& S, const Epi& E, const int scale_w = 0x7F7F7F7F, const int scale_a = 0x7F7F7F7F, const int stagger_ticks = 0) {
    const int lane = lane_id(), tid = (wid << 6) | lane, wr = wid >> 2, wc = wid & 3, fr = lane & 15, fq = lane >> 4;
    const int nt = K / BK;
    int Ra[2], Ca[2]; unsigned voffB[2];
#pragma unroll
    for (int i = 0; i < 2; ++i) { int R, C; stage_rc(tid * 16 + i * 8192, R, C); Ra[i] = R; Ca[i] = C; const int Rb = (R & ~31) + perm32(R & 31); voffB[i] = (unsigned)(Rb * ldb + C) * 2u; }
    const size_t kstep = (size_t)(BK * 2);
    const size_t hstepB = (size_t)HALF * ldb * 2;
    const unsigned ldsw = (unsigned)wid * 1024u;
    const unsigned ldsb = (unsigned)(size_t)lds;
    const int aoff = lds_byte(wr * 64 + fr, fq * 8), boff = lds_byte(wc * 32 + fr, fq * 8);
#define PG8_SA(b, h) (((b) * 2 + (h)) * HTB)
#define PG8_SB(b, h) ((4 + (b) * 2 + (h)) * HTB)
#define PG8_STAGE(bufoff, gbase, voff) do { const unsigned long long _ub = (unsigned long long)uni_ptr((const char*)(gbase)); _Pragma("unroll") for (int _i = 0; _i < 2; ++_i) { \
        unsigned _keep; const unsigned _ld = (unsigned)__builtin_amdgcn_readfirstlane((int)(ldsb + (unsigned)(bufoff) + ldsw + (unsigned)_i * 8192u)); \
        asm volatile("s_nop 4\n\ts_mov_b32 %0, m0\n\ts_mov_b32 m0, %3\n\ts_nop 0\n\tglobal_load_lds_dwordx4 %1, %2\n\ts_mov_b32 m0, %0" : "=&s"(_keep) : "v"((voff)[_i]), "s"(_ub), "s"(_ld) : "memory"); } } while (0)
#define PG8_LDA(dst, b, h) do { _Pragma("unroll") for (int m = 0; m < 4; ++m) _Pragma("unroll") for (int k = 0; k < 2; ++k) dst[m][k] = *(const LAS bf16x8*)(lds + PG8_SA(b, h) + aoff + m * 2048 + k * 1024); } while (0)
#define PG8_LDB(dst, b, h) do { _Pragma("unroll") for (int n = 0; n < 2; ++n) _Pragma("unroll") for (int k = 0; k < 2; ++k) dst[n][k] = *(const LAS bf16x8*)(lds + PG8_SB(b, h) + boff + n * 2048 + k * 1024); } while (0)
#define PG8_MMA(ai, bj, At, Bt) do { __builtin_amdgcn_s_setprio(1); _Pragma("unroll") for (int m = 0; m < 4; ++m) _Pragma("unroll") for (int n = 0; n < 2; ++n) { \
        if constexpr (FP8) { mfma8_tied(acc[ai][bj][m][n], cat8(Bt[n][0], Bt[n][1]), cat8(At[m][0], At[m][1]), scale_w, scale_a); } \
        else { _Pragma("unroll") for (int k = 0; k < 2; ++k) acc[ai][bj][m][n] = __builtin_amdgcn_mfma_f32_16x16x32_bf16(Bt[n][k], At[m][k], acc[ai][bj][m][n], 0, 0, 0); } } \
        __builtin_amdgcn_s_setprio(0); } while (0)
#define PG8_WAIT_V(n) asm volatile("s_waitcnt vmcnt(" #n ")" ::: "memory")
#define PG8_WAIT_L(n) asm volatile("s_waitcnt lgkmcnt(" #n ")" ::: "memory")
#define PG8_BAR __builtin_amdgcn_s_barrier()
#define PG8_SCHED __builtin_amdgcn_sched_barrier(0)
    if (stagger_ticks > 0 && ((blockIdx.x >> 3) & 1)) { const unsigned long long t0 = __builtin_amdgcn_s_memrealtime(); while (__builtin_amdgcn_s_memrealtime() - t0 < (unsigned long long)stagger_ticks) __builtin_amdgcn_s_sleep(8); }
    Unit cur, nxt; int ui = 0;
    if (!S.next(0, cur)) return;
    unsigned offA[2][2], offN[2][2];
#pragma unroll
    for (int h = 0; h < 2; ++h)
#pragma unroll
        for (int i = 0; i < 2; ++i) {
            const int rr = h * HALF + Ra[i];
            const int row = GATHER ? cur.gidx[rr] : rr;
            offA[h][i] = (unsigned)(row * lda + Ca[i]) * 2u; offN[h][i] = offA[h][i];
        }
    f32x4 acc[2][2][4][2];
#pragma unroll
    for (int a = 0; a < 2; ++a)
#pragma unroll
        for (int b = 0; b < 2; ++b)
#pragma unroll
            for (int m = 0; m < 4; ++m)
#pragma unroll
                for (int n = 0; n < 2; ++n) acc[a][b][m][n] = (f32x4){0.f, 0.f, 0.f, 0.f};
    bf16x8 At[4][2], B0[2][2], B1[2][2];
    const char* cA = cur.A; const char* cB = cur.B;
    PG8_STAGE(PG8_SB(0, 0), cB, voffB); PG8_STAGE(PG8_SB(0, 1), cB + hstepB, voffB); PG8_STAGE(PG8_SA(0, 0), cA, offA[0]); PG8_STAGE(PG8_SA(0, 1), cA, offA[1]);
    if (wr == 1) PG8_BAR;
    PG8_WAIT_V(2); PG8_BAR;
    PG8_STAGE(PG8_SB(1, 0), cB + kstep, voffB); PG8_STAGE(PG8_SA(1, 0), cA + kstep, offA[0]); PG8_STAGE(PG8_SB(1, 1), cB + hstepB + kstep, voffB);
    PG8_WAIT_V(6); PG8_BAR;
    for (;;) {
        const bool has_next = S.next(ui + 1, nxt);
        const char* nA = has_next ? nxt.A : cA; const char* nB = has_next ? nxt.B : cB;
        if constexpr (GATHER) {
            if (has_next) {
#pragma unroll
                for (int h = 0; h < 2; ++h)
#pragma unroll
                    for (int i = 0; i < 2; ++i) offN[h][i] = (unsigned)(nxt.gidx[h * HALF + Ra[i]] * lda + Ca[i]) * 2u;
            }
        }
#pragma unroll 1
        for (int t = 0; t < nt; t += 2) {
            const bool last = (t == nt - 2);
            const char* a1 = cA + (size_t)(t + 1) * kstep;
            const char* a2 = last ? nA : cA + (size_t)(t + 2) * kstep; const char* b2 = last ? nB : cB + (size_t)(t + 2) * kstep;
            const char* a3 = a2 + kstep; const char* b3 = b2 + kstep;
            unsigned o2[2][2];
#pragma unroll
            for (int h = 0; h < 2; ++h)
#pragma unroll
                for (int i = 0; i < 2; ++i) o2[h][i] = (GATHER && last) ? offN[h][i] : offA[h][i];
            PG8_LDB(B0, 0, 0); PG8_LDB(B1, 0, 1); PG8_SCHED; PG8_LDA(At, 0, 0); PG8_STAGE(PG8_SA(1, 1), a1, offA[1]);
            PG8_WAIT_V(8); PG8_WAIT_L(0); PG8_BAR; PG8_MMA(0, 0, At, B0); PG8_MMA(0, 1, At, B1); PG8_BAR; PG8_SCHED;
            PG8_LDA(At, 0, 1); PG8_STAGE(PG8_SB(0, 0), b2, voffB); PG8_STAGE(PG8_SB(0, 1), b2 + hstepB, voffB); PG8_STAGE(PG8_SA(0, 0), a2, o2[0]);
            PG8_WAIT_V(8); PG8_WAIT_L(0); PG8_BAR; PG8_MMA(1, 0, At, B0); PG8_MMA(1, 1, At, B1); PG8_BAR; PG8_SCHED;
            PG8_LDB(B0, 1, 0); PG8_LDB(B1, 1, 1); PG8_SCHED; PG8_LDA(At, 1, 0); PG8_STAGE(PG8_SA(0, 1), a2, o2[1]);
            PG8_WAIT_V(8); PG8_WAIT_L(0); PG8_BAR; PG8_MMA(0, 0, At, B0); PG8_MMA(0, 1, At, B1); PG8_BAR; PG8_SCHED;
            PG8_LDA(At, 1, 1); PG8_STAGE(PG8_SB(1, 0), b3, voffB); PG8_STAGE(PG8_SB(1, 1), b3 + hstepB, voffB); PG8_STAGE(PG8_SA(1, 0), a3, o2[0]);
            PG8_WAIT_V(8); PG8_WAIT_L(0); PG8_BAR; PG8_MMA(1, 0, At, B0); PG8_MMA(1, 1, At, B1); PG8_BAR; PG8_SCHED;
        }
        if (wr == 0) PG8_BAR;
        if constexpr (FP8) asm volatile("s_nop 15\n\ts_nop 15" ::: "memory");
        E(acc, cur, wr, wc, fr, fq);
        if (!has_next) break;
#pragma unroll
        for (int a = 0; a < 2; ++a)
#pragma unroll
            for (int b = 0; b < 2; ++b)
#pragma unroll
                for (int m = 0; m < 4; ++m)
#pragma unroll
                    for (int n = 0; n < 2; ++n) acc[a][b][m][n] = (f32x4){0.f, 0.f, 0.f, 0.f};
        cur = nxt; cA = nA; cB = nB; ++ui;
        if constexpr (GATHER) {
#pragma unroll
            for (int h = 0; h < 2; ++h)
#pragma unroll
                for (int i = 0; i < 2; ++i) offA[h][i] = offN[h][i];
        }
        if (wr == 1) PG8_BAR;
    }
    PG8_WAIT_V(0);
    PG8_BAR;
#undef PG8_SA
#undef PG8_SB
#undef PG8_STAGE
#undef PG8_LDA
#undef PG8_LDB
#undef PG8_MMA
#undef PG8_WAIT_V
#undef PG8_WAIT_L
#undef PG8_BAR
#undef PG8_SCHED
}

struct DenseOrder {
    const char* A; const char* Bt; size_t a_tile_bytes, b_tile_bytes; int nM, nN, nwg, G, c;
    __device__ void init(const void* A_, const void* Bt_, int M, int N, int lda, int ldb, int G_, int c_) {
        A = (const char*)A_; Bt = (const char*)Bt_; nM = M / BM; nN = N / BM; nwg = nM * nN; G = G_; c = c_;
        a_tile_bytes = (size_t)BM * lda * 2; b_tile_bytes = (size_t)BM * ldb * 2;
    }
    __device__ __forceinline__ bool next(int i, Unit& u) const {
        const long L = (long)i * G + c; if (L >= nwg) return false;
        int wgid = (int)L; { const int q = nwg / NXCD, r = nwg % NXCD, xcd = wgid % NXCD, off = wgid / NXCD; wgid = (xcd < r ? xcd * (q + 1) : r * (q + 1) + (xcd - r) * q) + off; }
        const int nig = WGM * nN, gid = wgid / nig, fm = gid * WGM, gsz = (nM - fm) < WGM ? (nM - fm) : WGM;
        u.pm = fm + ((wgid % nig) % gsz); u.pn = (wgid % nig) / gsz; u.aux = 0; u.gidx = nullptr; u.gl = 0;
        u.A = A + (size_t)u.pm * a_tile_bytes; u.B = Bt + (size_t)u.pn * b_tile_bytes; return true;
    }
};
}

#ifndef OUTPROJ_FP8
#define OUTPROJ_FP8 0
#endif
#define XB_TMO      128
#define XB_XCNT(j)  (256  + 64 * (j))
#define XB_XSUB(j)  (1280 + 64 * (j))
#define XB_XGEN(j)  (2304 + 64 * (j))
#define XB_TOP      3328
#define XB_TOPGEN   3392
#define XCD_BAR_WORDS 3456
#define XB_SPIN_CAP (1u << 18)

__device__ __forceinline__ unsigned xb_ld(unsigned* p)              { return __hip_atomic_load(p, __ATOMIC_RELAXED, __HIP_MEMORY_SCOPE_AGENT); }
__device__ __forceinline__ unsigned xb_add(unsigned* p, unsigned v) { return __hip_atomic_fetch_add(p, v, __ATOMIC_RELAXED, __HIP_MEMORY_SCOPE_AGENT); }
__device__ __forceinline__ unsigned xb_xcc_id() { return (unsigned)__builtin_amdgcn_s_getreg((3 << 11) | 20) & 0xFu; }
#define XB_SPIN(cond, bar) do { unsigned _sp = 0; while (cond) { __builtin_amdgcn_s_sleep(1); \
    if ((++_sp & 255u) == 0u) { if (xb_ld(&(bar)[XB_TMO])) break; if (_sp > XB_SPIN_CAP) { atomicAdd(&(bar)[XB_TMO], 1u); break; } } } } while (0)

struct XcdBarrier {
    unsigned* bar; unsigned x; int w;
    volatile LAS unsigned* st;
};
__device__ __forceinline__ XcdBarrier xcd_barrier_post(unsigned* bar, volatile LAS unsigned* st, int wave) {
    XcdBarrier b; b.bar = bar; b.x = xb_xcc_id(); b.st = st; b.w = wave;
    if (wave == 0 && lane_id() == 0) (void)xb_add(&bar[XB_XCNT(b.x)], 1u);
    return b;
}
__device__ __forceinline__ void xcd_barrier_complete(unsigned* bar, unsigned x, unsigned& nloc, unsigned& nx) {
    const unsigned G = gridDim.x * gridDim.y * gridDim.z;
    unsigned sum, cnt, mine, sp = 0u;
    for (;;) {
        sum = 0u; cnt = 0u; mine = 0u;
#pragma unroll
        for (unsigned j = 0; j < 16; ++j) { const unsigned c = xb_ld(&bar[XB_XCNT(j)]); sum += c; cnt += (c > 0u) ? 1u : 0u; mine = (j == x) ? c : mine; }
        if (sum == G) break;
        __builtin_amdgcn_s_sleep(1);
        if ((++sp & 255u) == 0u) { if (xb_ld(&bar[XB_TMO])) break; if (sp > XB_SPIN_CAP) { atomicAdd(&bar[XB_TMO], 1u); break; } }
    }
    nloc = mine > 0u ? mine : 1u; nx = cnt > 0u ? cnt : 1u;
}
__device__ __forceinline__ void xcd_barrier(const XcdBarrier& b) {
    asm volatile("s_waitcnt vmcnt(0)" ::: "memory");
    __syncthreads();
    if (b.w == 0 && lane_id() == 0) {
        unsigned* bar = b.bar;
        __builtin_amdgcn_s_waitcnt(0);
        unsigned nloc = b.st[0], nx = b.st[1];
        if (nloc == 0u) { xcd_barrier_complete(bar, b.x, nloc, nx); b.st[0] = nloc; b.st[1] = nx; }
        const unsigned old = xb_add(&bar[XB_XSUB(b.x)], 1u);
        const unsigned gen = old / nloc;
        if (old + 1u == (gen + 1u) * nloc) {
            __builtin_amdgcn_fence(__ATOMIC_RELEASE, "agent");
            asm volatile("s_waitcnt vmcnt(0)" ::: "memory");
            const unsigned og = xb_add(&bar[XB_TOP], 1u);
            const unsigned tg = og / nx;
            if (og + 1u == (tg + 1u) * nx) xb_add(&bar[XB_TOPGEN], 1u);
            else XB_SPIN(xb_ld(&bar[XB_TOPGEN]) == tg, bar);
            __builtin_amdgcn_fence(__ATOMIC_ACQUIRE, "agent");
            xb_add(&bar[XB_XGEN(b.x)], 1u);
            asm volatile("s_waitcnt vmcnt(0)" ::: "memory");
        } else {
            XB_SPIN(xb_ld(&bar[XB_XGEN(b.x)]) == gen, bar);
            __builtin_amdgcn_fence(__ATOMIC_ACQUIRE, "agent");
            asm volatile("s_waitcnt vmcnt(0)" ::: "memory");
        }
    }
    __syncthreads();
}

constexpr size_t MiB = 1u << 20;
constexpr size_t WS_CTL = 0, CTL_ZERO_BYTES = 1 * MiB;
constexpr size_t WS_SMALL = 1 * MiB;
constexpr size_t WS_RSTD1 = WS_SMALL;
constexpr size_t WS_LOGI = WS_SMALL + 1 * MiB;
constexpr size_t WS_LOGF = WS_SMALL + 2 * MiB;
constexpr size_t WS_TOPI = WS_SMALL + 3 * MiB;
constexpr size_t WS_TOPG = WS_SMALL + 4 * MiB;
constexpr size_t WS_STOK = WS_SMALL + 5 * MiB;
constexpr size_t WS_SGATE = WS_SMALL + 6 * MiB;
constexpr size_t WS_ESTART = WS_SMALL + 7 * MiB;
constexpr size_t WS_BTIN = 17 * MiB;
constexpr size_t WS_BTOUT = 25 * MiB;
constexpr size_t WS_BT1 = 29 * MiB;
constexpr size_t WS_BT2 = 157 * MiB;
constexpr size_t WS_R1 = 221 * MiB;
constexpr size_t WS_XM = 285 * MiB;
constexpr size_t WS_SZ = 349 * MiB;
constexpr size_t WS_U = 413 * MiB;
constexpr size_t WS_Q = 477 * MiB;
constexpr size_t WS_YMIX = 477 * MiB;
constexpr size_t WS_ACT = 285 * MiB;
constexpr size_t WS_NEED = 925 * MiB;

constexpr int NWAVES = 8;
constexpr int RING_BYTES = 131072;
constexpr int LDSCTL_OFF = RING_BYTES;
constexpr int LDS_BYTES = 147456;
constexpr int CW_BAR = 4096;

struct MegaArgs {
    const float* in[27];
    float* out;
    unsigned char* ws;
    int ph_lo, ph_hi, li, pad;
};

__device__ __forceinline__ unsigned pk2(float lo, float hi) { return pg8::cvt_pk_bf16(lo, hi); }

__device__ __forceinline__ void unpack8(const u32x4 r, float (&f)[8]) {
    f[0] = __uint_as_float(r.x << 16); f[1] = __uint_as_float(r.x & 0xFFFF0000u); f[2] = __uint_as_float(r.y << 16); f[3] = __uint_as_float(r.y & 0xFFFF0000u);
    f[4] = __uint_as_float(r.z << 16); f[5] = __uint_as_float(r.z & 0xFFFF0000u); f[6] = __uint_as_float(r.w << 16); f[7] = __uint_as_float(r.w & 0xFFFF0000u);
}

__device__ __forceinline__ f32x4 up4(const u32x2 r) { f32x4 v; v.x = __uint_as_float(r.x << 16); v.y = __uint_as_float(r.x & 0xFFFF0000u); v.z = __uint_as_float(r.y << 16); v.w = __uint_as_float(r.y & 0xFFFF0000u); return v; }

__device__ __forceinline__ void p0_transpose_item(const float* W, int K, int N, bf16_t* WT, const float* ksc, int k0, int n0s, int n0d, LAS float* scr, int lane) {
    const int kr = lane >> 4, nq = lane & 15;
    f32x4 v[16];
#pragma unroll
    for (int i = 0; i < 16; ++i) v[i] = *(const f32x4*)(W + (size_t)(k0 + 4 * i + kr) * N + n0s + 4 * nq);
    if (ksc) {
#pragma unroll
        for (int i = 0; i < 16; ++i) v[i] = v[i] * ksc[k0 + 4 * i + kr];
    }
    const int c = lane >> 4, nl = lane & 15;
#pragma unroll
    for (int half = 0; half < 2; ++half) {
#pragma unroll
        for (int ii = 0; ii < 8; ++ii) *(LAS f32x4*)(scr + (4 * ii + kr) * 68 + 4 * nq) = v[8 * half + ii];
        asm volatile("s_waitcnt lgkmcnt(0)" ::: "memory");
#pragma unroll
        for (int j = 0; j < 4; ++j) { const int n = nl + 16 * j; const LAS float* sp = scr + (8 * c) * 68 + n;
            u32x4 o; o.x = pk2(sp[0 * 68], sp[1 * 68]); o.y = pk2(sp[2 * 68], sp[3 * 68]); o.z = pk2(sp[4 * 68], sp[5 * 68]); o.w = pk2(sp[6 * 68], sp[7 * 68]);
            *(u32x4*)(WT + (size_t)(n0d + n) * K + k0 + 32 * half + 8 * c) = o; }
        asm volatile("s_waitcnt lgkmcnt(0)" ::: "memory");
    }
}
__device__ __forceinline__ unsigned pk4_fp8(float a, float b, float c, float d) { int w = __builtin_amdgcn_cvt_pk_fp8_f32(a, b, 0, false); w = __builtin_amdgcn_cvt_pk_fp8_f32(c, d, w, true); return (unsigned)w; }
struct TrItem { const float* W; unsigned char* WT; const float* ksc; int K, N, k0, n0s, n0d; };
__device__ __forceinline__ void tr8_load(const TrItem& t, int lane, f32x4 (&v)[16]) {
    const int kr = lane >> 4, nq = lane & 15;
#pragma unroll
    for (int i = 0; i < 16; ++i) v[i] = *(const f32x4*)(t.W + (size_t)(t.k0 + 4 * i + kr) * t.N + t.n0s + 4 * nq);
}
__device__ __forceinline__ void tr8_finish(const TrItem& t, float mul, LAS float* scr, int lane, f32x4 (&v)[16]) {
    const int kr = lane >> 4, nq = lane & 15;
#pragma unroll
    for (int i = 0; i < 16; ++i) v[i] = v[i] * (t.ksc ? t.ksc[t.k0 + 4 * i + kr] * mul : mul);
    const int c = lane >> 4, nl = lane & 15;
#pragma unroll
    for (int half = 0; half < 2; ++half) {
#pragma unroll
        for (int ii = 0; ii < 8; ++ii) *(LAS f32x4*)(scr + (4 * ii + kr) * 68 + 4 * nq) = v[8 * half + ii];
        asm volatile("s_waitcnt lgkmcnt(0)" ::: "memory");
#pragma unroll
        for (int j = 0; j < 4; ++j) { const int n = nl + 16 * j; const LAS float* sp = scr + (8 * c) * 68 + n;
            u32x2 o; o.x = pk4_fp8(sp[0 * 68], sp[1 * 68], sp[2 * 68], sp[3 * 68]); o.y = pk4_fp8(sp[4 * 68], sp[5 * 68], sp[6 * 68], sp[7 * 68]);
            *(u32x2*)(t.WT + (size_t)(t.n0d + n) * t.K + t.k0 + 32 * half + 8 * c) = o; }
        asm volatile("s_waitcnt lgkmcnt(0)" ::: "memory");
    }
}
__device__ __forceinline__ void p0_transpose_item8(const float* W, int K, int N, unsigned char* WT, const float* ksc, float mul, int k0, int n0s, int n0d, LAS float* scr, int lane) {
    TrItem t{W, WT, ksc, K, N, k0, n0s, n0d}; f32x4 v[16]; tr8_load(t, lane, v); tr8_finish(t, mul, scr, lane, v);
}
__device__ __forceinline__ int inproj_src_col(int nd) { if (nd < 2048) return nd; const int pn = (nd >> 8) - 8, lc = nd & 255; return 2048 + (lc >> 7) * 1024 + 128 * pn + (lc & 127); }
__device__ __forceinline__ int w1_src_col(int nd) { const int pn = nd >> 8, lc = nd & 255; return (lc >> 7) * 1024 + 128 * pn + (lc & 127); }

__device__ __forceinline__ void p0_prologue(const MegaArgs& a, LAS unsigned char* lds, int gw, int NGW, int wave, int lane) {
    LAS float* scr = (LAS float*)(lds + wave * 16384);
    unsigned char* ws = a.ws;
    const float* x = a.in[0];
    {
        bf16_t* xbf = (bf16_t*)(ws + WS_R1); float* rstd1 = (float*)(ws + WS_RSTD1);
        f32x4 va[4], vb[4];
#define XROW_LOAD(V, m_) do { const f32x4* xr_ = (const f32x4*)(x + (size_t)(m_) * DM) + lane; _Pragma("unroll") for (int j = 0; j < 4; ++j) V[j] = xr_[64 * j]; } while (0)
#define XROW_DONE(V, m_) do { float s_ = 0.f; _Pragma("unroll") for (int j = 0; j < 4; ++j) s_ += (V[j].x * V[j].x + V[j].y * V[j].y) + (V[j].z * V[j].z + V[j].w * V[j].w); \
            s_ = wave_sum(s_); if (lane == 0) rstd1[m_] = rsqrtf(s_ * (1.0f / DM) + EPSV); \
            unsigned long long* o8_ = (unsigned long long*)(xbf + (size_t)(m_) * DM) + lane; \
            _Pragma("unroll") for (int j = 0; j < 4; ++j) o8_[64 * j] = (unsigned long long)pk2(V[j].x, V[j].y) | ((unsigned long long)pk2(V[j].z, V[j].w) << 32); } while (0)
        int m = gw;
        if (m < NTOK) XROW_LOAD(va, m);
        for (; m < NTOK; m += 2 * NGW) {
            const int m2 = m + NGW;
            if (m2 < NTOK) XROW_LOAD(vb, m2);
            XROW_DONE(va, m);
            if (m2 < NTOK) { const int m3 = m2 + NGW; if (m3 < NTOK) XROW_LOAD(va, m3); XROW_DONE(vb, m2); }
        }
#undef XROW_LOAD
#undef XROW_DONE
    }
    constexpr int I_IN = (1024 / 64) * (4096 / 64);
    for (int it = gw; it < I_IN; it += NGW) { const int kb = it / 64, nb = it % 64; p0_transpose_item(a.in[2], 1024, 4096, (bf16_t*)(ws + WS_BTIN), a.in[1], 64 * kb, inproj_src_col(64 * nb), 64 * nb, scr, lane); }
}
__device__ __forceinline__ TrItem p0b_item(const MegaArgs& a, int r) {
    unsigned char* ws = a.ws;
    constexpr int I_W1 = 32 * (1024 / 64) * (2048 / 64);
    if (r < I_W1) { const int e = r / 512, rr = r % 512, kb = rr / 32, nb = rr % 32;
        return TrItem{a.in[22] + (size_t)e * 1024 * 2048, ws + WS_BT1 + (size_t)e * 2048 * 1024, a.in[19], 1024, 2048, 64 * kb, w1_src_col(64 * nb), 64 * nb}; }
    r -= I_W1;
    const int e = r / 256, rr = r % 256, kb = rr / 16, nb = rr % 16;
    return TrItem{a.in[24] + (size_t)e * 1024 * 1024, ws + WS_BT2 + (size_t)e * 1024 * 1024, nullptr, 1024, 1024, 64 * kb, 64 * nb, 64 * nb};
}
__device__ __forceinline__ void p0b_weights(const MegaArgs& a, LAS unsigned char* lds, int gw, int NGW, int wave, int lane) {
    LAS float* scr = (LAS float*)(lds + wave * 16384);
    unsigned char* ws = a.ws;
    constexpr int I_OUT = (2048 / 64) * (1024 / 64);
    constexpr int NITEMS = 32 * (1024 / 64) * (2048 / 64) + 32 * (1024 / 64) * (1024 / 64);
    for (int it = gw; it < I_OUT; it += NGW) { const int kb = it / 16, nb = it % 16;
#if OUTPROJ_FP8
        p0_transpose_item8(a.in[18], 2048, 1024, ws + WS_BTOUT, nullptr, 32.0f, 64 * kb, 64 * nb, 64 * nb, scr, lane);
#else
        p0_transpose_item(a.in[18], 2048, 1024, (bf16_t*)(ws + WS_BTOUT), nullptr, 64 * kb, 64 * nb, 64 * nb, scr, lane);
#endif
    }
    f32x4 vA[16], vB[16];
    int it = gw;
    if (it < NITEMS) { const TrItem t = p0b_item(a, it); tr8_load(t, lane, vA); }
    for (; it < NITEMS; it += 2 * NGW) {
        const int it2 = it + NGW;
        if (it2 < NITEMS) { const TrItem t2 = p0b_item(a, it2); tr8_load(t2, lane, vB); }
        { const TrItem t = p0b_item(a, it); tr8_finish(t, 32.0f, scr, lane, vA); }
        if (it2 < NITEMS) {
            const int it3 = it2 + NGW;
            if (it3 < NITEMS) { const TrItem t3 = p0b_item(a, it3); tr8_load(t3, lane, vA); }
            const TrItem t2 = p0b_item(a, it2); tr8_finish(t2, 32.0f, scr, lane, vB);
        }
    }
}

struct EpiInProj {
    const float* rstd; bf16_t* xm; bf16_t* sz; bf16_t* u; int variant;
    __device__ __forceinline__ void operator()(const f32x4 (&acc)[2][2][4][2], const pg8::Unit& un, int wr, int wc, int fr, int fq) const {
        if (variant & 8) return;
        const int row0 = un.pm * 256 + wr * 64 + fr;
        const int cl = wc * 32 + 8 * fq;
        float rsv[2][4];
#pragma unroll
        for (int ai = 0; ai < 2; ++ai)
#pragma unroll
            for (int m = 0; m < 4; ++m) rsv[ai][m] = rstd[row0 + ai * 128 + m * 16];
#pragma unroll
        for (int ai = 0; ai < 2; ++ai)
#pragma unroll
            for (int m = 0; m < 4; ++m) {
                const int row = row0 + ai * 128 + m * 16;
                const float rs = rsv[ai][m];
                if (un.pn < 8) {
                    bf16_t* dst = (un.pn < 4 ? xm : sz) + (size_t)row * DM + (un.pn & 3) * 256 + cl;
#pragma unroll
                    for (int bj = 0; bj < 2; ++bj) {
                        f32x4 v0 = acc[ai][bj][m][0] * rs, v1 = acc[ai][bj][m][1] * rs;
                        if (un.pn >= 4) {
#pragma unroll
                            for (int j = 0; j < 4; ++j) { v0[j] = siluf_(v0[j]); v1[j] = siluf_(v1[j]); }
                        }
                        u32x4 w; w.x = pg8::cvt_pk_bf16(v0[0], v0[1]); w.y = pg8::cvt_pk_bf16(v0[2], v0[3]); w.z = pg8::cvt_pk_bf16(v1[0], v1[1]); w.w = pg8::cvt_pk_bf16(v1[2], v1[3]);
                        if (!(variant & 4)) *(u32x4*)(dst + bj * 128) = w;
                    }
                } else {
                    bf16_t* dst = u + (size_t)row * DM + (un.pn - 8) * 128 + cl;
                    f32x4 o0, o1;
#pragma unroll
                    for (int j = 0; j < 4; ++j) {
                        o0[j] = (acc[ai][0][m][0][j] * rs) * sigmoidf_(acc[ai][1][m][0][j] * rs);
                        o1[j] = (acc[ai][0][m][1][j] * rs) * sigmoidf_(acc[ai][1][m][1][j] * rs);
                    }
                    u32x4 w; w.x = pg8::cvt_pk_bf16(o0[0], o0[1]); w.y = pg8::cvt_pk_bf16(o0[2], o0[3]); w.z = pg8::cvt_pk_bf16(o1[0], o1[1]); w.w = pg8::cvt_pk_bf16(o1[2], o1[3]);
                    if (!(variant & 4)) *(u32x4*)dst = w;
                }
            }
    }
};

constexpr size_t WS_WGCNT = WS_SMALL + 8 * MiB;
constexpr size_t WS_ASGE = WS_SMALL + 9 * MiB;
constexpr size_t WS_ASGR = WS_SMALL + 10 * MiB;
constexpr size_t WS_ASGG = WS_SMALL + 11 * MiB;
constexpr size_t WS_RSTD2 = WS_SMALL + 12 * MiB;
constexpr size_t WS_SRSTD = WS_SMALL + 13 * MiB;
constexpr size_t WS_TOKSLOT = WS_SMALL + 14 * MiB;
constexpr size_t WS_TILEEXP = WS_SMALL + 15 * MiB;
constexpr size_t WS_HBF = WS_R1;
constexpr size_t WS_YROWS = 605 * MiB;
constexpr size_t WS_HB16 = 750 * MiB;
constexpr int NSLOT = NASSIGN + NEXP * 256;
constexpr int TOK_PER_WG = NTOK / 256;

constexpr size_t WS_WRH = WS_SMALL + 576 * 1024;
constexpr size_t WS_WRL = WS_SMALL + 640 * 1024;
__device__ __forceinline__ void p0_router_tables(const MegaArgs& a, int gw, int NGW, int lane) {
    const float* nfw = a.in[19]; const float* wr = a.in[20];
    bf16_t* wh = (bf16_t*)(a.ws + WS_WRH); bf16_t* wl = (bf16_t*)(a.ws + WS_WRL);
    for (int idx = gw * 64 + lane; idx < 32 * 1024; idx += NGW * 64) {
        const int e = idx >> 10, k = idx & 1023;
        const float w = nfw[k] * wr[(size_t)k * 32 + e];
        const bf16_t hi = f2bf(w);
        wh[idx] = hi; wl[idx] = f2bf(w - bf2f(hi));
    }
}
constexpr int RT_LDS_OFF = LDSCTL_OFF + 5120;
struct RtGrp { u32x4 h[8]; };
__device__ __forceinline__ void rt_load_grp(const bf16_t* hrow, int k0, RtGrp& B) {
#pragma unroll
    for (int q = 0; q < 8; ++q) B.h[q] = *(const u32x4*)(hrow + k0 + 32 * q);
}
__device__ __forceinline__ void rt_step(const LAS bf16_t* whl, const LAS bf16_t* wll, int col, int kk, const u32x4 hraw, f32x4& acc0, f32x4& acc1, float& ssq) {
    float v[8]; unpack8(hraw, v);
#pragma unroll
    for (int i = 0; i < 8; ++i) ssq += v[i] * v[i];
    const bf16x8 ah = __builtin_bit_cast(bf16x8, hraw);
    const int ks = kk ^ (col << 3);
    const u32x4 bh0 = *(const LAS u32x4*)(whl + col * 1024 + ks), bh1 = *(const LAS u32x4*)(whl + (col + 16) * 1024 + ks);
    const u32x4 bl0 = *(const LAS u32x4*)(wll + col * 1024 + ks), bl1 = *(const LAS u32x4*)(wll + (col + 16) * 1024 + ks);
    acc0 = __builtin_amdgcn_mfma_f32_16x16x32_bf16(ah, __builtin_bit_cast(bf16x8, bh0), acc0, 0, 0, 0);
    acc0 = __builtin_amdgcn_mfma_f32_16x16x32_bf16(ah, __builtin_bit_cast(bf16x8, bl0), acc0, 0, 0, 0);
    acc1 = __builtin_amdgcn_mfma_f32_16x16x32_bf16(ah, __builtin_bit_cast(bf16x8, bh1), acc1, 0, 0, 0);
    acc1 = __builtin_amdgcn_mfma_f32_16x16x32_bf16(ah, __builtin_bit_cast(bf16x8, bl1), acc1, 0, 0, 0);
}
template <int CTRL> __device__ __forceinline__ void argmax_step(float& v, int& i) {
    const float ov = dpp_mov_f<CTRL>(v); const int oi = __builtin_amdgcn_update_dpp(0, i, CTRL, 0xf, 0xf, false);
    const bool take = (ov > v) || (ov == v && oi < i);
    v = take ? ov : v; i = take ? oi : i;
}
__device__ __forceinline__ void phase_router(const MegaArgs& a, LAS unsigned char* lds, int tid, int lane, int wave) {
    unsigned char* ws = a.ws;
    const bf16_t* hbuf = (const bf16_t*)(ws + WS_HB16);
    const float* br = a.in[21];
    const bf16_t* wh = (const bf16_t*)(ws + WS_WRH); const bf16_t* wl = (const bf16_t*)(ws + WS_WRL);
    float* rstd2 = (float*)(ws + WS_RSTD2);
    int* wgcnt = (int*)(ws + WS_WGCNT); int* asg_e = (int*)(ws + WS_ASGE); int* asg_r = (int*)(ws + WS_ASGR); float* asg_g = (float*)(ws + WS_ASGG);
    LAS int* topi_l = (LAS int*)(lds + RT_LDS_OFF);
    LAS float* topg_l = (LAS float*)(lds + RT_LDS_OFF + 2048);
    LAS int* rank_l = (LAS int*)(lds + RT_LDS_OFF + 4096);
    LAS float* rstd_l = (LAS float*)(lds + RT_LDS_OFF + 6144);
    LAS bf16_t* whl = (LAS bf16_t*)lds;
    LAS bf16_t* wll = (LAS bf16_t*)(lds + 65536);
    for (int i = tid; i < 8192; i += NWAVES * 64) { const int r = i >> 7, c8 = i & 127;
        *(LAS u32x4*)(lds + 16 * ((r << 7) + (c8 ^ (r & 15)))) = *(const u32x4*)((const unsigned char*)wh + 16 * (size_t)i); }
    __syncthreads();
    const int b = blockIdx.x;
    const int col = lane & 15, kq = lane >> 4;
    {
        const int t = b * TOK_PER_WG + wave * 16 + col;
        const bf16_t* hrow = hbuf + (size_t)t * DM + 8 * kq;
        f32x4 acc0 = (f32x4){0.f, 0.f, 0.f, 0.f}, acc1 = acc0; float ssq = 0.f;
        RtGrp A, B;
        rt_load_grp(hrow, 0, A);
        for (int g = 0; g < 4; g += 2) {
            rt_load_grp(hrow, 256 * (g + 1), B);
#pragma unroll
            for (int q = 0; q < 8; ++q) rt_step(whl, wll, col, 256 * g + 32 * q + 8 * kq, A.h[q], acc0, acc1, ssq);
            if (g + 2 < 4) rt_load_grp(hrow, 256 * (g + 2), A);
#pragma unroll
            for (int q = 0; q < 8; ++q) rt_step(whl, wll, col, 256 * (g + 1) + 32 * q + 8 * kq, B.h[q], acc0, acc1, ssq);
        }
        ssq += __builtin_bit_cast(float, __builtin_amdgcn_ds_swizzle(__builtin_bit_cast(int, ssq), 0x401F));
        { const auto rr = __builtin_amdgcn_permlane32_swap(__float_as_uint(ssq), __float_as_uint(ssq), false, false); ssq = __uint_as_float(rr[0]) + __uint_as_float(rr[1]); }
        const float rs = rsqrtf(ssq * (1.0f / DM) + EPSV);
        if (kq == 0) { rstd_l[wave * 16 + col] = rs; rstd2[t] = rs; }
        asm volatile("s_waitcnt lgkmcnt(0)" ::: "memory");
        const float b0 = br[col], b1 = br[col + 16];
#pragma unroll
        for (int r = 0; r < 4; ++r) {
            const float rsr = rstd_l[wave * 16 + 4 * kq + r];
            float v0 = acc0[r] * rsr + b0, v1 = acc1[r] * rsr + b1;
            int sel[4]; float val[4];
#pragma unroll
            for (int it = 0; it < 4; ++it) {
                float bv = (v1 > v0) ? v1 : v0; int bi = (v1 > v0) ? col + 16 : col;
                argmax_step<0xB1>(bv, bi); argmax_step<0x4E>(bv, bi); argmax_step<0x124>(bv, bi); argmax_step<0x128>(bv, bi);
                sel[it] = bi; val[it] = bv;
                if (bi == col) v0 = -3.0e38f;
                if (bi == col + 16) v1 = -3.0e38f;
            }
            float ex[4], sum = 0.f;
#pragma unroll
            for (int it = 0; it < 4; ++it) { ex[it] = __expf(val[it] - val[0]); sum += ex[it]; }
            const float inv = 1.0f / sum;
            if (col == 0) {
                const int tw = wave * 16 + 4 * kq + r;
#pragma unroll
                for (int it = 0; it < 4; ++it) { topi_l[tw * 4 + it] = sel[it]; topg_l[tw * 4 + it] = ex[it] * inv; }
            }
        }
    }
    __syncthreads();
    if (wave == 0) {
        int base = 0;
        for (int ch = 0; ch < 8; ++ch) {
            const int E = topi_l[ch * 64 + lane];
            int myrank = 0;
#pragma unroll
            for (int e = 0; e < 32; ++e) {
                const unsigned long long m = __ballot(E == e);
                const int be = __builtin_amdgcn_readlane(base, e);
                if (E == e) myrank = be + __builtin_popcountll(m & ((1ull << lane) - 1ull));
                if (lane == e) base += __builtin_popcountll(m);
            }
            rank_l[ch * 64 + lane] = myrank;
        }
        if (lane < 32) wgcnt[b * 32 + lane] = base;
    }
    __syncthreads();
    {
        int i = tid; asm volatile("" : "+v"(i));
        const int aidx = b * TOK_PER_WG * 4 + i;
        asg_e[aidx] = topi_l[i]; asg_r[aidx] = rank_l[i]; asg_g[aidx] = topg_l[i];
    }
}

__device__ __forceinline__ void phase_slots(const MegaArgs& a, LAS unsigned char* lds, int tid) {
    unsigned char* ws = a.ws;
    const int* wgcnt = (const int*)(ws + WS_WGCNT); const int* asg_e = (const int*)(ws + WS_ASGE); const int* asg_r = (const int*)(ws + WS_ASGR); const float* asg_g = (const float*)(ws + WS_ASGG);
    const float* rstd2 = (const float*)(ws + WS_RSTD2);
    int* slot_tok = (int*)(ws + WS_STOK); float* slot_gate = (float*)(ws + WS_SGATE); float* slot_rstd = (float*)(ws + WS_SRSTD);
    int* tok_slot = (int*)(ws + WS_TOKSLOT); int* tile_exp = (int*)(ws + WS_TILEEXP);
    LAS int* tot = (LAS int*)lds; LAS int* bef = tot + 32; LAS int* tstart = bef + 32;
    const int b = blockIdx.x;
    if (tid < 32) {
        int t = 0, bf = 0;
        for (int bb = 0; bb < 256; ++bb) { const int c = wgcnt[bb * 32 + tid]; t += c; if (bb < b) bf += c; }
        tot[tid] = t; bef[tid] = bf;
    }
    __syncthreads();
    if (tid == 0) { int ts = 0; for (int e = 0; e < 32; ++e) { tstart[e] = ts; ts += (tot[e] + 255) >> 8; } tstart[32] = ts; }
    __syncthreads();
    {
        int tid_o = tid; asm volatile("" : "+v"(tid_o));
        const int aidx = b * TOK_PER_WG * 4 + tid_o;
        const int e = asg_e[aidx];
        const int slot = 256 * tstart[e] + bef[e] + asg_r[aidx];
        const int tk = aidx >> 2;
        slot_tok[slot] = tk; slot_gate[slot] = asg_g[aidx]; slot_rstd[slot] = rstd2[tk]; tok_slot[aidx] = slot;
    }
    if (b < 32) {
        const int e = b; const int s0 = 256 * tstart[e] + tot[e], s1 = 256 * tstart[e + 1];
        for (int s = s0 + tid; s < s1; s += NWAVES * 64) { slot_tok[s] = 0; slot_gate[s] = 0.f; slot_rstd[s] = 0.f; }
    }
    if (b == 0) {
        if (tid < 32) for (int t = tstart[tid]; t < tstart[tid + 1]; ++t) tile_exp[t] = tid;
        if (tid == 0) tile_exp[2048] = tstart[32];
    }
}

struct MoeOrder {
    const char* A; const char* Bt; const int* gidx; const int* tile_exp; size_t a_tile_bytes, b_exp_bytes, b_tile_bytes; int T, nN, group, c;
    __device__ __forceinline__ bool next(int i, pg8::Unit& u) const {
        const int x = c & 7, j = c >> 3;
        const int tile = (i * 8 + x) * group + (j % group);
        if (tile >= T) return false;
        const int e = __builtin_amdgcn_readfirstlane(tile_exp[tile]);
        u.pm = tile; u.pn = j / group; u.aux = e; u.gl = 0;
        u.gidx = gidx ? gidx + 256 * tile : nullptr;
        u.A = gidx ? A : A + (size_t)tile * a_tile_bytes;
        u.B = Bt + (size_t)e * b_exp_bytes + (size_t)u.pn * b_tile_bytes;
        return true;
    }
};

struct EpiMoe1 {
    const float* srstd; const float* b1; unsigned char* act; int variant;
    __device__ __forceinline__ void operator()(const f32x4 (&acc)[2][2][4][2], const pg8::Unit& un, int wr, int wc, int fr, int fq) const {
        if (variant & 8) return;
        const int e = un.aux;
        const int cl = un.pn * 128 + wc * 32 + 8 * fq;
        f32x4 bg[2], bl[2];
#pragma unroll
        for (int n = 0; n < 2; ++n) { bg[n] = *(const f32x4*)(b1 + (size_t)e * 2048 + cl + 4 * n); bl[n] = *(const f32x4*)(b1 + (size_t)e * 2048 + 1024 + cl + 4 * n); }
        const int slot0 = un.pm * 256 + wr * 64 + fr;
        float rsv[2][4];
#pragma unroll
        for (int ai = 0; ai < 2; ++ai)
#pragma unroll
            for (int m = 0; m < 4; ++m) rsv[ai][m] = srstd[slot0 + ai * 128 + m * 16];
#pragma unroll
        for (int ai = 0; ai < 2; ++ai)
#pragma unroll
            for (int m = 0; m < 4; ++m) {
                const int slot = slot0 + ai * 128 + m * 16;
                const float rs = rsv[ai][m];
                f32x4 o[2];
#pragma unroll
                for (int n = 0; n < 2; ++n)
#pragma unroll
                    for (int j = 0; j < 4; ++j) {
                        const float g = acc[ai][0][m][n][j] * rs + bg[n][j];
                        const float l = acc[ai][1][m][n][j] * rs + bl[n][j];
                        const float xg = fminf(g, 7.0f);
                        const float xl = fminf(fmaxf(l, -7.0f), 7.0f);
                        o[n][j] = xg * sigmoidf_(1.702f * xg) * (xl + 1.0f);
                    }
                u32x2 w; w.x = pk4_fp8(o[0][0], o[0][1], o[0][2], o[0][3]); w.y = pk4_fp8(o[1][0], o[1][1], o[1][2], o[1][3]);
                *(u32x2*)(act + (size_t)slot * DM + cl) = w;
            }
    }
};
struct EpiMoe2 {
    const float* sgate; const float* b2; unsigned char* yrows;
    __device__ __forceinline__ void operator()(const f32x4 (&acc)[2][2][4][2], const pg8::Unit& un, int wr, int wc, int fr, int fq) const {
        const int e = un.aux;
        const int c0 = un.pn * 256 + wc * 32 + 8 * fq;
        f32x4 bv[2][2];
#pragma unroll
        for (int bj = 0; bj < 2; ++bj)
#pragma unroll
            for (int n = 0; n < 2; ++n) bv[bj][n] = *(const f32x4*)(b2 + (size_t)e * DM + c0 + bj * 128 + 4 * n);
        const int slot0 = un.pm * 256 + wr * 64 + fr;
        float gtv[2][4];
#pragma unroll
        for (int ai = 0; ai < 2; ++ai)
#pragma unroll
            for (int m = 0; m < 4; ++m) gtv[ai][m] = sgate[slot0 + ai * 128 + m * 16] * 16.0f;
#pragma unroll
        for (int ai = 0; ai < 2; ++ai)
#pragma unroll
            for (int m = 0; m < 4; ++m) {
                const int slot = slot0 + ai * 128 + m * 16;
                const float gt = gtv[ai][m];
#pragma unroll
                for (int bj = 0; bj < 2; ++bj) {
                    const f32x4 v0 = (acc[ai][bj][m][0] + bv[bj][0]) * gt, v1 = (acc[ai][bj][m][1] + bv[bj][1]) * gt;
                    u32x2 w; w.x = pk4_fp8(v0[0], v0[1], v0[2], v0[3]); w.y = pk4_fp8(v1[0], v1[1], v1[2], v1[3]);
                    *(u32x2*)(yrows + (size_t)slot * DM + c0 + bj * 128) = w;
                }
            }
    }
};

struct FinBuf { u32x2 h[4]; unsigned y[4][4]; };
__device__ __forceinline__ void fin_load(const bf16_t* hbuf, const unsigned char* yrows, const int slots, int kk, int t, int lane, FinBuf& B) {
    const u32x2* hp = (const u32x2*)(hbuf + (size_t)t * DM) + lane;
#pragma unroll
    for (int j = 0; j < 4; ++j) B.h[j] = hp[64 * j];
#pragma unroll
    for (int r = 0; r < 4; ++r) {
        const int slot = __builtin_amdgcn_readlane(slots, 4 * kk + r);
        const unsigned* yp = (const unsigned*)(yrows + (size_t)slot * DM) + lane;
#pragma unroll
        for (int j = 0; j < 4; ++j) B.y[r][j] = yp[64 * j];
    }
}
__device__ __forceinline__ void fin_compute(float* obuf, const float* fw, int t, int lane, const FinBuf& B) {
    f32x4 v[4];
#pragma unroll
    for (int j = 0; j < 4; ++j) {
        v[j] = up4(B.h[j]);
#pragma unroll
        for (int r = 0; r < 4; ++r) {
            const unsigned w = B.y[r][j];
            const f32x2 lo = __builtin_amdgcn_cvt_pk_f32_fp8(w, false), hi = __builtin_amdgcn_cvt_pk_f32_fp8(w, true);
            v[j].x += lo.x * 0.0625f; v[j].y += lo.y * 0.0625f; v[j].z += hi.x * 0.0625f; v[j].w += hi.y * 0.0625f;
        }
    }
    float s = 0.f;
#pragma unroll
    for (int j = 0; j < 4; ++j) s += (v[j].x * v[j].x + v[j].y * v[j].y) + (v[j].z * v[j].z + v[j].w * v[j].w);
    s = wave_sum(s);
    const float rs = rsqrtf(s * (1.0f / DM) + EPSV);
    f32x4* hp = (f32x4*)(obuf + (size_t)t * DM) + lane;
#pragma unroll
    for (int j = 0; j < 4; ++j) {
        const f32x4 w = *((const f32x4*)fw + lane + 64 * j);
        hp[64 * j] = v[j] * rs * w;
    }
}
__device__ __forceinline__ void phase_final(const MegaArgs& a, int gw, int NGW, int lane) {
    unsigned char* ws = a.ws;
    float* obuf = a.out; const float* fw = a.in[26]; const bf16_t* hbuf = (const bf16_t*)(ws + WS_HB16);
    const unsigned char* yrows = ws + WS_YROWS; const int* tok_slot = (const int*)(ws + WS_TOKSLOT);
    int slots = 0;
    { const int tk = gw + (lane >> 2) * NGW; if (tk < NTOK) slots = __hip_atomic_load(tok_slot + (size_t)tk * 4 + (lane & 3), __ATOMIC_RELAXED, __HIP_MEMORY_SCOPE_AGENT); }
    FinBuf A, B;
    int t = gw, kk = 0;
    if (t < NTOK) fin_load(hbuf, yrows, slots, 0, t, lane, A);
    for (; t < NTOK; t += 2 * NGW, kk += 2) {
        const int t2 = t + NGW;
        if (t2 < NTOK) fin_load(hbuf, yrows, slots, kk + 1, t2, lane, B);
        fin_compute(obuf, fw, t, lane, A);
        if (t2 < NTOK) {
            const int t3 = t2 + NGW;
            if (t3 < NTOK) fin_load(hbuf, yrows, slots, kk + 2, t3, lane, A);
            fin_compute(obuf, fw, t2, lane, B);
        }
    }
}

#ifndef OUTPROJ_FP8
#define OUTPROJ_FP8 0
#endif
constexpr int CT = 16;
constexpr int CONV_RED_OFF = LDSCTL_OFF + 4096;
__device__ __forceinline__ void conv_load_rows(const __amdgpu_buffer_rsrc_t urs, int t0, int tid, unsigned (&R)[CT + 30]) {
    const int s0 = t0 & (SEQ - 1);
#pragma unroll
    for (int r = 0; r < CT + 30; ++r) {
        const int sp = s0 - 30 + r;
        R[r] = (sp >= 0) ? (unsigned)__builtin_amdgcn_raw_buffer_load_b32(urs, tid * 4, (t0 - 30 + r) * 2048, 0) : 0u;
    }
}
__device__ __forceinline__ void phase_conv31(const MegaArgs& a, LAS unsigned char* lds, int tid, int lane, int wave, int G) {
    unsigned char* ws = a.ws;
    const __amdgpu_buffer_rsrc_t urs = __builtin_amdgcn_make_buffer_rsrc((void*)(ws + WS_U), 0, NTOK * 2048, 0x00020000);
    const float* cw = a.in[14]; const float* cb = a.in[15]; const float* nw = a.in[16]; const float* nb = a.in[17];
#if OUTPROJ_FP8
    unsigned short* ymix = (unsigned short*)(ws + WS_YMIX);
#else
    unsigned* ymix = (unsigned*)(ws + WS_YMIX);
#endif
    LAS float* wl = (LAS float*)lds;
    LAS float* red = (LAS float*)(lds + CONV_RED_OFF);
    LAS float* stat = red + 32 * 32;
    for (int i = tid; i < 31 * 256; i += NWAVES * 64) *(LAS f32x4*)(wl + 4 * i) = *(const f32x4*)(cw + 4 * i);
    const f32x2 bias = *(const f32x2*)(cb + 2 * tid);
    const f32x2 gw2 = *(const f32x2*)(nw + 2 * tid);
    const f32x2 gb2 = *(const f32x2*)(nb + 2 * tid);
    __syncthreads();
    unsigned R[CT + 30];
    int it = blockIdx.x;
    if (it < NTOK / CT) conv_load_rows(urs, it * CT, tid, R);
    for (; it < NTOK / CT; it += G) {
        const int t0 = it * CT;
        f32x2 uf[CT + 30];
#pragma unroll
        for (int r = 0; r < CT + 30; ++r) { uf[r].x = __uint_as_float(R[r] << 16); uf[r].y = __uint_as_float(R[r] & 0xFFFF0000u); }
        if (it + G < NTOK / CT) conv_load_rows(urs, (it + G) * CT, tid, R);
        f32x2 acc[CT];
#pragma unroll
        for (int t = 0; t < CT; ++t) acc[t] = bias;
#pragma unroll
        for (int k = 0; k < 31; ++k) {
            const f32x2 w = *(const LAS f32x2*)(wl + k * 1024 + 2 * tid);
#pragma unroll
            for (int t = 0; t < CT; ++t) acc[t] = __builtin_elementwise_fma(w, uf[t + k], acc[t]);
        }
        float acc0[CT], acc1[CT];
#pragma unroll
        for (int t = 0; t < CT; ++t) { acc0[t] = acc[t].x; acc1[t] = acc[t].y; }
        float sm[CT], sq[CT];
#pragma unroll
        for (int t = 0; t < CT; ++t) { sm[t] = acc0[t] + acc1[t]; sq[t] = acc0[t] * acc0[t] + acc1[t] * acc1[t]; }
#pragma unroll
        for (int t = 0; t < CT; ++t) {
            sm[t] += dpp_mov_f<0xB1>(sm[t]); sm[t] += dpp_mov_f<0x4E>(sm[t]); sm[t] += dpp_mov_f<0x124>(sm[t]); sm[t] += dpp_mov_f<0x128>(sm[t]);
            sq[t] += dpp_mov_f<0xB1>(sq[t]); sq[t] += dpp_mov_f<0x4E>(sq[t]); sq[t] += dpp_mov_f<0x124>(sq[t]); sq[t] += dpp_mov_f<0x128>(sq[t]);
        }
        __syncthreads();
        if ((lane & 15) == 0) {
            const int pr = wave * 4 + (lane >> 4);
#pragma unroll
            for (int t = 0; t < CT; ++t) { red[pr * 32 + t] = sm[t]; red[pr * 32 + CT + t] = sq[t]; }
        }
        __syncthreads();
        if (wave == 0 && lane < 32) {
            float s2 = 0.f;
#pragma unroll
            for (int p2 = 0; p2 < 32; ++p2) s2 += red[p2 * 32 + lane];
            const float other = __shfl_xor(s2, 16);
            if (lane < 16) {
                const float mean = s2 * (1.0f / DM);
                const float var = fmaxf(other * (1.0f / DM) - mean * mean, 0.f);
                stat[2 * lane] = mean; stat[2 * lane + 1] = rsqrtf(var + EPSV);
            }
        }
        __syncthreads();
#pragma unroll
        for (int t = 0; t < CT; ++t) {
            const f32x2 ms = *(const LAS f32x2*)(stat + 2 * t);
            const float y0 = siluf_((acc0[t] - ms.x) * ms.y * gw2.x + gb2.x);
            const float y1 = siluf_((acc1[t] - ms.x) * ms.y * gw2.y + gb2.y);
#if OUTPROJ_FP8
            ymix[(size_t)(t0 + t) * 1024 + 512 + tid] = (unsigned short)__builtin_amdgcn_cvt_pk_fp8_f32(y0, y1, 0, false);
#else
            ymix[(size_t)(t0 + t) * 1024 + 512 + tid] = pk2(y0, y1);
#endif
        }
    }
    __syncthreads();
}

struct YmBuf { u32x2 X[4][4]; u32x2 H[4]; u32x2 Z[4]; };
__device__ __forceinline__ void ym_load(const bf16_t* xm, const bf16_t* hm, const bf16_t* szb, int t, int lane, YmBuf& B) {
    const int s = t & (SEQ - 1);
#pragma unroll
    for (int j = 0; j < 4; ++j) {
        const int ch = 4 * lane + 256 * j;
#pragma unroll
        for (int kk = 0; kk < 4; ++kk) B.X[j][kk] = (s - 3 + kk >= 0) ? *(const u32x2*)(xm + (size_t)(t - 3 + kk) * DM + ch) : (u32x2){0u, 0u};
        B.H[j] = *(const u32x2*)(hm + (size_t)t * DM + ch);
        B.Z[j] = *(const u32x2*)(szb + (size_t)t * DM + ch);
    }
}
__device__ __forceinline__ void ym_compute(const LAS float* wts, unsigned char* ymix, int t, int lane, const YmBuf& B) {
#pragma unroll
    for (int j = 0; j < 4; ++j) {
        const int ch = 4 * lane + 256 * j;
        f32x4 xc = *(const LAS f32x4*)(wts + 4 * 1024 + ch);
#pragma unroll
        for (int kk = 0; kk < 4; ++kk) xc = xc + *(const LAS f32x4*)(wts + kk * 1024 + ch) * up4(B.X[j][kk]);
        xc.x = siluf_(xc.x); xc.y = siluf_(xc.y); xc.z = siluf_(xc.z); xc.w = siluf_(xc.w);
        const f32x4 hv = up4(B.H[j]);
        const float mean = wave_sum((hv.x + hv.y) + (hv.z + hv.w)) * (1.0f / 256.0f);
        const f32x4 d = hv - mean;
        const float var = wave_sum((d.x * d.x + d.y * d.y) + (d.z * d.z + d.w * d.w)) * (1.0f / 256.0f);
        const float rs = rsqrtf(var + EPSV);
        const f32x4 nwv = *(const LAS f32x4*)(wts + 5 * 1024 + ch), sk = *(const LAS f32x4*)(wts + 6 * 1024 + ch);
        const f32x4 y = (d * rs * nwv + sk * xc) * up4(B.Z[j]);
#if OUTPROJ_FP8
        *(unsigned*)(ymix + (size_t)t * 2048 + ch) = pk4_fp8(y.x, y.y, y.z, y.w);
#else
        { u32x2 o; o.x = pk2(y.x, y.y); o.y = pk2(y.z, y.w); *(u32x2*)((bf16_t*)ymix + (size_t)t * 2048 + ch) = o; }
#endif
        __builtin_amdgcn_sched_barrier(0);
    }
}
__device__ __forceinline__ void phase_ym(const MegaArgs& a, LAS unsigned char* lds, int tid, int gw, int NGW, int lane) {
    unsigned char* ws = a.ws;
    const bf16_t* xm = (const bf16_t*)(ws + WS_XM); const bf16_t* szb = (const bf16_t*)(ws + WS_SZ); const bf16_t* hm = (const bf16_t*)(ws + WS_R1);
    unsigned char* ymix = ws + WS_YMIX;
    LAS float* wts = (LAS float*)lds;
    for (int i = tid; i < 7 * 1024; i += NWAVES * 64) {
        const int r = i >> 10, c = i & 1023;
        wts[i] = (r < 4) ? a.in[3][r * DM + c] : (r == 4 ? a.in[4][c] : (r == 5 ? a.in[12][c] : a.in[13][c]));
    }
    __syncthreads();
    YmBuf A, B;
    int t = gw;
    if (t < NTOK) ym_load(xm, hm, szb, t, lane, A);
    for (; t < NTOK; t += 2 * NGW) {
        const int t2 = t + NGW;
        if (t2 < NTOK) ym_load(xm, hm, szb, t2, lane, B);
        ym_compute(wts, ymix, t, lane, A);
        if (t2 < NTOK) {
            const int t3 = t2 + NGW;
            if (t3 < NTOK) ym_load(xm, hm, szb, t3, lane, A);
            ym_compute(wts, ymix, t2, lane, B);
        }
    }
    __syncthreads();
}

struct EpiOutProj {
    const float* x; bf16_t* hb; unsigned char* hq;
    __device__ __forceinline__ void operator()(const f32x4 (&acc)[2][2][4][2], const pg8::Unit& un, int wr, int wc, int fr, int fq) const {
        const int row0 = un.pm * 256 + wr * 64 + fr;
        const int c0 = un.pn * 256 + wc * 32 + 8 * fq;
#pragma unroll
        for (int ai = 0; ai < 2; ++ai)
#pragma unroll
            for (int mp = 0; mp < 2; ++mp) {
                f32x4 xv[2][2][2];
#pragma unroll
                for (int mm = 0; mm < 2; ++mm)
#pragma unroll
                    for (int bj = 0; bj < 2; ++bj) {
                        const float* xp = x + (size_t)(row0 + ai * 128 + (2 * mp + mm) * 16) * DM + c0 + bj * 128;
                        xv[mm][bj][0] = *(const f32x4*)xp; xv[mm][bj][1] = *(const f32x4*)(xp + 4);
                    }
#pragma unroll
                for (int mm = 0; mm < 2; ++mm) {
                    const int m = 2 * mp + mm;
                    const size_t off = (size_t)(row0 + ai * 128 + m * 16) * DM + c0;
#pragma unroll
                    for (int bj = 0; bj < 2; ++bj) {
                        const f32x4 v0 = acc[ai][bj][m][0] + xv[mm][bj][0], v1 = acc[ai][bj][m][1] + xv[mm][bj][1];
                        u32x4 wb; wb.x = pg8::cvt_pk_bf16(v0[0], v0[1]); wb.y = pg8::cvt_pk_bf16(v0[2], v0[3]); wb.z = pg8::cvt_pk_bf16(v1[0], v1[1]); wb.w = pg8::cvt_pk_bf16(v1[2], v1[3]);
                        *(u32x4*)(hb + off + bj * 128) = wb;
                        u32x2 w; w.x = pk4_fp8(v0[0], v0[1], v0[2], v0[3]); w.y = pk4_fp8(v1[0], v1[1], v1[2], v1[3]);
                        *(u32x2*)(hq + off + bj * 128) = w;
                    }
                }
            }
    }
};


constexpr size_t WS_GCT = WS_SMALL + 512 * 1024;
constexpr size_t WS_GVT = WS_GCT + 32 * 1024;
constexpr size_t WS_FCUM = WS_SMALL + 3 * MiB;
constexpr size_t WS_UVAL = WS_SMALL + 4 * MiB;
constexpr size_t WS_MVAL = WS_SMALL + 7 * MiB;
constexpr size_t WS_ITEMS = WS_SMALL + 8 * MiB;
constexpr size_t WS_DN = WS_SMALL + 9 * MiB;
constexpr size_t WS_NPREV = WS_SMALL + 10 * MiB;
constexpr size_t WS_QB = 477 * MiB;
constexpr size_t WS_KB = 541 * MiB;
constexpr size_t WS_AEXT = 605 * MiB;
constexpr size_t WS_BEXT = 733 * MiB;
constexpr size_t WS_DCT = 861 * MiB;
constexpr size_t WS_KWT = WS_R1;
constexpr size_t WS_HM = WS_R1;
constexpr int RINV_OFF = LDSCTL_OFF + 1024;

__device__ __forceinline__ void p0_gate_tables(const MegaArgs& a, int gw, int NGW, int lane) {
    const float* wq = a.in[5]; const float* wk = a.in[6]; const float* wv = a.in[7]; const float* wig = a.in[8]; const float* wfg = a.in[10];
    bf16_t* gct = (bf16_t*)(a.ws + WS_GCT);
    for (int idx = gw * 64 + lane; idx < 2 * 16 * 1024; idx += NGW * 64) {
        const int tbl = idx >> 14, col = (idx >> 10) & 15, ch = idx & 1023;
        float v = 0.f;
        if (col < 8) {
            const float* Wg = (col < 4) ? wig : wfg; const int hh = col & 3, n = ch >> 2, i = ch & 3;
#pragma unroll
            for (int o = 0; o < 4; ++o) {
                if (tbl == 0) v += wq[n * 16 + i * 4 + o] * Wg[(size_t)(4 * n + o) * 4 + hh] + wk[n * 16 + i * 4 + o] * Wg[(size_t)(1024 + 4 * n + o) * 4 + hh];
                else v += wv[n * 16 + i * 4 + o] * Wg[(size_t)(2048 + 4 * n + o) * 4 + hh];
            }
        }
        gct[idx] = f2bf(v);
    }
}

struct GateGrp { u32x4 row[4][4]; };
__device__ __forceinline__ void gate_load_grp(const bf16_t* xm, int t, int s, int chb, GateGrp& B) {
#pragma unroll
    for (int q = 0; q < 4; ++q)
#pragma unroll
        for (int kk = 0; kk < 4; ++kk) B.row[q][kk] = (s - 3 + kk >= 0) ? *(const u32x4*)(xm + (size_t)(t - 3 + kk) * DM + chb + 32 * q) : (u32x4){0u, 0u, 0u, 0u};
}
__device__ __forceinline__ f32x4 gate_step(const LAS float* cwl, const LAS bf16_t* gtl, int tok, int ch0, const u32x4 (&row)[4], f32x4 acc) {
    float xc[8];
    {
        const f32x4 b0 = *(const LAS f32x4*)(cwl + 4 * 1024 + ch0), b1 = *(const LAS f32x4*)(cwl + 4 * 1024 + ch0 + 4);
        xc[0] = b0.x; xc[1] = b0.y; xc[2] = b0.z; xc[3] = b0.w; xc[4] = b1.x; xc[5] = b1.y; xc[6] = b1.z; xc[7] = b1.w;
    }
#pragma unroll
    for (int kk = 0; kk < 4; ++kk) {
        float xf[8]; unpack8(row[kk], xf);
        const f32x4 w0 = *(const LAS f32x4*)(cwl + kk * 1024 + ch0), w1 = *(const LAS f32x4*)(cwl + kk * 1024 + ch0 + 4);
        xc[0] += w0.x * xf[0]; xc[1] += w0.y * xf[1]; xc[2] += w0.z * xf[2]; xc[3] += w0.w * xf[3];
        xc[4] += w1.x * xf[4]; xc[5] += w1.y * xf[5]; xc[6] += w1.z * xf[6]; xc[7] += w1.w * xf[7];
    }
#pragma unroll
    for (int i = 0; i < 8; ++i) xc[i] = siluf_(xc[i]);
    u32x4 a1; a1.x = pk2(xc[0], xc[1]); a1.y = pk2(xc[2], xc[3]); a1.z = pk2(xc[4], xc[5]); a1.w = pk2(xc[6], xc[7]);
    const u32x4 b1 = *(const LAS u32x4*)(gtl + tok * 1032 + ch0);
    const u32x4 b2 = *(const LAS u32x4*)(gtl + (16 + tok) * 1032 + ch0);
    acc = __builtin_amdgcn_mfma_f32_16x16x32_bf16(__builtin_bit_cast(bf16x8, a1), __builtin_bit_cast(bf16x8, b1), acc, 0, 0, 0);
    acc = __builtin_amdgcn_mfma_f32_16x16x32_bf16(__builtin_bit_cast(bf16x8, row[3]), __builtin_bit_cast(bf16x8, b2), acc, 0, 0, 0);
    return acc;
}
__device__ __forceinline__ void phase_gates(const MegaArgs& a, LAS unsigned char* lds, int tid, int gw, int NGW, int lane) {
    unsigned char* ws = a.ws;
    const bf16_t* xm = (const bf16_t*)(ws + WS_XM);
    const bf16_t* gct = (const bf16_t*)(ws + WS_GCT);
    const float* big = a.in[9]; const float* bfg = a.in[11];
    float* logi = (float*)(ws + WS_LOGI); float* logf = (float*)(ws + WS_LOGF);
    LAS float* cwl = (LAS float*)lds;
    LAS bf16_t* gtl = (LAS bf16_t*)(lds + 20480);
    for (int i = tid; i < 5 * 1024; i += NWAVES * 64) cwl[i] = (i < 4096) ? a.in[3][i] : a.in[4][i - 4096];
    for (int i = tid; i < 32 * 128; i += NWAVES * 64) { const int r = i >> 7, c8 = i & 127; *(LAS u32x4*)(gtl + r * 1032 + 8 * c8) = *(const u32x4*)(gct + (size_t)r * 1024 + 8 * c8); }
    __syncthreads();
    const int tok = lane & 15, kq = lane >> 4;
    for (int tile = gw; tile < NTOK / 16; tile += NGW) {
        const int t = tile * 16 + tok, s = t & (SEQ - 1);
        f32x4 acc = (f32x4){0.f, 0.f, 0.f, 0.f};
        GateGrp A, B;
        gate_load_grp(xm, t, s, 8 * kq, A);
        for (int g = 0; g < 8; g += 2) {
            gate_load_grp(xm, t, s, 128 * (g + 1) + 8 * kq, B);
#pragma unroll
            for (int q = 0; q < 4; ++q) acc = gate_step(cwl, gtl, tok, 128 * g + 32 * q + 8 * kq, A.row[q], acc);
            if (g + 2 < 8) gate_load_grp(xm, t, s, 128 * (g + 2) + 8 * kq, A);
#pragma unroll
            for (int q = 0; q < 4; ++q) acc = gate_step(cwl, gtl, tok, 128 * (g + 1) + 32 * q + 8 * kq, B.row[q], acc);
        }
        const int col = lane & 15;
        if (col < 8) {
            const int hh = col & 3;
#pragma unroll
            for (int r = 0; r < 4; ++r) {
                const int tt = tile * 16 + 4 * kq + r;
                if (col < 4) logi[(size_t)hh * NTOK + tt] = acc[r] + big[hh];
                else logf[(size_t)hh * NTOK + tt] = logsigmoidf_(acc[r] + bfg[hh]);
            }
        }
    }
    __syncthreads();
}

__device__ __forceinline__ void phase_prep(const MegaArgs& a, LAS unsigned char* lds, int tid, int lane, int wave, int G) {
    unsigned char* ws = a.ws;
    const float* logi = (const float*)(ws + WS_LOGI); const float* logf = (const float*)(ws + WS_LOGF);
    float* Fcum = (float*)(ws + WS_FCUM); float* Uval = (float*)(ws + WS_UVAL); float* Mval = (float*)(ws + WS_MVAL);
    float* items = (float*)(ws + WS_ITEMS); float* dn = (float*)(ws + WS_DN);
    const bf16_t* xm = (const bf16_t*)(ws + WS_XM);
    bf16_t* qb = (bf16_t*)(ws + WS_QB); bf16_t* kb = (bf16_t*)(ws + WS_KB); bf16_t* aext = (bf16_t*)(ws + WS_AEXT); bf16_t* bext = (bf16_t*)(ws + WS_BEXT); bf16_t* kwt = (bf16_t*)(ws + WS_KWT);
    const float* cw = a.in[3]; const float* cb = a.in[4]; const float* wq = a.in[5]; const float* wk = a.in[6]; const float* wv = a.in[7];
    LAS float* gch = (LAS float*)lds;
    LAS float* umaxch = gch + 32;
    LAS float* wint_l = umaxch + 32;
    LAS float* wst_l = wint_l + 256;
    LAS float* dn_l = wst_l + 256;
    LAS float* wtl = dn_l + 8 * 256;
    for (int it = blockIdx.x; it < 512; it += G) {
        const int bh = it >> 5, c = it & 31, b = bh >> 2, h = bh & 3;
        const int tb = b * SEQ, t0 = tb + c * 256;
        {
            const int cc = tid >> 4, sub = tid & 15;
            const size_t gbase = (size_t)h * NTOK + tb + cc * 256 + 16 * sub;
            float F[16], u[16];
            {
                const f32x4* lfp = (const f32x4*)(logf + gbase); const f32x4* lip = (const f32x4*)(logi + gbase);
#pragma unroll
                for (int q4 = 0; q4 < 4; ++q4) { const f32x4 v = lfp[q4], w = lip[q4]; F[4 * q4] = v.x; F[4 * q4 + 1] = v.y; F[4 * q4 + 2] = v.z; F[4 * q4 + 3] = v.w; u[4 * q4] = w.x; u[4 * q4 + 1] = w.y; u[4 * q4 + 2] = w.z; u[4 * q4 + 3] = w.w; }
            }
#pragma unroll
            for (int jj = 1; jj < 16; ++jj) F[jj] += F[jj - 1];
            const float total = F[15];
            float incl = total;
#pragma unroll
            for (int o = 1; o < 16; o <<= 1) { const float v = __shfl_up(incl, o, 16); if (sub >= o) incl += v; }
            const float excl = incl - total;
            float um = -3.0e38f;
#pragma unroll
            for (int jj = 0; jj < 16; ++jj) { F[jj] += excl; u[jj] -= F[jj]; um = fmaxf(um, u[jj]); }
            float umx = um;
#pragma unroll
            for (int o = 1; o < 16; o <<= 1) umx = fmaxf(umx, __shfl_xor(umx, o, 16));
            const float gsum = __shfl(incl, 15, 16);
            if (sub == 0) { gch[cc] = gsum; umaxch[cc] = umx; }
            float cm[16]; cm[0] = u[0];
#pragma unroll
            for (int jj = 1; jj < 16; ++jj) cm[jj] = fmaxf(cm[jj - 1], u[jj]);
            float inclm = cm[15];
#pragma unroll
            for (int o = 1; o < 16; o <<= 1) { const float v = __shfl_up(inclm, o, 16); if (sub >= o) inclm = fmaxf(inclm, v); }
            float exclm = __shfl_up(inclm, 1, 16); if (sub == 0) exclm = -3.0e38f;
            __syncthreads();
            float m = 0.f;
            for (int c2 = 0; c2 < c; ++c2) m = gch[c2] + fmaxf(m, umaxch[c2]);
            const float mprev = m, g_c = gch[c], umax_c = umaxch[c], m_c = g_c + fmaxf(mprev, umax_c);
            if (tid == 0) { items[it] = __expf(g_c + mprev - m_c); items[512 + it] = __expf(g_c + umax_c - m_c); items[1024 + it] = mprev; }
            if (cc == c) {
#pragma unroll
                for (int jj = 0; jj < 16; ++jj) {
                    const float M = fmaxf(mprev, fmaxf(cm[jj], exclm));
                    Fcum[gbase + jj] = F[jj]; Uval[gbase + jj] = u[jj]; Mval[gbase + jj] = M;
                    wint_l[16 * sub + jj] = __expf(mprev - M); wst_l[16 * sub + jj] = __expf(u[jj] - umax_c);
                }
            }
            __syncthreads();
        }
        {
            const int ch = h * 256 + 4 * lane;
            float cwv[4][4];
            const f32x4 cbv = *(const f32x4*)(cb + ch);
#pragma unroll
            for (int kk = 0; kk < 4; ++kk) { const f32x4 w = *(const f32x4*)(cw + kk * DM + ch); cwv[kk][0] = w.x; cwv[kk][1] = w.y; cwv[kk][2] = w.z; cwv[kk][3] = w.w; }
            for (int i = tid; i < 768; i += NWAVES * 64) {
                const int mat = i >> 8, q4 = (i >> 6) & 3, ln = i & 63;
                const float* src = (mat == 0 ? wq : (mat == 1 ? wk : wv)) + (h * 64 + ln) * 16 + 4 * q4;
                *(LAS f32x4*)(wtl + 4 * i) = *(const f32x4*)src;
            }
            __syncthreads();
            const __amdgpu_buffer_rsrc_t xrs = __builtin_amdgcn_make_buffer_rsrc((void*)xm, 0, NTOK * 2048, 0x00020000);
            LAS unsigned* tile_v = (LAS unsigned*)(lds + 24576);
            LAS unsigned* tile_k = tile_v + 64 * 129;
            u32x2 cur[11], nx[11];
#define PREP_LOAD(R, p_) do { _Pragma("unroll") for (int r = 0; r < 11; ++r) { const int sp = c * 256 + 64 * (p_) + 8 * wave - 3 + r; \
                R[r] = (sp >= 0) ? (u32x2)__builtin_amdgcn_raw_buffer_load_b64(xrs, ch * 2, (t0 + 64 * (p_) + 8 * wave - 3 + r) * 2048, 0) : (u32x2){0u, 0u}; } } while (0)
            PREP_LOAD(cur, 0);
            float dnacc[4] = {0.f, 0.f, 0.f, 0.f};
#pragma unroll 1
            for (int pb = 0; pb < 4; ++pb) {
                if (pb < 3) PREP_LOAD(nx, pb + 1);
#pragma unroll
                for (int pp = 0; pp < 8; ++pp) {
                    const int i = 64 * pb + 8 * wave + pp;
                    const f32x4 x0v = up4(cur[pp]), x1v = up4(cur[pp + 1]), x2v = up4(cur[pp + 2]), x3v = up4(cur[pp + 3]);
                    float x3[4]; x3[0] = x3v.x; x3[1] = x3v.y; x3[2] = x3v.z; x3[3] = x3v.w;
                    float xc[4];
#pragma unroll
                    for (int cc = 0; cc < 4; ++cc) xc[cc] = siluf_(cbv[cc] + cwv[0][cc] * x0v[cc] + cwv[1][cc] * x1v[cc] + cwv[2][cc] * x2v[cc] + cwv[3][cc] * x3v[cc]);
                    float qv[4], kv[4], vv[4];
                    {
                        f32x4 qa = (f32x4){0.f, 0.f, 0.f, 0.f}, ka = qa, va = qa;
#pragma unroll
                        for (int q4 = 0; q4 < 4; ++q4) {
                            qa = qa + *(const LAS f32x4*)(wtl + ((0 * 4 + q4) * 64 + lane) * 4) * xc[q4];
                            ka = ka + *(const LAS f32x4*)(wtl + ((1 * 4 + q4) * 64 + lane) * 4) * xc[q4];
                            va = va + *(const LAS f32x4*)(wtl + ((2 * 4 + q4) * 64 + lane) * 4) * x3[q4];
                        }
#pragma unroll
                        for (int o = 0; o < 4; ++o) { qv[o] = qa[o] * 0.0625f; kv[o] = ka[o]; vv[o] = va[o]; }
                    }
                    const float wi = wint_l[i], wsj = wst_l[i];
                    u32x2 o2;
                    o2.x = pk2(qv[0], qv[1]); o2.y = pk2(qv[2], qv[3]);
                    *(u32x2*)(qb + (size_t)(t0 + i) * DM + ch) = o2;
                    o2.x = pk2(kv[0], kv[1]); o2.y = pk2(kv[2], kv[3]);
                    *(u32x2*)(kb + (size_t)(t0 + i) * DM + ch) = o2;
                    o2.x = pk2(qv[0] * wi, qv[1] * wi); o2.y = pk2(qv[2] * wi, qv[3] * wi);
                    *(u32x2*)(aext + ((size_t)it * 256 + i) * 512 + 256 + 4 * lane) = o2;
                    float kwv[4];
#pragma unroll
                    for (int o = 0; o < 4; ++o) { kwv[o] = kv[o] * wsj; dnacc[o] += kwv[o]; }
                    const int tr = (8 * wave + pp) * 129 + 2 * lane;
                    tile_v[tr] = pk2(vv[0], vv[1]); tile_v[tr + 1] = pk2(vv[2], vv[3]);
                    tile_k[tr] = pk2(kwv[0], kwv[1]); tile_k[tr + 1] = pk2(kwv[2], kwv[3]);
                }
                __syncthreads();
#pragma unroll
                for (int kq = 0; kq < 4; ++kq) {
                    const int pid = tid + 512 * kq, chr = pid >> 3, jg = pid & 7;
                    const LAS unsigned short* tv = (const LAS unsigned short*)tile_v + (8 * jg) * 258 + chr;
                    const LAS unsigned short* tk = (const LAS unsigned short*)tile_k + (8 * jg) * 258 + chr;
                    u32x4 ov, ok;
                    ov.x = (unsigned)tv[0 * 258] | ((unsigned)tv[1 * 258] << 16); ov.y = (unsigned)tv[2 * 258] | ((unsigned)tv[3 * 258] << 16);
                    ov.z = (unsigned)tv[4 * 258] | ((unsigned)tv[5 * 258] << 16); ov.w = (unsigned)tv[6 * 258] | ((unsigned)tv[7 * 258] << 16);
                    ok.x = (unsigned)tk[0 * 258] | ((unsigned)tk[1 * 258] << 16); ok.y = (unsigned)tk[2 * 258] | ((unsigned)tk[3 * 258] << 16);
                    ok.z = (unsigned)tk[4 * 258] | ((unsigned)tk[5 * 258] << 16); ok.w = (unsigned)tk[6 * 258] | ((unsigned)tk[7 * 258] << 16);
                    *(u32x4*)(bext + ((size_t)it * 256 + chr) * 512 + 64 * pb + 8 * jg) = ov;
                    *(u32x4*)(kwt + ((size_t)it * 256 + chr) * 256 + 64 * pb + 8 * jg) = ok;
                }
                __syncthreads();
#pragma unroll
                for (int r = 0; r < 11; ++r) cur[r] = nx[r];
            }
#undef PREP_LOAD
#pragma unroll
            for (int o = 0; o < 4; ++o) dn_l[wave * 256 + 4 * lane + o] = dnacc[o];
            __syncthreads();
            if (tid < 256) {
                float s = 0.f;
#pragma unroll
                for (int w = 0; w < 8; ++w) s += dn_l[w * 256 + tid];
                dn[(size_t)it * 256 + tid] = s;
            }
            __syncthreads();
        }
    }
}

__device__ __forceinline__ void tr_subtile(const bf16_t* src, int lds_src, bf16_t* dst, int lds_dst, LAS unsigned short* tile, int lane) {
    const int rr = lane >> 3, pc = lane & 7;
    u32x4 v[8];
#pragma unroll
    for (int s2 = 0; s2 < 8; ++s2) v[s2] = *(const u32x4*)(src + (size_t)(rr + 8 * s2) * lds_src + 8 * pc);
#pragma unroll
    for (int s2 = 0; s2 < 8; ++s2) {
        LAS unsigned* tp = (LAS unsigned*)(tile + (rr + 8 * s2) * 66 + 8 * pc);
        tp[0] = v[s2].x; tp[1] = v[s2].y; tp[2] = v[s2].z; tp[3] = v[s2].w;
    }
    asm volatile("s_waitcnt lgkmcnt(0)" ::: "memory");
#pragma unroll
    for (int s2 = 0; s2 < 8; ++s2) {
        const int c = rr + 8 * s2;
        const LAS unsigned short* tp = tile + (8 * pc) * 66 + c;
        u32x4 o;
        o.x = (unsigned)tp[0 * 66] | ((unsigned)tp[1 * 66] << 16); o.y = (unsigned)tp[2 * 66] | ((unsigned)tp[3 * 66] << 16);
        o.z = (unsigned)tp[4 * 66] | ((unsigned)tp[5 * 66] << 16); o.w = (unsigned)tp[6 * 66] | ((unsigned)tp[7 * 66] << 16);
        *(u32x4*)(dst + (size_t)c * lds_dst + 8 * pc) = o;
    }
    asm volatile("s_waitcnt lgkmcnt(0)" ::: "memory");
}
__device__ __forceinline__ void phase_transposes(const MegaArgs& a, LAS unsigned char* lds, int wave, int lane, int G) {
    unsigned char* ws = a.ws;
    bf16_t* aext = (bf16_t*)(ws + WS_AEXT); bf16_t* bext = (bf16_t*)(ws + WS_BEXT); bf16_t* kwt = (bf16_t*)(ws + WS_KWT);
    LAS unsigned short* tile = (LAS unsigned short*)(lds + wave * 16384);
    for (int it = blockIdx.x; it < 512; it += G) {
        for (int job = wave; job < 32; job += NWAVES) {
            const int arr = job >> 4, sj = (job >> 2) & 3, sc = job & 3;
            if (arr == 0) tr_subtile(bext + ((size_t)it * 256 + 64 * sj) * 512 + 256 + 64 * sc, 512, bext + ((size_t)it * 256 + 64 * sc) * 512 + 64 * sj, 512, tile, lane);
            else          tr_subtile(aext + ((size_t)it * 256 + 64 * sj) * 512 + 64 * sc, 512, kwt + ((size_t)it * 256 + 64 * sc) * 256 + 64 * sj, 256, tile, lane);
        }
    }
    asm volatile("s_waitcnt vmcnt(0)" ::: "memory");
    __syncthreads();
}

struct ItemOrder {
    const char* A; const char* B; size_t a_item_bytes, b_item_bytes; int per_token; int G, c;
    __device__ __forceinline__ bool next(int i, pg8::Unit& u) const {
        const int it = i * G + c; if (it >= 512) return false;
        u.pm = it; u.pn = 0; u.aux = i; u.gidx = nullptr; u.gl = 0;
        if (per_token) { const int bh = it >> 5, cc = it & 31, b = bh >> 2, h = bh & 3; const size_t off = ((size_t)(b * SEQ + cc * 256) * DM + h * 256) * 2; u.A = A + off; u.B = B + off; }
        else { u.A = A + (size_t)it * a_item_bytes; u.B = B + (size_t)it * b_item_bytes; }
        return true;
    }
};
struct EpiP {
    const float* Uval; const float* Mval; bf16_t* aext;
    __device__ __forceinline__ void operator()(const f32x4 (&acc)[2][2][4][2], const pg8::Unit& un, int wr, int wc, int fr, int fq) const {
        const int it = un.pm, bh = it >> 5, cc = it & 31, b = bh >> 2, h = bh & 3;
        const size_t gb = (size_t)h * NTOK + b * SEQ + cc * 256;
        const int jb = wc * 32 + 8 * fq;
        float Mv[2][4];
#pragma unroll
        for (int ai = 0; ai < 2; ++ai)
#pragma unroll
            for (int m = 0; m < 4; ++m) Mv[ai][m] = Mval[gb + ai * 128 + wr * 64 + m * 16 + fr];
#pragma unroll
        for (int bj = 0; bj < 2; ++bj) {
            f32x4 uj[2];
#pragma unroll
            for (int n = 0; n < 2; ++n) uj[n] = *(const f32x4*)(Uval + gb + bj * 128 + jb + 4 * n);
#pragma unroll
            for (int ai = 0; ai < 2; ++ai)
#pragma unroll
                for (int m = 0; m < 4; ++m) {
                    const int i = ai * 128 + wr * 64 + m * 16 + fr;
                    const float Mi = Mv[ai][m];
                    f32x4 o[2];
#pragma unroll
                    for (int n = 0; n < 2; ++n)
#pragma unroll
                        for (int jj = 0; jj < 4; ++jj) {
                            const int j = bj * 128 + jb + 4 * n + jj;
                            o[n][jj] = (j <= i) ? acc[ai][bj][m][n][jj] * __expf(uj[n][jj] - Mi) : 0.f;
                        }
                    u32x4 w; w.x = pg8::cvt_pk_bf16(o[0][0], o[0][1]); w.y = pg8::cvt_pk_bf16(o[0][2], o[0][3]); w.z = pg8::cvt_pk_bf16(o[1][0], o[1][1]); w.w = pg8::cvt_pk_bf16(o[1][2], o[1][3]);
                    *(u32x4*)(aext + ((size_t)it * 256 + i) * 512 + bj * 128 + jb) = w;
                    asm volatile("" ::: "memory");
                }
        }
    }
};
struct EpiDC {
    bf16_t* dct;
    __device__ __forceinline__ void operator()(const f32x4 (&acc)[2][2][4][2], const pg8::Unit& un, int wr, int wc, int fr, int fq) const {
        const int it = un.pm; const int cb0 = wc * 32 + 8 * fq;
#pragma unroll
        for (int ai = 0; ai < 2; ++ai)
#pragma unroll
            for (int m = 0; m < 4; ++m) {
                const int r = ai * 128 + wr * 64 + m * 16 + fr;
#pragma unroll
                for (int bj = 0; bj < 2; ++bj) {
                    const f32x4 v0 = acc[ai][bj][m][0], v1 = acc[ai][bj][m][1];
                    u32x4 w; w.x = pg8::cvt_pk_bf16(v0[0], v0[1]); w.y = pg8::cvt_pk_bf16(v0[2], v0[3]); w.z = pg8::cvt_pk_bf16(v1[0], v1[1]); w.w = pg8::cvt_pk_bf16(v1[2], v1[3]);
                    *(u32x4*)(dct + ((size_t)it * 256 + r) * 256 + bj * 128 + cb0) = w;
                }
            }
    }
};
struct EpiO {
    LAS const float* rinv; bf16_t* hm;
    __device__ __forceinline__ void operator()(const f32x4 (&acc)[2][2][4][2], const pg8::Unit& un, int wr, int wc, int fr, int fq) const {
        const int it = un.pm, bh = it >> 5, cc = it & 31, b = bh >> 2, h = bh & 3;
        const size_t t0 = (size_t)b * SEQ + cc * 256; const int eb = wc * 32 + 8 * fq;
#pragma unroll
        for (int ai = 0; ai < 2; ++ai)
#pragma unroll
            for (int m = 0; m < 4; ++m) {
                const int i = ai * 128 + wr * 64 + m * 16 + fr;
                const float ri = rinv[un.aux * 256 + i];
#pragma unroll
                for (int bj = 0; bj < 2; ++bj) {
                    const f32x4 v0 = acc[ai][bj][m][0] * ri, v1 = acc[ai][bj][m][1] * ri;
                    u32x4 w; w.x = pg8::cvt_pk_bf16(v0[0], v0[1]); w.y = pg8::cvt_pk_bf16(v0[2], v0[3]); w.z = pg8::cvt_pk_bf16(v1[0], v1[1]); w.w = pg8::cvt_pk_bf16(v1[2], v1[3]);
                    *(u32x4*)(hm + (t0 + i) * DM + h * 256 + bj * 128 + eb) = w;
                }
            }
    }
};

__device__ __forceinline__ void phase_scan(const MegaArgs& a, int tid) {
    unsigned char* ws = a.ws;
    const float* items = (const float*)(ws + WS_ITEMS); const bf16_t* dct = (const bf16_t*)(ws + WS_DCT); bf16_t* bext = (bf16_t*)(ws + WS_BEXT);
    const float* dn = (const float*)(ws + WS_DN); float* nprev = (float*)(ws + WS_NPREV);
    int tid_o = tid; asm volatile("" : "+v"(tid_o));
    const int gid = blockIdx.x * (NWAVES * 64) + tid_o;
    if (gid < 16 * 256 * 32) {
        const int bh = gid >> 13, e = (gid >> 5) & 255, d8 = gid & 31;
        float st[8];
#pragma unroll
        for (int i = 0; i < 8; ++i) st[i] = 0.f;
        u32x4 rA[4], rB[4]; float decA[4], scA[4], decB[4], scB[4];
#define SCAN_LOAD(R, D, S, c0) do { _Pragma("unroll") for (int q = 0; q < 4; ++q) { const int it_ = bh * 32 + (c0) + q; R[q] = *(const u32x4*)(dct + ((size_t)it_ * 256 + e) * 256 + 8 * d8); D[q] = items[it_]; S[q] = items[512 + it_]; } } while (0)
#define SCAN_STEP(R, D, S, c0) do { _Pragma("unroll") for (int q = 0; q < 4; ++q) { const int it_ = bh * 32 + (c0) + q; \
            u32x4 w; w.x = pk2(st[0], st[1]); w.y = pk2(st[2], st[3]); w.z = pk2(st[4], st[5]); w.w = pk2(st[6], st[7]); \
            *(u32x4*)(bext + ((size_t)it_ * 256 + e) * 512 + 256 + 8 * d8) = w; \
            float dv[8]; unpack8(R[q], dv); \
            _Pragma("unroll") for (int i = 0; i < 8; ++i) st[i] = D[q] * st[i] + S[q] * dv[i]; } } while (0)
        SCAN_LOAD(rA, decA, scA, 0);
        for (int c0 = 0; c0 < 32; c0 += 8) {
            SCAN_LOAD(rB, decB, scB, c0 + 4);
            SCAN_STEP(rA, decA, scA, c0);
            if (c0 + 8 < 32) SCAN_LOAD(rA, decA, scA, c0 + 8);
            SCAN_STEP(rB, decB, scB, c0 + 4);
        }
#undef SCAN_LOAD
#undef SCAN_STEP
    }
    if (gid < 16 * 256) {
        const int bh = gid >> 8, d = gid & 255;
        float dnv[32], dcv[32], scv[32];
#pragma unroll
        for (int c = 0; c < 32; ++c) { const int it = bh * 32 + c; dnv[c] = dn[(size_t)it * 256 + d]; dcv[c] = items[it]; scv[c] = items[512 + it]; }
        float st = 0.f;
#pragma unroll
        for (int c = 0; c < 32; ++c) { const int it = bh * 32 + c; nprev[(size_t)it * 256 + d] = st; st = dcv[c] * st + scv[c] * dnv[c]; }
    }
}

__device__ __forceinline__ void g3_rinv(const MegaArgs& a, LAS unsigned char* lds, int wave, int lane, int G) {
    unsigned char* ws = a.ws;
    const bf16_t* aext = (const bf16_t*)(ws + WS_AEXT); const float* nprev = (const float*)(ws + WS_NPREV);
    const float* Fcum = (const float*)(ws + WS_FCUM); const float* Mval = (const float*)(ws + WS_MVAL);
    LAS float* rinv = (LAS float*)(lds + RINV_OFF);
    const int l16 = lane & 15, rsub = lane >> 4;
    for (int ui = 0; ui < 2; ++ui) {
        const int it = ui * G + blockIdx.x; if (it >= 512) break;
        const int bh = it >> 5, cc = it & 31, b = bh >> 2, h = bh & 3;
        f32x4 nv[2][2];
#pragma unroll
        for (int pz = 0; pz < 2; ++pz) { const f32x4* np = (const f32x4*)(nprev + (size_t)it * 256 + 8 * (l16 + 16 * pz)); nv[pz][0] = np[0]; nv[pz][1] = np[1]; }
        u32x4 pc[8][4];
#pragma unroll
        for (int ps = 0; ps < 8; ++ps) {
            const u32x4* rowp = (const u32x4*)(aext + ((size_t)it * 256 + 32 * ps + 4 * wave + rsub) * 512);
#pragma unroll
            for (int q = 0; q < 4; ++q) pc[ps][q] = rowp[l16 + 16 * q];
        }
#pragma unroll
        for (int ps = 0; ps < 8; ++ps) {
            float s = 0.f;
#pragma unroll
            for (int q = 0; q < 2; ++q) { float f[8]; unpack8(pc[ps][q], f); s += ((f[0] + f[1]) + (f[2] + f[3])) + ((f[4] + f[5]) + (f[6] + f[7])); }
#pragma unroll
            for (int q = 0; q < 2; ++q) { float f[8]; unpack8(pc[ps][2 + q], f); const f32x4 n0 = nv[q][0], n1 = nv[q][1];
                s += (f[0] * n0.x + f[1] * n0.y + f[2] * n0.z + f[3] * n0.w) + (f[4] * n1.x + f[5] * n1.y + f[6] * n1.z + f[7] * n1.w); }
            s += dpp_mov_f<0xB1>(s); s += dpp_mov_f<0x4E>(s); s += dpp_mov_f<0x124>(s); s += dpp_mov_f<0x128>(s);
            const int i = 32 * ps + 4 * wave + rsub;
            const size_t gi = (size_t)h * NTOK + b * SEQ + cc * 256 + i;
            if (l16 == 0) { const float mi = Fcum[gi] + Mval[gi]; rinv[ui * 256 + i] = 1.0f / fmaxf(fabsf(s), __expf(-mi)); }
        }
    }
    __syncthreads();
}

#ifndef NG1_SPLIT
#define NG1_SPLIT 256
#endif
#ifndef STAG1
#define STAG1 0
#endif
#ifndef STAG12
#define STAG12 0
#endif
__global__ void __launch_bounds__(NWAVES * 64, 2) mega_fwd(MegaArgs args) {
    extern __shared__ __attribute__((aligned(16))) unsigned char lds_raw[];
    LAS unsigned char* lds = (LAS unsigned char*)lds_raw;
    const int wave = __builtin_amdgcn_readfirstlane(threadIdx.x >> 6);
#define lane lane_id()
#define tid ((wave << 6) | lane_id())
    const int G = gridDim.x;
    const int gw = blockIdx.x * NWAVES + wave, NGW = G * NWAVES;
    unsigned char* ws = args.ws;
    unsigned* ctl = (unsigned*)(ws + WS_CTL);
    for (int u = tid; u < (LDS_BYTES - LDSCTL_OFF) / 4; u += NWAVES * 64) ((LAS unsigned*)(lds + LDSCTL_OFF))[u] = 0u;
    __syncthreads();
    XcdBarrier bar = xcd_barrier_post(ctl + CW_BAR + args.li * XCD_BAR_WORDS, (volatile LAS unsigned*)(lds + LDSCTL_OFF + 64), wave);
    const int lo = args.ph_lo, hi = args.ph_hi;
#define IN(k) (lo <= (k) && (k) < hi)
#define BOTH(k) (IN(k) && IN((k) + 1))

    if (IN(0)) { p0_prologue(args, lds, gw, NGW, wave, lane); if (NG1_SPLIT >= 256) p0b_weights(args, lds, gw, NGW, wave, lane);
        p0_gate_tables(args, gw, NGW, lane); p0_router_tables(args, gw, NGW, lane); if (BOTH(0)) xcd_barrier(bar); }

    if (IN(1)) {
        const int NG1 = NG1_SPLIT;
        if ((int)blockIdx.x < NG1) {
            pg8::DenseOrder S; S.init(ws + WS_R1, ws + WS_BTIN, NTOK, DPROJ, DM, DM, NG1, (int)blockIdx.x);
            EpiInProj E{(const float*)(ws + WS_RSTD1), (bf16_t*)(ws + WS_XM), (bf16_t*)(ws + WS_SZ), (bf16_t*)(ws + WS_U), args.pad};
            pg8::gemm_phase<EpiInProj, pg8::DenseOrder, false>(lds, wave, DM, DM, DM, S, E, 0x7F7F7F7F, 0x7F7F7F7F, STAG1);
        } else {
            p0b_weights(args, lds, ((int)blockIdx.x - NG1) * NWAVES + wave, (G - NG1) * NWAVES, wave, lane);
        }
        if (BOTH(1)) xcd_barrier(bar);
    }
    if (IN(2)) { phase_gates(args, lds, tid, gw, NGW, lane); if (BOTH(2)) xcd_barrier(bar); }
    if (IN(3)) { phase_prep(args, lds, tid, lane, wave, G); if (BOTH(3)) xcd_barrier(bar); }
    if (IN(4)) {
        {
            ItemOrder S; S.A = (const char*)(ws + WS_QB); S.B = (const char*)(ws + WS_KB); S.a_item_bytes = 0; S.b_item_bytes = 0; S.per_token = 1; S.G = G; S.c = (int)blockIdx.x;
            EpiP E{(const float*)(ws + WS_UVAL), (const float*)(ws + WS_MVAL), (bf16_t*)(ws + WS_AEXT)};
            pg8::gemm_phase<EpiP, ItemOrder, false>(lds, wave, 256, DM, DM, S, E);
        }
        {
            ItemOrder S; S.A = (const char*)(ws + WS_BEXT); S.B = (const char*)(ws + WS_KWT); S.a_item_bytes = (size_t)256 * 512 * 2; S.b_item_bytes = (size_t)256 * 256 * 2; S.per_token = 0; S.G = G; S.c = (int)blockIdx.x;
            EpiDC E{(bf16_t*)(ws + WS_DCT)};
            pg8::gemm_phase<EpiDC, ItemOrder, false>(lds, wave, 256, 512, 256, S, E);
        }
        if (BOTH(4)) xcd_barrier(bar);
    }
    if (IN(5)) {
        if ((blockIdx.x >> 3) & 1) { phase_conv31(args, lds, tid, lane, wave, G); phase_scan(args, tid); }
        else { phase_scan(args, tid); phase_conv31(args, lds, tid, lane, wave, G); }
        if (BOTH(5)) xcd_barrier(bar);
    }
    if (IN(6)) {
        g3_rinv(args, lds, wave, lane, G);
        ItemOrder S; S.A = (const char*)(ws + WS_AEXT); S.B = (const char*)(ws + WS_BEXT); S.a_item_bytes = (size_t)256 * 512 * 2; S.b_item_bytes = (size_t)256 * 512 * 2; S.per_token = 0; S.G = G; S.c = (int)blockIdx.x;
        EpiO E{(LAS const float*)(lds + RINV_OFF), (bf16_t*)(ws + WS_HM)};
        pg8::gemm_phase<EpiO, ItemOrder, false>(lds, wave, 512, 512, 512, S, E);
        if (BOTH(6)) xcd_barrier(bar);
    }
    if (IN(7)) { phase_ym(args, lds, tid, gw, NGW, lane); if (BOTH(7)) xcd_barrier(bar); }
    if (IN(8)) {
        EpiOutProj E{args.in[0], (bf16_t*)(ws + WS_HB16), ws + WS_HBF};
#if OUTPROJ_FP8
        pg8::DenseOrder S; S.init(ws + WS_YMIX, ws + WS_BTOUT, NTOK, DM, 1024, 1024, G, (int)blockIdx.x);
        pg8::gemm_phase<EpiOutProj, pg8::DenseOrder, false, true>(lds, wave, 1024, 1024, 1024, S, E, 0x7A7A7A7A, 0x7F7F7F7F);
#else
        pg8::DenseOrder S; S.init(ws + WS_YMIX, ws + WS_BTOUT, NTOK, DM, 2048, 2048, G, (int)blockIdx.x);
        pg8::gemm_phase<EpiOutProj, pg8::DenseOrder, false>(lds, wave, 2048, 2048, 2048, S, E);
#endif
        if (BOTH(8)) xcd_barrier(bar);
    }
    if (IN(9)) { phase_router(args, lds, tid, lane, wave); if (BOTH(9)) xcd_barrier(bar); }
    if (IN(10)) { phase_slots(args, lds, tid); if (BOTH(10)) xcd_barrier(bar); }
    if (IN(11)) {
        const int T = __builtin_amdgcn_readfirstlane(__hip_atomic_load((const int*)(ws + WS_TILEEXP) + 2048, __ATOMIC_RELAXED, __HIP_MEMORY_SCOPE_AGENT));
        MoeOrder S; S.A = (const char*)(ws + WS_HBF); S.Bt = (const char*)(ws + WS_BT1); S.gidx = (const int*)(ws + WS_STOK); S.tile_exp = (const int*)(ws + WS_TILEEXP);
        S.a_tile_bytes = 0; S.b_exp_bytes = (size_t)2048 * 1024; S.b_tile_bytes = (size_t)256 * 1024; S.T = T; S.nN = 8; S.group = 4; S.c = (int)blockIdx.x;
        EpiMoe1 E{(const float*)(ws + WS_SRSTD), args.in[23], ws + WS_ACT, args.pad};
        pg8::gemm_phase<EpiMoe1, MoeOrder, true, true>(lds, wave, DM / 2, DM / 2, DM / 2, S, E, 0x7A7A7A7A, 0x7F7F7F7F);
        if (BOTH(11)) xcd_barrier(bar);
    }
    if (IN(12)) {
        const int T = __builtin_amdgcn_readfirstlane(__hip_atomic_load((const int*)(ws + WS_TILEEXP) + 2048, __ATOMIC_RELAXED, __HIP_MEMORY_SCOPE_AGENT));
        MoeOrder S; S.A = (const char*)(ws + WS_ACT); S.Bt = (const char*)(ws + WS_BT2); S.gidx = nullptr; S.tile_exp = (const int*)(ws + WS_TILEEXP);
        S.a_tile_bytes = (size_t)256 * 1024; S.b_exp_bytes = (size_t)1024 * 1024; S.b_tile_bytes = (size_t)256 * 1024; S.T = T; S.nN = 4; S.group = 8; S.c = (int)blockIdx.x;
        EpiMoe2 E{(const float*)(ws + WS_SGATE), args.in[25], ws + WS_YROWS};
        pg8::gemm_phase<EpiMoe2, MoeOrder, false, true>(lds, wave, DM / 2, DM / 2, DM / 2, S, E, 0x7A7A7A7A, 0x7F7F7F7F, STAG12);
        if (BOTH(12)) xcd_barrier(bar);
    }
    if (IN(13)) { phase_final(args, gw, NGW, lane); }
#undef IN
#undef BOTH
#undef lane
#undef tid
}

static int g_grid = 0;
static bool mega_setup(size_t ws_size) {
    if (g_grid == 0) {
        int dev = 0, cus = 0, per_cu = 0;
        if (ws_size < WS_NEED) { g_grid = -1; return false; }
        if (hipGetDevice(&dev) != hipSuccess || hipDeviceGetAttribute(&cus, hipDeviceAttributeMultiprocessorCount, dev) != hipSuccess) { g_grid = -1; return false; }
        if (hipFuncSetAttribute((const void*)mega_fwd, hipFuncAttributeMaxDynamicSharedMemorySize, LDS_BYTES) != hipSuccess) { g_grid = -1; return false; }
        (void)hipOccupancyMaxActiveBlocksPerMultiprocessor(&per_cu, (const void*)mega_fwd, NWAVES * 64, LDS_BYTES);
        (void)hipGetLastError();
        if (cus < 256) { g_grid = -1; return false; }
        g_grid = 256;
    }
    return g_grid > 0;
}
static void mega_launch(const MegaArgs& base, int lo, int hi, int li, hipStream_t stream, int variant = 0) {
    MegaArgs a = base; a.ph_lo = lo; a.ph_hi = hi; a.li = li; a.pad = variant;
    hipLaunchKernelGGL(mega_fwd, dim3(g_grid), dim3(NWAVES * 64), LDS_BYTES, stream, a);
}

extern "C" void kernel_launch(void* const* d_in, const int* in_sizes, int n_in, void* d_out, int out_size, void* d_ws,
                              size_t ws_size, hipStream_t stream) {
    if (n_in != 27 || out_size != NTOK * DM) return;
    if (!mega_setup(ws_size)) return;
    unsigned char* ws = (unsigned char*)d_ws;
    (void)hipMemsetAsync(ws + WS_CTL, 0, CTL_ZERO_BYTES, stream);
    MegaArgs a{};
    for (int i = 0; i < 27; ++i) a.in[i] = (const float*)d_in[i];
    a.out = (float*)d_out; a.ws = ws;

#ifndef PROBE_K
    mega_launch(a, 0, 14, 0, stream);
#else
    mega_launch(a, 0, PROBE_K + 1, 0, stream);
#ifndef PROBE_V
#define PROBE_V 0
#endif
    mega_launch(a, PROBE_K, PROBE_K + 1, 1, stream, PROBE_V);
    if (PROBE_K + 1 < 14) mega_launch(a, PROBE_K + 1, 14, 2, stream);
#endif
}
```

```cpp
#include <hip/hip_runtime.h>
#include <stdint.h>

#define NTOK 32768
#define SEQ 8192
#define DM 1024
#define DPROJ 4096
#define NEXP 32
#define NASSIGN (NTOK * 4)
#define EPSV 1e-5f

typedef unsigned short bf16_t;

__device__ __forceinline__ float bf2f(bf16_t h) { return __uint_as_float(((uint32_t)h) << 16); }
__device__ __forceinline__ bf16_t f2bf(float f) {
    uint32_t u = __float_as_uint(f);
    u += 0x7FFFu + ((u >> 16) & 1u);
    return (bf16_t)(u >> 16);
}
__device__ __forceinline__ float sigmoidf_(float x) { return __builtin_amdgcn_rcpf(1.0f + __expf(-x)); }
__device__ __forceinline__ float siluf_(float x) { return x * sigmoidf_(x); }
__device__ __forceinline__ float logsigmoidf_(float x) { return fminf(x, 0.0f) - log1pf(__expf(-fabsf(x))); }

template <int CTRL> __device__ __forceinline__ float dpp_mov_f(float v) { return __builtin_bit_cast(float, __builtin_amdgcn_update_dpp(0, __builtin_bit_cast(int, v), CTRL, 0xf, 0xf, false)); }
__device__ __forceinline__ float wave_sum(float v) {
    v += dpp_mov_f<0xB1>(v); v += dpp_mov_f<0x4E>(v); v += dpp_mov_f<0x124>(v); v += dpp_mov_f<0x128>(v);
    v += __builtin_bit_cast(float, __builtin_amdgcn_ds_swizzle(__builtin_bit_cast(int, v), 0x401F));
    const auto rr = __builtin_amdgcn_permlane32_swap(__float_as_uint(v), __float_as_uint(v), false, false);
    return __uint_as_float(rr[0]) + __uint_as_float(rr[1]);
}
__device__ __forceinline__ float block_sum256(float v, float* red) {
    v = wave_sum(v);
    __syncthreads();
    if ((threadIdx.x & 63) == 0) red[threadIdx.x >> 6] = v;
    __syncthreads();
    return red[0] + red[1] + red[2] + red[3];
}


#define LAS __attribute__((address_space(3)))
#define GAS __attribute__((address_space(1)))
typedef short bf16x8 __attribute__((ext_vector_type(8)));
typedef float f32x4 __attribute__((ext_vector_type(4)));
typedef float f32x2 __attribute__((ext_vector_type(2)));
typedef unsigned u32x4 __attribute__((ext_vector_type(4)));
typedef unsigned u32x2 __attribute__((ext_vector_type(2)));

__device__ __forceinline__ int lane_id() { int l = (int)__builtin_amdgcn_mbcnt_hi(~0u, __builtin_amdgcn_mbcnt_lo(~0u, 0u)); asm volatile("" : "+v"(l)); return l; }
namespace pg8 {
__device__ __forceinline__ const char* uni_ptr(const char* p) { const unsigned long long v = (unsigned long long)p; const unsigned lo = __builtin_amdgcn_readfirstlane((unsigned)v), hi = __builtin_amdgcn_readfirstlane((unsigned)(v >> 32)); return (const char*)(((unsigned long long)hi << 32) | lo); }
typedef int i32x4 __attribute__((ext_vector_type(4)));
typedef int i32x8 __attribute__((ext_vector_type(8)));
__device__ __forceinline__ void mfma8_tied(f32x4& acc, const i32x8 a, const i32x8 b, const int sa, const int sb) {
    asm volatile("v_mfma_scale_f32_16x16x128_f8f6f4 %0, %1, %2, %0, %3, %4 op_sel_hi:[0,0,0]" : "+v"(acc) : "v"(a), "v"(b), "v"(sa), "v"(sb));
}
__device__ __forceinline__ i32x8 cat8(const bf16x8 lo, const bf16x8 hi) { return __builtin_shufflevector(__builtin_bit_cast(i32x4, lo), __builtin_bit_cast(i32x4, hi), 0, 1, 2, 3, 4, 5, 6, 7); }
constexpr int BM = 256, BK = 64, HALF = 128, HTB = HALF * BK * 2, STAGE_BYTES = 8 * HTB, NXCD = 8, WGM = 8;
__host__ __device__ __forceinline__ int lds_byte(int r, int c) { const int st = (r >> 4) * 2 + (c >> 5), rr = r & 15, cc = c & 31, ob = rr * 64 + cc * 2; return st * 1024 + (ob ^ (((ob >> 9) & 1) << 5)); }
__host__ __device__ __forceinline__ void stage_rc(int b, int& R, int& C) { const int st = b / 1024, sb = b % 1024, swz = sb ^ (((sb >> 9) & 1) << 5); R = (st >> 1) * 16 + swz / 64; C = (st & 1) * 32 + (swz % 64) / 2; }
__host__ __device__ __forceinline__ int perm32(int rho) { const int n = rho >> 4, i = rho & 15; return 8 * (i >> 2) + 4 * n + (i & 3); }
__device__ __forceinline__ unsigned cvt_pk_bf16(float lo, float hi) { unsigned r; asm volatile("v_cvt_pk_bf16_f32 %0, %1, %2" : "=v"(r) : "v"(lo), "v"(hi)); return r; }

struct Unit { const char* A; const char* B; const int* gidx; int pm, pn, aux; int gl; };

template <class Epi, class Sched, bool GATHER, bool FP8 = false>
__device__ __forceinline__ void gemm_phase(LAS unsigned char* lds, const int wid, const int K, const int lda, const int ldb, const Sched& S, const Epi& E, const int scale_w = 0x7F7F7F7F, const int scale_a = 0x7F7F7F7F, const int stagger_ticks = 0) {
    const int lane = lane_id(), tid = (wid << 6) | lane, wr = wid >> 2, wc = wid & 3, fr = lane & 15, fq = lane >> 4;
    const int nt = K / BK;
    int Ra[2], Ca[2]; unsigned voffB[2];
#pragma unroll
    for (int i = 0; i < 2; ++i) { int R, C; stage_rc(tid * 16 + i * 8192, R, C); Ra[i] = R; Ca[i] = C; const int Rb = (R & ~31) + perm32(R & 31); voffB[i] = (unsigned)(Rb * ldb + C) * 2u; }
    const size_t kstep = (size_t)(BK * 2);
    const size_t hstepB = (size_t)HALF * ldb * 2;
    const unsigned ldsw = (unsigned)wid * 1024u;
    const unsigned ldsb = (unsigned)(size_t)lds;
    const int aoff = lds_byte(wr * 64 + fr, fq * 8), boff = lds_byte(wc * 32 + fr, fq * 8);
#define PG8_SA(b, h) (((b) * 2 + (h)) * HTB)
#define PG8_SB(b, h) ((4 + (b) * 2 + (h)) * HTB)
#define PG8_STAGE(bufoff, gbase, voff) do { const unsigned long long _ub = (unsigned long long)uni_ptr((const char*)(gbase)); _Pragma("unroll") for (int _i = 0; _i < 2; ++_i) { \
        unsigned _keep; const unsigned _ld = (unsigned)__builtin_amdgcn_readfirstlane((int)(ldsb + (unsigned)(bufoff) + ldsw + (unsigned)_i * 8192u)); \
        asm volatile("s_nop 4\n\ts_mov_b32 %0, m0\n\ts_mov_b32 m0, %3\n\ts_nop 0\n\tglobal_load_lds_dwordx4 %1, %2\n\ts_mov_b32 m0, %0" : "=&s"(_keep) : "v"((voff)[_i]), "s"(_ub), "s"(_ld) : "memory"); } } while (0)
#define PG8_LDA(dst, b, h) do { _Pragma("unroll") for (int m = 0; m < 4; ++m) _Pragma("unroll") for (int k = 0; k < 2; ++k) dst[m][k] = *(const LAS bf16x8*)(lds + PG8_SA(b, h) + aoff + m * 2048 + k * 1024); } while (0)
#define PG8_LDB(dst, b, h) do { _Pragma("unroll") for (int n = 0; n < 2; ++n) _Pragma("unroll") for (int k = 0; k < 2; ++k) dst[n][k] = *(const LAS bf16x8*)(lds + PG8_SB(b, h) + boff + n * 2048 + k * 1024); } while (0)
#define PG8_MMA(ai, bj, At, Bt) do { __builtin_amdgcn_s_setprio(1); _Pragma("unroll") for (int m = 0; m < 4; ++m) _Pragma("unroll") for (int n = 0; n < 2; ++n) { \
        if constexpr (FP8) { mfma8_tied(acc[ai][bj][m][n], cat8(Bt[n][0], Bt[n][1]), cat8(At[m][0], At[m][1]), scale_w, scale_a); } \
        else { _Pragma("unroll") for (int k = 0; k < 2; ++k) acc[ai][bj][m][n] = __builtin_amdgcn_mfma_f32_16x16x32_bf16(Bt[n][k], At[m][k], acc[ai][bj][m][n], 0, 0, 0); } } \
        __builtin_amdgcn_s_setprio(0); } while (0)
#define PG8_WAIT_V(n) asm volatile("s_waitcnt vmcnt(" #n ")" ::: "memory")
#define PG8_WAIT_L(n) asm volatile("s_waitcnt lgkmcnt(" #n ")" ::: "memory")
#define PG8_BAR __builtin_amdgcn_s_barrier()
#define PG8_SCHED __builtin_amdgcn_sched_barrier(0)
    if (stagger_ticks > 0 && ((blockIdx.x >> 3) & 1)) { const unsigned long long t0 = __builtin_amdgcn_s_memrealtime(); while (__builtin_amdgcn_s_memrealtime() - t0 < (unsigned long long)stagger_ticks) __builtin_amdgcn_s_sleep(8); }
    Unit cur, nxt; int ui = 0;
    if (!S.next(0, cur)) return;
    unsigned offA[2][2], offN[2][2];
#pragma unroll
    for (int h = 0; h < 2; ++h)
#pragma unroll
        for (int i = 0; i < 2; ++i) {
            const int rr = h * HALF + Ra[i];
            const int row = GATHER ? cur.gidx[rr] : rr;
            offA[h][i] = (unsigned)(row * lda + Ca[i]) * 2u; offN[h][i] = offA[h][i];
        }
    f32x4 acc[2][2][4][2];
#pragma unroll
    for (int a = 0; a < 2; ++a)
#pragma unroll
        for (int b = 0; b < 2; ++b)
#pragma unroll
            for (int m = 0; m < 4; ++m)
#pragma unroll
                for (int n = 0; n < 2; ++n) acc[a][b][m][n] = (f32x4){0.f, 0.f, 0.f, 0.f};
    bf16x8 At[4][2], B0[2][2], B1[2][2];
    const char* cA = cur.A; const char* cB = cur.B;
    PG8_STAGE(PG8_SB(0, 0), cB, voffB); PG8_STAGE(PG8_SB(0, 1), cB + hstepB, voffB); PG8_STAGE(PG8_SA(0, 0), cA, offA[0]); PG8_STAGE(PG8_SA(0, 1), cA, offA[1]);
    if (wr == 1) PG8_BAR;
    PG8_WAIT_V(2); PG8_BAR;
    PG8_STAGE(PG8_SB(1, 0), cB + kstep, voffB); PG8_STAGE(PG8_SA(1, 0), cA + kstep, offA[0]); PG8_STAGE(PG8_SB(1, 1), cB + hstepB + kstep, voffB);
    PG8_WAIT_V(6); PG8_BAR;
    for (;;) {
        const bool has_next = S.next(ui + 1, nxt);
        const char* nA = has_next ? nxt.A : cA; const char* nB = has_next ? nxt.B : cB;
        if constexpr (GATHER) {
            if (has_next) {
#pragma unroll
                for (int h = 0; h < 2; ++h)
#pragma unroll
                    for (int i = 0; i < 2; ++i) offN[h][i] = (unsigned)(nxt.gidx[h * HALF + Ra[i]] * lda + Ca[i]) * 2u;
            }
        }
#pragma unroll 1
        for (int t = 0; t < nt; t += 2) {
            const bool last = (t == nt - 2);
            const char* a1 = cA + (size_t)(t + 1) * kstep;
            const char* a2 = last ? nA : cA + (size_t)(t + 2) * kstep; const char* b2 = last ? nB : cB + (size_t)(t + 2) * kstep;
            const char* a3 = a2 + kstep; const char* b3 = b2 + kstep;
            unsigned o2[2][2];
#pragma unroll
            for (int h = 0; h < 2; ++h)
#pragma unroll
                for (int i = 0; i < 2; ++i) o2[h][i] = (GATHER && last) ? offN[h][i] : offA[h][i];
            PG8_LDB(B0, 0, 0); PG8_LDB(B1, 0, 1); PG8_SCHED; PG8_LDA(At, 0, 0); PG8_STAGE(PG8_SA(1, 1), a1, offA[1]);
            PG8_WAIT_V(8); PG8_WAIT_L(0); PG8_BAR; PG8_MMA(0, 0, At, B0); PG8_MMA(0, 1, At, B1); PG8_BAR; PG8_SCHED;
            PG8_LDA(At, 0, 1); PG8_STAGE(PG8_SB(0, 0), b2, voffB); PG8_STAGE(PG8_SB(0, 1), b2 + hstepB, voffB); PG8_STAGE(PG8_SA(0, 0), a2, o2[0]);
            PG8_WAIT_V(8); PG8_WAIT_L(0); PG8_BAR; PG8_MMA(1, 0, At, B0); PG8_MMA(1, 1, At, B1); PG8_BAR; PG8_SCHED;
            PG8_LDB(B0, 1, 0); PG8_LDB(B1, 1, 1); PG8_SCHED; PG8_LDA(At, 1, 0); PG8_STAGE(PG8_SA(0, 1), a2, o2[1]);
            PG8_WAIT_V(8); PG8_WAIT_L(0); PG8_BAR; PG8_MMA(0, 0, At, B0); PG8_MMA(0, 1, At, B1); PG8_BAR; PG8_SCHED;
            PG8_LDA(At, 1, 1); PG8_STAGE(PG8_SB(1, 0), b3, voffB); PG8_STAGE(PG8_SB(1, 1), b3 + hstepB, voffB); PG8_STAGE(PG8_SA(1, 0), a3, o2[0]);
            PG8_WAIT_V(8); PG8_WAIT_L(0); PG8_BAR; PG8_MMA(1, 0, At, B0); PG8_MMA(1, 1, At, B1); PG8_BAR; PG8_SCHED;
        }
        if (wr == 0) PG8_BAR;
        if constexpr (FP8) asm volatile("s_nop 15\n\ts_nop 15" ::: "memory");
        E(acc, cur, wr, wc, fr, fq);
        if (!has_next) break;
#pragma unroll
        for (int a = 0; a < 2; ++a)
#pragma unroll
            for (int b = 0; b < 2; ++b)
#pragma unroll
                for (int m = 0; m < 4; ++m)
#pragma unroll
                    for (int n = 0; n < 2; ++n) acc[a][b][m][n] = (f32x4){0.f, 0.f, 0.f, 0.f};
        cur = nxt; cA = nA; cB = nB; ++ui;
        if constexpr (GATHER) {
#pragma unroll
            for (int h = 0; h < 2; ++h)
#pragma unroll
                for (int i = 0; i < 2; ++i) offA[h][i] = offN[h][i];
        }
        if (wr == 1) PG8_BAR;
    }
    PG8_WAIT_V(0);
    PG8_BAR;
#undef PG8_SA
#undef PG8_SB
#undef PG8_STAGE
#undef PG8_LDA
#undef PG8_LDB
#undef PG8_MMA
#undef PG8_WAIT_V
#undef PG8_WAIT_L
#undef PG8_BAR
#undef PG8_SCHED
}

struct DenseOrder {
    const char* A; const char* Bt; size_t a_tile_bytes, b_tile_bytes; int nM, nN, nwg, G, c;
    __device__ void init(const void* A_, const void* Bt_, int M, int N, int lda, int ldb, int G_, int c_) {
        A = (const char*)A_; Bt = (const char*)Bt_; nM = M / BM; nN = N / BM; nwg = nM * nN; G = G_; c = c_;
        a_tile_bytes = (size_t)BM * lda * 2; b_tile_bytes = (size_t)BM * ldb * 2;
    }
    __device__ __forceinline__ bool next(int i, Unit& u) const {
        const long L = (long)i * G + c; if (L >= nwg) return false;
        int wgid = (int)L; { const int q = nwg / NXCD, r = nwg % NXCD, xcd = wgid % NXCD, off = wgid / NXCD; wgid = (xcd < r ? xcd * (q + 1) : r * (q + 1) + (xcd - r) * q) + off; }
        const int nig = WGM * nN, gid = wgid / nig, fm = gid * WGM, gsz = (nM - fm) < WGM ? (nM - fm) : WGM;
        u.pm = fm + ((wgid % nig) % gsz); u.pn = (wgid % nig) / gsz; u.aux = 0; u.gidx = nullptr; u.gl = 0;
        u.A = A + (size_t)u.pm * a_tile_bytes; u.B = Bt + (size_t)u.pn * b_tile_bytes; return true;
    }
};
}

#ifndef OUTPROJ_FP8
#define OUTPROJ_FP8 0
#endif
#define XB_TMO      128
#define XB_XCNT(j)  (256  + 64 * (j))
#define XB_XSUB(j)  (1280 + 64 * (j))
#define XB_XGEN(j)  (2304 + 64 * (j))
#define XB_TOP      3328
#define XB_TOPGEN   3392
#define XCD_BAR_WORDS 3456
#define XB_SPIN_CAP (1u << 18)

__device__ __forceinline__ unsigned xb_ld(unsigned* p)              { return __hip_atomic_load(p, __ATOMIC_RELAXED, __HIP_MEMORY_SCOPE_AGENT); }
__device__ __forceinline__ unsigned xb_add(unsigned* p, unsigned v) { return __hip_atomic_fetch_add(p, v, __ATOMIC_RELAXED, __HIP_MEMORY_SCOPE_AGENT); }
__device__ __forceinline__ unsigned xb_xcc_id() { return (unsigned)__builtin_amdgcn_s_getreg((3 << 11) | 20) & 0xFu; }
#define XB_SPIN(cond, bar) do { unsigned _sp = 0; while (cond) { __builtin_amdgcn_s_sleep(1); \
    if ((++_sp & 255u) == 0u) { if (xb_ld(&(bar)[XB_TMO])) break; if (_sp > XB_SPIN_CAP) { atomicAdd(&(bar)[XB_TMO], 1u); break; } } } } while (0)

struct XcdBarrier {
    unsigned* bar; unsigned x; int w;
    volatile LAS unsigned* st;
};
__device__ __forceinline__ XcdBarrier xcd_barrier_post(unsigned* bar, volatile LAS unsigned* st, int wave) {
    XcdBarrier b; b.bar = bar; b.x = xb_xcc_id(); b.st = st; b.w = wave;
    if (wave == 0 && lane_id() == 0) (void)xb_add(&bar[XB_XCNT(b.x)], 1u);
    return b;
}
__device__ __forceinline__ void xcd_barrier_complete(unsigned* bar, unsigned x, unsigned& nloc, unsigned& nx) {
    const unsigned G = gridDim.x * gridDim.y * gridDim.z;
    unsigned sum, cnt, mine, sp = 0u;
    for (;;) {
        sum = 0u; cnt = 0u; mine = 0u;
#pragma unroll
        for (unsigned j = 0; j < 16; ++j) { const unsigned c = xb_ld(&bar[XB_XCNT(j)]); sum += c; cnt += (c > 0u) ? 1u : 0u; mine = (j == x) ? c : mine; }
        if (sum == G) break;
        __builtin_amdgcn_s_sleep(1);
        if ((++sp & 255u) == 0u) { if (xb_ld(&bar[XB_TMO])) break; if (sp > XB_SPIN_CAP) { atomicAdd(&bar[XB_TMO], 1u); break; } }
    }
    nloc = mine > 0u ? mine : 1u; nx = cnt > 0u ? cnt : 1u;
}
__device__ __forceinline__ void xcd_barrier(const XcdBarrier& b) {
    asm volatile("s_waitcnt vmcnt(0)" ::: "memory");
    __syncthreads();
    if (b.w == 0 && lane_id() == 0) {
        unsigned* bar = b.bar;
        __builtin_amdgcn_s_waitcnt(0);
        unsigned nloc = b.st[0], nx = b.st[1];
        if (nloc == 0u) { xcd_barrier_complete(bar, b.x, nloc, nx); b.st[0] = nloc; b.st[1] = nx; }
        const unsigned old = xb_add(&bar[XB_XSUB(b.x)], 1u);
        const unsigned gen = old / nloc;
        if (old + 1u == (gen + 1u) * nloc) {
            __builtin_amdgcn_fence(__ATOMIC_RELEASE, "agent");
            asm volatile("s_waitcnt vmcnt(0)" ::: "memory");
            const unsigned og = xb_add(&bar[XB_TOP], 1u);
            const unsigned tg = og / nx;
            if (og + 1u == (tg + 1u) * nx) xb_add(&bar[XB_TOPGEN], 1u);
            else XB_SPIN(xb_ld(&bar[XB_TOPGEN]) == tg, bar);
            __builtin_amdgcn_fence(__ATOMIC_ACQUIRE, "agent");
            xb_add(&bar[XB_XGEN(b.x)], 1u);
            asm volatile("s_waitcnt vmcnt(0)" ::: "memory");
        } else {
            XB_SPIN(xb_ld(&bar[XB_XGEN(b.x)]) == gen, bar);
            __builtin_amdgcn_fence(__ATOMIC_ACQUIRE, "agent");
            asm volatile("s_waitcnt vmcnt(0)" ::: "memory");
        }
    }
    __syncthreads();
}

constexpr size_t MiB = 1u << 20;
constexpr size_t WS_CTL = 0, CTL_ZERO_BYTES = 64 * 1024;
constexpr size_t WS_SMALL = 1 * MiB;
constexpr size_t WS_RSTD1 = WS_SMALL;
constexpr size_t WS_LOGI = WS_SMALL + 1 * MiB;
constexpr size_t WS_LOGF = WS_SMALL + 2 * MiB;
constexpr size_t WS_TOPI = WS_SMALL + 3 * MiB;
constexpr size_t WS_TOPG = WS_SMALL + 4 * MiB;
constexpr size_t WS_STOK = WS_SMALL + 5 * MiB;
constexpr size_t WS_SGATE = WS_SMALL + 6 * MiB;
constexpr size_t WS_ESTART = WS_SMALL + 7 * MiB;
constexpr size_t WS_BTIN = 17 * MiB;
constexpr size_t WS_BTOUT = 25 * MiB;
constexpr size_t WS_BT1 = 29 * MiB;
constexpr size_t WS_BT2 = 157 * MiB;
constexpr size_t WS_R1 = 221 * MiB;
constexpr size_t WS_XM = 285 * MiB;
constexpr size_t WS_SZ = 349 * MiB;
constexpr size_t WS_U = 413 * MiB;
constexpr size_t WS_Q = 477 * MiB;
constexpr size_t WS_YMIX = 477 * MiB;
constexpr size_t WS_ACT = 285 * MiB;
constexpr size_t WS_NEED = 925 * MiB;

constexpr int NWAVES = 8;
constexpr int RING_BYTES = 131072;
constexpr int LDSCTL_OFF = RING_BYTES;
constexpr int LDS_BYTES = 147456;
constexpr int CW_BAR = 4096;

struct MegaArgs {
    const float* in[27];
    float* out;
    unsigned char* ws;
    int ph_lo, ph_hi, li, pad;
};

__device__ __forceinline__ unsigned pk2(float lo, float hi) { return pg8::cvt_pk_bf16(lo, hi); }

__device__ __forceinline__ void unpack8(const u32x4 r, float (&f)[8]) {
    f[0] = __uint_as_float(r.x << 16); f[1] = __uint_as_float(r.x & 0xFFFF0000u); f[2] = __uint_as_float(r.y << 16); f[3] = __uint_as_float(r.y & 0xFFFF0000u);
    f[4] = __uint_as_float(r.z << 16); f[5] = __uint_as_float(r.z & 0xFFFF0000u); f[6] = __uint_as_float(r.w << 16); f[7] = __uint_as_float(r.w & 0xFFFF0000u);
}

__device__ __forceinline__ f32x4 up4(const u32x2 r) { f32x4 v; v.x = __uint_as_float(r.x << 16); v.y = __uint_as_float(r.x & 0xFFFF0000u); v.z = __uint_as_float(r.y << 16); v.w = __uint_as_float(r.y & 0xFFFF0000u); return v; }

__device__ __forceinline__ void p0_transpose_item(const float* W, int K, int N, bf16_t* WT, const float* ksc, int k0, int n0s, int n0d, LAS float* scr, int lane) {
    const int kr = lane >> 4, nq = lane & 15;
    f32x4 v[16];
#pragma unroll
    for (int i = 0; i < 16; ++i) v[i] = *(const f32x4*)(W + (size_t)(k0 + 4 * i + kr) * N + n0s + 4 * nq);
    if (ksc) {
#pragma unroll
        for (int i = 0; i < 16; ++i) v[i] = v[i] * ksc[k0 + 4 * i + kr];
    }
    const int c = lane >> 4, nl = lane & 15;
#pragma unroll
    for (int half = 0; half < 2; ++half) {
#pragma unroll
        for (int ii = 0; ii < 8; ++ii) *(LAS f32x4*)(scr + (4 * ii + kr) * 68 + 4 * nq) = v[8 * half + ii];
        asm volatile("s_waitcnt lgkmcnt(0)" ::: "memory");
#pragma unroll
        for (int j = 0; j < 4; ++j) { const int n = nl + 16 * j; const LAS float* sp = scr + (8 * c) * 68 + n;
            u32x4 o; o.x = pk2(sp[0 * 68], sp[1 * 68]); o.y = pk2(sp[2 * 68], sp[3 * 68]); o.z = pk2(sp[4 * 68], sp[5 * 68]); o.w = pk2(sp[6 * 68], sp[7 * 68]);
            *(u32x4*)(WT + (size_t)(n0d + n) * K + k0 + 32 * half + 8 * c) = o; }
        asm volatile("s_waitcnt lgkmcnt(0)" ::: "memory");
    }
}
__device__ __forceinline__ unsigned pk4_fp8(float a, float b, float c, float d) { int w = __builtin_amdgcn_cvt_pk_fp8_f32(a, b, 0, false); w = __builtin_amdgcn_cvt_pk_fp8_f32(c, d, w, true); return (unsigned)w; }
struct TrItem { const float* W; unsigned char* WT; const float* ksc; int K, N, k0, n0s, n0d; };
__device__ __forceinline__ void tr8_load(const TrItem& t, int lane, f32x4 (&v)[16]) {
    const int kr = lane >> 4, nq = lane & 15;
#pragma unroll
    for (int i = 0; i < 16; ++i) v[i] = *(const f32x4*)(t.W + (size_t)(t.k0 + 4 * i + kr) * t.N + t.n0s + 4 * nq);
}
__device__ __forceinline__ void tr8_finish(const TrItem& t, float mul, LAS float* scr, int lane, f32x4 (&v)[16]) {
    const int kr = lane >> 4, nq = lane & 15;
#pragma unroll
    for (int i = 0; i < 16; ++i) v[i] = v[i] * (t.ksc ? t.ksc[t.k0 + 4 * i + kr] * mul : mul);
    const int c = lane >> 4, nl = lane & 15;
#pragma unroll
    for (int half = 0; half < 2; ++half) {
#pragma unroll
        for (int ii = 0; ii < 8; ++ii) *(LAS f32x4*)(scr + (4 * ii + kr) * 68 + 4 * nq) = v[8 * half + ii];
        asm volatile("s_waitcnt lgkmcnt(0)" ::: "memory");
#pragma unroll
        for (int j = 0; j < 4; ++j) { const int n = nl + 16 * j; const LAS float* sp = scr + (8 * c) * 68 + n;
            u32x2 o; o.x = pk4_fp8(sp[0 * 68], sp[1 * 68], sp[2 * 68], sp[3 * 68]); o.y = pk4_fp8(sp[4 * 68], sp[5 * 68], sp[6 * 68], sp[7 * 68]);
            *(u32x2*)(t.WT + (size_t)(t.n0d + n) * t.K + t.k0 + 32 * half + 8 * c) = o; }
        asm volatile("s_waitcnt lgkmcnt(0)" ::: "memory");
    }
}
__device__ __forceinline__ void p0_transpose_item8(const float* W, int K, int N, unsigned char* WT, const float* ksc, float mul, int k0, int n0s, int n0d, LAS float* scr, int lane) {
    TrItem t{W, WT, ksc, K, N, k0, n0s, n0d}; f32x4 v[16]; tr8_load(t, lane, v); tr8_finish(t, mul, scr, lane, v);
}
__device__ __forceinline__ int inproj_src_col(int nd) { if (nd < 2048) return nd; const int pn = (nd >> 8) - 8, lc = nd & 255; return 2048 + (lc >> 7) * 1024 + 128 * pn + (lc & 127); }
__device__ __forceinline__ int w1_src_col(int nd) { const int pn = nd >> 8, lc = nd & 255; return (lc >> 7) * 1024 + 128 * pn + (lc & 127); }

__device__ __forceinline__ void p0_prologue(const MegaArgs& a, LAS unsigned char* lds, int gw, int NGW, int wave, int lane) {
    LAS float* scr = (LAS float*)(lds + wave * 16384);
    unsigned char* ws = a.ws;
    const float* x = a.in[0];
    {
        bf16_t* xbf = (bf16_t*)(ws + WS_R1); float* rstd1 = (float*)(ws + WS_RSTD1);
        f32x4 va[4], vb[4];
#define XROW_LOAD(V, m_) do { const f32x4* xr_ = (const f32x4*)(x + (size_t)(m_) * DM) + lane; _Pragma("unroll") for (int j = 0; j < 4; ++j) V[j] = xr_[64 * j]; } while (0)
#define XROW_DONE(V, m_) do { float s_ = 0.f; _Pragma("unroll") for (int j = 0; j < 4; ++j) s_ += (V[j].x * V[j].x + V[j].y * V[j].y) + (V[j].z * V[j].z + V[j].w * V[j].w); \
            s_ = wave_sum(s_); if (lane == 0) rstd1[m_] = rsqrtf(s_ * (1.0f / DM) + EPSV); \
            unsigned long long* o8_ = (unsigned long long*)(xbf + (size_t)(m_) * DM) + lane; \
            _Pragma("unroll") for (int j = 0; j < 4; ++j) o8_[64 * j] = (unsigned long long)pk2(V[j].x, V[j].y) | ((unsigned long long)pk2(V[j].z, V[j].w) << 32); } while (0)
        int m = gw;
        if (m < NTOK) XROW_LOAD(va, m);
        for (; m < NTOK; m += 2 * NGW) {
            const int m2 = m + NGW;
            if (m2 < NTOK) XROW_LOAD(vb, m2);
            XROW_DONE(va, m);
            if (m2 < NTOK) { const int m3 = m2 + NGW; if (m3 < NTOK) XROW_LOAD(va, m3); XROW_DONE(vb, m2); }
        }
#undef XROW_LOAD
#undef XROW_DONE
    }
    constexpr int I_IN = (1024 / 64) * (4096 / 64);
    for (int it = gw; it < I_IN; it += NGW) { const int kb = it / 64, nb = it % 64; p0_transpose_item(a.in[2], 1024, 4096, (bf16_t*)(ws + WS_BTIN), a.in[1], 64 * kb, inproj_src_col(64 * nb), 64 * nb, scr, lane); }
}
__device__ __forceinline__ TrItem p0b_item(const MegaArgs& a, int r) {
    unsigned char* ws = a.ws;
    constexpr int I_W1 = 32 * (1024 / 64) * (2048 / 64);
    if (r < I_W1) { const int e = r / 512, rr = r % 512, kb = rr / 32, nb = rr % 32;
        return TrItem{a.in[22] + (size_t)e * 1024 * 2048, ws + WS_BT1 + (size_t)e * 2048 * 1024, a.in[19], 1024, 2048, 64 * kb, w1_src_col(64 * nb), 64 * nb}; }
    r -= I_W1;
    const int e = r / 256, rr = r % 256, kb = rr / 16, nb = rr % 16;
    return TrItem{a.in[24] + (size_t)e * 1024 * 1024, ws + WS_BT2 + (size_t)e * 1024 * 1024, nullptr, 1024, 1024, 64 * kb, 64 * nb, 64 * nb};
}
__device__ __forceinline__ void p0b_weights(const MegaArgs& a, LAS unsigned char* lds, int gw, int NGW, int wave, int lane) {
    LAS float* scr = (LAS float*)(lds + wave * 16384);
    unsigned char* ws = a.ws;
    constexpr int I_OUT = (2048 / 64) * (1024 / 64);
    constexpr int NITEMS = 32 * (1024 / 64) * (2048 / 64) + 32 * (1024 / 64) * (1024 / 64);
    for (int it = gw; it < I_OUT; it += NGW) { const int kb = it / 16, nb = it % 16;
#if OUTPROJ_FP8
        p0_transpose_item8(a.in[18], 2048, 1024, ws + WS_BTOUT, nullptr, 32.0f, 64 * kb, 64 * nb, 64 * nb, scr, lane);
#else
        p0_transpose_item(a.in[18], 2048, 1024, (bf16_t*)(ws + WS_BTOUT), nullptr, 64 * kb, 64 * nb, 64 * nb, scr, lane);
#endif
    }
    f32x4 vA[16], vB[16];
    int it = gw;
    if (it < NITEMS) { const TrItem t = p0b_item(a, it); tr8_load(t, lane, vA); }
    for (; it < NITEMS; it += 2 * NGW) {
        const int it2 = it + NGW;
        if (it2 < NITEMS) { const TrItem t2 = p0b_item(a, it2); tr8_load(t2, lane, vB); }
        { const TrItem t = p0b_item(a, it); tr8_finish(t, 32.0f, scr, lane, vA); }
        if (it2 < NITEMS) {
            const int it3 = it2 + NGW;
            if (it3 < NITEMS) { const TrItem t3 = p0b_item(a, it3); tr8_load(t3, lane, vA); }
            const TrItem t2 = p0b_item(a, it2); tr8_finish(t2, 32.0f, scr, lane, vB);
        }
    }
}

struct EpiInProj {
    const float* rstd; bf16_t* xm; bf16_t* sz; bf16_t* u; int variant;
    __device__ __forceinline__ void operator()(const f32x4 (&acc)[2][2][4][2], const pg8::Unit& un, int wr, int wc, int fr, int fq) const {
        if (variant & 8) return;
        const int row0 = un.pm * 256 + wr * 64 + fr;
        const int cl = wc * 32 + 8 * fq;
        float rsv[2][4];
#pragma unroll
        for (int ai = 0; ai < 2; ++ai)
#pragma unroll
            for (int m = 0; m < 4; ++m) rsv[ai][m] = rstd[row0 + ai * 128 + m * 16];
#pragma unroll
        for (int ai = 0; ai < 2; ++ai)
#pragma unroll
            for (int m = 0; m < 4; ++m) {
                const int row = row0 + ai * 128 + m * 16;
                const float rs = rsv[ai][m];
                if (un.pn < 8) {
                    bf16_t* dst = (un.pn < 4 ? xm : sz) + (size_t)row * DM + (un.pn & 3) * 256 + cl;
#pragma unroll
                    for (int bj = 0; bj < 2; ++bj) {
                        f32x4 v0 = acc[ai][bj][m][0] * rs, v1 = acc[ai][bj][m][1] * rs;
                        if (un.pn >= 4) {
#pragma unroll
                            for (int j = 0; j < 4; ++j) { v0[j] = siluf_(v0[j]); v1[j] = siluf_(v1[j]); }
                        }
                        u32x4 w; w.x = pg8::cvt_pk_bf16(v0[0], v0[1]); w.y = pg8::cvt_pk_bf16(v0[2], v0[3]); w.z = pg8::cvt_pk_bf16(v1[0], v1[1]); w.w = pg8::cvt_pk_bf16(v1[2], v1[3]);
                        if (!(variant & 4)) *(u32x4*)(dst + bj * 128) = w;
                    }
                } else {
                    bf16_t* dst = u + (size_t)row * DM + (un.pn - 8) * 128 + cl;
                    f32x4 o0, o1;
#pragma unroll
                    for (int j = 0; j < 4; ++j) {
                        o0[j] = (acc[ai][0][m][0][j] * rs) * sigmoidf_(acc[ai][1][m][0][j] * rs);
                        o1[j] = (acc[ai][0][m][1][j] * rs) * sigmoidf_(acc[ai][1][m][1][j] * rs);
                    }
                    u32x4 w; w.x = pg8::cvt_pk_bf16(o0[0], o0[1]); w.y = pg8::cvt_pk_bf16(o0[2], o0[3]); w.z = pg8::cvt_pk_bf16(o1[0], o1[1]); w.w = pg8::cvt_pk_bf16(o1[2], o1[3]);
                    if (!(variant & 4)) *(u32x4*)dst = w;
                }
            }
    }
};

constexpr size_t WS_WGCNT = WS_SMALL + 8 * MiB;
constexpr size_t WS_ASGE = WS_SMALL + 9 * MiB;
constexpr size_t WS_ASGR = WS_SMALL + 10 * MiB;
constexpr size_t WS_ASGG = WS_SMALL + 11 * MiB;
constexpr size_t WS_RSTD2 = WS_SMALL + 12 * MiB;
constexpr size_t WS_SRSTD = WS_SMALL + 13 * MiB;
constexpr size_t WS_TOKSLOT = WS_SMALL + 14 * MiB;
constexpr size_t WS_TILEEXP = WS_SMALL + 15 * MiB;
constexpr size_t WS_HBF = WS_R1;
constexpr size_t WS_YROWS = 605 * MiB;
constexpr size_t WS_HB16 = 750 * MiB;
constexpr int NSLOT = NASSIGN + NEXP * 256;
constexpr int TOK_PER_WG = NTOK / 256;

constexpr size_t WS_WRH = WS_SMALL + 576 * 1024;
constexpr size_t WS_WRL = WS_SMALL + 640 * 1024;
__device__ __forceinline__ void p0_router_tables(const MegaArgs& a, int gw, int NGW, int lane) {
    const float* nfw = a.in[19]; const float* wr = a.in[20];
    bf16_t* wh = (bf16_t*)(a.ws + WS_WRH); bf16_t* wl = (bf16_t*)(a.ws + WS_WRL);
    for (int idx = gw * 64 + lane; idx < 32 * 1024; idx += NGW * 64) {
        const int e = idx >> 10, k = idx & 1023;
        const float w = nfw[k] * wr[(size_t)k * 32 + e];
        const bf16_t hi = f2bf(w);
        wh[idx] = hi; wl[idx] = f2bf(w - bf2f(hi));
    }
}
constexpr int RT_LDS_OFF = LDSCTL_OFF + 5120;
struct RtGrp { u32x4 h[8]; };
__device__ __forceinline__ void rt_load_grp(const bf16_t* hrow, int k0, RtGrp& B) {
#pragma unroll
    for (int q = 0; q < 8; ++q) B.h[q] = *(const u32x4*)(hrow + k0 + 32 * q);
}
__device__ __forceinline__ void rt_step(const LAS bf16_t* whl, const LAS bf16_t* wll, int col, int kk, const u32x4 hraw, f32x4& acc0, f32x4& acc1, float& ssq) {
    float v[8]; unpack8(hraw, v);
#pragma unroll
    for (int i = 0; i < 8; ++i) ssq += v[i] * v[i];
    const bf16x8 ah = __builtin_bit_cast(bf16x8, hraw);
    const int ks = kk ^ (col << 3);
    const u32x4 bh0 = *(const LAS u32x4*)(whl + col * 1024 + ks), bh1 = *(const LAS u32x4*)(whl + (col + 16) * 1024 + ks);
    const u32x4 bl0 = *(const LAS u32x4*)(wll + col * 1024 + ks), bl1 = *(const LAS u32x4*)(wll + (col + 16) * 1024 + ks);
    acc0 = __builtin_amdgcn_mfma_f32_16x16x32_bf16(ah, __builtin_bit_cast(bf16x8, bh0), acc0, 0, 0, 0);
    acc0 = __builtin_amdgcn_mfma_f32_16x16x32_bf16(ah, __builtin_bit_cast(bf16x8, bl0), acc0, 0, 0, 0);
    acc1 = __builtin_amdgcn_mfma_f32_16x16x32_bf16(ah, __builtin_bit_cast(bf16x8, bh1), acc1, 0, 0, 0);
    acc1 = __builtin_amdgcn_mfma_f32_16x16x32_bf16(ah, __builtin_bit_cast(bf16x8, bl1), acc1, 0, 0, 0);
}
template <int CTRL> __device__ __forceinline__ void argmax_step(float& v, int& i) {
    const float ov = dpp_mov_f<CTRL>(v); const int oi = __builtin_amdgcn_update_dpp(0, i, CTRL, 0xf, 0xf, false);
    const bool take = (ov > v) || (ov == v && oi < i);
    v = take ? ov : v; i = take ? oi : i;
}
__device__ __forceinline__ void phase_router(const MegaArgs& a, LAS unsigned char* lds, int tid, int lane, int wave) {
    unsigned char* ws = a.ws;
    const bf16_t* hbuf = (const bf16_t*)(ws + WS_HB16);
    const float* br = a.in[21];
    const bf16_t* wh = (const bf16_t*)(ws + WS_WRH); const bf16_t* wl = (const bf16_t*)(ws + WS_WRL);
    float* rstd2 = (float*)(ws + WS_RSTD2);
    int* wgcnt = (int*)(ws + WS_WGCNT); int* asg_e = (int*)(ws + WS_ASGE); int* asg_r = (int*)(ws + WS_ASGR); float* asg_g = (float*)(ws + WS_ASGG);
    LAS int* topi_l = (LAS int*)(lds + RT_LDS_OFF);
    LAS float* topg_l = (LAS float*)(lds + RT_LDS_OFF + 2048);
    LAS int* rank_l = (LAS int*)(lds + RT_LDS_OFF + 4096);
    LAS float* rstd_l = (LAS float*)(lds + RT_LDS_OFF + 6144);
    LAS bf16_t* whl = (LAS bf16_t*)lds;
    LAS bf16_t* wll = (LAS bf16_t*)(lds + 65536);
    for (int i = tid; i < 8192; i += NWAVES * 64) { const int r = i >> 7, c8 = i & 127;
        *(LAS u32x4*)(lds + 16 * ((r << 7) + (c8 ^ (r & 15)))) = *(const u32x4*)((const unsigned char*)wh + 16 * (size_t)i); }
    __syncthreads();
    const int b = blockIdx.x;
    const int col = lane & 15, kq = lane >> 4;
    {
        const int t = b * TOK_PER_WG + wave * 16 + col;
        const bf16_t* hrow = hbuf + (size_t)t * DM + 8 * kq;
        f32x4 acc0 = (f32x4){0.f, 0.f, 0.f, 0.f}, acc1 = acc0; float ssq = 0.f;
        RtGrp A, B;
        rt_load_grp(hrow, 0, A);
        for (int g = 0; g < 4; g += 2) {
            rt_load_grp(hrow, 256 * (g + 1), B);
#pragma unroll
            for (int q = 0; q < 8; ++q) rt_step(whl, wll, col, 256 * g + 32 * q + 8 * kq, A.h[q], acc0, acc1, ssq);
            if (g + 2 < 4) rt_load_grp(hrow, 256 * (g + 2), A);
#pragma unroll
            for (int q = 0; q < 8; ++q) rt_step(whl, wll, col, 256 * (g + 1) + 32 * q + 8 * kq, B.h[q], acc0, acc1, ssq);
        }
        ssq += __builtin_bit_cast(float, __builtin_amdgcn_ds_swizzle(__builtin_bit_cast(int, ssq), 0x401F));
        { const auto rr = __builtin_amdgcn_permlane32_swap(__float_as_uint(ssq), __float_as_uint(ssq), false, false); ssq = __uint_as_float(rr[0]) + __uint_as_float(rr[1]); }
        const float rs = rsqrtf(ssq * (1.0f / DM) + EPSV);
        if (kq == 0) { rstd_l[wave * 16 + col] = rs; rstd2[t] = rs; }
        asm volatile("s_waitcnt lgkmcnt(0)" ::: "memory");
        const float b0 = br[col], b1 = br[col + 16];
#pragma unroll
        for (int r = 0; r < 4; ++r) {
            const float rsr = rstd_l[wave * 16 + 4 * kq + r];
            float v0 = acc0[r] * rsr + b0, v1 = acc1[r] * rsr + b1;
            int sel[4]; float val[4];
#pragma unroll
            for (int it = 0; it < 4; ++it) {
                float bv = (v1 > v0) ? v1 : v0; int bi = (v1 > v0) ? col + 16 : col;
                argmax_step<0xB1>(bv, bi); argmax_step<0x4E>(bv, bi); argmax_step<0x124>(bv, bi); argmax_step<0x128>(bv, bi);
                sel[it] = bi; val[it] = bv;
                if (bi == col) v0 = -3.0e38f;
                if (bi == col + 16) v1 = -3.0e38f;
            }
            float ex[4], sum = 0.f;
#pragma unroll
            for (int it = 0; it < 4; ++it) { ex[it] = __expf(val[it] - val[0]); sum += ex[it]; }
            const float inv = 1.0f / sum;
            if (col == 0) {
                const int tw = wave * 16 + 4 * kq + r;
#pragma unroll
                for (int it = 0; it < 4; ++it) { topi_l[tw * 4 + it] = sel[it]; topg_l[tw * 4 + it] = ex[it] * inv; }
            }
        }
    }
    __syncthreads();
    if (wave == 0) {
        int base = 0;
        for (int ch = 0; ch < 8; ++ch) {
            const int E = topi_l[ch * 64 + lane];
            int myrank = 0;
#pragma unroll
            for (int e = 0; e < 32; ++e) {
                const unsigned long long m = __ballot(E == e);
                const int be = __builtin_amdgcn_readlane(base, e);
                if (E == e) myrank = be + __builtin_popcountll(m & ((1ull << lane) - 1ull));
                if (lane == e) base += __builtin_popcountll(m);
            }
            rank_l[ch * 64 + lane] = myrank;
        }
        if (lane < 32) wgcnt[b * 32 + lane] = base;
    }
    __syncthreads();
    {
        int i = tid; asm volatile("" : "+v"(i));
        const int aidx = b * TOK_PER_WG * 4 + i;
        asg_e[aidx] = topi_l[i]; asg_r[aidx] = rank_l[i]; asg_g[aidx] = topg_l[i];
    }
}

__device__ __forceinline__ void phase_slots(const MegaArgs& a, LAS unsigned char* lds, int tid) {
    unsigned char* ws = a.ws;
    const int* wgcnt = (const int*)(ws + WS_WGCNT); const int* asg_e = (const int*)(ws + WS_ASGE); const int* asg_r = (const int*)(ws + WS_ASGR); const float* asg_g = (const float*)(ws + WS_ASGG);
    const float* rstd2 = (const float*)(ws + WS_RSTD2);
    int* slot_tok = (int*)(ws + WS_STOK); float* slot_gate = (float*)(ws + WS_SGATE); float* slot_rstd = (float*)(ws + WS_SRSTD);
    int* tok_slot = (int*)(ws + WS_TOKSLOT); int* tile_exp = (int*)(ws + WS_TILEEXP);
    LAS int* tot = (LAS int*)lds; LAS int* bef = tot + 32; LAS int* tstart = bef + 32;
    const int b = blockIdx.x;
    if (tid < 32) {
        int t = 0, bf = 0;
        for (int bb = 0; bb < 256; ++bb) { const int c = wgcnt[bb * 32 + tid]; t += c; if (bb < b) bf += c; }
        tot[tid] = t; bef[tid] = bf;
    }
    __syncthreads();
    if (tid == 0) { int ts = 0; for (int e = 0; e < 32; ++e) { tstart[e] = ts; ts += (tot[e] + 255) >> 8; } tstart[32] = ts; }
    __syncthreads();
    {
        int tid_o = tid; asm volatile("" : "+v"(tid_o));
        const int aidx = b * TOK_PER_WG * 4 + tid_o;
        const int e = asg_e[aidx];
        const int slot = 256 * tstart[e] + bef[e] + asg_r[aidx];
        const int tk = aidx >> 2;
        slot_tok[slot] = tk; slot_gate[slot] = asg_g[aidx]; slot_rstd[slot] = rstd2[tk]; tok_slot[aidx] = slot;
    }
    if (b < 32) {
        const int e = b; const int s0 = 256 * tstart[e] + tot[e], s1 = 256 * tstart[e + 1];
        for (int s = s0 + tid; s < s1; s += NWAVES * 64) { slot_tok[s] = 0; slot_gate[s] = 0.f; slot_rstd[s] = 0.f; }
    }
    if (b == 0) {
        if (tid < 32) for (int t = tstart[tid]; t < tstart[tid + 1]; ++t) tile_exp[t] = tid;
        if (tid == 0) tile_exp[2048] = tstart[32];
    }
}

struct MoeOrder {
    const char* A; const char* Bt; const int* gidx; const int* tile_exp; size_t a_tile_bytes, b_exp_bytes, b_tile_bytes; int T, nN, group, c;
    __device__ __forceinline__ bool next(int i, pg8::Unit& u) const {
        const int x = c & 7, j = c >> 3;
        const int tile = (i * 8 + x) * group + (j % group);
        if (tile >= T) return false;
        const int e = __builtin_amdgcn_readfirstlane(tile_exp[tile]);
        u.pm = tile; u.pn = j / group; u.aux = e; u.gl = 0;
        u.gidx = gidx ? gidx + 256 * tile : nullptr;
        u.A = gidx ? A : A + (size_t)tile * a_tile_bytes;
        u.B = Bt + (size_t)e * b_exp_bytes + (size_t)u.pn * b_tile_bytes;
        return true;
    }
};

struct EpiMoe1 {
    const float* srstd; const float* b1; unsigned char* act; int variant;
    __device__ __forceinline__ void operator()(const f32x4 (&acc)[2][2][4][2], const pg8::Unit& un, int wr, int wc, int fr, int fq) const {
        if (variant & 8) return;
        const int e = un.aux;
        const int cl = un.pn * 128 + wc * 32 + 8 * fq;
        f32x4 bg[2], bl[2];
#pragma unroll
        for (int n = 0; n < 2; ++n) { bg[n] = *(const f32x4*)(b1 + (size_t)e * 2048 + cl + 4 * n); bl[n] = *(const f32x4*)(b1 + (size_t)e * 2048 + 1024 + cl + 4 * n); }
        const int slot0 = un.pm * 256 + wr * 64 + fr;
        float rsv[2][4];
#pragma unroll
        for (int ai = 0; ai < 2; ++ai)
#pragma unroll
            for (int m = 0; m < 4; ++m) rsv[ai][m] = srstd[slot0 + ai * 128 + m * 16];
#pragma unroll
        for (int ai = 0; ai < 2; ++ai)
#pragma unroll
            for (int m = 0; m < 4; ++m) {
                const int slot = slot0 + ai * 128 + m * 16;
                const float rs = rsv[ai][m];
                f32x4 o[2];
#pragma unroll
                for (int n = 0; n < 2; ++n)
#pragma unroll
                    for (int j = 0; j < 4; ++j) {
                        const float g = acc[ai][0][m][n][j] * rs + bg[n][j];
                        const float l = acc[ai][1][m][n][j] * rs + bl[n][j];
                        const float xg = fminf(g, 7.0f);
                        const float xl = fminf(fmaxf(l, -7.0f), 7.0f);
                        o[n][j] = xg * sigmoidf_(1.702f * xg) * (xl + 1.0f);
                    }
                u32x2 w; w.x = pk4_fp8(o[0][0], o[0][1], o[0][2], o[0][3]); w.y = pk4_fp8(o[1][0], o[1][1], o[1][2], o[1][3]);
                *(u32x2*)(act + (size_t)slot * DM + cl) = w;
            }
    }
};
struct EpiMoe2 {
    const float* sgate; const float* b2; unsigned char* yrows;
    __device__ __forceinline__ void operator()(const f32x4 (&acc)[2][2][4][2], const pg8::Unit& un, int wr, int wc, int fr, int fq) const {
        const int e = un.aux;
        const int c0 = un.pn * 256 + wc * 32 + 8 * fq;
        f32x4 bv[2][2];
#pragma unroll
        for (int bj = 0; bj < 2; ++bj)
#pragma unroll
            for (int n = 0; n < 2; ++n) bv[bj][n] = *(const f32x4*)(b2 + (size_t)e * DM + c0 + bj * 128 + 4 * n);
        const int slot0 = un.pm * 256 + wr * 64 + fr;
        float gtv[2][4];
#pragma unroll
        for (int ai = 0; ai < 2; ++ai)
#pragma unroll
            for (int m = 0; m < 4; ++m) gtv[ai][m] = sgate[slot0 + ai * 128 + m * 16] * 16.0f;
#pragma unroll
        for (int ai = 0; ai < 2; ++ai)
#pragma unroll
            for (int m = 0; m < 4; ++m) {
                const int slot = slot0 + ai * 128 + m * 16;
                const float gt = gtv[ai][m];
#pragma unroll
                for (int bj = 0; bj < 2; ++bj) {
                    const f32x4 v0 = (acc[ai][bj][m][0] + bv[bj][0]) * gt, v1 = (acc[ai][bj][m][1] + bv[bj][1]) * gt;
                    u32x2 w; w.x = pk4_fp8(v0[0], v0[1], v0[2], v0[3]); w.y = pk4_fp8(v1[0], v1[1], v1[2], v1[3]);
                    *(u32x2*)(yrows + (size_t)slot * DM + c0 + bj * 128) = w;
                }
            }
    }
};

struct FinBuf { u32x2 h[4]; unsigned y[4][4]; };
__device__ __forceinline__ void fin_load(const bf16_t* hbuf, const unsigned char* yrows, const int slots, int kk, int t, int lane, FinBuf& B) {
    const u32x2* hp = (const u32x2*)(hbuf + (size_t)t * DM) + lane;
#pragma unroll
    for (int j = 0; j < 4; ++j) B.h[j] = hp[64 * j];
#pragma unroll
    for (int r = 0; r < 4; ++r) {
        const int slot = __builtin_amdgcn_readlane(slots, 4 * kk + r);
        const unsigned* yp = (const unsigned*)(yrows + (size_t)slot * DM) + lane;
#pragma unroll
        for (int j = 0; j < 4; ++j) B.y[r][j] = yp[64 * j];
    }
}
__device__ __forceinline__ void fin_compute(float* obuf, const float* fw, int t, int lane, const FinBuf& B) {
    f32x4 v[4];
#pragma unroll
    for (int j = 0; j < 4; ++j) {
        v[j] = up4(B.h[j]);
#pragma unroll
        for (int r = 0; r < 4; ++r) {
            const unsigned w = B.y[r][j];
            const f32x2 lo = __builtin_amdgcn_cvt_pk_f32_fp8(w, false), hi = __builtin_amdgcn_cvt_pk_f32_fp8(w, true);
            v[j].x += lo.x * 0.0625f; v[j].y += lo.y * 0.0625f; v[j].z += hi.x * 0.0625f; v[j].w += hi.y * 0.0625f;
        }
    }
    float s = 0.f;
#pragma unroll
    for (int j = 0; j < 4; ++j) s += (v[j].x * v[j].x + v[j].y * v[j].y) + (v[j].z * v[j].z + v[j].w * v[j].w);
    s = wave_sum(s);
    const float rs = rsqrtf(s * (1.0f / DM) + EPSV);
    f32x4* hp = (f32x4*)(obuf + (size_t)t * DM) + lane;
#pragma unroll
    for (int j = 0; j < 4; ++j) {
        const f32x4 w = *((const f32x4*)fw + lane + 64 * j);
        hp[64 * j] = v[j] * rs * w;
    }
}
__device__ __forceinline__ void phase_final(const MegaArgs& a, int gw, int NGW, int lane) {
    unsigned char* ws = a.ws;
    float* obuf = a.out; const float* fw = a.in[26]; const bf16_t* hbuf = (const bf16_t*)(ws + WS_HB16);
    const unsigned char* yrows = ws + WS_YROWS; const int* tok_slot = (const int*)(ws + WS_TOKSLOT);
    int slots = 0;
    { const int tk = gw + (lane >> 2) * NGW; if (tk < NTOK) slots = __hip_atomic_load(tok_slot + (size_t)tk * 4 + (lane & 3), __ATOMIC_RELAXED, __HIP_MEMORY_SCOPE_AGENT); }
    FinBuf A, B;
    int t = gw, kk = 0;
    if (t < NTOK) fin_load(hbuf, yrows, slots, 0, t, lane, A);
    for (; t < NTOK; t += 2 * NGW, kk += 2) {
        const int t2 = t + NGW;
        if (t2 < NTOK) fin_load(hbuf, yrows, slots, kk + 1, t2, lane, B);
        fin_compute(obuf, fw, t, lane, A);
        if (t2 < NTOK) {
            const int t3 = t2 + NGW;
            if (t3 < NTOK) fin_load(hbuf, yrows, slots, kk + 2, t3, lane, A);
            fin_compute(obuf, fw, t2, lane, B);
        }
    }
}

#ifndef OUTPROJ_FP8
#define OUTPROJ_FP8 0
#endif
constexpr int CT = 16;
constexpr int CONV_RED_OFF = LDSCTL_OFF + 4096;
__device__ __forceinline__ void conv_load_rows(const __amdgpu_buffer_rsrc_t urs, int t0, int tid, unsigned (&R)[CT + 30]) {
    const int s0 = t0 & (SEQ - 1);
#pragma unroll
    for (int r = 0; r < CT + 30; ++r) {
        const int sp = s0 - 30 + r;
        R[r] = (sp >= 0) ? (unsigned)__builtin_amdgcn_raw_buffer_load_b32(urs, tid * 4, (t0 - 30 + r) * 2048, 0) : 0u;
    }
}
__device__ __forceinline__ void phase_conv31(const MegaArgs& a, LAS unsigned char* lds, int tid, int lane, int wave, int G) {
    unsigned char* ws = a.ws;
    const __amdgpu_buffer_rsrc_t urs = __builtin_amdgcn_make_buffer_rsrc((void*)(ws + WS_U), 0, NTOK * 2048, 0x00020000);
    const float* cw = a.in[14]; const float* cb = a.in[15]; const float* nw = a.in[16]; const float* nb = a.in[17];
#if OUTPROJ_FP8
    unsigned short* ymix = (unsigned short*)(ws + WS_YMIX);
#else
    unsigned* ymix = (unsigned*)(ws + WS_YMIX);
#endif
    LAS float* wl = (LAS float*)lds;
    LAS float* red = (LAS float*)(lds + CONV_RED_OFF);
    LAS float* stat = red + 32 * 32;
    for (int i = tid; i < 31 * 256; i += NWAVES * 64) *(LAS f32x4*)(wl + 4 * i) = *(const f32x4*)(cw + 4 * i);
    const f32x2 bias = *(const f32x2*)(cb + 2 * tid);
    const f32x2 gw2 = *(const f32x2*)(nw + 2 * tid);
    const f32x2 gb2 = *(const f32x2*)(nb + 2 * tid);
    __syncthreads();
    unsigned R[CT + 30];
    int it = blockIdx.x;
    if (it < NTOK / CT) conv_load_rows(urs, it * CT, tid, R);
    for (; it < NTOK / CT; it += G) {
        const int t0 = it * CT;
        f32x2 uf[CT + 30];
#pragma unroll
        for (int r = 0; r < CT + 30; ++r) { uf[r].x = __uint_as_float(R[r] << 16); uf[r].y = __uint_as_float(R[r] & 0xFFFF0000u); }
        if (it + G < NTOK / CT) conv_load_rows(urs, (it + G) * CT, tid, R);
        f32x2 acc[CT];
#pragma unroll
        for (int t = 0; t < CT; ++t) acc[t] = bias;
#pragma unroll
        for (int k = 0; k < 31; ++k) {
            const f32x2 w = *(const LAS f32x2*)(wl + k * 1024 + 2 * tid);
#pragma unroll
            for (int t = 0; t < CT; ++t) acc[t] = __builtin_elementwise_fma(w, uf[t + k], acc[t]);
        }
        float acc0[CT], acc1[CT];
#pragma unroll
        for (int t = 0; t < CT; ++t) { acc0[t] = acc[t].x; acc1[t] = acc[t].y; }
        float sm[CT], sq[CT];
#pragma unroll
        for (int t = 0; t < CT; ++t) { sm[t] = acc0[t] + acc1[t]; sq[t] = acc0[t] * acc0[t] + acc1[t] * acc1[t]; }
#pragma unroll
        for (int t = 0; t < CT; ++t) {
            sm[t] += dpp_mov_f<0xB1>(sm[t]); sm[t] += dpp_mov_f<0x4E>(sm[t]); sm[t] += dpp_mov_f<0x124>(sm[t]); sm[t] += dpp_mov_f<0x128>(sm[t]);
            sq[t] += dpp_mov_f<0xB1>(sq[t]); sq[t] += dpp_mov_f<0x4E>(sq[t]); sq[t] += dpp_mov_f<0x124>(sq[t]); sq[t] += dpp_mov_f<0x128>(sq[t]);
        }
        __syncthreads();
        if ((lane & 15) == 0) {
            const int pr = wave * 4 + (lane >> 4);
#pragma unroll
            for (int t = 0; t < CT; ++t) { red[pr * 32 + t] = sm[t]; red[pr * 32 + CT + t] = sq[t]; }
        }
        __syncthreads();
        if (wave == 0 && lane < 32) {
            float s2 = 0.f;
#pragma unroll
            for (int p2 = 0; p2 < 32; ++p2) s2 += red[p2 * 32 + lane];
            const float other = __shfl_xor(s2, 16);
            if (lane < 16) {
                const float mean = s2 * (1.0f / DM);
                const float var = fmaxf(other * (1.0f / DM) - mean * mean, 0.f);
                stat[2 * lane] = mean; stat[2 * lane + 1] = rsqrtf(var + EPSV);
            }
        }
        __syncthreads();
#pragma unroll
        for (int t = 0; t < CT; ++t) {
            const f32x2 ms = *(const LAS f32x2*)(stat + 2 * t);
            const float y0 = siluf_((acc0[t] - ms.x) * ms.y * gw2.x + gb2.x);
            const float y1 = siluf_((acc1[t] - ms.x) * ms.y * gw2.y + gb2.y);
#if OUTPROJ_FP8
            ymix[(size_t)(t0 + t) * 1024 + 512 + tid] = (unsigned short)__builtin_amdgcn_cvt_pk_fp8_f32(y0, y1, 0, false);
#else
            ymix[(size_t)(t0 + t) * 1024 + 512 + tid] = pk2(y0, y1);
#endif
        }
    }
    __syncthreads();
}

struct YmBuf { u32x2 X[4][4]; u32x2 H[4]; u32x2 Z[4]; };
__device__ __forceinline__ void ym_load(const bf16_t* xm, const bf16_t* hm, const bf16_t* szb, int t, int lane, YmBuf& B) {
    const int s = t & (SEQ - 1);
#pragma unroll
    for (int j = 0; j < 4; ++j) {
        const int ch = 4 * lane + 256 * j;
#pragma unroll
        for (int kk = 0; kk < 4; ++kk) B.X[j][kk] = (s - 3 + kk >= 0) ? *(const u32x2*)(xm + (size_t)(t - 3 + kk) * DM + ch) : (u32x2){0u, 0u};
        B.H[j] = *(const u32x2*)(hm + (size_t)t * DM + ch);
        B.Z[j] = *(const u32x2*)(szb + (size_t)t * DM + ch);
    }
}
__device__ __forceinline__ void ym_compute(const LAS float* wts, unsigned char* ymix, int t, int lane, const YmBuf& B) {
#pragma unroll
    for (int j = 0; j < 4; ++j) {
        const int ch = 4 * lane + 256 * j;
        f32x4 xc = *(const LAS f32x4*)(wts + 4 * 1024 + ch);
#pragma unroll
        for (int kk = 0; kk < 4; ++kk) xc = xc + *(const LAS f32x4*)(wts + kk * 1024 + ch) * up4(B.X[j][kk]);
        xc.x = siluf_(xc.x); xc.y = siluf_(xc.y); xc.z = siluf_(xc.z); xc.w = siluf_(xc.w);
        const f32x4 hv = up4(B.H[j]);
        const float mean = wave_sum((hv.x + hv.y) + (hv.z + hv.w)) * (1.0f / 256.0f);
        const f32x4 d = hv - mean;
        const float var = wave_sum((d.x * d.x + d.y * d.y) + (d.z * d.z + d.w * d.w)) * (1.0f / 256.0f);
        const float rs = rsqrtf(var + EPSV);
        const f32x4 nwv = *(const LAS f32x4*)(wts + 5 * 1024 + ch), sk = *(const LAS f32x4*)(wts + 6 * 1024 + ch);
        const f32x4 y = (d * rs * nwv + sk * xc) * up4(B.Z[j]);
#if OUTPROJ_FP8
        *(unsigned*)(ymix + (size_t)t * 2048 + ch) = pk4_fp8(y.x, y.y, y.z, y.w);
#else
        { u32x2 o; o.x = pk2(y.x, y.y); o.y = pk2(y.z, y.w); *(u32x2*)((bf16_t*)ymix + (size_t)t * 2048 + ch) = o; }
#endif
        __builtin_amdgcn_sched_barrier(0);
    }
}
__device__ __forceinline__ void phase_ym(const MegaArgs& a, LAS unsigned char* lds, int tid, int gw, int NGW, int lane) {
    unsigned char* ws = a.ws;
    const bf16_t* xm = (const bf16_t*)(ws + WS_XM); const bf16_t* szb = (const bf16_t*)(ws + WS_SZ); const bf16_t* hm = (const bf16_t*)(ws + WS_R1);
    unsigned char* ymix = ws + WS_YMIX;
    LAS float* wts = (LAS float*)lds;
    for (int i = tid; i < 7 * 1024; i += NWAVES * 64) {
        const int r = i >> 10, c = i & 1023;
        wts[i] = (r < 4) ? a.in[3][r * DM + c] : (r == 4 ? a.in[4][c] : (r == 5 ? a.in[12][c] : a.in[13][c]));
    }
    __syncthreads();
    YmBuf A, B;
    int t = gw;
    if (t < NTOK) ym_load(xm, hm, szb, t, lane, A);
    for (; t < NTOK; t += 2 * NGW) {
        const int t2 = t + NGW;
        if (t2 < NTOK) ym_load(xm, hm, szb, t2, lane, B);
        ym_compute(wts, ymix, t, lane, A);
        if (t2 < NTOK) {
            const int t3 = t2 + NGW;
            if (t3 < NTOK) ym_load(xm, hm, szb, t3, lane, A);
            ym_compute(wts, ymix, t2, lane, B);
        }
    }
    __syncthreads();
}

struct EpiOutProj {
    const float* x; bf16_t* hb; unsigned char* hq;
    __device__ __forceinline__ void operator()(const f32x4 (&acc)[2][2][4][2], const pg8::Unit& un, int wr, int wc, int fr, int fq) const {
        const int row0 = un.pm * 256 + wr * 64 + fr;
        const int c0 = un.pn * 256 + wc * 32 + 8 * fq;
#pragma unroll
        for (int ai = 0; ai < 2; ++ai)
#pragma unroll
            for (int mp = 0; mp < 2; ++mp) {
                f32x4 xv[2][2][2];
#pragma unroll
                for (int mm = 0; mm < 2; ++mm)
#pragma unroll
                    for (int bj = 0; bj < 2; ++bj) {
                        const float* xp = x + (size_t)(row0 + ai * 128 + (2 * mp + mm) * 16) * DM + c0 + bj * 128;
                        xv[mm][bj][0] = *(const f32x4*)xp; xv[mm][bj][1] = *(const f32x4*)(xp + 4);
                    }
#pragma unroll
                for (int mm = 0; mm < 2; ++mm) {
                    const int m = 2 * mp + mm;
                    const size_t off = (size_t)(row0 + ai * 128 + m * 16) * DM + c0;
#pragma unroll
                    for (int bj = 0; bj < 2; ++bj) {
                        const f32x4 v0 = acc[ai][bj][m][0] + xv[mm][bj][0], v1 = acc[ai][bj][m][1] + xv[mm][bj][1];
                        u32x4 wb; wb.x = pg8::cvt_pk_bf16(v0[0], v0[1]); wb.y = pg8::cvt_pk_bf16(v0[2], v0[3]); wb.z = pg8::cvt_pk_bf16(v1[0], v1[1]); wb.w = pg8::cvt_pk_bf16(v1[2], v1[3]);
                        *(u32x4*)(hb + off + bj * 128) = wb;
                        u32x2 w; w.x = pk4_fp8(v0[0], v0[1], v0[2], v0[3]); w.y = pk4_fp8(v1[0], v1[1], v1[2], v1[3]);
                        *(u32x2*)(hq + off + bj * 128) = w;
                    }
                }
            }
    }
};


constexpr size_t WS_GCT = WS_SMALL + 512 * 1024;
constexpr size_t WS_GVT = WS_GCT + 32 * 1024;
constexpr size_t WS_FCUM = WS_SMALL + 3 * MiB;
constexpr size_t WS_UVAL = WS_SMALL + 4 * MiB;
constexpr size_t WS_MVAL = WS_SMALL + 7 * MiB;
constexpr size_t WS_ITEMS = WS_SMALL + 8 * MiB;
constexpr size_t WS_DN = WS_SMALL + 9 * MiB;
constexpr size_t WS_NPREV = WS_SMALL + 10 * MiB;
constexpr size_t WS_QB = 477 * MiB;
constexpr size_t WS_KB = 541 * MiB;
constexpr size_t WS_AEXT = 605 * MiB;
constexpr size_t WS_BEXT = 733 * MiB;
constexpr size_t WS_DCT = 861 * MiB;
constexpr size_t WS_KWT = WS_R1;
constexpr size_t WS_HM = WS_R1;
constexpr int RINV_OFF = LDSCTL_OFF + 1024;

__device__ __forceinline__ void p0_gate_tables(const MegaArgs& a, int gw, int NGW, int lane) {
    const float* wq = a.in[5]; const float* wk = a.in[6]; const float* wv = a.in[7]; const float* wig = a.in[8]; const float* wfg = a.in[10];
    bf16_t* gct = (bf16_t*)(a.ws + WS_GCT);
    for (int idx = gw * 64 + lane; idx < 2 * 16 * 1024; idx += NGW * 64) {
        const int tbl = idx >> 14, col = (idx >> 10) & 15, ch = idx & 1023;
        float v = 0.f;
        if (col < 8) {
            const float* Wg = (col < 4) ? wig : wfg; const int hh = col & 3, n = ch >> 2, i = ch & 3;
#pragma unroll
            for (int o = 0; o < 4; ++o) {
                if (tbl == 0) v += wq[n * 16 + i * 4 + o] * Wg[(size_t)(4 * n + o) * 4 + hh] + wk[n * 16 + i * 4 + o] * Wg[(size_t)(1024 + 4 * n + o) * 4 + hh];
                else v += wv[n * 16 + i * 4 + o] * Wg[(size_t)(2048 + 4 * n + o) * 4 + hh];
            }
        }
        gct[idx] = f2bf(v);
    }
}

struct GateGrp { u32x4 row[4][4]; };
__device__ __forceinline__ void gate_load_grp(const bf16_t* xm, int t, int s, int chb, GateGrp& B) {
#pragma unroll
    for (int q = 0; q < 4; ++q)
#pragma unroll
        for (int kk = 0; kk < 4; ++kk) B.row[q][kk] = (s - 3 + kk >= 0) ? *(const u32x4*)(xm + (size_t)(t - 3 + kk) * DM + chb + 32 * q) : (u32x4){0u, 0u, 0u, 0u};
}
__device__ __forceinline__ f32x4 gate_step(const LAS float* cwl, const LAS bf16_t* gtl, int tok, int ch0, const u32x4 (&row)[4], f32x4 acc) {
    float xc[8];
    {
        const f32x4 b0 = *(const LAS f32x4*)(cwl + 4 * 1024 + ch0), b1 = *(const LAS f32x4*)(cwl + 4 * 1024 + ch0 + 4);
        xc[0] = b0.x; xc[1] = b0.y; xc[2] = b0.z; xc[3] = b0.w; xc[4] = b1.x; xc[5] = b1.y; xc[6] = b1.z; xc[7] = b1.w;
    }
#pragma unroll
    for (int kk = 0; kk < 4; ++kk) {
        float xf[8]; unpack8(row[kk], xf);
        const f32x4 w0 = *(const LAS f32x4*)(cwl + kk * 1024 + ch0), w1 = *(const LAS f32x4*)(cwl + kk * 1024 + ch0 + 4);
        xc[0] += w0.x * xf[0]; xc[1] += w0.y * xf[1]; xc[2] += w0.z * xf[2]; xc[3] += w0.w * xf[3];
        xc[4] += w1.x * xf[4]; xc[5] += w1.y * xf[5]; xc[6] += w1.z * xf[6]; xc[7] += w1.w * xf[7];
    }
#pragma unroll
    for (int i = 0; i < 8; ++i) xc[i] = siluf_(xc[i]);
    u32x4 a1; a1.x = pk2(xc[0], xc[1]); a1.y = pk2(xc[2], xc[3]); a1.z = pk2(xc[4], xc[5]); a1.w = pk2(xc[6], xc[7]);
    const u32x4 b1 = *(const LAS u32x4*)(gtl + tok * 1032 + ch0);
    const u32x4 b2 = *(const LAS u32x4*)(gtl + (16 + tok) * 1032 + ch0);
    acc = __builtin_amdgcn_mfma_f32_16x16x32_bf16(__builtin_bit_cast(bf16x8, a1), __builtin_bit_cast(bf16x8, b1), acc, 0, 0, 0);
    acc = __builtin_amdgcn_mfma_f32_16x16x32_bf16(__builtin_bit_cast(bf16x8, row[3]), __builtin_bit_cast(bf16x8, b2), acc, 0, 0, 0);
    return acc;
}
__device__ __forceinline__ void phase_gates(const MegaArgs& a, LAS unsigned char* lds, int tid, int gw, int NGW, int lane) {
    unsigned char* ws = a.ws;
    const bf16_t* xm = (const bf16_t*)(ws + WS_XM);
    const bf16_t* gct = (const bf16_t*)(ws + WS_GCT);
    const float* big = a.in[9]; const float* bfg = a.in[11];
    float* logi = (float*)(ws + WS_LOGI); float* logf = (float*)(ws + WS_LOGF);
    LAS float* cwl = (LAS float*)lds;
    LAS bf16_t* gtl = (LAS bf16_t*)(lds + 20480);
    for (int i = tid; i < 5 * 1024; i += NWAVES * 64) cwl[i] = (i < 4096) ? a.in[3][i] : a.in[4][i - 4096];
    for (int i = tid; i < 32 * 128; i += NWAVES * 64) { const int r = i >> 7, c8 = i & 127; *(LAS u32x4*)(gtl + r * 1032 + 8 * c8) = *(const u32x4*)(gct + (size_t)r * 1024 + 8 * c8); }
    __syncthreads();
    const int tok = lane & 15, kq = lane >> 4;
    for (int tile = gw; tile < NTOK / 16; tile += NGW) {
        const int t = tile * 16 + tok, s = t & (SEQ - 1);
        f32x4 acc = (f32x4){0.f, 0.f, 0.f, 0.f};
        GateGrp A, B;
        gate_load_grp(xm, t, s, 8 * kq, A);
        for (int g = 0; g < 8; g += 2) {
            gate_load_grp(xm, t, s, 128 * (g + 1) + 8 * kq, B);
#pragma unroll
            for (int q = 0; q < 4; ++q) acc = gate_step(cwl, gtl, tok, 128 * g + 32 * q + 8 * kq, A.row[q], acc);
            if (g + 2 < 8) gate_load_grp(xm, t, s, 128 * (g + 2) + 8 * kq, A);
#pragma unroll
            for (int q = 0; q < 4; ++q) acc = gate_step(cwl, gtl, tok, 128 * (g + 1) + 32 * q + 8 * kq, B.row[q], acc);
        }
        const int col = lane & 15;
        if (col < 8) {
            const int hh = col & 3;
#pragma unroll
            for (int r = 0; r < 4; ++r) {
                const int tt = tile * 16 + 4 * kq + r;
                if (col < 4) logi[(size_t)hh * NTOK + tt] = acc[r] + big[hh];
                else logf[(size_t)hh * NTOK + tt] = logsigmoidf_(acc[r] + bfg[hh]);
            }
        }
    }
    __syncthreads();
}

__device__ __forceinline__ void phase_prep(const MegaArgs& a, LAS unsigned char* lds, int tid, int lane, int wave, int G) {
    unsigned char* ws = a.ws;
    const float* logi = (const float*)(ws + WS_LOGI); const float* logf = (const float*)(ws + WS_LOGF);
    float* Fcum = (float*)(ws + WS_FCUM); float* Uval = (float*)(ws + WS_UVAL); float* Mval = (float*)(ws + WS_MVAL);
    float* items = (float*)(ws + WS_ITEMS); float* dn = (float*)(ws + WS_DN);
    const bf16_t* xm = (const bf16_t*)(ws + WS_XM);
    bf16_t* qb = (bf16_t*)(ws + WS_QB); bf16_t* kb = (bf16_t*)(ws + WS_KB); bf16_t* aext = (bf16_t*)(ws + WS_AEXT); bf16_t* bext = (bf16_t*)(ws + WS_BEXT); bf16_t* kwt = (bf16_t*)(ws + WS_KWT);
    const float* cw = a.in[3]; const float* cb = a.in[4]; const float* wq = a.in[5]; const float* wk = a.in[6]; const float* wv = a.in[7];
    LAS float* gch = (LAS float*)lds;
    LAS float* umaxch = gch + 32;
    LAS float* wint_l = umaxch + 32;
    LAS float* wst_l = wint_l + 256;
    LAS float* dn_l = wst_l + 256;
    LAS float* wtl = dn_l + 8 * 256;
    for (int it = blockIdx.x; it < 512; it += G) {
        const int bh = it >> 5, c = it & 31, b = bh >> 2, h = bh & 3;
        const int tb = b * SEQ, t0 = tb + c * 256;
        {
            const int cc = tid >> 4, sub = tid & 15;
            const size_t gbase = (size_t)h * NTOK + tb + cc * 256 + 16 * sub;
            float F[16], u[16];
            {
                const f32x4* lfp = (const f32x4*)(logf + gbase); const f32x4* lip = (const f32x4*)(logi + gbase);
#pragma unroll
                for (int q4 = 0; q4 < 4; ++q4) { const f32x4 v = lfp[q4], w = lip[q4]; F[4 * q4] = v.x; F[4 * q4 + 1] = v.y; F[4 * q4 + 2] = v.z; F[4 * q4 + 3] = v.w; u[4 * q4] = w.x; u[4 * q4 + 1] = w.y; u[4 * q4 + 2] = w.z; u[4 * q4 + 3] = w.w; }
            }
#pragma unroll
            for (int jj = 1; jj < 16; ++jj) F[jj] += F[jj - 1];
            const float total = F[15];
            float incl = total;
#pragma unroll
            for (int o = 1; o < 16; o <<= 1) { const float v = __shfl_up(incl, o, 16); if (sub >= o) incl += v; }
            const float excl = incl - total;
            float um = -3.0e38f;
#pragma unroll
            for (int jj = 0; jj < 16; ++jj) { F[jj] += excl; u[jj] -= F[jj]; um = fmaxf(um, u[jj]); }
            float umx = um;
#pragma unroll
            for (int o = 1; o < 16; o <<= 1) umx = fmaxf(umx, __shfl_xor(umx, o, 16));
            const float gsum = __shfl(incl, 15, 16);
            if (sub == 0) { gch[cc] = gsum; umaxch[cc] = umx; }
            float cm[16]; cm[0] = u[0];
#pragma unroll
            for (int jj = 1; jj < 16; ++jj) cm[jj] = fmaxf(cm[jj - 1], u[jj]);
            float inclm = cm[15];
#pragma unroll
            for (int o = 1; o < 16; o <<= 1) { const float v = __shfl_up(inclm, o, 16); if (sub >= o) inclm = fmaxf(inclm, v); }
            float exclm = __shfl_up(inclm, 1, 16); if (sub == 0) exclm = -3.0e38f;
            __syncthreads();
            float m = 0.f;
            for (int c2 = 0; c2 < c; ++c2) m = gch[c2] + fmaxf(m, umaxch[c2]);
            const float mprev = m, g_c = gch[c], umax_c = umaxch[c], m_c = g_c + fmaxf(mprev, umax_c);
            if (tid == 0) { items[it] = __expf(g_c + mprev - m_c); items[512 + it] = __expf(g_c + umax_c - m_c); items[1024 + it] = mprev; }
            if (cc == c) {
#pragma unroll
                for (int jj = 0; jj < 16; ++jj) {
                    const float M = fmaxf(mprev, fmaxf(cm[jj], exclm));
                    Fcum[gbase + jj] = F[jj]; Uval[gbase + jj] = u[jj]; Mval[gbase + jj] = M;
                    wint_l[16 * sub + jj] = __expf(mprev - M); wst_l[16 * sub + jj] = __expf(u[jj] - umax_c);
                }
            }
            __syncthreads();
        }
        {
            const int ch = h * 256 + 4 * lane;
            float cwv[4][4];
            const f32x4 cbv = *(const f32x4*)(cb + ch);
#pragma unroll
            for (int kk = 0; kk < 4; ++kk) { const f32x4 w = *(const f32x4*)(cw + kk * DM + ch); cwv[kk][0] = w.x; cwv[kk][1] = w.y; cwv[kk][2] = w.z; cwv[kk][3] = w.w; }
            for (int i = tid; i < 768; i += NWAVES * 64) {
                const int mat = i >> 8, q4 = (i >> 6) & 3, ln = i & 63;
                const float* src = (mat == 0 ? wq : (mat == 1 ? wk : wv)) + (h * 64 + ln) * 16 + 4 * q4;
                *(LAS f32x4*)(wtl + 4 * i) = *(const f32x4*)src;
            }
            __syncthreads();
            const __amdgpu_buffer_rsrc_t xrs = __builtin_amdgcn_make_buffer_rsrc((void*)xm, 0, NTOK * 2048, 0x00020000);
            LAS unsigned* tile_v = (LAS unsigned*)(lds + 24576);
            LAS unsigned* tile_k = tile_v + 64 * 129;
            u32x2 cur[11], nx[11];
#define PREP_LOAD(R, p_) do { _Pragma("unroll") for (int r = 0; r < 11; ++r) { const int sp = c * 256 + 64 * (p_) + 8 * wave - 3 + r; \
                R[r] = (sp >= 0) ? (u32x2)__builtin_amdgcn_raw_buffer_load_b64(xrs, ch * 2, (t0 + 64 * (p_) + 8 * wave - 3 + r) * 2048, 0) : (u32x2){0u, 0u}; } } while (0)
            PREP_LOAD(cur, 0);
            float dnacc[4] = {0.f, 0.f, 0.f, 0.f};
#pragma unroll 1
            for (int pb = 0; pb < 4; ++pb) {
                if (pb < 3) PREP_LOAD(nx, pb + 1);
#pragma unroll
                for (int pp = 0; pp < 8; ++pp) {
                    const int i = 64 * pb + 8 * wave + pp;
                    const f32x4 x0v = up4(cur[pp]), x1v = up4(cur[pp + 1]), x2v = up4(cur[pp + 2]), x3v = up4(cur[pp + 3]);
                    float x3[4]; x3[0] = x3v.x; x3[1] = x3v.y; x3[2] = x3v.z; x3[3] = x3v.w;
                    float xc[4];
#pragma unroll
                    for (int cc = 0; cc < 4; ++cc) xc[cc] = siluf_(cbv[cc] + cwv[0][cc] * x0v[cc] + cwv[1][cc] * x1v[cc] + cwv[2][cc] * x2v[cc] + cwv[3][cc] * x3v[cc]);
                    float qv[4], kv[4], vv[4];
                    {
                        f32x4 qa = (f32x4){0.f, 0.f, 0.f, 0.f}, ka = qa, va = qa;
#pragma unroll
                        for (int q4 = 0; q4 < 4; ++q4) {
                            qa = qa + *(const LAS f32x4*)(wtl + ((0 * 4 + q4) * 64 + lane) * 4) * xc[q4];
                            ka = ka + *(const LAS f32x4*)(wtl + ((1 * 4 + q4) * 64 + lane) * 4) * xc[q4];
                            va = va + *(const LAS f32x4*)(wtl + ((2 * 4 + q4) * 64 + lane) * 4) * x3[q4];
                        }
#pragma unroll
                        for (int o = 0; o < 4; ++o) { qv[o] = qa[o] * 0.0625f; kv[o] = ka[o]; vv[o] = va[o]; }
                    }
                    const float wi = wint_l[i], wsj = wst_l[i];
                    u32x2 o2;
                    o2.x = pk2(qv[0], qv[1]); o2.y = pk2(qv[2], qv[3]);
                    *(u32x2*)(qb + (size_t)(t0 + i) * DM + ch) = o2;
                    o2.x = pk2(kv[0], kv[1]); o2.y = pk2(kv[2], kv[3]);
                    *(u32x2*)(kb + (size_t)(t0 + i) * DM + ch) = o2;
                    o2.x = pk2(qv[0] * wi, qv[1] * wi); o2.y = pk2(qv[2] * wi, qv[3] * wi);
                    *(u32x2*)(aext + ((size_t)it * 256 + i) * 512 + 256 + 4 * lane) = o2;
                    float kwv[4];
#pragma unroll
                    for (int o = 0; o < 4; ++o) { kwv[o] = kv[o] * wsj; dnacc[o] += kwv[o]; }
                    const int tr = (8 * wave + pp) * 129 + 2 * lane;
                    tile_v[tr] = pk2(vv[0], vv[1]); tile_v[tr + 1] = pk2(vv[2], vv[3]);
                    tile_k[tr] = pk2(kwv[0], kwv[1]); tile_k[tr + 1] = pk2(kwv[2], kwv[3]);
                }
                __syncthreads();
#pragma unroll
                for (int kq = 0; kq < 4; ++kq) {
                    const int pid = tid + 512 * kq, chr = pid >> 3, jg = pid & 7;
                    const LAS unsigned short* tv = (const LAS unsigned short*)tile_v + (8 * jg) * 258 + chr;
                    const LAS unsigned short* tk = (const LAS unsigned short*)tile_k + (8 * jg) * 258 + chr;
                    u32x4 ov, ok;
                    ov.x = (unsigned)tv[0 * 258] | ((unsigned)tv[1 * 258] << 16); ov.y = (unsigned)tv[2 * 258] | ((unsigned)tv[3 * 258] << 16);
                    ov.z = (unsigned)tv[4 * 258] | ((unsigned)tv[5 * 258] << 16); ov.w = (unsigned)tv[6 * 258] | ((unsigned)tv[7 * 258] << 16);
                    ok.x = (unsigned)tk[0 * 258] | ((unsigned)tk[1 * 258] << 16); ok.y = (unsigned)tk[2 * 258] | ((unsigned)tk[3 * 258] << 16);
                    ok.z = (unsigned)tk[4 * 258] | ((unsigned)tk[5 * 258] << 16); ok.w = (unsigned)tk[6 * 258] | ((unsigned)tk[7 * 258] << 16);
                    *(u32x4*)(bext + ((size_t)it * 256 + chr) * 512 + 64 * pb + 8 * jg) = ov;
                    *(u32x4*)(kwt + ((size_t)it * 256 + chr) * 256 + 64 * pb + 8 * jg) = ok;
                }
                __syncthreads();
#pragma unroll
                for (int r = 0; r < 11; ++r) cur[r] = nx[r];
            }
#undef PREP_LOAD
#pragma unroll
            for (int o = 0; o < 4; ++o) dn_l[wave * 256 + 4 * lane + o] = dnacc[o];
            __syncthreads();
            if (tid < 256) {
                float s = 0.f;
#pragma unroll
                for (int w = 0; w < 8; ++w) s += dn_l[w * 256 + tid];
                dn[(size_t)it * 256 + tid] = s;
            }
            __syncthreads();
        }
    }
}

__device__ __forceinline__ void tr_subtile(const bf16_t* src, int lds_src, bf16_t* dst, int lds_dst, LAS unsigned short* tile, int lane) {
    const int rr = lane >> 3, pc = lane & 7;
    u32x4 v[8];
#pragma unroll
    for (int s2 = 0; s2 < 8; ++s2) v[s2] = *(const u32x4*)(src + (size_t)(rr + 8 * s2) * lds_src + 8 * pc);
#pragma unroll
    for (int s2 = 0; s2 < 8; ++s2) {
        LAS unsigned* tp = (LAS unsigned*)(tile + (rr + 8 * s2) * 66 + 8 * pc);
        tp[0] = v[s2].x; tp[1] = v[s2].y; tp[2] = v[s2].z; tp[3] = v[s2].w;
    }
    asm volatile("s_waitcnt lgkmcnt(0)" ::: "memory");
#pragma unroll
    for (int s2 = 0; s2 < 8; ++s2) {
        const int c = rr + 8 * s2;
        const LAS unsigned short* tp = tile + (8 * pc) * 66 + c;
        u32x4 o;
        o.x = (unsigned)tp[0 * 66] | ((unsigned)tp[1 * 66] << 16); o.y = (unsigned)tp[2 * 66] | ((unsigned)tp[3 * 66] << 16);
        o.z = (unsigned)tp[4 * 66] | ((unsigned)tp[5 * 66] << 16); o.w = (unsigned)tp[6 * 66] | ((unsigned)tp[7 * 66] << 16);
        *(u32x4*)(dst + (size_t)c * lds_dst + 8 * pc) = o;
    }
    asm volatile("s_waitcnt lgkmcnt(0)" ::: "memory");
}
__device__ __forceinline__ void phase_transposes(const MegaArgs& a, LAS unsigned char* lds, int wave, int lane, int G) {
    unsigned char* ws = a.ws;
    bf16_t* aext = (bf16_t*)(ws + WS_AEXT); bf16_t* bext = (bf16_t*)(ws + WS_BEXT); bf16_t* kwt = (bf16_t*)(ws + WS_KWT);
    LAS unsigned short* tile = (LAS unsigned short*)(lds + wave * 16384);
    for (int it = blockIdx.x; it < 512; it += G) {
        for (int job = wave; job < 32; job += NWAVES) {
            const int arr = job >> 4, sj = (job >> 2) & 3, sc = job & 3;
            if (arr == 0) tr_subtile(bext + ((size_t)it * 256 + 64 * sj) * 512 + 256 + 64 * sc, 512, bext + ((size_t)it * 256 + 64 * sc) * 512 + 64 * sj, 512, tile, lane);
            else          tr_subtile(aext + ((size_t)it * 256 + 64 * sj) * 512 + 64 * sc, 512, kwt + ((size_t)it * 256 + 64 * sc) * 256 + 64 * sj, 256, tile, lane);
        }
    }
    asm volatile("s_waitcnt vmcnt(0)" ::: "memory");
    __syncthreads();
}

struct ItemOrder {
    const char* A; const char* B; size_t a_item_bytes, b_item_bytes; int per_token; int G, c;
    __device__ __forceinline__ bool next(int i, pg8::Unit& u) const {
        const int it = i * G + c; if (it >= 512) return false;
        u.pm = it; u.pn = 0; u.aux = i; u.gidx = nullptr; u.gl = 0;
        if (per_token) { const int bh = it >> 5, cc = it & 31, b = bh >> 2, h = bh & 3; const size_t off = ((size_t)(b * SEQ + cc * 256) * DM + h * 256) * 2; u.A = A + off; u.B = B + off; }
        else { u.A = A + (size_t)it * a_item_bytes; u.B = B + (size_t)it * b_item_bytes; }
        return true;
    }
};
struct EpiP {
    const float* Uval; const float* Mval; bf16_t* aext;
    __device__ __forceinline__ void operator()(const f32x4 (&acc)[2][2][4][2], const pg8::Unit& un, int wr, int wc, int fr, int fq) const {
        const int it = un.pm, bh = it >> 5, cc = it & 31, b = bh >> 2, h = bh & 3;
        const size_t gb = (size_t)h * NTOK + b * SEQ + cc * 256;
        const int jb = wc * 32 + 8 * fq;
        float Mv[2][4];
#pragma unroll
        for (int ai = 0; ai < 2; ++ai)
#pragma unroll
            for (int m = 0; m < 4; ++m) Mv[ai][m] = Mval[gb + ai * 128 + wr * 64 + m * 16 + fr];
#pragma unroll
        for (int bj = 0; bj < 2; ++bj) {
            f32x4 uj[2];
#pragma unroll
            for (int n = 0; n < 2; ++n) uj[n] = *(const f32x4*)(Uval + gb + bj * 128 + jb + 4 * n);
#pragma unroll
            for (int ai = 0; ai < 2; ++ai)
#pragma unroll
                for (int m = 0; m < 4; ++m) {
                    const int i = ai * 128 + wr * 64 + m * 16 + fr;
                    const float Mi = Mv[ai][m];
                    f32x4 o[2];
#pragma unroll
                    for (int n = 0; n < 2; ++n)
#pragma unroll
                        for (int jj = 0; jj < 4; ++jj) {
                            const int j = bj * 128 + jb + 4 * n + jj;
                            o[n][jj] = (j <= i) ? acc[ai][bj][m][n][jj] * __expf(uj[n][jj] - Mi) : 0.f;
                        }
                    u32x4 w; w.x = pg8::cvt_pk_bf16(o[0][0], o[0][1]); w.y = pg8::cvt_pk_bf16(o[0][2], o[0][3]); w.z = pg8::cvt_pk_bf16(o[1][0], o[1][1]); w.w = pg8::cvt_pk_bf16(o[1][2], o[1][3]);
                    *(u32x4*)(aext + ((size_t)it * 256 + i) * 512 + bj * 128 + jb) = w;
                    asm volatile("" ::: "memory");
                }
        }
    }
};
struct EpiDC {
    bf16_t* dct;
    __device__ __forceinline__ void operator()(const f32x4 (&acc)[2][2][4][2], const pg8::Unit& un, int wr, int wc, int fr, int fq) const {
        const int it = un.pm; const int cb0 = wc * 32 + 8 * fq;
#pragma unroll
        for (int ai = 0; ai < 2; ++ai)
#pragma unroll
            for (int m = 0; m < 4; ++m) {
                const int r = ai * 128 + wr * 64 + m * 16 + fr;
#pragma unroll
                for (int bj = 0; bj < 2; ++bj) {
                    const f32x4 v0 = acc[ai][bj][m][0], v1 = acc[ai][bj][m][1];
                    u32x4 w; w.x = pg8::cvt_pk_bf16(v0[0], v0[1]); w.y = pg8::cvt_pk_bf16(v0[2], v0[3]); w.z = pg8::cvt_pk_bf16(v1[0], v1[1]); w.w = pg8::cvt_pk_bf16(v1[2], v1[3]);
                    *(u32x4*)(dct + ((size_t)it * 256 + r) * 256 + bj * 128 + cb0) = w;
                }
            }
    }
};
struct EpiO {
    LAS const float* rinv; bf16_t* hm;
    __device__ __forceinline__ void operator()(const f32x4 (&acc)[2][2][4][2], const pg8::Unit& un, int wr, int wc, int fr, int fq) const {
        const int it = un.pm, bh = it >> 5, cc = it & 31, b = bh >> 2, h = bh & 3;
        const size_t t0 = (size_t)b * SEQ + cc * 256; const int eb = wc * 32 + 8 * fq;
#pragma unroll
        for (int ai = 0; ai < 2; ++ai)
#pragma unroll
            for (int m = 0; m < 4; ++m) {
                const int i = ai * 128 + wr * 64 + m * 16 + fr;
                const float ri = rinv[un.aux * 256 + i];
#pragma unroll
                for (int bj = 0; bj < 2; ++bj) {
                    const f32x4 v0 = acc[ai][bj][m][0] * ri, v1 = acc[ai][bj][m][1] * ri;
                    u32x4 w; w.x = pg8::cvt_pk_bf16(v0[0], v0[1]); w.y = pg8::cvt_pk_bf16(v0[2], v0[3]); w.z = pg8::cvt_pk_bf16(v1[0], v1[1]); w.w = pg8::cvt_pk_bf16(v1[2], v1[3]);
                    *(u32x4*)(hm + (t0 + i) * DM + h * 256 + bj * 128 + eb) = w;
                }
            }
    }
};

__device__ __forceinline__ void phase_scan(const MegaArgs& a, int tid) {
    unsigned char* ws = a.ws;
    const float* items = (const float*)(ws + WS_ITEMS); const bf16_t* dct = (const bf16_t*)(ws + WS_DCT); bf16_t* bext = (bf16_t*)(ws + WS_BEXT);
    const float* dn = (const float*)(ws + WS_DN); float* nprev = (float*)(ws + WS_NPREV);
    int tid_o = tid; asm volatile("" : "+v"(tid_o));
    const int gid = blockIdx.x * (NWAVES * 64) + tid_o;
    if (gid < 16 * 256 * 32) {
        const int bh = gid >> 13, e = (gid >> 5) & 255, d8 = gid & 31;
        float st[8];
#pragma unroll
        for (int i = 0; i < 8; ++i) st[i] = 0.f;
        u32x4 rA[4], rB[4]; float decA[4], scA[4], decB[4], scB[4];
#define SCAN_LOAD(R, D, S, c0) do { _Pragma("unroll") for (int q = 0; q < 4; ++q) { const int it_ = bh * 32 + (c0) + q; R[q] = *(const u32x4*)(dct + ((size_t)it_ * 256 + e) * 256 + 8 * d8); D[q] = items[it_]; S[q] = items[512 + it_]; } } while (0)
#define SCAN_STEP(R, D, S, c0) do { _Pragma("unroll") for (int q = 0; q < 4; ++q) { const int it_ = bh * 32 + (c0) + q; \
            u32x4 w; w.x = pk2(st[0], st[1]); w.y = pk2(st[2], st[3]); w.z = pk2(st[4], st[5]); w.w = pk2(st[6], st[7]); \
            *(u32x4*)(bext + ((size_t)it_ * 256 + e) * 512 + 256 + 8 * d8) = w; \
            float dv[8]; unpack8(R[q], dv); \
            _Pragma("unroll") for (int i = 0; i < 8; ++i) st[i] = D[q] * st[i] + S[q] * dv[i]; } } while (0)
        SCAN_LOAD(rA, decA, scA, 0);
        for (int c0 = 0; c0 < 32; c0 += 8) {
            SCAN_LOAD(rB, decB, scB, c0 + 4);
            SCAN_STEP(rA, decA, scA, c0);
            if (c0 + 8 < 32) SCAN_LOAD(rA, decA, scA, c0 + 8);
            SCAN_STEP(rB, decB, scB, c0 + 4);
        }
#undef SCAN_LOAD
#undef SCAN_STEP
    }
    if (gid < 16 * 256) {
        const int bh = gid >> 8, d = gid & 255;
        float dnv[32], dcv[32], scv[32];
#pragma unroll
        for (int c = 0; c < 32; ++c) { const int it = bh * 32 + c; dnv[c] = dn[(size_t)it * 256 + d]; dcv[c] = items[it]; scv[c] = items[512 + it]; }
        float st = 0.f;
#pragma unroll
        for (int c = 0; c < 32; ++c) { const int it = bh * 32 + c; nprev[(size_t)it * 256 + d] = st; st = dcv[c] * st + scv[c] * dnv[c]; }
    }
}

__device__ __forceinline__ void g3_rinv(const MegaArgs& a, LAS unsigned char* lds, int wave, int lane, int G) {
    unsigned char* ws = a.ws;
    const bf16_t* aext = (const bf16_t*)(ws + WS_AEXT); const float* nprev = (const float*)(ws + WS_NPREV);
    const float* Fcum = (const float*)(ws + WS_FCUM); const float* Mval = (const float*)(ws + WS_MVAL);
    LAS float* rinv = (LAS float*)(lds + RINV_OFF);
    const int l16 = lane & 15, rsub = lane >> 4;
    for (int ui = 0; ui < 2; ++ui) {
        const int it = ui * G + blockIdx.x; if (it >= 512) break;
        const int bh = it >> 5, cc = it & 31, b = bh >> 2, h = bh & 3;
        f32x4 nv[2][2];
#pragma unroll
        for (int pz = 0; pz < 2; ++pz) { const f32x4* np = (const f32x4*)(nprev + (size_t)it * 256 + 8 * (l16 + 16 * pz)); nv[pz][0] = np[0]; nv[pz][1] = np[1]; }
        u32x4 pc[8][4];
#pragma unroll
        for (int ps = 0; ps < 8; ++ps) {
            const u32x4* rowp = (const u32x4*)(aext + ((size_t)it * 256 + 32 * ps + 4 * wave + rsub) * 512);
#pragma unroll
            for (int q = 0; q < 4; ++q) pc[ps][q] = rowp[l16 + 16 * q];
        }
#pragma unroll
        for (int ps = 0; ps < 8; ++ps) {
            float s = 0.f;
#pragma unroll
            for (int q = 0; q < 2; ++q) { float f[8]; unpack8(pc[ps][q], f); s += ((f[0] + f[1]) + (f[2] + f[3])) + ((f[4] + f[5]) + (f[6] + f[7])); }
#pragma unroll
            for (int q = 0; q < 2; ++q) { float f[8]; unpack8(pc[ps][2 + q], f); const f32x4 n0 = nv[q][0], n1 = nv[q][1];
                s += (f[0] * n0.x + f[1] * n0.y + f[2] * n0.z + f[3] * n0.w) + (f[4] * n1.x + f[5] * n1.y + f[6] * n1.z + f[7] * n1.w); }
            s += dpp_mov_f<0xB1>(s); s += dpp_mov_f<0x4E>(s); s += dpp_mov_f<0x124>(s); s += dpp_mov_f<0x128>(s);
            const int i = 32 * ps + 4 * wave + rsub;
            const size_t gi = (size_t)h * NTOK + b * SEQ + cc * 256 + i;
            if (l16 == 0) { const float mi = Fcum[gi] + Mval[gi]; rinv[ui * 256 + i] = 1.0f / fmaxf(fabsf(s), __expf(-mi)); }
        }
    }
    __syncthreads();
}

#ifndef NG1_SPLIT
#define NG1_SPLIT 256
#endif
#ifndef STAG1
#define STAG1 0
#endif
#ifndef STAG12
#define STAG12 0
#endif
__global__ void __launch_bounds__(NWAVES * 64, 2) mega_fwd(MegaArgs args) {
    extern __shared__ __attribute__((aligned(16))) unsigned char lds_raw[];
    LAS unsigned char* lds = (LAS unsigned char*)lds_raw;
    const int wave = __builtin_amdgcn_readfirstlane(threadIdx.x >> 6);
#define lane lane_id()
#define tid ((wave << 6) | lane_id())
    const int G = gridDim.x;
    const int gw = blockIdx.x * NWAVES + wave, NGW = G * NWAVES;
    unsigned char* ws = args.ws;
    unsigned* ctl = (unsigned*)(ws + WS_CTL);
    for (int u = tid; u < (LDS_BYTES - LDSCTL_OFF) / 4; u += NWAVES * 64) ((LAS unsigned*)(lds + LDSCTL_OFF))[u] = 0u;
    __syncthreads();
    XcdBarrier bar = xcd_barrier_post(ctl + CW_BAR + args.li * XCD_BAR_WORDS, (volatile LAS unsigned*)(lds + LDSCTL_OFF + 64), wave);
    const int lo = args.ph_lo, hi = args.ph_hi;
#define IN(k) (lo <= (k) && (k) < hi)
#define BOTH(k) (IN(k) && IN((k) + 1))

    if (IN(0)) { p0_prologue(args, lds, gw, NGW, wave, lane); if (NG1_SPLIT >= 256) p0b_weights(args, lds, gw, NGW, wave, lane);
        p0_gate_tables(args, gw, NGW, lane); p0_router_tables(args, gw, NGW, lane); if (BOTH(0)) xcd_barrier(bar); }

    if (IN(1)) {
        const int NG1 = NG1_SPLIT;
        if ((int)blockIdx.x < NG1) {
            pg8::DenseOrder S; S.init(ws + WS_R1, ws + WS_BTIN, NTOK, DPROJ, DM, DM, NG1, (int)blockIdx.x);
            EpiInProj E{(const float*)(ws + WS_RSTD1), (bf16_t*)(ws + WS_XM), (bf16_t*)(ws + WS_SZ), (bf16_t*)(ws + WS_U), args.pad};
            pg8::gemm_phase<EpiInProj, pg8::DenseOrder, false>(lds, wave, DM, DM, DM, S, E, 0x7F7F7F7F, 0x7F7F7F7F, STAG1);
        } else {
            p0b_weights(args, lds, ((int)blockIdx.x - NG1) * NWAVES + wave, (G - NG1) * NWAVES, wave, lane);
        }
        if (BOTH(1)) xcd_barrier(bar);
    }
    if (IN(2)) { phase_gates(args, lds, tid, gw, NGW, lane); if (BOTH(2)) xcd_barrier(bar); }
    if (IN(3)) { phase_prep(args, lds, tid, lane, wave, G); if (BOTH(3)) xcd_barrier(bar); }
    if (IN(4)) {
        {
            ItemOrder S; S.A = (const char*)(ws + WS_QB); S.B = (const char*)(ws + WS_KB); S.a_item_bytes = 0; S.b_item_bytes = 0; S.per_token = 1; S.G = G; S.c = (int)blockIdx.x;
            EpiP E{(const float*)(ws + WS_UVAL), (const float*)(ws + WS_MVAL), (bf16_t*)(ws + WS_AEXT)};
            pg8::gemm_phase<EpiP, ItemOrder, false>(lds, wave, 256, DM, DM, S, E);
        }
        {
            ItemOrder S; S.A = (const char*)(ws + WS_BEXT); S.B = (const char*)(ws + WS_KWT); S.a_item_bytes = (size_t)256 * 512 * 2; S.b_item_bytes = (size_t)256 * 256 * 2; S.per_token = 0; S.G = G; S.c = (int)blockIdx.x;
            EpiDC E{(bf16_t*)(ws + WS_DCT)};
            pg8::gemm_phase<EpiDC, ItemOrder, false>(lds, wave, 256, 512, 256, S, E);
        }
        if (BOTH(4)) xcd_barrier(bar);
    }
    if (IN(5)) {
        if ((blockIdx.x >> 3) & 1) { phase_conv31(args, lds, tid, lane, wave, G); phase_scan(args, tid); }
        else { phase_scan(args, tid); phase_conv31(args, lds, tid, lane, wave, G); }
        if (BOTH(5)) xcd_barrier(bar);
    }
    if (IN(6)) {
        g3_rinv(args, lds, wave, lane, G);
        ItemOrder S; S.A = (const char*)(ws + WS_AEXT); S.B = (const char*)(ws + WS_BEXT); S.a_item_bytes = (size_t)256 * 512 * 2; S.b_item_bytes = (size_t)256 * 512 * 2; S.per_token = 0; S.G = G; S.c = (int)blockIdx.x;
        EpiO E{(LAS const float*)(lds + RINV_OFF), (bf16_t*)(ws + WS_HM)};
        pg8::gemm_phase<EpiO, ItemOrder, false>(lds, wave, 512, 512, 512, S, E);
        if (BOTH(6)) xcd_barrier(bar);
    }
    if (IN(7)) { phase_ym(args, lds, tid, gw, NGW, lane); if (BOTH(7)) xcd_barrier(bar); }
    if (IN(8)) {
        EpiOutProj E{args.in[0], (bf16_t*)(ws + WS_HB16), ws + WS_HBF};
#if OUTPROJ_FP8
        pg8::DenseOrder S; S.init(ws + WS_YMIX, ws + WS_BTOUT, NTOK, DM, 1024, 1024, G, (int)blockIdx.x);
        pg8::gemm_phase<EpiOutProj, pg8::DenseOrder, false, true>(lds, wave, 1024, 1024, 1024, S, E, 0x7A7A7A7A, 0x7F7F7F7F);
#else
        pg8::DenseOrder S; S.init(ws + WS_YMIX, ws + WS_BTOUT, NTOK, DM, 2048, 2048, G, (int)blockIdx.x);
        pg8::gemm_phase<EpiOutProj, pg8::DenseOrder, false>(lds, wave, 2048, 2048, 2048, S, E);
#endif
        if (BOTH(8)) xcd_barrier(bar);
    }
    if (IN(9)) { phase_router(args, lds, tid, lane, wave); if (BOTH(9)) xcd_barrier(bar); }
    if (IN(10)) { phase_slots(args, lds, tid); if (BOTH(10)) xcd_barrier(bar); }
    if (IN(11)) {
        const int T = __builtin_amdgcn_readfirstlane(__hip_atomic_load((const int*)(ws + WS_TILEEXP) + 2048, __ATOMIC_RELAXED, __HIP_MEMORY_SCOPE_AGENT));
        MoeOrder S; S.A = (const char*)(ws + WS_HBF); S.Bt = (const char*)(ws + WS_BT1); S.gidx = (const int*)(ws + WS_STOK); S.tile_exp = (const int*)(ws + WS_TILEEXP);
        S.a_tile_bytes = 0; S.b_exp_bytes = (size_t)2048 * 1024; S.b_tile_bytes = (size_t)256 * 1024; S.T = T; S.nN = 8; S.group = 4; S.c = (int)blockIdx.x;
        EpiMoe1 E{(const float*)(ws + WS_SRSTD), args.in[23], ws + WS_ACT, args.pad};
        pg8::gemm_phase<EpiMoe1, MoeOrder, true, true>(lds, wave, DM / 2, DM / 2, DM / 2, S, E, 0x7A7A7A7A, 0x7F7F7F7F);
        if (BOTH(11)) xcd_barrier(bar);
    }
    if (IN(12)) {
        const int T = __builtin_amdgcn_readfirstlane(__hip_atomic_load((const int*)(ws + WS_TILEEXP) + 2048, __ATOMIC_RELAXED, __HIP_MEMORY_SCOPE_AGENT));
        MoeOrder S; S.A = (const char*)(ws + WS_ACT); S.Bt = (const char*)(ws + WS_BT2); S.gidx = nullptr; S.tile_exp = (const int*)(ws + WS_TILEEXP);
        S.a_tile_bytes = (size_t)256 * 1024; S.b_exp_bytes = (size_t)1024 * 1024; S.b_tile_bytes = (size_t)256 * 1024; S.T = T; S.nN = 4; S.group = 8; S.c = (int)blockIdx.x;
        EpiMoe2 E{(const float*)(ws + WS_SGATE), args.in[25], ws + WS_YROWS};
        pg8::gemm_phase<EpiMoe2, MoeOrder, false, true>(lds, wave, DM / 2, DM / 2, DM / 2, S, E, 0x7A7A7A7A, 0x7F7F7F7F, STAG12);
        if (BOTH(12)) xcd_barrier(bar);
    }
    if (IN(13)) { phase_final(args, gw, NGW, lane); }
#undef IN
#undef BOTH
#undef lane
#undef tid
}

static int g_grid = 0;
static bool mega_setup(size_t ws_size) {
    if (g_grid == 0) {
        int dev = 0, cus = 0, per_cu = 0;
        if (ws_size < WS_NEED) { g_grid = -1; return false; }
        if (hipGetDevice(&dev) != hipSuccess || hipDeviceGetAttribute(&cus, hipDeviceAttributeMultiprocessorCount, dev) != hipSuccess) { g_grid = -1; return false; }
        if (hipFuncSetAttribute((const void*)mega_fwd, hipFuncAttributeMaxDynamicSharedMemorySize, LDS_BYTES) != hipSuccess) { g_grid = -1; return false; }
        (void)hipOccupancyMaxActiveBlocksPerMultiprocessor(&per_cu, (const void*)mega_fwd, NWAVES * 64, LDS_BYTES);
        (void)hipGetLastError();
        if (cus < 256) { g_grid = -1; return false; }
        g_grid = 256;
    }
    return g_grid > 0;
}
static void mega_launch(const MegaArgs& base, int lo, int hi, int li, hipStream_t stream, int variant = 0) {
    MegaArgs a = base; a.ph_lo = lo; a.ph_hi = hi; a.li = li; a.pad = variant;
    hipLaunchKernelGGL(mega_fwd, dim3(g_grid), dim3(NWAVES * 64), LDS_BYTES, stream, a);
}

extern "C" void kernel_launch(void* const* d_in, const int* in_sizes, int n_in, void* d_out, int out_size, void* d_ws,
                              size_t ws_size, hipStream_t stream) {
    if (n_in != 27 || out_size != NTOK * DM) return;
    if (!mega_setup(ws_size)) return;
    unsigned char* ws = (unsigned char*)d_ws;
    (void)hipMemsetAsync(ws + WS_CTL, 0, CTL_ZERO_BYTES, stream);
    MegaArgs a{};
    for (int i = 0; i < 27; ++i) a.in[i] = (const float*)d_in[i];
    a.out = (float*)d_out; a.ws = ws;

#ifndef PROBE_K
    mega_launch(a, 0, 14, 0, stream);
#else
    mega_launch(a, 0, PROBE_K + 1, 0, stream);
#ifndef PROBE_V
#define PROBE_V 0
#endif
    mega_launch(a, PROBE_K, PROBE_K + 1, 1, stream, PROBE_V);
    if (PROBE_K + 1 < 14) mega_launch(a, PROBE_K + 1, 14, 2, stream);
#endif
}
```

```cpp
#include <hip/hip_runtime.h>
#include <stdint.h>

#define NTOK 32768
#define SEQ 8192
#define DM 1024
#define DPROJ 4096
#define NEXP 32
#define NASSIGN (NTOK * 4)
#define EPSV 1e-5f

typedef unsigned short bf16_t;

__device__ __forceinline__ float bf2f(bf16_t h) { return __uint_as_float(((uint32_t)h) << 16); }
__device__ __forceinline__ bf16_t f2bf(float f) {
    uint32_t u = __float_as_uint(f);
    u += 0x7FFFu + ((u >> 16) & 1u);
    return (bf16_t)(u >> 16);
}
__device__ __forceinline__ float sigmoidf_(float x) { return __builtin_amdgcn_rcpf(1.0f + __expf(-x)); }
__device__ __forceinline__ float siluf_(float x) { return x * sigmoidf_(x); }
__device__ __forceinline__ float logsigmoidf_(float x) { return fminf(x, 0.0f) - log1pf(__expf(-fabsf(x))); }

template <int CTRL> __device__ __forceinline__ float dpp_mov_f(float v) { return __builtin_bit_cast(float, __builtin_amdgcn_update_dpp(0, __builtin_bit_cast(int, v), CTRL, 0xf, 0xf, false)); }
__device__ __forceinline__ float wave_sum(float v) {
    v += dpp_mov_f<0xB1>(v); v += dpp_mov_f<0x4E>(v); v += dpp_mov_f<0x124>(v); v += dpp_mov_f<0x128>(v);
    v += __builtin_bit_cast(float, __builtin_amdgcn_ds_swizzle(__builtin_bit_cast(int, v), 0x401F));
    const auto rr = __builtin_amdgcn_permlane32_swap(__float_as_uint(v), __float_as_uint(v), false, false);
    return __uint_as_float(rr[0]) + __uint_as_float(rr[1]);
}
__device__ __forceinline__ float block_sum256(float v, float* red) {
    v = wave_sum(v);
    __syncthreads();
    if ((threadIdx.x & 63) == 0) red[threadIdx.x >> 6] = v;
    __syncthreads();
    return red[0] + red[1] + red[2] + red[3];
}


#define LAS __attribute__((address_space(3)))
#define GAS __attribute__((address_space(1)))
typedef short bf16x8 __attribute__((ext_vector_type(8)));
typedef float f32x4 __attribute__((ext_vector_type(4)));
typedef float f32x2 __attribute__((ext_vector_type(2)));
typedef unsigned u32x4 __attribute__((ext_vector_type(4)));
typedef unsigned u32x2 __attribute__((ext_vector_type(2)));

__device__ __forceinline__ int lane_id() { int l = (int)__builtin_amdgcn_mbcnt_hi(~0u, __builtin_amdgcn_mbcnt_lo(~0u, 0u)); asm volatile("" : "+v"(l)); return l; }
namespace pg8 {
__device__ __forceinline__ const char* uni_ptr(const char* p) { const unsigned long long v = (unsigned long long)p; const unsigned lo = __builtin_amdgcn_readfirstlane((unsigned)v), hi = __builtin_amdgcn_readfirstlane((unsigned)(v >> 32)); return (const char*)(((unsigned long long)hi << 32) | lo); }
typedef int i32x4 __attribute__((ext_vector_type(4)));
typedef int i32x8 __attribute__((ext_vector_type(8)));
__device__ __forceinline__ void mfma8_tied(f32x4& acc, const i32x8 a, const i32x8 b, const int sa, const int sb) {
    asm volatile("v_mfma_scale_f32_16x16x128_f8f6f4 %0, %1, %2, %0, %3, %4 op_sel_hi:[0,0,0]" : "+v"(acc) : "v"(a), "v"(b), "v"(sa), "v"(sb));
}
__device__ __forceinline__ i32x8 cat8(const bf16x8 lo, const bf16x8 hi) { return __builtin_shufflevector(__builtin_bit_cast(i32x4, lo), __builtin_bit_cast(i32x4, hi), 0, 1, 2, 3, 4, 5, 6, 7); }
constexpr int BM = 256, BK = 64, HALF = 128, HTB = HALF * BK * 2, STAGE_BYTES = 8 * HTB, NXCD = 8, WGM = 8;
__host__ __device__ __forceinline__ int lds_byte(int r, int c) { const int st = (r >> 4) * 2 + (c >> 5), rr = r & 15, cc = c & 31, ob = rr * 64 + cc * 2; return st * 1024 + (ob ^ (((ob >> 9) & 1) << 5)); }
__host__ __device__ __forceinline__ void stage_rc(int b, int& R, int& C) { const int st = b / 1024, sb = b % 1024, swz = sb ^ (((sb >> 9) & 1) << 5); R = (st >> 1) * 16 + swz / 64; C = (st & 1) * 32 + (swz % 64) / 2; }
__host__ __device__ __forceinline__ int perm32(int rho) { const int n = rho >> 4, i = rho & 15; return 8 * (i >> 2) + 4 * n + (i & 3); }
__device__ __forceinline__ unsigned cvt_pk_bf16(float lo, float hi) { unsigned r; asm volatile("v_cvt_pk_bf16_f32 %0, %1, %2" : "=v"(r) : "v"(lo), "v"(hi)); return r; }

struct Unit { const char* A; const char* B; const int* gidx; int pm, pn, aux; int gl; };

template <class Epi, class Sched, bool GATHER, bool FP8 = false>
__device__ __forceinline__ void gemm_phase(LAS unsigned char* lds, const int wid, const int K, const int lda, const int ldb, const Sched& S, const Epi& E, const int scale_w = 0x7F7F7F7F, const int scale_a = 0x7F7F7F7F, const int stagger_ticks = 0) {
    const int lane = lane_id(), tid = (wid << 6) | lane, wr = wid >> 2, wc = wid & 3, fr = lane & 15, fq = lane >> 4;
    const int nt = K / BK;
    int Ra[2], Ca[2]; unsigned voffB[2];
#pragma unroll
    for (int i = 0; i < 2; ++i) { int R, C; stage_rc(tid * 16 + i * 8192, R, C); Ra[i] = R; Ca[i] = C; const int Rb = (R & ~31) + perm32(R & 31); voffB[i] = (unsigned)(Rb * ldb + C) * 2u; }
    const size_t kstep = (size_t)(BK * 2);
    const size_t hstepB = (size_t)HALF * ldb * 2;
    const unsigned ldsw = (unsigned)wid * 1024u;
    const unsigned ldsb = (unsigned)(size_t)lds;
    const int aoff = lds_byte(wr * 64 + fr, fq * 8), boff = lds_byte(wc * 32 + fr, fq * 8);
#define PG8_SA(b, h) (((b) * 2 + (h)) * HTB)
#define PG8_SB(b, h) ((4 + (b) * 2 + (h)) * HTB)
#define PG8_STAGE(bufoff, gbase, voff) do { const unsigned long long _ub = (unsigned long long)uni_ptr((const char*)(gbase)); _Pragma("unroll") for (int _i = 0; _i < 2; ++_i) { \
        unsigned _keep; const unsigned _ld = (unsigned)__builtin_amdgcn_readfirstlane((int)(ldsb + (unsigned)(bufoff) + ldsw + (unsigned)_i * 8192u)); \
        asm volatile("s_nop 4\n\ts_mov_b32 %0, m0\n\ts_mov_b32 m0, %3\n\ts_nop 0\n\tglobal_load_lds_dwordx4 %1, %2\n\ts_mov_b32 m0, %0" : "=&s"(_keep) : "v"((voff)[_i]), "s"(_ub), "s"(_ld) : "memory"); } } while (0)
#define PG8_LDA(dst, b, h) do { _Pragma("unroll") for (int m = 0; m < 4; ++m) _Pragma("unroll") for (int k = 0; k < 2; ++k) dst[m][k] = *(const LAS bf16x8*)(lds + PG8_SA(b, h) + aoff + m * 2048 + k * 1024); } while (0)
#define PG8_LDB(dst, b, h) do { _Pragma("unroll") for (int n = 0; n < 2; ++n) _Pragma("unroll") for (int k = 0; k < 2; ++k) dst[n][k] = *(const LAS bf16x8*)(lds + PG8_SB(b, h) + boff + n * 2048 + k * 1024); } while (0)
#define PG8_MMA(ai, bj, At, Bt) do { __builtin_amdgcn_s_setprio(1); _Pragma("unroll") for (int m = 0; m < 4; ++m) _Pragma("unroll") for (int n = 0; n < 2; ++n) { \
        if constexpr (FP8) { mfma8_tied(acc[ai][bj][m][n], cat8(Bt[n][0], Bt[n][1]), cat8(At[m][0], At[m][1]), scale_w, scale_a); } \
        else { _Pragma("unroll") for (int k = 0; k < 2; ++k) acc[ai][bj][m][n] = __builtin_amdgcn_mfma_f32_16x16x32_bf16(Bt[n][k], At[m][k], acc[ai][bj][m][n], 0, 0, 0); } } \
        __builtin_amdgcn_s_setprio(0); } while (0)
#define PG8_WAIT_V(n) asm volatile("s_waitcnt vmcnt(" #n ")" ::: "memory")
#define PG8_WAIT_L(n) asm volatile("s_waitcnt lgkmcnt(" #n ")" ::: "memory")
#define PG8_BAR __builtin_amdgcn_s_barrier()
#define PG8_SCHED __builtin_amdgcn_sched_barrier(0)
    if (stagger_ticks > 0 && ((blockIdx.x >> 3) & 1)) { const unsigned long long t0 = __builtin_amdgcn_s_memrealtime(); while (__builtin_amdgcn_s_memrealtime() - t0 < (unsigned long long)stagger_ticks) __builtin_amdgcn_s_sleep(8); }
    Unit cur, nxt; int ui = 0;
    if (!S.next(0, cur)) return;
    unsigned offA[2][2], offN[2][2];
#pragma unroll
    for (int h = 0; h < 2; ++h)
#pragma unroll
        for (int i = 0; i < 2; ++i) {
            const int rr = h * HALF + Ra[i];
            const int row = GATHER ? cur.gidx[rr] : rr;
            offA[h][i] = (unsigned)(row * lda + Ca[i]) * 2u; offN[h][i] = offA[h][i];
        }
    f32x4 acc[2][2][4][2];
#pragma unroll
    for (int a = 0; a < 2; ++a)
#pragma unroll
        for (int b = 0; b < 2; ++b)
#pragma unroll
            for (int m = 0; m < 4; ++m)
#pragma unroll
                for (int n = 0; n < 2; ++n) acc[a][b][m][n] = (f32x4){0.f, 0.f, 0.f, 0.f};
    bf16x8 At[4][2], B0[2][2], B1[2][2];
    const char* cA = cur.A; const char* cB = cur.B;
    PG8_STAGE(PG8_SB(0, 0), cB, voffB); PG8_STAGE(PG8_SB(0, 1), cB + hstepB, voffB); PG8_STAGE(PG8_SA(0, 0), cA, offA[0]); PG8_STAGE(PG8_SA(0, 1), cA, offA[1]);
    if (wr == 1) PG8_BAR;
    PG8_WAIT_V(2); PG8_BAR;
    PG8_STAGE(PG8_SB(1, 0), cB + kstep, voffB); PG8_STAGE(PG8_SA(1, 0), cA + kstep, offA[0]); PG8_STAGE(PG8_SB(1, 1), cB + hstepB + kstep, voffB);
    PG8_WAIT_V(6); PG8_BAR;
    for (;;) {
        const bool has_next = S.next(ui + 1, nxt);
        const char* nA = has_next ? nxt.A : cA; const char* nB = has_next ? nxt.B : cB;
        if constexpr (GATHER) {
            if (has_next) {
#pragma unroll
                for (int h = 0; h < 2; ++h)
#pragma unroll
                    for (int i = 0; i < 2; ++i) offN[h][i] = (unsigned)(nxt.gidx[h * HALF + Ra[i]] * lda + Ca[i]) * 2u;
            }
        }
#pragma unroll 1
        for (int t = 0; t < nt; t += 2) {
            const bool last = (t == nt - 2);
            const char* a1 = cA + (size_t)(t + 1) * kstep;
            const char* a2 = last ? nA : cA + (size_t)(t + 2) * kstep; const char* b2 = last ? nB : cB + (size_t)(t + 2) * kstep;
            const char* a3 = a2 + kstep; const char* b3 = b2 + kstep;
            unsigned o2[2][2];
#pragma unroll
            for (int h = 0; h < 2; ++h)
#pragma unroll
                for (int i = 0; i < 2; ++i) o2[h][i] = (GATHER && last) ? offN[h][i] : offA[h][i];
            PG8_LDB(B0, 0, 0); PG8_LDB(B1, 0, 1); PG8_SCHED; PG8_LDA(At, 0, 0); PG8_STAGE(PG8_SA(1, 1), a1, offA[1]);
            PG8_WAIT_V(8); PG8_WAIT_L(0); PG8_BAR; PG8_MMA(0, 0, At, B0); PG8_MMA(0, 1, At, B1); PG8_BAR; PG8_SCHED;
            PG8_LDA(At, 0, 1); PG8_STAGE(PG8_SB(0, 0), b2, voffB); PG8_STAGE(PG8_SB(0, 1), b2 + hstepB, voffB); PG8_STAGE(PG8_SA(0, 0), a2, o2[0]);
            PG8_WAIT_V(8); PG8_WAIT_L(0); PG8_BAR; PG8_MMA(1, 0, At, B0); PG8_MMA(1, 1, At, B1); PG8_BAR; PG8_SCHED;
            PG8_LDB(B0, 1, 0); PG8_LDB(B1, 1, 1); PG8_SCHED; PG8_LDA(At, 1, 0); PG8_STAGE(PG8_SA(0, 1), a2, o2[1]);
            PG8_WAIT_V(8); PG8_WAIT_L(0); PG8_BAR; PG8_MMA(0, 0, At, B0); PG8_MMA(0, 1, At, B1); PG8_BAR; PG8_SCHED;
            PG8_LDA(At, 1, 1); PG8_STAGE(PG8_SB(1, 0), b3, voffB); PG8_STAGE(PG8_SB(1, 1), b3 + hstepB, voffB); PG8_STAGE(PG8_SA(1, 0), a3, o2[0]);
            PG8_WAIT_V(8); PG8_WAIT_L(0); PG8_BAR; PG8_MMA(1, 0, At, B0); PG8_MMA(1, 1, At, B1); PG8_BAR; PG8_SCHED;
        }
        if (wr == 0) PG8_BAR;
        if constexpr (FP8) asm volatile("s_nop 15\n\ts_nop 15" ::: "memory");
        E(acc, cur, wr, wc, fr, fq);
        if (!has_next) break;
#pragma unroll
        for (int a = 0; a < 2; ++a)
#pragma unroll
            for (int b = 0; b < 2; ++b)
#pragma unroll
                for (int m = 0; m < 4; ++m)
#pragma unroll
                    for (int n = 0; n < 2; ++n) acc[a][b][m][n] = (f32x4){0.f, 0.f, 0.f, 0.f};
        cur = nxt; cA = nA; cB = nB; ++ui;
        if constexpr (GATHER) {
#pragma unroll
            for (int h = 0; h < 2; ++h)
#pragma unroll
                for (int i = 0; i < 2; ++i) offA[h][i] = offN[h][i];
        }
        if (wr == 1) PG8_BAR;
    }
    PG8_WAIT_V(0);
    PG8_BAR;
#undef PG8_SA
#undef PG8_SB
#undef PG8_STAGE
#undef PG8_LDA
#undef PG8_LDB
#undef PG8_MMA
#undef PG8_WAIT_V
#undef PG8_WAIT_L
#undef PG8_BAR
#undef PG8_SCHED
}

struct DenseOrder {
    const char* A; const char* Bt; size_t a_tile_bytes, b_tile_bytes; int nM, nN, nwg, G, c;
    __device__ void init(const void* A_, const void* Bt_, int M, int N, int lda, int ldb, int G_, int c_) {
        A = (const char*)A_; Bt = (const char*)Bt_; nM = M / BM; nN = N / BM; nwg = nM * nN; G = G_; c = c_;
        a_tile_bytes = (size_t)BM * lda * 2; b_tile_bytes = (size_t)BM * ldb * 2;
    }
    __device__ __forceinline__ bool next(int i, Unit& u) const {
        const long L = (long)i * G + c; if (L >= nwg) return false;
        int wgid = (int)L; { const int q = nwg / NXCD, r = nwg % NXCD, xcd = wgid % NXCD, off = wgid / NXCD; wgid = (xcd < r ? xcd * (q + 1) : r * (q + 1) + (xcd - r) * q) + off; }
        const int nig = WGM * nN, gid = wgid / nig, fm = gid * WGM, gsz = (nM - fm) < WGM ? (nM - fm) : WGM;
        u.pm = fm + ((wgid % nig) % gsz); u.pn = (wgid % nig) / gsz; u.aux = 0; u.gidx = nullptr; u.gl = 0;
        u.A = A + (size_t)u.pm * a_tile_bytes; u.B = Bt + (size_t)u.pn * b_tile_bytes; return true;
    }
};
}

#ifndef OUTPROJ_FP8
#define OUTPROJ_FP8 0
#endif
#define XB_TMO      128
#define XB_XCNT(j)  (256  + 64 * (j))
#define XB_XSUB(j)  (1280 + 64 * (j))
#define XB_XGEN(j)  (2304 + 64 * (j))
#define XB_TOP      3328
#define XB_TOPGEN   3392
#define XCD_BAR_WORDS 3456
#define XB_SPIN_CAP (1u << 18)

__device__ __forceinline__ unsigned xb_ld(unsigned* p)              { return __hip_atomic_load(p, __ATOMIC_RELAXED, __HIP_MEMORY_SCOPE_AGENT); }
__device__ __forceinline__ unsigned xb_add(unsigned* p, unsigned v) { return __hip_atomic_fetch_add(p, v, __ATOMIC_RELAXED, __HIP_MEMORY_SCOPE_AGENT); }
__device__ __forceinline__ unsigned xb_xcc_id() { return (unsigned)__builtin_amdgcn_s_getreg((3 << 11) | 20) & 0xFu; }
#define XB_SPIN(cond, bar) do { unsigned _sp = 0; while (cond) { __builtin_amdgcn_s_sleep(1); \
    if ((++_sp & 255u) == 0u) { if (xb_ld(&(bar)[XB_TMO])) break; if (_sp > XB_SPIN_CAP) { atomicAdd(&(bar)[XB_TMO], 1u); break; } } } } while (0)

struct XcdBarrier {
    unsigned* bar; unsigned x; int w;
    volatile LAS unsigned* st;
};
__device__ __forceinline__ XcdBarrier xcd_barrier_post(unsigned* bar, volatile LAS unsigned* st, int wave) {
    XcdBarrier b; b.bar = bar; b.x = xb_xcc_id(); b.st = st; b.w = wave;
    if (wave == 0 && lane_id() == 0) (void)xb_add(&bar[XB_XCNT(b.x)], 1u);
    return b;
}
__device__ __forceinline__ void xcd_barrier_complete(unsigned* bar, unsigned x, unsigned& nloc, unsigned& nx) {
    const unsigned G = gridDim.x * gridDim.y * gridDim.z;
    unsigned sum, cnt, mine, sp = 0u;
    for (;;) {
        sum = 0u; cnt = 0u; mine = 0u;
#pragma unroll
        for (unsigned j = 0; j < 16; ++j) { const unsigned c = xb_ld(&bar[XB_XCNT(j)]); sum += c; cnt += (c > 0u) ? 1u : 0u; mine = (j == x) ? c : mine; }
        if (sum == G) break;
        __builtin_amdgcn_s_sleep(1);
        if ((++sp & 255u) == 0u) { if (xb_ld(&bar[XB_TMO])) break; if (sp > XB_SPIN_CAP) { atomicAdd(&bar[XB_TMO], 1u); break; } }
    }
    nloc = mine > 0u ? mine : 1u; nx = cnt > 0u ? cnt : 1u;
}
__device__ __forceinline__ void xcd_barrier(const XcdBarrier& b) {
    asm volatile("s_waitcnt vmcnt(0)" ::: "memory");
    __syncthreads();
    if (b.w == 0 && lane_id() == 0) {
        unsigned* bar = b.bar;
        __builtin_amdgcn_s_waitcnt(0);
        unsigned nloc = b.st[0], nx = b.st[1];
        if (nloc == 0u) { xcd_barrier_complete(bar, b.x, nloc, nx); b.st[0] = nloc; b.st[1] = nx; }
        const unsigned old = xb_add(&bar[XB_XSUB(b.x)], 1u);
        const unsigned gen = old / nloc;
        if (old + 1u == (gen + 1u) * nloc) {
            __builtin_amdgcn_fence(__ATOMIC_RELEASE, "agent");
            asm volatile("s_waitcnt vmcnt(0)" ::: "memory");
            const unsigned og = xb_add(&bar[XB_TOP], 1u);
            const unsigned tg = og / nx;
            if (og + 1u == (tg + 1u) * nx) xb_add(&bar[XB_TOPGEN], 1u);
            else XB_SPIN(xb_ld(&bar[XB_TOPGEN]) == tg, bar);
            __builtin_amdgcn_fence(__ATOMIC_ACQUIRE, "agent");
            xb_add(&bar[XB_XGEN(b.x)], 1u);
            asm volatile("s_waitcnt vmcnt(0)" ::: "memory");
        } else {
            XB_SPIN(xb_ld(&bar[XB_XGEN(b.x)]) == gen, bar);
            __builtin_amdgcn_fence(__ATOMIC_ACQUIRE, "agent");
            asm volatile("s_waitcnt vmcnt(0)" ::: "memory");
        }
    }
    __syncthreads();
}

constexpr size_t MiB = 1u << 20;
constexpr size_t WS_CTL = 0, CTL_ZERO_BYTES = 1 * MiB;
constexpr size_t WS_SMALL = 1 * MiB;
constexpr size_t WS_RSTD1 = WS_SMALL;
constexpr size_t WS_LOGI = WS_SMALL + 1 * MiB;
constexpr size_t WS_LOGF = WS_SMALL + 2 * MiB;
constexpr size_t WS_TOPI = WS_SMALL + 3 * MiB;
constexpr size_t WS_TOPG = WS_SMALL + 4 * MiB;
constexpr size_t WS_STOK = WS_SMALL + 5 * MiB;
constexpr size_t WS_SGATE = WS_SMALL + 6 * MiB;
constexpr size_t WS_ESTART = WS_SMALL + 7 * MiB;
constexpr size_t WS_BTIN = 17 * MiB;
constexpr size_t WS_BTOUT = 25 * MiB;
constexpr size_t WS_BT1 = 29 * MiB;
constexpr size_t WS_BT2 = 157 * MiB;
constexpr size_t WS_R1 = 221 * MiB;
constexpr size_t WS_XM = 285 * MiB;
constexpr size_t WS_SZ = 349 * MiB;
constexpr size_t WS_U = 413 * MiB;
constexpr size_t WS_Q = 477 * MiB;
constexpr size_t WS_YMIX = 477 * MiB;
constexpr size_t WS_ACT = 285 * MiB;
constexpr size_t WS_NEED = 925 * MiB;

constexpr int NWAVES = 8;
constexpr int RING_BYTES = 131072;
constexpr int LDSCTL_OFF = RING_BYTES;
constexpr int LDS_BYTES = 147456;
constexpr int CW_BAR = 4096;

struct MegaArgs {
    const float* in[27];
    float* out;
    unsigned char* ws;
    int ph_lo, ph_hi, li, pad;
};

__device__ __forceinline__ unsigned pk2(float lo, float hi) { return pg8::cvt_pk_bf16(lo, hi); }

__device__ __forceinline__ void unpack8(const u32x4 r, float (&f)[8]) {
    f[0] = __uint_as_float(r.x << 16); f[1] = __uint_as_float(r.x & 0xFFFF0000u); f[2] = __uint_as_float(r.y << 16); f[3] = __uint_as_float(r.y & 0xFFFF0000u);
    f[4] = __uint_as_float(r.z << 16); f[5] = __uint_as_float(r.z & 0xFFFF0000u); f[6] = __uint_as_float(r.w << 16); f[7] = __uint_as_float(r.w & 0xFFFF0000u);
}

__device__ __forceinline__ f32x4 up4(const u32x2 r) { f32x4 v; v.x = __uint_as_float(r.x << 16); v.y = __uint_as_float(r.x & 0xFFFF0000u); v.z = __uint_as_float(r.y << 16); v.w = __uint_as_float(r.y & 0xFFFF0000u); return v; }

__device__ __forceinline__ void p0_transpose_item(const float* W, int K, int N, bf16_t* WT, const float* ksc, int k0, int n0s, int n0d, LAS float* scr, int lane) {
    const int kr = lane >> 4, nq = lane & 15;
    f32x4 v[16];
#pragma unroll
    for (int i = 0; i < 16; ++i) v[i] = *(const f32x4*)(W + (size_t)(k0 + 4 * i + kr) * N + n0s + 4 * nq);
    if (ksc) {
#pragma unroll
        for (int i = 0; i < 16; ++i) v[i] = v[i] * ksc[k0 + 4 * i + kr];
    }
    const int c = lane >> 4, nl = lane & 15;
#pragma unroll
    for (int half = 0; half < 2; ++half) {
#pragma unroll
        for (int ii = 0; ii < 8; ++ii) *(LAS f32x4*)(scr + (4 * ii + kr) * 68 + 4 * nq) = v[8 * half + ii];
        asm volatile("s_waitcnt lgkmcnt(0)" ::: "memory");
#pragma unroll
        for (int j = 0; j < 4; ++j) { const int n = nl + 16 * j; const LAS float* sp = scr + (8 * c) * 68 + n;
            u32x4 o; o.x = pk2(sp[0 * 68], sp[1 * 68]); o.y = pk2(sp[2 * 68], sp[3 * 68]); o.z = pk2(sp[4 * 68], sp[5 * 68]); o.w = pk2(sp[6 * 68], sp[7 * 68]);
            *(u32x4*)(WT + (size_t)(n0d + n) * K + k0 + 32 * half + 8 * c) = o; }
        asm volatile("s_waitcnt lgkmcnt(0)" ::: "memory");
    }
}
__device__ __forceinline__ unsigned pk4_fp8(float a, float b, float c, float d) { int w = __builtin_amdgcn_cvt_pk_fp8_f32(a, b, 0, false); w = __builtin_amdgcn_cvt_pk_fp8_f32(c, d, w, true); return (unsigned)w; }
struct TrItem { const float* W; unsigned char* WT; const float* ksc; int K, N, k0, n0s, n0d; };
__device__ __forceinline__ void tr8_load(const TrItem& t, int lane, f32x4 (&v)[16]) {
    const int kr = lane >> 4, nq = lane & 15;
#pragma unroll
    for (int i = 0; i < 16; ++i) v[i] = __builtin_nontemporal_load((const f32x4*)(t.W + (size_t)(t.k0 + 4 * i + kr) * t.N + t.n0s + 4 * nq));
}
__device__ __forceinline__ void tr8_finish(const TrItem& t, float mul, LAS float* scr, int lane, f32x4 (&v)[16]) {
    const int kr = lane >> 4, nq = lane & 15;
#pragma unroll
    for (int i = 0; i < 16; ++i) v[i] = v[i] * (t.ksc ? t.ksc[t.k0 + 4 * i + kr] * mul : mul);
    const int c = lane >> 4, nl = lane & 15;
#pragma unroll
    for (int half = 0; half < 2; ++half) {
#pragma unroll
        for (int ii = 0; ii < 8; ++ii) *(LAS f32x4*)(scr + (4 * ii + kr) * 68 + 4 * nq) = v[8 * half + ii];
        asm volatile("s_waitcnt lgkmcnt(0)" ::: "memory");
#pragma unroll
        for (int j = 0; j < 4; ++j) { const int n = nl + 16 * j; const LAS float* sp = scr + (8 * c) * 68 + n;
            u32x2 o; o.x = pk4_fp8(sp[0 * 68], sp[1 * 68], sp[2 * 68], sp[3 * 68]); o.y = pk4_fp8(sp[4 * 68], sp[5 * 68], sp[6 * 68], sp[7 * 68]);
            *(u32x2*)(t.WT + (size_t)(t.n0d + n) * t.K + t.k0 + 32 * half + 8 * c) = o; }
        asm volatile("s_waitcnt lgkmcnt(0)" ::: "memory");
    }
}
__device__ __forceinline__ void p0_transpose_item8(const float* W, int K, int N, unsigned char* WT, const float* ksc, float mul, int k0, int n0s, int n0d, LAS float* scr, int lane) {
    TrItem t{W, WT, ksc, K, N, k0, n0s, n0d}; f32x4 v[16]; tr8_load(t, lane, v); tr8_finish(t, mul, scr, lane, v);
}
__device__ __forceinline__ int inproj_src_col(int nd) { if (nd < 2048) return nd; const int pn = (nd >> 8) - 8, lc = nd & 255; return 2048 + (lc >> 7) * 1024 + 128 * pn + (lc & 127); }
__device__ __forceinline__ int w1_src_col(int nd) { const int pn = nd >> 8, lc = nd & 255; return (lc >> 7) * 1024 + 128 * pn + (lc & 127); }

__device__ __forceinline__ void p0_prologue(const MegaArgs& a, LAS unsigned char* lds, int gw, int NGW, int wave, int lane) {
    LAS float* scr = (LAS float*)(lds + wave * 16384);
    unsigned char* ws = a.ws;
    const float* x = a.in[0];
    {
        bf16_t* xbf = (bf16_t*)(ws + WS_R1); float* rstd1 = (float*)(ws + WS_RSTD1);
        f32x4 va[4], vb[4];
#define XROW_LOAD(V, m_) do { const f32x4* xr_ = (const f32x4*)(x + (size_t)(m_) * DM) + lane; _Pragma("unroll") for (int j = 0; j < 4; ++j) V[j] = __builtin_nontemporal_load(xr_ + 64 * j); } while (0)
#define XROW_DONE(V, m_) do { float s_ = 0.f; _Pragma("unroll") for (int j = 0; j < 4; ++j) s_ += (V[j].x * V[j].x + V[j].y * V[j].y) + (V[j].z * V[j].z + V[j].w * V[j].w); \
            s_ = wave_sum(s_); if (lane == 0) rstd1[m_] = rsqrtf(s_ * (1.0f / DM) + EPSV); \
            unsigned long long* o8_ = (unsigned long long*)(xbf + (size_t)(m_) * DM) + lane; \
            _Pragma("unroll") for (int j = 0; j < 4; ++j) o8_[64 * j] = (unsigned long long)pk2(V[j].x, V[j].y) | ((unsigned long long)pk2(V[j].z, V[j].w) << 32); } while (0)
        int m = gw;
        if (m < NTOK) XROW_LOAD(va, m);
        for (; m < NTOK; m += 2 * NGW) {
            const int m2 = m + NGW;
            if (m2 < NTOK) XROW_LOAD(vb, m2);
            XROW_DONE(va, m);
            if (m2 < NTOK) { const int m3 = m2 + NGW; if (m3 < NTOK) XROW_LOAD(va, m3); XROW_DONE(vb, m2); }
        }
#undef XROW_LOAD
#undef XROW_DONE
    }
    constexpr int I_IN = (1024 / 64) * (4096 / 64);
    for (int it = gw; it < I_IN; it += NGW) { const int kb = it / 64, nb = it % 64; p0_transpose_item(a.in[2], 1024, 4096, (bf16_t*)(ws + WS_BTIN), a.in[1], 64 * kb, inproj_src_col(64 * nb), 64 * nb, scr, lane); }
}
__device__ __forceinline__ TrItem p0b_item(const MegaArgs& a, int r) {
    unsigned char* ws = a.ws;
    constexpr int I_W1 = 32 * (1024 / 64) * (2048 / 64);
    if (r < I_W1) { const int e = r / 512, rr = r % 512, kb = rr / 32, nb = rr % 32;
        return TrItem{a.in[22] + (size_t)e * 1024 * 2048, ws + WS_BT1 + (size_t)e * 2048 * 1024, a.in[19], 1024, 2048, 64 * kb, w1_src_col(64 * nb), 64 * nb}; }
    r -= I_W1;
    const int e = r / 256, rr = r % 256, kb = rr / 16, nb = rr % 16;
    return TrItem{a.in[24] + (size_t)e * 1024 * 1024, ws + WS_BT2 + (size_t)e * 1024 * 1024, nullptr, 1024, 1024, 64 * kb, 64 * nb, 64 * nb};
}
__device__ __forceinline__ void p0b_weights(const MegaArgs& a, LAS unsigned char* lds, int gw, int NGW, int wave, int lane) {
    LAS float* scr = (LAS float*)(lds + wave * 16384);
    unsigned char* ws = a.ws;
    constexpr int I_OUT = (2048 / 64) * (1024 / 64);
    constexpr int NITEMS = 32 * (1024 / 64) * (2048 / 64) + 32 * (1024 / 64) * (1024 / 64);
    for (int it = gw; it < I_OUT; it += NGW) { const int kb = it / 16, nb = it % 16;
#if OUTPROJ_FP8
        p0_transpose_item8(a.in[18], 2048, 1024, ws + WS_BTOUT, nullptr, 32.0f, 64 * kb, 64 * nb, 64 * nb, scr, lane);
#else
        p0_transpose_item(a.in[18], 2048, 1024, (bf16_t*)(ws + WS_BTOUT), nullptr, 64 * kb, 64 * nb, 64 * nb, scr, lane);
#endif
    }
    f32x4 vA[16], vB[16];
    int it = gw;
    if (it < NITEMS) { const TrItem t = p0b_item(a, it); tr8_load(t, lane, vA); }
    for (; it < NITEMS; it += 2 * NGW) {
        const int it2 = it + NGW;
        if (it2 < NITEMS) { const TrItem t2 = p0b_item(a, it2); tr8_load(t2, lane, vB); }
        { const TrItem t = p0b_item(a, it); tr8_finish(t, 32.0f, scr, lane, vA); }
        if (it2 < NITEMS) {
            const int it3 = it2 + NGW;
            if (it3 < NITEMS) { const TrItem t3 = p0b_item(a, it3); tr8_load(t3, lane, vA); }
            const TrItem t2 = p0b_item(a, it2); tr8_finish(t2, 32.0f, scr, lane, vB);
        }
    }
}

struct EpiInProj {
    const float* rstd; bf16_t* xm; bf16_t* sz; bf16_t* u; int variant;
    __device__ __forceinline__ void operator()(const f32x4 (&acc)[2][2][4][2], const pg8::Unit& un, int wr, int wc, int fr, int fq) const {
        if (variant & 8) return;
        const int row0 = un.pm * 256 + wr * 64 + fr;
        const int cl = wc * 32 + 8 * fq;
        float rsv[2][4];
#pragma unroll
        for (int ai = 0; ai < 2; ++ai)
#pragma unroll
            for (int m = 0; m < 4; ++m) rsv[ai][m] = rstd[row0 + ai * 128 + m * 16];
#pragma unroll
        for (int ai = 0; ai < 2; ++ai)
#pragma unroll
            for (int m = 0; m < 4; ++m) {
                const int row = row0 + ai * 128 + m * 16;
                const float rs = rsv[ai][m];
                if (un.pn < 8) {
                    bf16_t* dst = (un.pn < 4 ? xm : sz) + (size_t)row * DM + (un.pn & 3) * 256 + cl;
#pragma unroll
                    for (int bj = 0; bj < 2; ++bj) {
                        f32x4 v0 = acc[ai][bj][m][0] * rs, v1 = acc[ai][bj][m][1] * rs;
                        if (un.pn >= 4) {
#pragma unroll
                            for (int j = 0; j < 4; ++j) { v0[j] = siluf_(v0[j]); v1[j] = siluf_(v1[j]); }
                        }
                        u32x4 w; w.x = pg8::cvt_pk_bf16(v0[0], v0[1]); w.y = pg8::cvt_pk_bf16(v0[2], v0[3]); w.z = pg8::cvt_pk_bf16(v1[0], v1[1]); w.w = pg8::cvt_pk_bf16(v1[2], v1[3]);
                        if (!(variant & 4)) *(u32x4*)(dst + bj * 128) = w;
                    }
                } else {
                    bf16_t* dst = u + (size_t)row * DM + (un.pn - 8) * 128 + cl;
                    f32x4 o0, o1;
#pragma unroll
                    for (int j = 0; j < 4; ++j) {
                        o0[j] = (acc[ai][0][m][0][j] * rs) * sigmoidf_(acc[ai][1][m][0][j] * rs);
                        o1[j] = (acc[ai][0][m][1][j] * rs) * sigmoidf_(acc[ai][1][m][1][j] * rs);
                    }
                    u32x4 w; w.x = pg8::cvt_pk_bf16(o0[0], o0[1]); w.y = pg8::cvt_pk_bf16(o0[2], o0[3]); w.z = pg8::cvt_pk_bf16(o1[0], o1[1]); w.w = pg8::cvt_pk_bf16(o1[2], o1[3]);
                    if (!(variant & 4)) *(u32x4*)dst = w;
                }
            }
    }
};

constexpr size_t WS_WGCNT = WS_SMALL + 8 * MiB;
constexpr size_t WS_ASGE = WS_SMALL + 9 * MiB;
constexpr size_t WS_ASGR = WS_SMALL + 10 * MiB;
constexpr size_t WS_ASGG = WS_SMALL + 11 * MiB;
constexpr size_t WS_RSTD2 = WS_SMALL + 12 * MiB;
constexpr size_t WS_SRSTD = WS_SMALL + 13 * MiB;
constexpr size_t WS_TOKSLOT = WS_SMALL + 14 * MiB;
constexpr size_t WS_TILEEXP = WS_SMALL + 15 * MiB;
constexpr size_t WS_HBF = WS_R1;
constexpr size_t WS_YROWS = 605 * MiB;
constexpr size_t WS_HB16 = 750 * MiB;
constexpr int NSLOT = NASSIGN + NEXP * 256;
constexpr int TOK_PER_WG = NTOK / 256;

constexpr size_t WS_WRH = WS_SMALL + 576 * 1024;
constexpr size_t WS_WRL = WS_SMALL + 640 * 1024;
__device__ __forceinline__ void p0_router_tables(const MegaArgs& a, int gw, int NGW, int lane) {
    const float* nfw = a.in[19]; const float* wr = a.in[20];
    bf16_t* wh = (bf16_t*)(a.ws + WS_WRH); bf16_t* wl = (bf16_t*)(a.ws + WS_WRL);
    for (int idx = gw * 64 + lane; idx < 32 * 1024; idx += NGW * 64) {
        const int e = idx >> 10, k = idx & 1023;
        const float w = nfw[k] * wr[(size_t)k * 32 + e];
        const bf16_t hi = f2bf(w);
        wh[idx] = hi; wl[idx] = f2bf(w - bf2f(hi));
    }
}
constexpr int RT_LDS_OFF = LDSCTL_OFF + 5120;
struct RtGrp { u32x4 h[8]; };
__device__ __forceinline__ void rt_load_grp(const bf16_t* hrow, int k0, RtGrp& B) {
#pragma unroll
    for (int q = 0; q < 8; ++q) B.h[q] = *(const u32x4*)(hrow + k0 + 32 * q);
}
__device__ __forceinline__ void rt_step(const LAS bf16_t* whl, const LAS bf16_t* wll, int col, int kk, const u32x4 hraw, f32x4& acc0, f32x4& acc1, float& ssq) {
    float v[8]; unpack8(hraw, v);
#pragma unroll
    for (int i = 0; i < 8; ++i) ssq += v[i] * v[i];
    const bf16x8 ah = __builtin_bit_cast(bf16x8, hraw);
    const int ks = kk ^ (col << 3);
    const u32x4 bh0 = *(const LAS u32x4*)(whl + col * 1024 + ks), bh1 = *(const LAS u32x4*)(whl + (col + 16) * 1024 + ks);
    const u32x4 bl0 = *(const LAS u32x4*)(wll + col * 1024 + ks), bl1 = *(const LAS u32x4*)(wll + (col + 16) * 1024 + ks);
    acc0 = __builtin_amdgcn_mfma_f32_16x16x32_bf16(ah, __builtin_bit_cast(bf16x8, bh0), acc0, 0, 0, 0);
    acc0 = __builtin_amdgcn_mfma_f32_16x16x32_bf16(ah, __builtin_bit_cast(bf16x8, bl0), acc0, 0, 0, 0);
    acc1 = __builtin_amdgcn_mfma_f32_16x16x32_bf16(ah, __builtin_bit_cast(bf16x8, bh1), acc1, 0, 0, 0);
    acc1 = __builtin_amdgcn_mfma_f32_16x16x32_bf16(ah, __builtin_bit_cast(bf16x8, bl1), acc1, 0, 0, 0);
}
template <int CTRL> __device__ __forceinline__ void argmax_step(float& v, int& i) {
    const float ov = dpp_mov_f<CTRL>(v); const int oi = __builtin_amdgcn_update_dpp(0, i, CTRL, 0xf, 0xf, false);
    const bool take = (ov > v) || (ov == v && oi < i);
    v = take ? ov : v; i = take ? oi : i;
}
__device__ __forceinline__ void phase_router(const MegaArgs& a, LAS unsigned char* lds, int tid, int lane, int wave) {
    unsigned char* ws = a.ws;
    const bf16_t* hbuf = (const bf16_t*)(ws + WS_HB16);
    const float* br = a.in[21];
    const bf16_t* wh = (const bf16_t*)(ws + WS_WRH); const bf16_t* wl = (const bf16_t*)(ws + WS_WRL);
    float* rstd2 = (float*)(ws + WS_RSTD2);
    int* wgcnt = (int*)(ws + WS_WGCNT); int* asg_e = (int*)(ws + WS_ASGE); int* asg_r = (int*)(ws + WS_ASGR); float* asg_g = (float*)(ws + WS_ASGG);
    LAS int* topi_l = (LAS int*)(lds + RT_LDS_OFF);
    LAS float* topg_l = (LAS float*)(lds + RT_LDS_OFF + 2048);
    LAS int* rank_l = (LAS int*)(lds + RT_LDS_OFF + 4096);
    LAS float* rstd_l = (LAS float*)(lds + RT_LDS_OFF + 6144);
    LAS bf16_t* whl = (LAS bf16_t*)lds;
    LAS bf16_t* wll = (LAS bf16_t*)(lds + 65536);
    for (int i = tid; i < 8192; i += NWAVES * 64) { const int r = i >> 7, c8 = i & 127;
        *(LAS u32x4*)(lds + 16 * ((r << 7) + (c8 ^ (r & 15)))) = *(const u32x4*)((const unsigned char*)wh + 16 * (size_t)i); }
    __syncthreads();
    const int b = blockIdx.x;
    const int col = lane & 15, kq = lane >> 4;
    {
        const int t = b * TOK_PER_WG + wave * 16 + col;
        const bf16_t* hrow = hbuf + (size_t)t * DM + 8 * kq;
        f32x4 acc0 = (f32x4){0.f, 0.f, 0.f, 0.f}, acc1 = acc0; float ssq = 0.f;
        RtGrp A, B;
        rt_load_grp(hrow, 0, A);
        for (int g = 0; g < 4; g += 2) {
            rt_load_grp(hrow, 256 * (g + 1), B);
#pragma unroll
            for (int q = 0; q < 8; ++q) rt_step(whl, wll, col, 256 * g + 32 * q + 8 * kq, A.h[q], acc0, acc1, ssq);
            if (g + 2 < 4) rt_load_grp(hrow, 256 * (g + 2), A);
#pragma unroll
            for (int q = 0; q < 8; ++q) rt_step(whl, wll, col, 256 * (g + 1) + 32 * q + 8 * kq, B.h[q], acc0, acc1, ssq);
        }
        ssq += __builtin_bit_cast(float, __builtin_amdgcn_ds_swizzle(__builtin_bit_cast(int, ssq), 0x401F));
        { const auto rr = __builtin_amdgcn_permlane32_swap(__float_as_uint(ssq), __float_as_uint(ssq), false, false); ssq = __uint_as_float(rr[0]) + __uint_as_float(rr[1]); }
        const float rs = rsqrtf(ssq * (1.0f / DM) + EPSV);
        if (kq == 0) { rstd_l[wave * 16 + col] = rs; rstd2[t] = rs; }
        asm volatile("s_waitcnt lgkmcnt(0)" ::: "memory");
        const float b0 = br[col], b1 = br[col + 16];
#pragma unroll
        for (int r = 0; r < 4; ++r) {
            const float rsr = rstd_l[wave * 16 + 4 * kq + r];
            float v0 = acc0[r] * rsr + b0, v1 = acc1[r] * rsr + b1;
            int sel[4]; float val[4];
#pragma unroll
            for (int it = 0; it < 4; ++it) {
                float bv = (v1 > v0) ? v1 : v0; int bi = (v1 > v0) ? col + 16 : col;
                argmax_step<0xB1>(bv, bi); argmax_step<0x4E>(bv, bi); argmax_step<0x124>(bv, bi); argmax_step<0x128>(bv, bi);
                sel[it] = bi; val[it] = bv;
                if (bi == col) v0 = -3.0e38f;
                if (bi == col + 16) v1 = -3.0e38f;
            }
            float ex[4], sum = 0.f;
#pragma unroll
            for (int it = 0; it < 4; ++it) { ex[it] = __expf(val[it] - val[0]); sum += ex[it]; }
            const float inv = 1.0f / sum;
            if (col == 0) {
                const int tw = wave * 16 + 4 * kq + r;
#pragma unroll
                for (int it = 0; it < 4; ++it) { topi_l[tw * 4 + it] = sel[it]; topg_l[tw * 4 + it] = ex[it] * inv; }
            }
        }
    }
    __syncthreads();
    if (wave == 0) {
        int base = 0;
        for (int ch = 0; ch < 8; ++ch) {
            const int E = topi_l[ch * 64 + lane];
            int myrank = 0;
#pragma unroll
            for (int e = 0; e < 32; ++e) {
                const unsigned long long m = __ballot(E == e);
                const int be = __builtin_amdgcn_readlane(base, e);
                if (E == e) myrank = be + __builtin_popcountll(m & ((1ull << lane) - 1ull));
                if (lane == e) base += __builtin_popcountll(m);
            }
            rank_l[ch * 64 + lane] = myrank;
        }
        if (lane < 32) wgcnt[b * 32 + lane] = base;
    }
    __syncthreads();
    {
        int i = tid; asm volatile("" : "+v"(i));
        const int aidx = b * TOK_PER_WG * 4 + i;
        asg_e[aidx] = topi_l[i]; asg_r[aidx] = rank_l[i]; asg_g[aidx] = topg_l[i];
    }
}

__device__ __forceinline__ void phase_slots(const MegaArgs& a, LAS unsigned char* lds, int tid) {
    unsigned char* ws = a.ws;
    const int* wgcnt = (const int*)(ws + WS_WGCNT); const int* asg_e = (const int*)(ws + WS_ASGE); const int* asg_r = (const int*)(ws + WS_ASGR); const float* asg_g = (const float*)(ws + WS_ASGG);
    const float* rstd2 = (const float*)(ws + WS_RSTD2);
    int* slot_tok = (int*)(ws + WS_STOK); float* slot_gate = (float*)(ws + WS_SGATE); float* slot_rstd = (float*)(ws + WS_SRSTD);
    int* tok_slot = (int*)(ws + WS_TOKSLOT); int* tile_exp = (int*)(ws + WS_TILEEXP);
    LAS int* tot = (LAS int*)lds; LAS int* bef = tot + 32; LAS int* tstart = bef + 32;
    const int b = blockIdx.x;
    if (tid < 32) {
        int t = 0, bf = 0;
        for (int bb = 0; bb < 256; ++bb) { const int c = wgcnt[bb * 32 + tid]; t += c; if (bb < b) bf += c; }
        tot[tid] = t; bef[tid] = bf;
    }
    __syncthreads();
    if (tid == 0) { int ts = 0; for (int e = 0; e < 32; ++e) { tstart[e] = ts; ts += (tot[e] + 255) >> 8; } tstart[32] = ts; }
    __syncthreads();
    {
        int tid_o = tid; asm volatile("" : "+v"(tid_o));
        const int aidx = b * TOK_PER_WG * 4 + tid_o;
        const int e = asg_e[aidx];
        const int slot = 256 * tstart[e] + bef[e] + asg_r[aidx];
        const int tk = aidx >> 2;
        slot_tok[slot] = tk; slot_gate[slot] = asg_g[aidx]; slot_rstd[slot] = rstd2[tk]; tok_slot[aidx] = slot;
    }
    if (b < 32) {
        const int e = b; const int s0 = 256 * tstart[e] + tot[e], s1 = 256 * tstart[e + 1];
        for (int s = s0 + tid; s < s1; s += NWAVES * 64) { slot_tok[s] = 0; slot_gate[s] = 0.f; slot_rstd[s] = 0.f; }
    }
    if (b == 0) {
        if (tid < 32) for (int t = tstart[tid]; t < tstart[tid + 1]; ++t) tile_exp[t] = tid;
        if (tid == 0) tile_exp[2048] = tstart[32];
    }
}

struct MoeOrder {
    const char* A; const char* Bt; const int* gidx; const int* tile_exp; size_t a_tile_bytes, b_exp_bytes, b_tile_bytes; int T, nN, group, c;
    __device__ __forceinline__ bool next(int i, pg8::Unit& u) const {
        const int x = c & 7, j = c >> 3;
        const int tile = (i * 8 + x) * group + (j % group);
        if (tile >= T) return false;
        const int e = __builtin_amdgcn_readfirstlane(tile_exp[tile]);
        u.pm = tile; u.pn = j / group; u.aux = e; u.gl = 0;
        u.gidx = gidx ? gidx + 256 * tile : nullptr;
        u.A = gidx ? A : A + (size_t)tile * a_tile_bytes;
        u.B = Bt + (size_t)e * b_exp_bytes + (size_t)u.pn * b_tile_bytes;
        return true;
    }
};

struct EpiMoe1 {
    const float* srstd; const float* b1; unsigned char* act; int variant;
    __device__ __forceinline__ void operator()(const f32x4 (&acc)[2][2][4][2], const pg8::Unit& un, int wr, int wc, int fr, int fq) const {
        if (variant & 8) return;
        const int e = un.aux;
        const int cl = un.pn * 128 + wc * 32 + 8 * fq;
        f32x4 bg[2], bl[2];
#pragma unroll
        for (int n = 0; n < 2; ++n) { bg[n] = *(const f32x4*)(b1 + (size_t)e * 2048 + cl + 4 * n); bl[n] = *(const f32x4*)(b1 + (size_t)e * 2048 + 1024 + cl + 4 * n); }
        const int slot0 = un.pm * 256 + wr * 64 + fr;
        float rsv[2][4];
#pragma unroll
        for (int ai = 0; ai < 2; ++ai)
#pragma unroll
            for (int m = 0; m < 4; ++m) rsv[ai][m] = srstd[slot0 + ai * 128 + m * 16];
#pragma unroll
        for (int ai = 0; ai < 2; ++ai)
#pragma unroll
            for (int m = 0; m < 4; ++m) {
                const int slot = slot0 + ai * 128 + m * 16;
                const float rs = rsv[ai][m];
                f32x4 o[2];
#pragma unroll
                for (int n = 0; n < 2; ++n)
#pragma unroll
                    for (int j = 0; j < 4; ++j) {
                        const float g = acc[ai][0][m][n][j] * rs + bg[n][j];
                        const float l = acc[ai][1][m][n][j] * rs + bl[n][j];
                        const float xg = fminf(g, 7.0f);
                        const float xl = fminf(fmaxf(l, -7.0f), 7.0f);
                        o[n][j] = xg * sigmoidf_(1.702f * xg) * (xl + 1.0f);
                    }
                u32x2 w; w.x = pk4_fp8(o[0][0], o[0][1], o[0][2], o[0][3]); w.y = pk4_fp8(o[1][0], o[1][1], o[1][2], o[1][3]);
                *(u32x2*)(act + (size_t)slot * DM + cl) = w;
            }
    }
};
struct EpiMoe2 {
    const float* sgate; const float* b2; unsigned char* yrows;
    __device__ __forceinline__ void operator()(const f32x4 (&acc)[2][2][4][2], const pg8::Unit& un, int wr, int wc, int fr, int fq) const {
        const int e = un.aux;
        const int c0 = un.pn * 256 + wc * 32 + 8 * fq;
        f32x4 bv[2][2];
#pragma unroll
        for (int bj = 0; bj < 2; ++bj)
#pragma unroll
            for (int n = 0; n < 2; ++n) bv[bj][n] = *(const f32x4*)(b2 + (size_t)e * DM + c0 + bj * 128 + 4 * n);
        const int slot0 = un.pm * 256 + wr * 64 + fr;
        float gtv[2][4];
#pragma unroll
        for (int ai = 0; ai < 2; ++ai)
#pragma unroll
            for (int m = 0; m < 4; ++m) gtv[ai][m] = sgate[slot0 + ai * 128 + m * 16] * 16.0f;
#pragma unroll
        for (int ai = 0; ai < 2; ++ai)
#pragma unroll
            for (int m = 0; m < 4; ++m) {
                const int slot = slot0 + ai * 128 + m * 16;
                const float gt = gtv[ai][m];
#pragma unroll
                for (int bj = 0; bj < 2; ++bj) {
                    const f32x4 v0 = (acc[ai][bj][m][0] + bv[bj][0]) * gt, v1 = (acc[ai][bj][m][1] + bv[bj][1]) * gt;
                    u32x2 w; w.x = pk4_fp8(v0[0], v0[1], v0[2], v0[3]); w.y = pk4_fp8(v1[0], v1[1], v1[2], v1[3]);
                    *(u32x2*)(yrows + (size_t)slot * DM + c0 + bj * 128) = w;
                }
            }
    }
};

struct FinBuf { u32x2 h[4]; unsigned y[4][4]; };
__device__ __forceinline__ void fin_load(const bf16_t* hbuf, const unsigned char* yrows, const int slots, int kk, int t, int lane, FinBuf& B) {
    const u32x2* hp = (const u32x2*)(hbuf + (size_t)t * DM) + lane;
#pragma unroll
    for (int j = 0; j < 4; ++j) B.h[j] = hp[64 * j];
#pragma unroll
    for (int r = 0; r < 4; ++r) {
        const int slot = __builtin_amdgcn_readlane(slots, 4 * kk + r);
        const unsigned* yp = (const unsigned*)(yrows + (size_t)slot * DM) + lane;
#pragma unroll
        for (int j = 0; j < 4; ++j) B.y[r][j] = yp[64 * j];
    }
}
__device__ __forceinline__ void fin_compute(float* obuf, const float* fw, int t, int lane, const FinBuf& B) {
    f32x4 v[4];
#pragma unroll
    for (int j = 0; j < 4; ++j) {
        v[j] = up4(B.h[j]);
#pragma unroll
        for (int r = 0; r < 4; ++r) {
            const unsigned w = B.y[r][j];
            const f32x2 lo = __builtin_amdgcn_cvt_pk_f32_fp8(w, false), hi = __builtin_amdgcn_cvt_pk_f32_fp8(w, true);
            v[j].x += lo.x * 0.0625f; v[j].y += lo.y * 0.0625f; v[j].z += hi.x * 0.0625f; v[j].w += hi.y * 0.0625f;
        }
    }
    float s = 0.f;
#pragma unroll
    for (int j = 0; j < 4; ++j) s += (v[j].x * v[j].x + v[j].y * v[j].y) + (v[j].z * v[j].z + v[j].w * v[j].w);
    s = wave_sum(s);
    const float rs = rsqrtf(s * (1.0f / DM) + EPSV);
    f32x4* hp = (f32x4*)(obuf + (size_t)t * DM) + lane;
#pragma unroll
    for (int j = 0; j < 4; ++j) {
        const f32x4 w = *((const f32x4*)fw + lane + 64 * j);
        hp[64 * j] = v[j] * rs * w;
    }
}
__device__ __forceinline__ void phase_final(const MegaArgs& a, int gw, int NGW, int lane) {
    unsigned char* ws = a.ws;
    float* obuf = a.out; const float* fw = a.in[26]; const bf16_t* hbuf = (const bf16_t*)(ws + WS_HB16);
    const unsigned char* yrows = ws + WS_YROWS; const int* tok_slot = (const int*)(ws + WS_TOKSLOT);
    int slots = 0;
    { const int tk = gw + (lane >> 2) * NGW; if (tk < NTOK) slots = __hip_atomic_load(tok_slot + (size_t)tk * 4 + (lane & 3), __ATOMIC_RELAXED, __HIP_MEMORY_SCOPE_AGENT); }
    FinBuf A, B;
    int t = gw, kk = 0;
    if (t < NTOK) fin_load(hbuf, yrows, slots, 0, t, lane, A);
    for (; t < NTOK; t += 2 * NGW, kk += 2) {
        const int t2 = t + NGW;
        if (t2 < NTOK) fin_load(hbuf, yrows, slots, kk + 1, t2, lane, B);
        fin_compute(obuf, fw, t, lane, A);
        if (t2 < NTOK) {
            const int t3 = t2 + NGW;
            if (t3 < NTOK) fin_load(hbuf, yrows, slots, kk + 2, t3, lane, A);
            fin_compute(obuf, fw, t2, lane, B);
        }
    }
}

#ifndef OUTPROJ_FP8
#define OUTPROJ_FP8 0
#endif
constexpr int CT = 16;
constexpr int CONV_RED_OFF = LDSCTL_OFF + 4096;
__device__ __forceinline__ void conv_load_rows(const __amdgpu_buffer_rsrc_t urs, int t0, int tid, unsigned (&R)[CT + 30]) {
    const int s0 = t0 & (SEQ - 1);
#pragma unroll
    for (int r = 0; r < CT + 30; ++r) {
        const int sp = s0 - 30 + r;
        R[r] = (sp >= 0) ? (unsigned)__builtin_amdgcn_raw_buffer_load_b32(urs, tid * 4, (t0 - 30 + r) * 2048, 0) : 0u;
    }
}
__device__ __forceinline__ void phase_conv31(const MegaArgs& a, LAS unsigned char* lds, int tid, int lane, int wave, int G) {
    unsigned char* ws = a.ws;
    const __amdgpu_buffer_rsrc_t urs = __builtin_amdgcn_make_buffer_rsrc((void*)(ws + WS_U), 0, NTOK * 2048, 0x00020000);
    const float* cw = a.in[14]; const float* cb = a.in[15]; const float* nw = a.in[16]; const float* nb = a.in[17];
#if OUTPROJ_FP8
    unsigned short* ymix = (unsigned short*)(ws + WS_YMIX);
#else
    unsigned* ymix = (unsigned*)(ws + WS_YMIX);
#endif
    LAS float* wl = (LAS float*)lds;
    LAS float* red = (LAS float*)(lds + CONV_RED_OFF);
    LAS float* stat = red + 32 * 32;
    for (int i = tid; i < 31 * 256; i += NWAVES * 64) *(LAS f32x4*)(wl + 4 * i) = *(const f32x4*)(cw + 4 * i);
    const f32x2 bias = *(const f32x2*)(cb + 2 * tid);
    const f32x2 gw2 = *(const f32x2*)(nw + 2 * tid);
    const f32x2 gb2 = *(const f32x2*)(nb + 2 * tid);
    __syncthreads();
    unsigned R[CT + 30];
    int it = blockIdx.x;
    if (it < NTOK / CT) conv_load_rows(urs, it * CT, tid, R);
    for (; it < NTOK / CT; it += G) {
        const int t0 = it * CT;
        f32x2 uf[CT + 30];
#pragma unroll
        for (int r = 0; r < CT + 30; ++r) { uf[r].x = __uint_as_float(R[r] << 16); uf[r].y = __uint_as_float(R[r] & 0xFFFF0000u); }
        if (it + G < NTOK / CT) conv_load_rows(urs, (it + G) * CT, tid, R);
        f32x2 acc[CT];
#pragma unroll
        for (int t = 0; t < CT; ++t) acc[t] = bias;
#pragma unroll
        for (int k = 0; k < 31; ++k) {
            const f32x2 w = *(const LAS f32x2*)(wl + k * 1024 + 2 * tid);
#pragma unroll
            for (int t = 0; t < CT; ++t) acc[t] = __builtin_elementwise_fma(w, uf[t + k], acc[t]);
        }
        float acc0[CT], acc1[CT];
#pragma unroll
        for (int t = 0; t < CT; ++t) { acc0[t] = acc[t].x; acc1[t] = acc[t].y; }
        float sm[CT], sq[CT];
#pragma unroll
        for (int t = 0; t < CT; ++t) { sm[t] = acc0[t] + acc1[t]; sq[t] = acc0[t] * acc0[t] + acc1[t] * acc1[t]; }
#pragma unroll
        for (int t = 0; t < CT; ++t) {
            sm[t] += dpp_mov_f<0xB1>(sm[t]); sm[t] += dpp_mov_f<0x4E>(sm[t]); sm[t] += dpp_mov_f<0x124>(sm[t]); sm[t] += dpp_mov_f<0x128>(sm[t]);
            sq[t] += dpp_mov_f<0xB1>(sq[t]); sq[t] += dpp_mov_f<0x4E>(sq[t]); sq[t] += dpp_mov_f<0x124>(sq[t]); sq[t] += dpp_mov_f<0x128>(sq[t]);
        }
        __syncthreads();
        if ((lane & 15) == 0) {
            const int pr = wave * 4 + (lane >> 4);
#pragma unroll
            for (int t = 0; t < CT; ++t) { red[pr * 32 + t] = sm[t]; red[pr * 32 + CT + t] = sq[t]; }
        }
        __syncthreads();
        if (wave == 0 && lane < 32) {
            float s2 = 0.f;
#pragma unroll
            for (int p2 = 0; p2 < 32; ++p2) s2 += red[p2 * 32 + lane];
            const float other = __shfl_xor(s2, 16);
            if (lane < 16) {
                const float mean = s2 * (1.0f / DM);
                const float var = fmaxf(other * (1.0f / DM) - mean * mean, 0.f);
                stat[2 * lane] = mean; stat[2 * lane + 1] = rsqrtf(var + EPSV);
            }
        }
        __syncthreads();
#pragma unroll
        for (int t = 0; t < CT; ++t) {
            const f32x2 ms = *(const LAS f32x2*)(stat + 2 * t);
            const float y0 = siluf_((acc0[t] - ms.x) * ms.y * gw2.x + gb2.x);
            const float y1 = siluf_((acc1[t] - ms.x) * ms.y * gw2.y + gb2.y);
#if OUTPROJ_FP8
            ymix[(size_t)(t0 + t) * 1024 + 512 + tid] = (unsigned short)__builtin_amdgcn_cvt_pk_fp8_f32(y0, y1, 0, false);
#else
            ymix[(size_t)(t0 + t) * 1024 + 512 + tid] = pk2(y0, y1);
#endif
        }
    }
    __syncthreads();
}

struct YmBuf { u32x2 X[4][4]; u32x2 H[4]; u32x2 Z[4]; };
__device__ __forceinline__ void ym_load(const bf16_t* xm, const bf16_t* hm, const bf16_t* szb, int t, int lane, YmBuf& B) {
    const int s = t & (SEQ - 1);
#pragma unroll
    for (int j = 0; j < 4; ++j) {
        const int ch = 4 * lane + 256 * j;
#pragma unroll
        for (int kk = 0; kk < 4; ++kk) B.X[j][kk] = (s - 3 + kk >= 0) ? *(const u32x2*)(xm + (size_t)(t - 3 + kk) * DM + ch) : (u32x2){0u, 0u};
        B.H[j] = *(const u32x2*)(hm + (size_t)t * DM + ch);
        B.Z[j] = *(const u32x2*)(szb + (size_t)t * DM + ch);
    }
}
__device__ __forceinline__ void ym_compute(const LAS float* wts, unsigned char* ymix, int t, int lane, const YmBuf& B) {
#pragma unroll
    for (int j = 0; j < 4; ++j) {
        const int ch = 4 * lane + 256 * j;
        f32x4 xc = *(const LAS f32x4*)(wts + 4 * 1024 + ch);
#pragma unroll
        for (int kk = 0; kk < 4; ++kk) xc = xc + *(const LAS f32x4*)(wts + kk * 1024 + ch) * up4(B.X[j][kk]);
        xc.x = siluf_(xc.x); xc.y = siluf_(xc.y); xc.z = siluf_(xc.z); xc.w = siluf_(xc.w);
        const f32x4 hv = up4(B.H[j]);
        const float mean = wave_sum((hv.x + hv.y) + (hv.z + hv.w)) * (1.0f / 256.0f);
        const f32x4 d = hv - mean;
        const float var = wave_sum((d.x * d.x + d.y * d.y) + (d.z * d.z + d.w * d.w)) * (1.0f / 256.0f);
        const float rs = rsqrtf(var + EPSV);
        const f32x4 nwv = *(const LAS f32x4*)(wts + 5 * 1024 + ch), sk = *(const LAS f32x4*)(wts + 6 * 1024 + ch);
        const f32x4 y = (d * rs * nwv + sk * xc) * up4(B.Z[j]);
#if OUTPROJ_FP8
        *(unsigned*)(ymix + (size_t)t * 2048 + ch) = pk4_fp8(y.x, y.y, y.z, y.w);
#else
        { u32x2 o; o.x = pk2(y.x, y.y); o.y = pk2(y.z, y.w); *(u32x2*)((bf16_t*)ymix + (size_t)t * 2048 + ch) = o; }
#endif
        __builtin_amdgcn_sched_barrier(0);
    }
}
__device__ __forceinline__ void phase_ym(const MegaArgs& a, LAS unsigned char* lds, int tid, int gw, int NGW, int lane) {
    unsigned char* ws = a.ws;
    const bf16_t* xm = (const bf16_t*)(ws + WS_XM); const bf16_t* szb = (const bf16_t*)(ws + WS_SZ); const bf16_t* hm = (const bf16_t*)(ws + WS_R1);
    unsigned char* ymix = ws + WS_YMIX;
    LAS float* wts = (LAS float*)lds;
    for (int i = tid; i < 7 * 1024; i += NWAVES * 64) {
        const int r = i >> 10, c = i & 1023;
        wts[i] = (r < 4) ? a.in[3][r * DM + c] : (r == 4 ? a.in[4][c] : (r == 5 ? a.in[12][c] : a.in[13][c]));
    }
    __syncthreads();
    YmBuf A, B;
    int t = gw;
    if (t < NTOK) ym_load(xm, hm, szb, t, lane, A);
    for (; t < NTOK; t += 2 * NGW) {
        const int t2 = t + NGW;
        if (t2 < NTOK) ym_load(xm, hm, szb, t2, lane, B);
        ym_compute(wts, ymix, t, lane, A);
        if (t2 < NTOK) {
            const int t3 = t2 + NGW;
            if (t3 < NTOK) ym_load(xm, hm, szb, t3, lane, A);
            ym_compute(wts, ymix, t2, lane, B);
        }
    }
    __syncthreads();
}

struct EpiOutProj {
    const float* x; bf16_t* hb; unsigned char* hq;
    __device__ __forceinline__ void operator()(const f32x4 (&acc)[2][2][4][2], const pg8::Unit& un, int wr, int wc, int fr, int fq) const {
        const int row0 = un.pm * 256 + wr * 64 + fr;
        const int c0 = un.pn * 256 + wc * 32 + 8 * fq;
#pragma unroll
        for (int ai = 0; ai < 2; ++ai)
#pragma unroll
            for (int mp = 0; mp < 2; ++mp) {
                f32x4 xv[2][2][2];
#pragma unroll
                for (int mm = 0; mm < 2; ++mm)
#pragma unroll
                    for (int bj = 0; bj < 2; ++bj) {
                        const float* xp = x + (size_t)(row0 + ai * 128 + (2 * mp + mm) * 16) * DM + c0 + bj * 128;
                        xv[mm][bj][0] = *(const f32x4*)xp; xv[mm][bj][1] = *(const f32x4*)(xp + 4);
                    }
#pragma unroll
                for (int mm = 0; mm < 2; ++mm) {
                    const int m = 2 * mp + mm;
                    const size_t off = (size_t)(row0 + ai * 128 + m * 16) * DM + c0;
#pragma unroll
                    for (int bj = 0; bj < 2; ++bj) {
                        const f32x4 v0 = acc[ai][bj][m][0] + xv[mm][bj][0], v1 = acc[ai][bj][m][1] + xv[mm][bj][1];
                        u32x4 wb; wb.x = pg8::cvt_pk_bf16(v0[0], v0[1]); wb.y = pg8::cvt_pk_bf16(v0[2], v0[3]); wb.z = pg8::cvt_pk_bf16(v1[0], v1[1]); wb.w = pg8::cvt_pk_bf16(v1[2], v1[3]);
                        *(u32x4*)(hb + off + bj * 128) = wb;
                        u32x2 w; w.x = pk4_fp8(v0[0], v0[1], v0[2], v0[3]); w.y = pk4_fp8(v1[0], v1[1], v1[2], v1[3]);
                        *(u32x2*)(hq + off + bj * 128) = w;
                    }
                }
            }
    }
};


constexpr size_t WS_GCT = WS_SMALL + 512 * 1024;
constexpr size_t WS_GVT = WS_GCT + 32 * 1024;
constexpr size_t WS_FCUM = WS_SMALL + 3 * MiB;
constexpr size_t WS_UVAL = WS_SMALL + 4 * MiB;
constexpr size_t WS_MVAL = WS_SMALL + 7 * MiB;
constexpr size_t WS_ITEMS = WS_SMALL + 8 * MiB;
constexpr size_t WS_DN = WS_SMALL + 9 * MiB;
constexpr size_t WS_NPREV = WS_SMALL + 10 * MiB;
constexpr size_t WS_QB = 477 * MiB;
constexpr size_t WS_KB = 541 * MiB;
constexpr size_t WS_AEXT = 605 * MiB;
constexpr size_t WS_BEXT = 733 * MiB;
constexpr size_t WS_DCT = 861 * MiB;
constexpr size_t WS_KWT = WS_R1;
constexpr size_t WS_HM = WS_R1;
constexpr int RINV_OFF = LDSCTL_OFF + 1024;

__device__ __forceinline__ void p0_gate_tables(const MegaArgs& a, int gw, int NGW, int lane) {
    const float* wq = a.in[5]; const float* wk = a.in[6]; const float* wv = a.in[7]; const float* wig = a.in[8]; const float* wfg = a.in[10];
    bf16_t* gct = (bf16_t*)(a.ws + WS_GCT);
    for (int idx = gw * 64 + lane; idx < 2 * 16 * 1024; idx += NGW * 64) {
        const int tbl = idx >> 14, col = (idx >> 10) & 15, ch = idx & 1023;
        float v = 0.f;
        if (col < 8) {
            const float* Wg = (col < 4) ? wig : wfg; const int hh = col & 3, n = ch >> 2, i = ch & 3;
#pragma unroll
            for (int o = 0; o < 4; ++o) {
                if (tbl == 0) v += wq[n * 16 + i * 4 + o] * Wg[(size_t)(4 * n + o) * 4 + hh] + wk[n * 16 + i * 4 + o] * Wg[(size_t)(1024 + 4 * n + o) * 4 + hh];
                else v += wv[n * 16 + i * 4 + o] * Wg[(size_t)(2048 + 4 * n + o) * 4 + hh];
            }
        }
        gct[idx] = f2bf(v);
    }
}

struct GateGrp { u32x4 row[4][4]; };
__device__ __forceinline__ void gate_load_grp(const bf16_t* xm, int t, int s, int chb, GateGrp& B) {
#pragma unroll
    for (int q = 0; q < 4; ++q)
#pragma unroll
        for (int kk = 0; kk < 4; ++kk) B.row[q][kk] = (s - 3 + kk >= 0) ? *(const u32x4*)(xm + (size_t)(t - 3 + kk) * DM + chb + 32 * q) : (u32x4){0u, 0u, 0u, 0u};
}
__device__ __forceinline__ f32x4 gate_step(const LAS float* cwl, const LAS bf16_t* gtl, int tok, int ch0, const u32x4 (&row)[4], f32x4 acc) {
    float xc[8];
    {
        const f32x4 b0 = *(const LAS f32x4*)(cwl + 4 * 1024 + ch0), b1 = *(const LAS f32x4*)(cwl + 4 * 1024 + ch0 + 4);
        xc[0] = b0.x; xc[1] = b0.y; xc[2] = b0.z; xc[3] = b0.w; xc[4] = b1.x; xc[5] = b1.y; xc[6] = b1.z; xc[7] = b1.w;
    }
#pragma unroll
    for (int kk = 0; kk < 4; ++kk) {
        float xf[8]; unpack8(row[kk], xf);
        const f32x4 w0 = *(const LAS f32x4*)(cwl + kk * 1024 + ch0), w1 = *(const LAS f32x4*)(cwl + kk * 1024 + ch0 + 4);
        xc[0] += w0.x * xf[0]; xc[1] += w0.y * xf[1]; xc[2] += w0.z * xf[2]; xc[3] += w0.w * xf[3];
        xc[4] += w1.x * xf[4]; xc[5] += w1.y * xf[5]; xc[6] += w1.z * xf[6]; xc[7] += w1.w * xf[7];
    }
#pragma unroll
    for (int i = 0; i < 8; ++i) xc[i] = siluf_(xc[i]);
    u32x4 a1; a1.x = pk2(xc[0], xc[1]); a1.y = pk2(xc[2], xc[3]); a1.z = pk2(xc[4], xc[5]); a1.w = pk2(xc[6], xc[7]);
    const u32x4 b1 = *(const LAS u32x4*)(gtl + tok * 1032 + ch0);
    const u32x4 b2 = *(const LAS u32x4*)(gtl + (16 + tok) * 1032 + ch0);
    acc = __builtin_amdgcn_mfma_f32_16x16x32_bf16(__builtin_bit_cast(bf16x8, a1), __builtin_bit_cast(bf16x8, b1), acc, 0, 0, 0);
    acc = __builtin_amdgcn_mfma_f32_16x16x32_bf16(__builtin_bit_cast(bf16x8, row[3]), __builtin_bit_cast(bf16x8, b2), acc, 0, 0, 0);
    return acc;
}
__device__ __forceinline__ void phase_gates(const MegaArgs& a, LAS unsigned char* lds, int tid, int gw, int NGW, int lane) {
    unsigned char* ws = a.ws;
    const bf16_t* xm = (const bf16_t*)(ws + WS_XM);
    const bf16_t* gct = (const bf16_t*)(ws + WS_GCT);
    const float* big = a.in[9]; const float* bfg = a.in[11];
    float* logi = (float*)(ws + WS_LOGI); float* logf = (float*)(ws + WS_LOGF);
    LAS float* cwl = (LAS float*)lds;
    LAS bf16_t* gtl = (LAS bf16_t*)(lds + 20480);
    for (int i = tid; i < 5 * 1024; i += NWAVES * 64) cwl[i] = (i < 4096) ? a.in[3][i] : a.in[4][i - 4096];
    for (int i = tid; i < 32 * 128; i += NWAVES * 64) { const int r = i >> 7, c8 = i & 127; *(LAS u32x4*)(gtl + r * 1032 + 8 * c8) = *(const u32x4*)(gct + (size_t)r * 1024 + 8 * c8); }
    __syncthreads();
    const int tok = lane & 15, kq = lane >> 4;
    for (int tile = gw; tile < NTOK / 16; tile += NGW) {
        const int t = tile * 16 + tok, s = t & (SEQ - 1);
        f32x4 acc = (f32x4){0.f, 0.f, 0.f, 0.f};
        GateGrp A, B;
        gate_load_grp(xm, t, s, 8 * kq, A);
        for (int g = 0; g < 8; g += 2) {
            gate_load_grp(xm, t, s, 128 * (g + 1) + 8 * kq, B);
#pragma unroll
            for (int q = 0; q < 4; ++q) acc = gate_step(cwl, gtl, tok, 128 * g + 32 * q + 8 * kq, A.row[q], acc);
            if (g + 2 < 8) gate_load_grp(xm, t, s, 128 * (g + 2) + 8 * kq, A);
#pragma unroll
            for (int q = 0; q < 4; ++q) acc = gate_step(cwl, gtl, tok, 128 * (g + 1) + 32 * q + 8 * kq, B.row[q], acc);
        }
        const int col = lane & 15;
        if (col < 8) {
            const int hh = col & 3;
#pragma unroll
            for (int r = 0; r < 4; ++r) {
                const int tt = tile * 16 + 4 * kq + r;
                if (col < 4) logi[(size_t)hh * NTOK + tt] = acc[r] + big[hh];
                else logf[(size_t)hh * NTOK + tt] = logsigmoidf_(acc[r] + bfg[hh]);
            }
        }
    }
    __syncthreads();
}

__device__ __forceinline__ void phase_prep(const MegaArgs& a, LAS unsigned char* lds, int tid, int lane, int wave, int G) {
    unsigned char* ws = a.ws;
    const float* logi = (const float*)(ws + WS_LOGI); const float* logf = (const float*)(ws + WS_LOGF);
    float* Fcum = (float*)(ws + WS_FCUM); float* Uval = (float*)(ws + WS_UVAL); float* Mval = (float*)(ws + WS_MVAL);
    float* items = (float*)(ws + WS_ITEMS); float* dn = (float*)(ws + WS_DN);
    const bf16_t* xm = (const bf16_t*)(ws + WS_XM);
    bf16_t* qb = (bf16_t*)(ws + WS_QB); bf16_t* kb = (bf16_t*)(ws + WS_KB); bf16_t* aext = (bf16_t*)(ws + WS_AEXT); bf16_t* bext = (bf16_t*)(ws + WS_BEXT); bf16_t* kwt = (bf16_t*)(ws + WS_KWT);
    const float* cw = a.in[3]; const float* cb = a.in[4]; const float* wq = a.in[5]; const float* wk = a.in[6]; const float* wv = a.in[7];
    LAS float* gch = (LAS float*)lds;
    LAS float* umaxch = gch + 32;
    LAS float* wint_l = umaxch + 32;
    LAS float* wst_l = wint_l + 256;
    LAS float* dn_l = wst_l + 256;
    LAS float* wtl = dn_l + 8 * 256;
    for (int it = blockIdx.x; it < 512; it += G) {
        const int bh = it >> 5, c = it & 31, b = bh >> 2, h = bh & 3;
        const int tb = b * SEQ, t0 = tb + c * 256;
        {
            const int cc = tid >> 4, sub = tid & 15;
            const size_t gbase = (size_t)h * NTOK + tb + cc * 256 + 16 * sub;
            float F[16], u[16];
            {
                const f32x4* lfp = (const f32x4*)(logf + gbase); const f32x4* lip = (const f32x4*)(logi + gbase);
#pragma unroll
                for (int q4 = 0; q4 < 4; ++q4) { const f32x4 v = lfp[q4], w = lip[q4]; F[4 * q4] = v.x; F[4 * q4 + 1] = v.y; F[4 * q4 + 2] = v.z; F[4 * q4 + 3] = v.w; u[4 * q4] = w.x; u[4 * q4 + 1] = w.y; u[4 * q4 + 2] = w.z; u[4 * q4 + 3] = w.w; }
            }
#pragma unroll
            for (int jj = 1; jj < 16; ++jj) F[jj] += F[jj - 1];
            const float total = F[15];
            float incl = total;
#pragma unroll
            for (int o = 1; o < 16; o <<= 1) { const float v = __shfl_up(incl, o, 16); if (sub >= o) incl += v; }
            const float excl = incl - total;
            float um = -3.0e38f;
#pragma unroll
            for (int jj = 0; jj < 16; ++jj) { F[jj] += excl; u[jj] -= F[jj]; um = fmaxf(um, u[jj]); }
            float umx = um;
#pragma unroll
            for (int o = 1; o < 16; o <<= 1) umx = fmaxf(umx, __shfl_xor(umx, o, 16));
            const float gsum = __shfl(incl, 15, 16);
            if (sub == 0) { gch[cc] = gsum; umaxch[cc] = umx; }
            float cm[16]; cm[0] = u[0];
#pragma unroll
            for (int jj = 1; jj < 16; ++jj) cm[jj] = fmaxf(cm[jj - 1], u[jj]);
            float inclm = cm[15];
#pragma unroll
            for (int o = 1; o < 16; o <<= 1) { const float v = __shfl_up(inclm, o, 16); if (sub >= o) inclm = fmaxf(inclm, v); }
            float exclm = __shfl_up(inclm, 1, 16); if (sub == 0) exclm = -3.0e38f;
            __syncthreads();
            float m = 0.f;
            for (int c2 = 0; c2 < c; ++c2) m = gch[c2] + fmaxf(m, umaxch[c2]);
            const float mprev = m, g_c = gch[c], umax_c = umaxch[c], m_c = g_c + fmaxf(mprev, umax_c);
            if (tid == 0) { items[it] = __expf(g_c + mprev - m_c); items[512 + it] = __expf(g_c + umax_c - m_c); items[1024 + it] = mprev; }
            if (cc == c) {
#pragma unroll
                for (int jj = 0; jj < 16; ++jj) {
                    const float M = fmaxf(mprev, fmaxf(cm[jj], exclm));
                    Fcum[gbase + jj] = F[jj]; Uval[gbase + jj] = u[jj]; Mval[gbase + jj] = M;
                    wint_l[16 * sub + jj] = __expf(mprev - M); wst_l[16 * sub + jj] = __expf(u[jj] - umax_c);
                }
            }
            __syncthreads();
        }
        {
            const int ch = h * 256 + 4 * lane;
            float cwv[4][4];
            const f32x4 cbv = *(const f32x4*)(cb + ch);
#pragma unroll
            for (int kk = 0; kk < 4; ++kk) { const f32x4 w = *(const f32x4*)(cw + kk * DM + ch); cwv[kk][0] = w.x; cwv[kk][1] = w.y; cwv[kk][2] = w.z; cwv[kk][3] = w.w; }
            for (int i = tid; i < 768; i += NWAVES * 64) {
                const int mat = i >> 8, q4 = (i >> 6) & 3, ln = i & 63;
                const float* src = (mat == 0 ? wq : (mat == 1 ? wk : wv)) + (h * 64 + ln) * 16 + 4 * q4;
                *(LAS f32x4*)(wtl + 4 * i) = *(const f32x4*)src;
            }
            __syncthreads();
            const __amdgpu_buffer_rsrc_t xrs = __builtin_amdgcn_make_buffer_rsrc((void*)xm, 0, NTOK * 2048, 0x00020000);
            LAS unsigned* tile_v = (LAS unsigned*)(lds + 24576);
            LAS unsigned* tile_k = tile_v + 64 * 129;
            u32x2 cur[11], nx[11];
#define PREP_LOAD(R, p_) do { _Pragma("unroll") for (int r = 0; r < 11; ++r) { const int sp = c * 256 + 64 * (p_) + 8 * wave - 3 + r; \
                R[r] = (sp >= 0) ? (u32x2)__builtin_amdgcn_raw_buffer_load_b64(xrs, ch * 2, (t0 + 64 * (p_) + 8 * wave - 3 + r) * 2048, 0) : (u32x2){0u, 0u}; } } while (0)
            PREP_LOAD(cur, 0);
            float dnacc[4] = {0.f, 0.f, 0.f, 0.f};
#pragma unroll 1
            for (int pb = 0; pb < 4; ++pb) {
                if (pb < 3) PREP_LOAD(nx, pb + 1);
#pragma unroll
                for (int pp = 0; pp < 8; ++pp) {
                    const int i = 64 * pb + 8 * wave + pp;
                    const f32x4 x0v = up4(cur[pp]), x1v = up4(cur[pp + 1]), x2v = up4(cur[pp + 2]), x3v = up4(cur[pp + 3]);
                    float x3[4]; x3[0] = x3v.x; x3[1] = x3v.y; x3[2] = x3v.z; x3[3] = x3v.w;
                    float xc[4];
#pragma unroll
                    for (int cc = 0; cc < 4; ++cc) xc[cc] = siluf_(cbv[cc] + cwv[0][cc] * x0v[cc] + cwv[1][cc] * x1v[cc] + cwv[2][cc] * x2v[cc] + cwv[3][cc] * x3v[cc]);
                    float qv[4], kv[4], vv[4];
                    {
                        f32x4 qa = (f32x4){0.f, 0.f, 0.f, 0.f}, ka = qa, va = qa;
#pragma unroll
                        for (int q4 = 0; q4 < 4; ++q4) {
                            qa = qa + *(const LAS f32x4*)(wtl + ((0 * 4 + q4) * 64 + lane) * 4) * xc[q4];
                            ka = ka + *(const LAS f32x4*)(wtl + ((1 * 4 + q4) * 64 + lane) * 4) * xc[q4];
                            va = va + *(const LAS f32x4*)(wtl + ((2 * 4 + q4) * 64 + lane) * 4) * x3[q4];
                        }
#pragma unroll
                        for (int o = 0; o < 4; ++o) { qv[o] = qa[o] * 0.0625f; kv[o] = ka[o]; vv[o] = va[o]; }
                    }
                    const float wi = wint_l[i], wsj = wst_l[i];
                    u32x2 o2;
                    o2.x = pk2(qv[0], qv[1]); o2.y = pk2(qv[2], qv[3]);
                    *(u32x2*)(qb + (size_t)(t0 + i) * DM + ch) = o2;
                    o2.x = pk2(kv[0], kv[1]); o2.y = pk2(kv[2], kv[3]);
                    *(u32x2*)(kb + (size_t)(t0 + i) * DM + ch) = o2;
                    o2.x = pk2(qv[0] * wi, qv[1] * wi); o2.y = pk2(qv[2] * wi, qv[3] * wi);
                    *(u32x2*)(aext + ((size_t)it * 256 + i) * 512 + 256 + 4 * lane) = o2;
                    float kwv[4];
#pragma unroll
                    for (int o = 0; o < 4; ++o) { kwv[o] = kv[o] * wsj; dnacc[o] += kwv[o]; }
                    const int tr = (8 * wave + pp) * 129 + 2 * lane;
                    tile_v[tr] = pk2(vv[0], vv[1]); tile_v[tr + 1] = pk2(vv[2], vv[3]);
                    tile_k[tr] = pk2(kwv[0], kwv[1]); tile_k[tr + 1] = pk2(kwv[2], kwv[3]);
                }
                __syncthreads();
#pragma unroll
                for (int kq = 0; kq < 4; ++kq) {
                    const int pid = tid + 512 * kq, chr = pid >> 3, jg = pid & 7;
                    const LAS unsigned short* tv = (const LAS unsigned short*)tile_v + (8 * jg) * 258 + chr;
                    const LAS unsigned short* tk = (const LAS unsigned short*)tile_k + (8 * jg) * 258 + chr;
                    u32x4 ov, ok;
                    ov.x = (unsigned)tv[0 * 258] | ((unsigned)tv[1 * 258] << 16); ov.y = (unsigned)tv[2 * 258] | ((unsigned)tv[3 * 258] << 16);
                    ov.z = (unsigned)tv[4 * 258] | ((unsigned)tv[5 * 258] << 16); ov.w = (unsigned)tv[6 * 258] | ((unsigned)tv[7 * 258] << 16);
                    ok.x = (unsigned)tk[0 * 258] | ((unsigned)tk[1 * 258] << 16); ok.y = (unsigned)tk[2 * 258] | ((unsigned)tk[3 * 258] << 16);
                    ok.z = (unsigned)tk[4 * 258] | ((unsigned)tk[5 * 258] << 16); ok.w = (unsigned)tk[6 * 258] | ((unsigned)tk[7 * 258] << 16);
                    *(u32x4*)(bext + ((size_t)it * 256 + chr) * 512 + 64 * pb + 8 * jg) = ov;
                    *(u32x4*)(kwt + ((size_t)it * 256 + chr) * 256 + 64 * pb + 8 * jg) = ok;
                }
                __syncthreads();
#pragma unroll
                for (int r = 0; r < 11; ++r) cur[r] = nx[r];
            }
#undef PREP_LOAD
#pragma unroll
            for (int o = 0; o < 4; ++o) dn_l[wave * 256 + 4 * lane + o] = dnacc[o];
            __syncthreads();
            if (tid < 256) {
                float s = 0.f;
#pragma unroll
                for (int w = 0; w < 8; ++w) s += dn_l[w * 256 + tid];
                dn[(size_t)it * 256 + tid] = s;
            }
            __syncthreads();
        }
    }
}

__device__ __forceinline__ void tr_subtile(const bf16_t* src, int lds_src, bf16_t* dst, int lds_dst, LAS unsigned short* tile, int lane) {
    const int rr = lane >> 3, pc = lane & 7;
    u32x4 v[8];
#pragma unroll
    for (int s2 = 0; s2 < 8; ++s2) v[s2] = *(const u32x4*)(src + (size_t)(rr + 8 * s2) * lds_src + 8 * pc);
#pragma unroll
    for (int s2 = 0; s2 < 8; ++s2) {
        LAS unsigned* tp = (LAS unsigned*)(tile + (rr + 8 * s2) * 66 + 8 * pc);
        tp[0] = v[s2].x; tp[1] = v[s2].y; tp[2] = v[s2].z; tp[3] = v[s2].w;
    }
    asm volatile("s_waitcnt lgkmcnt(0)" ::: "memory");
#pragma unroll
    for (int s2 = 0; s2 < 8; ++s2) {
        const int c = rr + 8 * s2;
        const LAS unsigned short* tp = tile + (8 * pc) * 66 + c;
        u32x4 o;
        o.x = (unsigned)tp[0 * 66] | ((unsigned)tp[1 * 66] << 16); o.y = (unsigned)tp[2 * 66] | ((unsigned)tp[3 * 66] << 16);
        o.z = (unsigned)tp[4 * 66] | ((unsigned)tp[5 * 66] << 16); o.w = (unsigned)tp[6 * 66] | ((unsigned)tp[7 * 66] << 16);
        *(u32x4*)(dst + (size_t)c * lds_dst + 8 * pc) = o;
    }
    asm volatile("s_waitcnt lgkmcnt(0)" ::: "memory");
}
__device__ __forceinline__ void phase_transposes(const MegaArgs& a, LAS unsigned char* lds, int wave, int lane, int G) {
    unsigned char* ws = a.ws;
    bf16_t* aext = (bf16_t*)(ws + WS_AEXT); bf16_t* bext = (bf16_t*)(ws + WS_BEXT); bf16_t* kwt = (bf16_t*)(ws + WS_KWT);
    LAS unsigned short* tile = (LAS unsigned short*)(lds + wave * 16384);
    for (int it = blockIdx.x; it < 512; it += G) {
        for (int job = wave; job < 32; job += NWAVES) {
            const int arr = job >> 4, sj = (job >> 2) & 3, sc = job & 3;
            if (arr == 0) tr_subtile(bext + ((size_t)it * 256 + 64 * sj) * 512 + 256 + 64 * sc, 512, bext + ((size_t)it * 256 + 64 * sc) * 512 + 64 * sj, 512, tile, lane);
            else          tr_subtile(aext + ((size_t)it * 256 + 64 * sj) * 512 + 64 * sc, 512, kwt + ((size_t)it * 256 + 64 * sc) * 256 + 64 * sj, 256, tile, lane);
        }
    }
    asm volatile("s_waitcnt vmcnt(0)" ::: "memory");
    __syncthreads();
}

struct ItemOrder {
    const char* A; const char* B; size_t a_item_bytes, b_item_bytes; int per_token; int G, c;
    __device__ __forceinline__ bool next(int i, pg8::Unit& u) const {
        const int it = i * G + c; if (it >= 512) return false;
        u.pm = it; u.pn = 0; u.aux = i; u.gidx = nullptr; u.gl = 0;
        if (per_token) { const int bh = it >> 5, cc = it & 31, b = bh >> 2, h = bh & 3; const size_t off = ((size_t)(b * SEQ + cc * 256) * DM + h * 256) * 2; u.A = A + off; u.B = B + off; }
        else { u.A = A + (size_t)it * a_item_bytes; u.B = B + (size_t)it * b_item_bytes; }
        return true;
    }
};
struct EpiP {
    const float* Uval; const float* Mval; bf16_t* aext;
    __device__ __forceinline__ void operator()(const f32x4 (&acc)[2][2][4][2], const pg8::Unit& un, int wr, int wc, int fr, int fq) const {
        const int it = un.pm, bh = it >> 5, cc = it & 31, b = bh >> 2, h = bh & 3;
        const size_t gb = (size_t)h * NTOK + b * SEQ + cc * 256;
        const int jb = wc * 32 + 8 * fq;
        float Mv[2][4];
#pragma unroll
        for (int ai = 0; ai < 2; ++ai)
#pragma unroll
            for (int m = 0; m < 4; ++m) Mv[ai][m] = Mval[gb + ai * 128 + wr * 64 + m * 16 + fr];
#pragma unroll
        for (int bj = 0; bj < 2; ++bj) {
            f32x4 uj[2];
#pragma unroll
            for (int n = 0; n < 2; ++n) uj[n] = *(const f32x4*)(Uval + gb + bj * 128 + jb + 4 * n);
#pragma unroll
            for (int ai = 0; ai < 2; ++ai)
#pragma unroll
                for (int m = 0; m < 4; ++m) {
                    const int i = ai * 128 + wr * 64 + m * 16 + fr;
                    const float Mi = Mv[ai][m];
                    f32x4 o[2];
#pragma unroll
                    for (int n = 0; n < 2; ++n)
#pragma unroll
                        for (int jj = 0; jj < 4; ++jj) {
                            const int j = bj * 128 + jb + 4 * n + jj;
                            o[n][jj] = (j <= i) ? acc[ai][bj][m][n][jj] * __expf(uj[n][jj] - Mi) : 0.f;
                        }
                    u32x4 w; w.x = pg8::cvt_pk_bf16(o[0][0], o[0][1]); w.y = pg8::cvt_pk_bf16(o[0][2], o[0][3]); w.z = pg8::cvt_pk_bf16(o[1][0], o[1][1]); w.w = pg8::cvt_pk_bf16(o[1][2], o[1][3]);
                    *(u32x4*)(aext + ((size_t)it * 256 + i) * 512 + bj * 128 + jb) = w;
                    asm volatile("" ::: "memory");
                }
        }
    }
};
struct EpiDC {
    bf16_t* dct;
    __device__ __forceinline__ void operator()(const f32x4 (&acc)[2][2][4][2], const pg8::Unit& un, int wr, int wc, int fr, int fq) const {
        const int it = un.pm; const int cb0 = wc * 32 + 8 * fq;
#pragma unroll
        for (int ai = 0; ai < 2; ++ai)
#pragma unroll
            for (int m = 0; m < 4; ++m) {
                const int r = ai * 128 + wr * 64 + m * 16 + fr;
#pragma unroll
                for (int bj = 0; bj < 2; ++bj) {
                    const f32x4 v0 = acc[ai][bj][m][0], v1 = acc[ai][bj][m][1];
                    u32x4 w; w.x = pg8::cvt_pk_bf16(v0[0], v0[1]); w.y = pg8::cvt_pk_bf16(v0[2], v0[3]); w.z = pg8::cvt_pk_bf16(v1[0], v1[1]); w.w = pg8::cvt_pk_bf16(v1[2], v1[3]);
                    *(u32x4*)(dct + ((size_t)it * 256 + r) * 256 + bj * 128 + cb0) = w;
                }
            }
    }
};
struct EpiO {
    LAS const float* rinv; bf16_t* hm;
    __device__ __forceinline__ void operator()(const f32x4 (&acc)[2][2][4][2], const pg8::Unit& un, int wr, int wc, int fr, int fq) const {
        const int it = un.pm, bh = it >> 5, cc = it & 31, b = bh >> 2, h = bh & 3;
        const size_t t0 = (size_t)b * SEQ + cc * 256; const int eb = wc * 32 + 8 * fq;
#pragma unroll
        for (int ai = 0; ai < 2; ++ai)
#pragma unroll
            for (int m = 0; m < 4; ++m) {
                const int i = ai * 128 + wr * 64 + m * 16 + fr;
                const float ri = rinv[un.aux * 256 + i];
#pragma unroll
                for (int bj = 0; bj < 2; ++bj) {
                    const f32x4 v0 = acc[ai][bj][m][0] * ri, v1 = acc[ai][bj][m][1] * ri;
                    u32x4 w; w.x = pg8::cvt_pk_bf16(v0[0], v0[1]); w.y = pg8::cvt_pk_bf16(v0[2], v0[3]); w.z = pg8::cvt_pk_bf16(v1[0], v1[1]); w.w = pg8::cvt_pk_bf16(v1[2], v1[3]);
                    *(u32x4*)(hm + (t0 + i) * DM + h * 256 + bj * 128 + eb) = w;
                }
            }
    }
};

__device__ __forceinline__ void phase_scan(const MegaArgs& a, int tid) {
    unsigned char* ws = a.ws;
    const float* items = (const float*)(ws + WS_ITEMS); const bf16_t* dct = (const bf16_t*)(ws + WS_DCT); bf16_t* bext = (bf16_t*)(ws + WS_BEXT);
    const float* dn = (const float*)(ws + WS_DN); float* nprev = (float*)(ws + WS_NPREV);
    int tid_o = tid; asm volatile("" : "+v"(tid_o));
    const int gid = blockIdx.x * (NWAVES * 64) + tid_o;
    if (gid < 16 * 256 * 32) {
        const int bh = gid >> 13, e = (gid >> 5) & 255, d8 = gid & 31;
        float st[8];
#pragma unroll
        for (int i = 0; i < 8; ++i) st[i] = 0.f;
        u32x4 rA[4], rB[4]; float decA[4], scA[4], decB[4], scB[4];
#define SCAN_LOAD(R, D, S, c0) do { _Pragma("unroll") for (int q = 0; q < 4; ++q) { const int it_ = bh * 32 + (c0) + q; R[q] = *(const u32x4*)(dct + ((size_t)it_ * 256 + e) * 256 + 8 * d8); D[q] = items[it_]; S[q] = items[512 + it_]; } } while (0)
#define SCAN_STEP(R, D, S, c0) do { _Pragma("unroll") for (int q = 0; q < 4; ++q) { const int it_ = bh * 32 + (c0) + q; \
            u32x4 w; w.x = pk2(st[0], st[1]); w.y = pk2(st[2], st[3]); w.z = pk2(st[4], st[5]); w.w = pk2(st[6], st[7]); \
            *(u32x4*)(bext + ((size_t)it_ * 256 + e) * 512 + 256 + 8 * d8) = w; \
            float dv[8]; unpack8(R[q], dv); \
            _Pragma("unroll") for (int i = 0; i < 8; ++i) st[i] = D[q] * st[i] + S[q] * dv[i]; } } while (0)
        SCAN_LOAD(rA, decA, scA, 0);
        for (int c0 = 0; c0 < 32; c0 += 8) {
            SCAN_LOAD(rB, decB, scB, c0 + 4);
            SCAN_STEP(rA, decA, scA, c0);
            if (c0 + 8 < 32) SCAN_LOAD(rA, decA, scA, c0 + 8);
            SCAN_STEP(rB, decB, scB, c0 + 4);
        }
#undef SCAN_LOAD
#undef SCAN_STEP
    }
    if (gid < 16 * 256) {
        const int bh = gid >> 8, d = gid & 255;
        float dnv[32], dcv[32], scv[32];
#pragma unroll
        for (int c = 0; c < 32; ++c) { const int it = bh * 32 + c; dnv[c] = dn[(size_t)it * 256 + d]; dcv[c] = items[it]; scv[c] = items[512 + it]; }
        float st = 0.f;
#pragma unroll
        for (int c = 0; c < 32; ++c) { const int it = bh * 32 + c; nprev[(size_t)it * 256 + d] = st; st = dcv[c] * st + scv[c] * dnv[c]; }
    }
}

__device__ __forceinline__ void g3_rinv(const MegaArgs& a, LAS unsigned char* lds, int wave, int lane, int G) {
    unsigned char* ws = a.ws;
    const bf16_t* aext = (const bf16_t*)(ws + WS_AEXT); const float* nprev = (const float*)(ws + WS_NPREV);
    const float* Fcum = (const float*)(ws + WS_FCUM); const float* Mval = (const float*)(ws + WS_MVAL);
    LAS float* rinv = (LAS float*)(lds + RINV_OFF);
    const int l16 = lane & 15, rsub = lane >> 4;
    for (int ui = 0; ui < 2; ++ui) {
        const int it = ui * G + blockIdx.x; if (it >= 512) break;
        const int bh = it >> 5, cc = it & 31, b = bh >> 2, h = bh & 3;
        f32x4 nv[2][2];
#pragma unroll
        for (int pz = 0; pz < 2; ++pz) { const f32x4* np = (const f32x4*)(nprev + (size_t)it * 256 + 8 * (l16 + 16 * pz)); nv[pz][0] = np[0]; nv[pz][1] = np[1]; }
        u32x4 pc[8][4];
#pragma unroll
        for (int ps = 0; ps < 8; ++ps) {
            const u32x4* rowp = (const u32x4*)(aext + ((size_t)it * 256 + 32 * ps + 4 * wave + rsub) * 512);
#pragma unroll
            for (int q = 0; q < 4; ++q) pc[ps][q] = rowp[l16 + 16 * q];
        }
#pragma unroll
        for (int ps = 0; ps < 8; ++ps) {
            float s = 0.f;
#pragma unroll
            for (int q = 0; q < 2; ++q) { float f[8]; unpack8(pc[ps][q], f); s += ((f[0] + f[1]) + (f[2] + f[3])) + ((f[4] + f[5]) + (f[6] + f[7])); }
#pragma unroll
            for (int q = 0; q < 2; ++q) { float f[8]; unpack8(pc[ps][2 + q], f); const f32x4 n0 = nv[q][0], n1 = nv[q][1];
                s += (f[0] * n0.x + f[1] * n0.y + f[2] * n0.z + f[3] * n0.w) + (f[4] * n1.x + f[5] * n1.y + f[6] * n1.z + f[7] * n1.w); }
            s += dpp_mov_f<0xB1>(s); s += dpp_mov_f<0x4E>(s); s += dpp_mov_f<0x124>(s); s += dpp_mov_f<0x128>(s);
            const int i = 32 * ps + 4 * wave + rsub;
            const size_t gi = (size_t)h * NTOK + b * SEQ + cc * 256 + i;
            if (l16 == 0) { const float mi = Fcum[gi] + Mval[gi]; rinv[ui * 256 + i] = 1.0f / fmaxf(fabsf(s), __expf(-mi)); }
        }
    }
    __syncthreads();
}

#ifndef NG1_SPLIT
#define NG1_SPLIT 256
#endif
#ifndef STAG1
#define STAG1 0
#endif
#ifndef STAG12
#define STAG12 0
#endif
__global__ void __launch_bounds__(NWAVES * 64, 2) mega_fwd(MegaArgs args) {
    extern __shared__ __attribute__((aligned(16))) unsigned char lds_raw[];
    LAS unsigned char* lds = (LAS unsigned char*)lds_raw;
    const int wave = __builtin_amdgcn_readfirstlane(threadIdx.x >> 6);
#define lane lane_id()
#define tid ((wave << 6) | lane_id())
    const int G = gridDim.x;
    const int gw = blockIdx.x * NWAVES + wave, NGW = G * NWAVES;
    unsigned char* ws = args.ws;
    unsigned* ctl = (unsigned*)(ws + WS_CTL);
    for (int u = tid; u < (LDS_BYTES - LDSCTL_OFF) / 4; u += NWAVES * 64) ((LAS unsigned*)(lds + LDSCTL_OFF))[u] = 0u;
    __syncthreads();
    XcdBarrier bar = xcd_barrier_post(ctl + CW_BAR + args.li * XCD_BAR_WORDS, (volatile LAS unsigned*)(lds + LDSCTL_OFF + 64), wave);
    const int lo = args.ph_lo, hi = args.ph_hi;
#define IN(k) (lo <= (k) && (k) < hi)
#define BOTH(k) (IN(k) && IN((k) + 1))

    if (IN(0)) { p0_prologue(args, lds, gw, NGW, wave, lane); if (NG1_SPLIT >= 256) p0b_weights(args, lds, gw, NGW, wave, lane);
        p0_gate_tables(args, gw, NGW, lane); p0_router_tables(args, gw, NGW, lane); if (BOTH(0)) xcd_barrier(bar); }

    if (IN(1)) {
        const int NG1 = NG1_SPLIT;
        if ((int)blockIdx.x < NG1) {
            pg8::DenseOrder S; S.init(ws + WS_R1, ws + WS_BTIN, NTOK, DPROJ, DM, DM, NG1, (int)blockIdx.x);
            EpiInProj E{(const float*)(ws + WS_RSTD1), (bf16_t*)(ws + WS_XM), (bf16_t*)(ws + WS_SZ), (bf16_t*)(ws + WS_U), args.pad};
            pg8::gemm_phase<EpiInProj, pg8::DenseOrder, false>(lds, wave, DM, DM, DM, S, E, 0x7F7F7F7F, 0x7F7F7F7F, STAG1);
        } else {
            p0b_weights(args, lds, ((int)blockIdx.x - NG1) * NWAVES + wave, (G - NG1) * NWAVES, wave, lane);
        }
        if (BOTH(1)) xcd_barrier(bar);
    }
    if (IN(2)) { phase_gates(args, lds, tid, gw, NGW, lane); if (BOTH(2)) xcd_barrier(bar); }
    if (IN(3)) { phase_prep(args, lds, tid, lane, wave, G); if (BOTH(3)) xcd_barrier(bar); }
    if (IN(4)) {
        {
            ItemOrder S; S.A = (const char*)(ws + WS_QB); S.B = (const char*)(ws + WS_KB); S.a_item_bytes = 0; S.b_item_bytes = 0; S.per_token = 1; S.G = G; S.c = (int)blockIdx.x;
            EpiP E{(const float*)(ws + WS_UVAL), (const float*)(ws + WS_MVAL), (bf16_t*)(ws + WS_AEXT)};
            pg8::gemm_phase<EpiP, ItemOrder, false>(lds, wave, 256, DM, DM, S, E);
        }
        {
            ItemOrder S; S.A = (const char*)(ws + WS_BEXT); S.B = (const char*)(ws + WS_KWT); S.a_item_bytes = (size_t)256 * 512 * 2; S.b_item_bytes = (size_t)256 * 256 * 2; S.per_token = 0; S.G = G; S.c = (int)blockIdx.x;
            EpiDC E{(bf16_t*)(ws + WS_DCT)};
            pg8::gemm_phase<EpiDC, ItemOrder, false>(lds, wave, 256, 512, 256, S, E);
        }
        if (BOTH(4)) xcd_barrier(bar);
    }
    if (IN(5)) {
        if ((blockIdx.x >> 3) & 1) { phase_conv31(args, lds, tid, lane, wave, G); phase_scan(args, tid); }
        else { phase_scan(args, tid); phase_conv31(args, lds, tid, lane, wave, G); }
        if (BOTH(5)) xcd_barrier(bar);
    }
    if (IN(6)) {
        g3_rinv(args, lds, wave, lane, G);
        ItemOrder S; S.A = (const char*)(ws + WS_AEXT); S.B = (const char*)(ws + WS_BEXT); S.a_item_bytes = (size_t)256 * 512 * 2; S.b_item_bytes = (size_t)256 * 512 * 2; S.per_token = 0; S.G = G; S.c = (int)blockIdx.x;
        EpiO E{(LAS const float*)(lds + RINV_OFF), (bf16_t*)(ws + WS_HM)};
        pg8::gemm_phase<EpiO, ItemOrder, false>(lds, wave, 512, 512, 512, S, E);
        if (BOTH(6)) xcd_barrier(bar);
    }
    if (IN(7)) { phase_ym(args, lds, tid, gw, NGW, lane); if (BOTH(7)) xcd_barrier(bar); }
    if (IN(8)) {
        EpiOutProj E{args.in[0], (bf16_t*)(ws + WS_HB16), ws + WS_HBF};
#if OUTPROJ_FP8
        pg8::DenseOrder S; S.init(ws + WS_YMIX, ws + WS_BTOUT, NTOK, DM, 1024, 1024, G, (int)blockIdx.x);
        pg8::gemm_phase<EpiOutProj, pg8::DenseOrder, false, true>(lds, wave, 1024, 1024, 1024, S, E, 0x7A7A7A7A, 0x7F7F7F7F);
#else
        pg8::DenseOrder S; S.init(ws + WS_YMIX, ws + WS_BTOUT, NTOK, DM, 2048, 2048, G, (int)blockIdx.x);
        pg8::gemm_phase<EpiOutProj, pg8::DenseOrder, false>(lds, wave, 2048, 2048, 2048, S, E);
#endif
        if (BOTH(8)) xcd_barrier(bar);
    }
    if (IN(9)) { phase_router(args, lds, tid, lane, wave); if (BOTH(9)) xcd_barrier(bar); }
    if (IN(10)) { phase_slots(args, lds, tid); if (BOTH(10)) xcd_barrier(bar); }
    if (IN(11)) {
        const int T = __builtin_amdgcn_readfirstlane(__hip_atomic_load((const int*)(ws + WS_TILEEXP) + 2048, __ATOMIC_RELAXED, __HIP_MEMORY_SCOPE_AGENT));
        MoeOrder S; S.A = (const char*)(ws + WS_HBF); S.Bt = (const char*)(ws + WS_BT1); S.gidx = (const int*)(ws + WS_STOK); S.tile_exp = (const int*)(ws + WS_TILEEXP);
        S.a_tile_bytes = 0; S.b_exp_bytes = (size_t)2048 * 1024; S.b_tile_bytes = (size_t)256 * 1024; S.T = T; S.nN = 8; S.group = 4; S.c = (int)blockIdx.x;
        EpiMoe1 E{(const float*)(ws + WS_SRSTD), args.in[23], ws + WS_ACT, args.pad};
        pg8::gemm_phase<EpiMoe1, MoeOrder, true, true>(lds, wave, DM / 2, DM / 2, DM / 2, S, E, 0x7A7A7A7A, 0x7F7F7F7F);
        if (BOTH(11)) xcd_barrier(bar);
    }
    if (IN(12)) {
        const int T = __builtin_amdgcn_readfirstlane(__hip_atomic_load((const int*)(ws + WS_TILEEXP) + 2048, __ATOMIC_RELAXED, __HIP_MEMORY_SCOPE_AGENT));
        MoeOrder S; S.A = (const char*)(ws + WS_ACT); S.Bt = (const char*)(ws + WS_BT2); S.gidx = nullptr; S.tile_exp = (const int*)(ws + WS_TILEEXP);
        S.a_tile_bytes = (size_t)256 * 1024; S.b_exp_bytes = (size_t)1024 * 1024; S.b_tile_bytes = (size_t)256 * 1024; S.T = T; S.nN = 4; S.group = 8; S.c = (int)blockIdx.x;
        EpiMoe2 E{(const float*)(ws + WS_SGATE), args.in[25], ws + WS_YROWS};
        pg8::gemm_phase<EpiMoe2, MoeOrder, false, true>(lds, wave, DM / 2, DM / 2, DM / 2, S, E, 0x7A7A7A7A, 0x7F7F7F7F, STAG12);
        if (BOTH(12)) xcd_barrier(bar);
    }
    if (IN(13)) { phase_final(args, gw, NGW, lane); }
#undef IN
#undef BOTH
#undef lane
#undef tid
}

static int g_grid = 0;
static bool mega_setup(size_t ws_size) {
    if (g_grid == 0) {
        int dev = 0, cus = 0, per_cu = 0;
        if (ws_size < WS_NEED) { g_grid = -1; return false; }
        if (hipGetDevice(&dev) != hipSuccess || hipDeviceGetAttribute(&cus, hipDeviceAttributeMultiprocessorCount, dev) != hipSuccess) { g_grid = -1; return false; }
        if (hipFuncSetAttribute((const void*)mega_fwd, hipFuncAttributeMaxDynamicSharedMemorySize, LDS_BYTES) != hipSuccess) { g_grid = -1; return false; }
        (void)hipOccupancyMaxActiveBlocksPerMultiprocessor(&per_cu, (const void*)mega_fwd, NWAVES * 64, LDS_BYTES);
        (void)hipGetLastError();
        if (cus < 256) { g_grid = -1; return false; }
        g_grid = 256;
    }
    return g_grid > 0;
}
static void mega_launch(const MegaArgs& base, int lo, int hi, int li, hipStream_t stream, int variant = 0) {
    MegaArgs a = base; a.ph_lo = lo; a.ph_hi = hi; a.li = li; a.pad = variant;
    hipLaunchKernelGGL(mega_fwd, dim3(g_grid), dim3(NWAVES * 64), LDS_BYTES, stream, a);
}

extern "C" void kernel_launch(void* const* d_in, const int* in_sizes, int n_in, void* d_out, int out_size, void* d_ws,
                              size_t ws_size, hipStream_t stream) {
    if (n_in != 27 || out_size != NTOK * DM) return;
    if (!mega_setup(ws_size)) return;
    unsigned char* ws = (unsigned char*)d_ws;
    (void)hipMemsetAsync(ws + WS_CTL, 0, CTL_ZERO_BYTES, stream);
    MegaArgs a{};
    for (int i = 0; i < 27; ++i) a.in[i] = (const float*)d_in[i];
    a.out = (float*)d_out; a.ws = ws;

#ifndef PROBE_K
    mega_launch(a, 0, 14, 0, stream);
#else
    mega_launch(a, 0, PROBE_K + 1, 0, stream);
#ifndef PROBE_V
#define PROBE_V 0
#endif
    mega_launch(a, PROBE_K, PROBE_K + 1, 1, stream, PROBE_V);
    if (PROBE_K + 1 < 14) mega_launch(a, PROBE_K + 1, 14, 2, stream);
#endif
}
```
